# Optimizing an MI355X kernel written in HIP

```python
import math
import jax, jax.numpy as jnp
from jax import lax
import numpy as np

D_MODEL = 2048
BATCH = 2
SEQ = 8192
DEPTH = 2

CONV_DIM = 1024
CONV_WIDTH = 31
N_HEADS = 16
N_KV_HEADS = 4
HEAD_DIM = 64
WINDOW = 128
BLOCK = 128
ATTN_DIM = N_HEADS * HEAD_DIM
KV_DIM = N_KV_HEADS * HEAD_DIM
N_BRANCHES = 2
IN_DIM = 2 * CONV_DIM + ATTN_DIM + 2 * KV_DIM + N_BRANCHES * D_MODEL
NUM_BUCKETS = 32
MAX_DISTANCE = 128
N_KEYS = 128
N_EXPERTS = N_KEYS * N_KEYS
PEER_HEADS = 8
PEER_TOPK = 16
PEER_QDIM = 256
PEER_HALF = PEER_QDIM // 2
PEER_CHUNK = 128
EPS = 1e-6

kernel_name = 'hybrid_conv_swa_peer_block'


def rms_norm(x, g):
    xf = x.astype(jnp.float32)
    y = xf * lax.rsqrt(jnp.mean(xf * xf, axis=-1, keepdims=True) + EPS)
    return (y * g.astype(jnp.float32)).astype(x.dtype)


def t5_bucket_causal(dist):
    max_exact = NUM_BUCKETS // 2
    d = jnp.maximum(dist, 0)
    large = max_exact + (jnp.log(jnp.maximum(d, 1).astype(jnp.float32) / max_exact)
                         / math.log(MAX_DISTANCE / max_exact)
                         * (NUM_BUCKETS - max_exact)).astype(jnp.int32)
    large = jnp.minimum(large, NUM_BUCKETS - 1)
    return jnp.where(d < max_exact, d, large)


def conformer_conv(a, b, dw_w, dw_b, ln_g, ln_b, w_out):
    u = a * jax.nn.sigmoid(b)
    u = jnp.pad(u, ((0, 0), (CONV_WIDTH - 1, 0), (0, 0)))
    u = lax.conv_general_dilated(u, dw_w[:, None, :], window_strides=(1,), padding='VALID',
                                 dimension_numbers=('NWC', 'WIO', 'NWC'),
                                 feature_group_count=CONV_DIM) + dw_b
    uf = u.astype(jnp.float32)
    mu = jnp.mean(uf, axis=-1, keepdims=True)
    var = jnp.mean(jnp.square(uf - mu), axis=-1, keepdims=True)
    uf = (uf - mu) * lax.rsqrt(var + EPS) * ln_g.astype(jnp.float32) + ln_b.astype(jnp.float32)
    u = jax.nn.silu(uf).astype(a.dtype)
    return u @ w_out


def sliding_window_attention(q, k, v, sinks, rel_bias):
    B, S = q.shape[0], q.shape[1]
    nb = S // BLOCK
    G = N_HEADS // N_KV_HEADS
    qb = q.reshape(B, nb, BLOCK, N_KV_HEADS, G, HEAD_DIM)
    kb = k.reshape(B, nb, BLOCK, N_KV_HEADS, HEAD_DIM)
    vb = v.reshape(B, nb, BLOCK, N_KV_HEADS, HEAD_DIM)
    prev = lambda t: jnp.concatenate([jnp.zeros_like(t[:, :1]), t[:, :-1]], axis=1)
    kk = jnp.concatenate([prev(kb), kb], axis=2)
    vv = jnp.concatenate([prev(vb), vb], axis=2)
    scores = jnp.einsum('bnqkgd,bnskd->bnkgqs', qb, kk).astype(jnp.float32) * (HEAD_DIM ** -0.5)
    qi = jnp.arange(BLOCK)[:, None] + BLOCK
    kj = jnp.arange(2 * BLOCK)[None, :]
    dist = qi - kj
    bias = rel_bias.astype(jnp.float32)[t5_bucket_causal(dist)]
    bias = bias.transpose(2, 0, 1).reshape(N_KV_HEADS, G, BLOCK, 2 * BLOCK)
    band = (dist >= 0) & (dist < WINDOW)
    kpos = jnp.arange(nb)[:, None] * BLOCK - BLOCK + kj
    valid = band[None] & (kpos >= 0)[:, None, :]
    scores = jnp.where(valid[None, :, None, None], scores + bias, -jnp.inf)
    sink = jnp.broadcast_to(sinks.astype(jnp.float32).reshape(N_KV_HEADS, G, 1, 1),
                            scores.shape[:-1] + (1,))
    probs = jax.nn.softmax(jnp.concatenate([scores, sink], axis=-1), axis=-1)[..., :-1]
    out = jnp.einsum('bnkgqs,bnskd->bnqkgd', probs.astype(v.dtype), vv)
    return out.reshape(B, S, ATTN_DIM)


def peer(h, w_pq, sub_keys, u_tab, v_tab):
    B, S, D = h.shape
    q = (h @ w_pq).reshape(B, S, PEER_HEADS, 2, PEER_HALF)
    s = jnp.einsum('bshpd,hpnd->bshpn', q, sub_keys).astype(jnp.float32)
    s_top, i_top = lax.top_k(s, PEER_TOPK)
    cand = s_top[..., 0, :, None] + s_top[..., 1, None, :]
    cand_idx = i_top[..., 0, :, None] * N_KEYS + i_top[..., 1, None, :]
    cand = cand.reshape(B, S, PEER_HEADS, PEER_TOPK * PEER_TOPK)
    cand_idx = cand_idx.reshape(B, S, PEER_HEADS, PEER_TOPK * PEER_TOPK)
    best, pos = lax.top_k(cand, PEER_TOPK)
    idx = jnp.take_along_axis(cand_idx, pos, axis=-1)
    gates = jax.nn.softmax(best, axis=-1)
    T = B * S
    n_chunks = T // PEER_CHUNK
    hc = h.reshape(n_chunks, PEER_CHUNK, D)
    ic = idx.reshape(n_chunks, PEER_CHUNK, PEER_HEADS * PEER_TOPK)
    gc = gates.reshape(n_chunks, PEER_CHUNK, PEER_HEADS * PEER_TOPK).astype(h.dtype)

    def chunk(args):
        xt, it, gt = args
        act = jnp.einsum('td,tkd->tk', xt, u_tab[it])
        w = gt * jax.nn.gelu(act, approximate=False)
        return jnp.einsum('tk,tkd->td', w, v_tab[it])

    out = lax.map(chunk, (hc, ic, gc))
    return out.reshape(B, S, D)


def setup_inputs(seed: int = 0) -> dict:
    key = jax.random.key(seed)
    ks = jax.random.split(key, 24)
    nrm = lambda k, shape, scale: jax.random.normal(k, shape, jnp.float32) * scale
    L, D = DEPTH, D_MODEL
    return {
        'x': nrm(ks[0], (BATCH, SEQ, D), 1.0),
        'c': nrm(ks[1], (BATCH, D), 1.0),
        'rel_bias': nrm(ks[2], (NUM_BUCKETS, N_HEADS), 0.2),
        'ada_w': nrm(ks[3], (L, D, 6 * D), 0.5 * D ** -0.5),
        'ada_b': nrm(ks[4], (L, 6 * D), 0.01),
        'norm1_g': 1.0 + nrm(ks[5], (L, D), 0.02),
        'w_in': nrm(ks[6], (L, D, IN_DIM), D ** -0.5),
        'dw_w': nrm(ks[7], (L, CONV_WIDTH, CONV_DIM), CONV_WIDTH ** -0.5),
        'dw_b': nrm(ks[8], (L, CONV_DIM), 0.01),
        'conv_ln_g': 1.0 + nrm(ks[9], (L, CONV_DIM), 0.02),
        'conv_ln_b': nrm(ks[10], (L, CONV_DIM), 0.01),
        'w_conv_out': nrm(ks[11], (L, CONV_DIM, D), CONV_DIM ** -0.5),
        'attn_sinks': nrm(ks[12], (L, N_HEADS), 0.5),
        'w_attn_out': nrm(ks[13], (L, ATTN_DIM, D), ATTN_DIM ** -0.5),
        'w_out': nrm(ks[14], (L, D, D), D ** -0.5),
        'norm2_g': 1.0 + nrm(ks[15], (L, D), 0.02),
        'w_pq': nrm(ks[16], (L, D, PEER_HEADS * PEER_QDIM), D ** -0.5),
        'sub_keys': nrm(ks[17], (L, PEER_HEADS, 2, N_KEYS, PEER_HALF), PEER_HALF ** -0.5),
        'peer_u': nrm(ks[18], (L, N_EXPERTS, D), D ** -0.5),
        'peer_v': nrm(ks[19], (L, N_EXPERTS, D), PEER_HEADS ** -0.5),
        'final_g': 1.0 + nrm(ks[20], (D,), 0.02),
    }


def reference(x, c, rel_bias, ada_w, ada_b, norm1_g, w_in, dw_w, dw_b, conv_ln_g, conv_ln_b,
              w_conv_out, attn_sinks, w_attn_out, w_out, norm2_g, w_pq, sub_keys, peer_u, peer_v,
              final_g):
    split_pts = [CONV_DIM, 2 * CONV_DIM, 2 * CONV_DIM + ATTN_DIM,
                 2 * CONV_DIM + ATTN_DIM + KV_DIM, 2 * CONV_DIM + ATTN_DIM + 2 * KV_DIM]
    cs = jax.nn.silu(c)
    for l in range(DEPTH):
        mod = cs @ ada_w[l] + ada_b[l]
        sh1, sc1, g1, sh2, sc2, g2 = jnp.split(mod, 6, axis=-1)
        h = rms_norm(x, norm1_g[l]) * (1.0 + sc1[:, None]) + sh1[:, None]
        proj = h @ w_in[l]
        a, b, q, k, v, gate_logits = jnp.split(proj, split_pts, axis=-1)
        y_conv = conformer_conv(a, b, dw_w[l], dw_b[l], conv_ln_g[l], conv_ln_b[l], w_conv_out[l])
        y_attn = sliding_window_attention(q, k, v, attn_sinks[l], rel_bias) @ w_attn_out[l]
        gates = jax.nn.sigmoid(gate_logits.astype(jnp.float32)).astype(x.dtype)
        gate_conv, gate_attn = jnp.split(gates, N_BRANCHES, axis=-1)
        mixed = (gate_conv * y_conv + gate_attn * y_attn) @ w_out[l]
        x = x + g1[:, None] * mixed
        h2 = rms_norm(x, norm2_g[l]) * (1.0 + sc2[:, None]) + sh2[:, None]
        x = x + g2[:, None] * peer(h2, w_pq[l], sub_keys[l], peer_u[l], peer_v[l])
    return rms_norm(x, final_g)
```

```cpp
#include <hip/hip_runtime.h>
#include <cstdio>
#include <cstdint>
namespace pg8 {
#define PG8_LAS __attribute__((address_space(3)))
typedef unsigned short bf16_t;
typedef short bf16x8 __attribute__((ext_vector_type(8)));
typedef float f32x4 __attribute__((ext_vector_type(4)));
typedef unsigned u32x4 __attribute__((ext_vector_type(4)));
typedef int i32x4 __attribute__((ext_vector_type(4)));
typedef int i32x8 __attribute__((ext_vector_type(8)));
__device__ __forceinline__ i32x8 cat8(const bf16x8& a, const bf16x8& b) { const i32x4 x = __builtin_bit_cast(i32x4, a), y = __builtin_bit_cast(i32x4, b); return (i32x8){x[0], x[1], x[2], x[3], y[0], y[1], y[2], y[3]}; }
constexpr int BM = 256, BK = 64, HALF = 128, HTB = HALF * BK * 2  , STAGE_BYTES = 8 * HTB, NXCD = 8, WGM = 4;

__host__ __device__ __forceinline__ int lds_byte(int r, int c) { const int st = (r >> 4) * 2 + (c >> 5), rr = r & 15, cc = c & 31, ob = rr * 64 + cc * 2; return st * 1024 + (ob ^ (((ob >> 9) & 1) << 5)); }
__host__ __device__ __forceinline__ void stage_rc(int b, int& R, int& C) { const int st = b / 1024, sb = b % 1024, swz = sb ^ (((sb >> 9) & 1) << 5); R = (st >> 1) * 16 + swz / 64; C = (st & 1) * 32 + (swz % 64) / 2; }
__host__ __device__ __forceinline__ int perm32(int rho) { const int n = rho >> 4, i = rho & 15; return 8 * (i >> 2) + 4 * n + (i & 3); }

struct Unit { int pm, pn; };
struct Gemm { const bf16_t* A; const bf16_t* Bt; int M, N, K, lda, ldb; };

struct StaticOrder {
    int nM, nN, nwg, G, c, wgm;
    __host__ __device__ void init(int M, int N, int G_, int c_, int wgm_ = WGM) { nM = M / BM; nN = N / BM; nwg = nM * nN; G = G_; c = c_; wgm = wgm_; }
    __host__ __device__ bool next(int i, Unit& u) const {
        const long L = (long)i * G + c; if (L >= nwg) return false;
        int wgid = (int)L; { const int q = nwg / NXCD, r = nwg % NXCD, xcd = wgid % NXCD, off = wgid / NXCD; wgid = (xcd < r ? xcd * (q + 1) : r * (q + 1) + (xcd - r) * q) + off; }
        const int nig = wgm * nN, gid = wgid / nig, fm = gid * wgm, gsz = (nM - fm) < wgm ? (nM - fm) : wgm;
        u.pm = fm + ((wgid % nig) % gsz); u.pn = (wgid % nig) / gsz; return true;
    }
    __device__ __forceinline__ void a_ready(const Unit&) const {}
    __device__ __forceinline__ void done(const Unit&) const {}
};

__device__ __forceinline__ unsigned cvt_pk_bf16(float lo, float hi) { unsigned r; asm volatile("v_cvt_pk_bf16_f32 %0, %1, %2" : "=v"(r) : "v"(lo), "v"(hi)); return r; }
typedef float f32x2 __attribute__((ext_vector_type(2)));
template <class Epi, class Sched, bool ALIGN_EPI = false, bool SP2 = false, bool FP8 = false>
__device__ __forceinline__ void gemm_phase(PG8_LAS unsigned char* lds, const Gemm g, const Sched& S, const Epi& E) {
    int tid_ = threadIdx.x; asm volatile("" : "+v"(tid_));
    const int tid = tid_, wid = __builtin_amdgcn_readfirstlane(tid >> 6), lane = tid & 63, wr = wid >> 2, wc = wid & 3, fr = lane & 15, fq = lane >> 4;
    const int K = g.K, nt = K / BK;
    unsigned voffA[2], voffB[2];
#pragma unroll
    for (int i = 0; i < 2; ++i) { int R, C; stage_rc(tid * 16 + i * 8192, R, C); const int Rb = Epi::PERM ? ((R & ~31) + perm32(R & 31)) : R;
        voffA[i] = (unsigned)(R * g.lda + C) * 2u; voffB[i] = (unsigned)(Rb * g.ldb + C) * 2u; }
    const size_t kstep = (size_t)(BK * 2);
    const size_t hstepA = (size_t)HALF * g.lda * 2, hstepB = (size_t)HALF * g.ldb * 2;
    const size_t tstepA = 2 * hstepA, tstepB = 2 * hstepB;
    const unsigned ldsw = (unsigned)wid * 1024u;
    const int aoff = lds_byte(wr * 64 + fr, fq * 8), boff = lds_byte(wc * 32 + fr, fq * 8);
#define PG8_SA(b, h) (((b) * 2 + (h)) * HTB)
#define PG8_SB(b, h) ((4 + (b) * 2 + (h)) * HTB)
#define PG8_STAGE(bufoff, gbase, voff) do { _Pragma("unroll") for (int _i = 0; _i < 2; ++_i) \
        __builtin_amdgcn_global_load_lds((const unsigned*)((const char*)(gbase) + (voff)[_i]), (PG8_LAS unsigned*)(lds + (bufoff) + ldsw + _i * 8192), 16, 0, 0); } while (0)
#define PG8_LDA(dst, b, h) do { _Pragma("unroll") for (int m = 0; m < 4; ++m) _Pragma("unroll") for (int k = 0; k < 2; ++k) dst[m][k] = *(const PG8_LAS bf16x8*)(lds + PG8_SA(b, h) + aoff + m * 2048 + k * 1024); } while (0)
#define PG8_LDB(dst, b, h) do { _Pragma("unroll") for (int n = 0; n < 2; ++n) _Pragma("unroll") for (int k = 0; k < 2; ++k) dst[n][k] = *(const PG8_LAS bf16x8*)(lds + PG8_SB(b, h) + boff + n * 2048 + k * 1024); } while (0)
#define PG8_MMA(ai, bj, At, Bt) do { __builtin_amdgcn_s_setprio(1); _Pragma("unroll") for (int m = 0; m < 4; ++m) _Pragma("unroll") for (int n = 0; n < 2; ++n) { \
        if constexpr (FP8) { asm volatile("v_mfma_f32_16x16x128_f8f6f4 %0, %1, %2, %0" : "+v"(acc[ai][bj][m][n]) : "v"(cat8(Bt[n][0], Bt[n][1])), "v"(cat8(At[m][0], At[m][1]))); } \
        else { _Pragma("unroll") for (int k = 0; k < 2; ++k) acc[ai][bj][m][n] = __builtin_amdgcn_mfma_f32_16x16x32_bf16(Bt[n][k], At[m][k], acc[ai][bj][m][n], 0, 0, 0); } } __builtin_amdgcn_s_setprio(0); } while (0)
#define PG8_WAIT_V(n) asm volatile("s_waitcnt vmcnt(" #n ")" ::: "memory")
#define PG8_WAIT_L(n) asm volatile("s_waitcnt lgkmcnt(" #n ")" ::: "memory")
#define PG8_BAR __builtin_amdgcn_s_barrier()
#define PG8_SCHED __builtin_amdgcn_sched_barrier(0)
    Unit cur, nxt; int ui = 0;
    if (!S.next(0, cur)) return;
    f32x4 acc[2][2][4][2];
#pragma unroll
    for (int a = 0; a < 2; ++a)
#pragma unroll
        for (int b = 0; b < 2; ++b)
#pragma unroll
            for (int m = 0; m < 4; ++m)
#pragma unroll
                for (int n = 0; n < 2; ++n) acc[a][b][m][n] = (f32x4){0.f, 0.f, 0.f, 0.f};
    bf16x8 At[4][2], B0[2][2], B1[2][2];
    const char* cA = (const char*)g.A + (size_t)cur.pm * tstepA; const char* cB = (const char*)g.Bt + (size_t)cur.pn * tstepB;
    S.a_ready(cur);
    if constexpr (SP2) {
        PG8_STAGE(PG8_SB(0, 0), cB, voffB); PG8_STAGE(PG8_SB(0, 1), cB + hstepB, voffB); PG8_STAGE(PG8_SA(0, 0), cA, voffA); PG8_STAGE(PG8_SA(0, 1), cA + hstepA, voffA);
        if (wr == 1) PG8_BAR;
        PG8_WAIT_V(2); PG8_BAR;
        PG8_STAGE(PG8_SB(1, 0), cB + kstep, voffB); PG8_STAGE(PG8_SA(1, 0), cA + kstep, voffA); PG8_STAGE(PG8_SB(1, 1), cB + hstepB + kstep, voffB);
        PG8_WAIT_V(6); PG8_BAR;
    } else {
        PG8_STAGE(PG8_SB(0, 0), cB, voffB); PG8_STAGE(PG8_SA(0, 0), cA, voffA); PG8_STAGE(PG8_SB(0, 1), cB + hstepB, voffB); PG8_STAGE(PG8_SA(0, 1), cA + hstepA, voffA);
        if (wr == 1) PG8_BAR;
        PG8_WAIT_V(4); PG8_BAR;
        PG8_STAGE(PG8_SB(1, 0), cB + kstep, voffB); PG8_STAGE(PG8_SA(1, 0), cA + kstep, voffA); PG8_STAGE(PG8_SB(1, 1), cB + hstepB + kstep, voffB);
        PG8_WAIT_V(6); PG8_BAR;
    }
    for (;;) {
        const bool has_next = S.next(ui + 1, nxt);
        const char* nA = has_next ? (const char*)g.A + (size_t)nxt.pm * tstepA : cA; const char* nB = has_next ? (const char*)g.Bt + (size_t)nxt.pn * tstepB : cB;
        for (int t = 0; t < nt; t += 2) {
            if constexpr (Epi::HAS_MID) { if (t == (nt >> 1)) { if constexpr (FP8) { asm volatile("s_nop 15\n\ts_nop 15" ::: "memory"); }
                E.mid(acc, cur, wr, wc, fr, fq); } }
            const bool last = (t == nt - 2);
            const char* a1 = cA + (size_t)(t + 1) * kstep;
            const char* a2 = last ? nA : cA + (size_t)(t + 2) * kstep; const char* b2 = last ? nB : cB + (size_t)(t + 2) * kstep;
            const char* a3 = a2 + kstep; const char* b3 = b2 + kstep;
            if (last && has_next) S.a_ready(nxt);
            if constexpr (SP2) {
            PG8_LDB(B0, 0, 0); PG8_LDB(B1, 0, 1); PG8_SCHED; PG8_LDA(At, 0, 0); PG8_STAGE(PG8_SA(1, 1), a1 + hstepA, voffA);
            PG8_WAIT_V(8); PG8_WAIT_L(0); PG8_BAR; PG8_MMA(0, 0, At, B0); PG8_MMA(0, 1, At, B1); PG8_BAR; PG8_SCHED;
            PG8_LDA(At, 0, 1); PG8_STAGE(PG8_SB(0, 0), b2, voffB); PG8_STAGE(PG8_SB(0, 1), b2 + hstepB, voffB); PG8_STAGE(PG8_SA(0, 0), a2, voffA);
            PG8_WAIT_V(8); PG8_WAIT_L(0); PG8_BAR; PG8_MMA(1, 0, At, B0); PG8_MMA(1, 1, At, B1); PG8_BAR; PG8_SCHED;
            PG8_LDB(B0, 1, 0); PG8_LDB(B1, 1, 1); PG8_SCHED; PG8_LDA(At, 1, 0); PG8_STAGE(PG8_SA(0, 1), a2 + hstepA, voffA);
            PG8_WAIT_V(8); PG8_WAIT_L(0); PG8_BAR; PG8_MMA(0, 0, At, B0); PG8_MMA(0, 1, At, B1); PG8_BAR; PG8_SCHED;
            PG8_LDA(At, 1, 1); PG8_STAGE(PG8_SB(1, 0), b3, voffB); PG8_STAGE(PG8_SB(1, 1), b3 + hstepB, voffB); PG8_STAGE(PG8_SA(1, 0), a3, voffA);
            PG8_WAIT_V(8); PG8_WAIT_L(0); PG8_BAR; PG8_MMA(1, 0, At, B0); PG8_MMA(1, 1, At, B1); PG8_BAR; PG8_SCHED;
            } else {
            PG8_LDB(B0, 0, 0); PG8_SCHED; PG8_LDA(At, 0, 0); PG8_STAGE(PG8_SA(1, 1), a1 + hstepA, voffA);
            PG8_WAIT_L(8); PG8_BAR; PG8_WAIT_L(0); PG8_MMA(0, 0, At, B0); PG8_BAR; PG8_SCHED;
            PG8_LDB(B1, 0, 1); PG8_STAGE(PG8_SB(0, 0), b2, voffB);
            PG8_BAR; PG8_WAIT_L(0); PG8_MMA(0, 1, At, B1); PG8_BAR;
            PG8_LDA(At, 0, 1); PG8_STAGE(PG8_SA(0, 0), a2, voffA);
            PG8_BAR; PG8_WAIT_L(0); PG8_MMA(1, 0, At, B0); PG8_BAR; PG8_SCHED;
            PG8_STAGE(PG8_SB(0, 1), b2 + hstepB, voffB);
            PG8_WAIT_V(6); PG8_BAR; PG8_MMA(1, 1, At, B1); PG8_BAR;
            PG8_LDB(B0, 1, 0); PG8_SCHED; PG8_LDA(At, 1, 0); PG8_STAGE(PG8_SA(0, 1), a2 + hstepA, voffA);
            PG8_WAIT_L(8); PG8_BAR; PG8_WAIT_L(0); PG8_MMA(0, 0, At, B0); PG8_BAR; PG8_SCHED;
            PG8_LDB(B1, 1, 1); PG8_STAGE(PG8_SB(1, 0), b3, voffB);
            PG8_BAR; PG8_WAIT_L(0); PG8_MMA(0, 1, At, B1); PG8_BAR;
            PG8_LDA(At, 1, 1); PG8_STAGE(PG8_SA(1, 0), a3, voffA);
            PG8_BAR; PG8_WAIT_L(0); PG8_MMA(1, 0, At, B0); PG8_BAR; PG8_SCHED;
            PG8_STAGE(PG8_SB(1, 1), b3 + hstepB, voffB);
            PG8_WAIT_V(6); PG8_BAR; PG8_MMA(1, 1, At, B1); PG8_BAR;
            }
        }
        if constexpr (FP8) { asm volatile("s_nop 15\n\ts_nop 15" ::: "memory"); }
        if constexpr (ALIGN_EPI) { if (wr == 0) PG8_BAR; }
        if constexpr (!Epi::AFTER_DRAIN) { E(acc, cur, wr, wc, fr, fq); S.done(cur); }
        if (!has_next) break;
#pragma unroll
        for (int a = 0; a < 2; ++a)
#pragma unroll
            for (int b = 0; b < 2; ++b)
#pragma unroll
                for (int m = 0; m < 4; ++m)
#pragma unroll
                    for (int n = 0; n < 2; ++n) acc[a][b][m][n] = (f32x4){0.f, 0.f, 0.f, 0.f};
        cur = nxt; cA = nA; cB = nB; ++ui;
        if constexpr (ALIGN_EPI) { if (wr == 1) PG8_BAR; }
    }
    PG8_WAIT_V(0);
    if constexpr (!ALIGN_EPI) { if (wr == 0) PG8_BAR; }
    PG8_BAR;
    if constexpr (Epi::AFTER_DRAIN) { E.fused(acc, cur, wr, wc, fr, fq, lds, wid, lane); S.done(cur); }
#undef PG8_SA
#undef PG8_SB
#undef PG8_STAGE
#undef PG8_LDA
#undef PG8_LDB
#undef PG8_MMA
#undef PG8_WAIT_V
#undef PG8_WAIT_L
#undef PG8_BAR
#undef PG8_SCHED
}
}

constexpr int T = 16384, D = 2048, SEQ = 8192, CONV = 1024, CWID = 31, NHEAD = 16, NKVH = 4, HD = 64, ATT = 1024, KVD = 256, IN_DIM = 7680, NEXP = 16384, PHEADS = 8, TOPK = 16;
constexpr float EPS = 1e-6f;
constexpr int NSL = 16, SLW = 128;
constexpr int NWAVES = 8, NTHR = NWAVES * 64;
enum { I_X = 0, I_C, I_RELB, I_ADAW, I_ADAB, I_N1G, I_WIN, I_DWW, I_DWB, I_CLNG, I_CLNB, I_WCO, I_SINK, I_WAO, I_WOUT, I_N2G, I_WPQ, I_SK, I_PU, I_PV, I_FG, N_IN };

constexpr size_t MiB = 1u << 20;
constexpr size_t WS_CTL = 0, CTL_ZERO_BYTES = 1 * MiB;
constexpr size_t WS_MOD = 1 * MiB;
constexpr size_t WS_BIAS = 1 * MiB + 512 * 1024;
constexpr size_t WS_SCL = 1 * MiB + 640 * 1024;
constexpr size_t WS_WIN = 2 * MiB;
constexpr size_t WS_SA = 1 * MiB + 896 * 1024;
constexpr size_t WS_WM = 62 * MiB;
constexpr size_t WS_WO = 78 * MiB;
constexpr size_t WS_WP = 94 * MiB;
constexpr size_t WS_PU = 110 * MiB;
constexpr size_t WS_PV = 238 * MiB;
constexpr size_t WS_H = 366 * MiB;
constexpr size_t WS_U = 430 * MiB;
constexpr size_t WS_Q = 462 * MiB;
constexpr size_t WS_K = 494 * MiB;
constexpr size_t WS_V = 502 * MiB;
constexpr size_t WS_GC = 510 * MiB;
constexpr size_t WS_GA = 574 * MiB;
constexpr size_t WS_AM = 638 * MiB;
constexpr size_t WS_Y1 = 702 * MiB;
constexpr size_t WS_XA = 766 * MiB;
constexpr size_t WS_END = 894 * MiB;
constexpr int CW_TMO = 0, CW_QUEUE = 64, CW_QUEUE2 = 128, CW_WMAX = 192, CW_WMAX2 = 194, CW_WMAX3 = 198, CW_VMAX = 200, CW_BC = 204, CW_BC2 = 206, CW_BAR = 4096;

constexpr int RING_BYTES = 131072, LDSCTL_OFF = RING_BYTES, MISC_OFF = LDSCTL_OFF + 320, LDS_BYTES = 147456;

#define GAS __attribute__((address_space(1)))
#define LAS __attribute__((address_space(3)))
typedef unsigned short bf16;
typedef unsigned v4u __attribute__((ext_vector_type(4)));
typedef unsigned v2u __attribute__((ext_vector_type(2)));
typedef float f32x4 __attribute__((ext_vector_type(4)));
typedef float f32x2 __attribute__((ext_vector_type(2)));
typedef float f32x16 __attribute__((ext_vector_type(16)));
typedef short bf16x8 __attribute__((ext_vector_type(8)));
typedef __bf16 bf16x2v __attribute__((ext_vector_type(2)));
typedef GAS unsigned gu32;
#define LDS_WAIT() asm volatile("s_waitcnt lgkmcnt(0)" ::: "memory")
#define VM_WAIT() asm volatile("s_waitcnt vmcnt(0)" ::: "memory")
__device__ __forceinline__ unsigned f2bf(float f) { unsigned u = __builtin_bit_cast(unsigned, f); return (u + 0x7fffu + ((u >> 16) & 1u)) >> 16; }
__device__ __forceinline__ unsigned pk2(float lo, float hi) { f32x2 v = {lo, hi}; bf16x2v b = __builtin_convertvector(v, bf16x2v); return __builtin_bit_cast(unsigned, b); }
__device__ __forceinline__ float bflo(unsigned p) { return __uint_as_float(p << 16); }
__device__ __forceinline__ float bfhi(unsigned p) { return __uint_as_float(p & 0xffff0000u); }
__device__ __forceinline__ float sigmoidf_(float x) { return __builtin_amdgcn_rcpf(1.0f + __expf(-x)); }
__device__ __forceinline__ float dot2bf(unsigned a, unsigned b, float c) { return __builtin_amdgcn_fdot2_f32_bf16(__builtin_bit_cast(bf16x2v, a), __builtin_bit_cast(bf16x2v, b), c, false); }
__device__ __forceinline__ float wave_sum(float v) {
#pragma unroll
    for (int o = 1; o < 64; o <<= 1) v += __shfl_xor(v, o);
    return v;
}

template <int CTRL> __device__ __forceinline__ float dpp_mov(float v) { return __builtin_bit_cast(float, __builtin_amdgcn_update_dpp(0, __builtin_bit_cast(int, v), CTRL, 0xf, 0xf, true)); }
__device__ __forceinline__ float lane_xor1(float v) { return dpp_mov<0xB1>(v); }
__device__ __forceinline__ float lane_xor2(float v) { return dpp_mov<0x4E>(v); }
__device__ __forceinline__ float lane_xor4(float v) { return dpp_mov<0x141>(dpp_mov<0x1B>(v)); }
__device__ __forceinline__ float lane_xor8(float v) { return dpp_mov<0x128>(v); }
__device__ __forceinline__ float lane_xor16(float v) { return __builtin_bit_cast(float, __builtin_amdgcn_ds_swizzle(__builtin_bit_cast(int, v), 0x401F)); }

namespace pg8 {
__device__ __forceinline__ float sigm(float x) { return __builtin_amdgcn_rcpf(1.0f + __expf(-x)); }
__device__ __forceinline__ u32x4 pack8(const f32x4& v0, const f32x4& v1) { u32x4 w; w.x = cvt_pk_bf16(v0[0], v0[1]); w.y = cvt_pk_bf16(v0[2], v0[3]); w.z = cvt_pk_bf16(v1[0], v1[1]); w.w = cvt_pk_bf16(v1[2], v1[3]); return w; }
__device__ __forceinline__ float blo(unsigned p) { return __uint_as_float(p << 16); }
__device__ __forceinline__ float bhi(unsigned p) { return __uint_as_float(p & 0xffff0000u); }
struct EpiInProj {
    static constexpr bool PERM = true, AFTER_DRAIN = false, HAS_MID = false;
    bf16_t *U, *Q, *K, *V, *GC, *GA; const float* sa; float sw; unsigned* vmax;
    __device__ __forceinline__ void operator()(const f32x4 (&acc)[2][2][4][2], const Unit& u, int wr, int wc, int fr, int fq) const {
        const int row0 = u.pm * BM + wr * 64 + fr, cw = wc * 32 + 8 * fq, pn = u.pn;
        float rsv[2][4];
        { const float* sp = sa + row0;
          asm volatile("global_load_dword %0, %8, off\n\tglobal_load_dword %1, %8, off offset:64\n\tglobal_load_dword %2, %8, off offset:128\n\tglobal_load_dword %3, %8, off offset:192\n\t"
                       "global_load_dword %4, %8, off offset:512\n\tglobal_load_dword %5, %8, off offset:576\n\tglobal_load_dword %6, %8, off offset:640\n\tglobal_load_dword %7, %8, off offset:704\n\ts_waitcnt vmcnt(0)"
                       : "=&v"(rsv[0][0]), "=&v"(rsv[0][1]), "=&v"(rsv[0][2]), "=&v"(rsv[0][3]), "=&v"(rsv[1][0]), "=&v"(rsv[1][1]), "=&v"(rsv[1][2]), "=&v"(rsv[1][3]) : "v"(sp) : "memory"); }
        if (pn < 8) {
#pragma unroll
            for (int ai = 0; ai < 2; ++ai)
#pragma unroll
                for (int m = 0; m < 4; ++m) { bf16_t* p = U + (size_t)(row0 + ai * HALF + m * 16) * 1024 + pn * 128 + cw; const float rs = rsv[ai][m] * sw;
                    f32x4 a0 = acc[ai][0][m][0] * rs, a1 = acc[ai][0][m][1] * rs; const f32x4 b0 = acc[ai][1][m][0] * rs, b1 = acc[ai][1][m][1] * rs;
#pragma unroll
                    for (int i = 0; i < 4; ++i) { a0[i] *= sigm(b0[i]); a1[i] *= sigm(b1[i]); }
                    *(u32x4*)p = pack8(a0, a1); }
        } else {
            bf16_t* base; int ld, cb, mode;
            if (pn < 12) { base = Q; ld = 1024; cb = (pn - 8) * 256; mode = 0; }
            else if (pn == 12) { base = K; ld = 256; cb = 0; mode = 1; }
            else if (pn == 13) { base = V; ld = 256; cb = 0; mode = 1; }
            else if (pn < 22) { base = GC; ld = 2048; cb = (pn - 14) * 256; mode = 2; }
            else { base = GA; ld = 2048; cb = (pn - 22) * 256; mode = 2; }
            float vm = 0.f;
#pragma unroll
            for (int ai = 0; ai < 2; ++ai)
#pragma unroll
                for (int m = 0; m < 4; ++m) { bf16_t* p = base + (size_t)(row0 + ai * HALF + m * 16) * ld + cb + cw; const float rs = rsv[ai][m] * sw;
#pragma unroll
                    for (int bj = 0; bj < 2; ++bj) { f32x4 v0 = acc[ai][bj][m][0] * rs, v1 = acc[ai][bj][m][1] * rs;
                        if (pn == 13) vm = fmaxf(vm, fmaxf(fmaxf(fmaxf(fabsf(v0[0]), fabsf(v0[1])), fmaxf(fabsf(v0[2]), fabsf(v0[3]))), fmaxf(fmaxf(fabsf(v1[0]), fabsf(v1[1])), fmaxf(fabsf(v1[2]), fabsf(v1[3])))));
                        if (mode == 0) { v0 = v0 * 0.125f; v1 = v1 * 0.125f; }
                        else if (mode == 2) {
#pragma unroll
                            for (int i = 0; i < 4; ++i) { v0[i] = sigm(v0[i]); v1[i] = sigm(v1[i]); } }
                        *(u32x4*)(p + bj * HALF) = pack8(v0, v1); } }
            if (pn == 13) {
#pragma unroll
                for (int o = 1; o < 64; o <<= 1) vm = fmaxf(vm, __shfl_xor(vm, o));
                if ((threadIdx.x & 63) == 0) __hip_atomic_fetch_max(vmax + (u.pm >> 5), __float_as_uint(vm), __ATOMIC_RELAXED, __HIP_MEMORY_SCOPE_AGENT); }
        }
    }
};
struct EpiMerge {
    static constexpr bool PERM = true, AFTER_DRAIN = false, HAS_MID = true;
    const bf16_t* GC; const bf16_t* GA; unsigned char* O; float fmid0, fmid1, fend0, fend1;
    __device__ __forceinline__ void mid(f32x4 (&acc)[2][2][4][2], const Unit& u, int wr, int wc, int fr, int fq) const {
        int row0 = u.pm * BM + wr * 64 + fr, c0 = u.pn * BM + wc * 32 + 8 * fq; const float fmd = (u.pm >> 5) ? fmid1 : fmid0;
        asm volatile("" : "+v"(row0), "+v"(c0));
#pragma unroll
        for (int ai = 0; ai < 2; ++ai)
#pragma unroll
            for (int mh = 0; mh < 2; ++mh) { u32x4 gc[2][2], ga[2][2];
#pragma unroll
                for (int mm = 0; mm < 2; ++mm)
#pragma unroll
                    for (int bj = 0; bj < 2; ++bj) { const size_t off = (size_t)(row0 + ai * HALF + (2 * mh + mm) * 16) * 2048 + c0 + bj * HALF; gc[mm][bj] = *(const u32x4*)(GC + off); ga[mm][bj] = *(const u32x4*)(GA + off); }
                __builtin_amdgcn_sched_barrier(0);
#pragma unroll
                for (int mm = 0; mm < 2; ++mm)
#pragma unroll
                    for (int bj = 0; bj < 2; ++bj) { const int m = 2 * mh + mm; const u32x4 c = gc[mm][bj], a = ga[mm][bj];
#define RT_(cw_, aw_, HI_) ((HI_ ? bhi(cw_) : blo(cw_)) * fmd * __builtin_amdgcn_rcpf(fmaxf(HI_ ? bhi(aw_) : blo(aw_), 1e-30f)))
                        acc[ai][bj][m][0][0] *= RT_(c.x, a.x, 0); acc[ai][bj][m][0][1] *= RT_(c.x, a.x, 1); acc[ai][bj][m][0][2] *= RT_(c.y, a.y, 0); acc[ai][bj][m][0][3] *= RT_(c.y, a.y, 1);
                        acc[ai][bj][m][1][0] *= RT_(c.z, a.z, 0); acc[ai][bj][m][1][1] *= RT_(c.z, a.z, 1); acc[ai][bj][m][1][2] *= RT_(c.w, a.w, 0); acc[ai][bj][m][1][3] *= RT_(c.w, a.w, 1);
#undef RT_
                    }
                __builtin_amdgcn_sched_barrier(0); }
    }
    __device__ __forceinline__ void operator()(const f32x4 (&acc)[2][2][4][2], const Unit& u, int wr, int wc, int fr, int fq) const {
        const int row0 = u.pm * BM + wr * 64 + fr, c0 = u.pn * BM + wc * 32 + 8 * fq; const float fe = (u.pm >> 5) ? fend1 : fend0;
#pragma unroll
        for (int ai = 0; ai < 2; ++ai) { u32x4 g[4][2];
#pragma unroll
            for (int m = 0; m < 4; ++m)
#pragma unroll
                for (int bj = 0; bj < 2; ++bj) g[m][bj] = *(const u32x4*)(GA + (size_t)(row0 + ai * HALF + m * 16) * 2048 + c0 + bj * HALF);
            __builtin_amdgcn_sched_barrier(0);
#pragma unroll
            for (int m = 0; m < 4; ++m)
#pragma unroll
                for (int bj = 0; bj < 2; ++bj) { const size_t off = (size_t)(row0 + ai * HALF + m * 16) * 2048 + c0 + bj * HALF; const u32x4 gg = g[m][bj]; f32x4 v0 = acc[ai][bj][m][0], v1 = acc[ai][bj][m][1];
                    v0[0] *= fmaxf(blo(gg.x), 1e-30f) * fe; v0[1] *= fmaxf(bhi(gg.x), 1e-30f) * fe; v0[2] *= fmaxf(blo(gg.y), 1e-30f) * fe; v0[3] *= fmaxf(bhi(gg.y), 1e-30f) * fe;
                    v1[0] *= fmaxf(blo(gg.z), 1e-30f) * fe; v1[1] *= fmaxf(bhi(gg.z), 1e-30f) * fe; v1[2] *= fmaxf(blo(gg.w), 1e-30f) * fe; v1[3] *= fmaxf(bhi(gg.w), 1e-30f) * fe;
                    int lo = __builtin_amdgcn_cvt_pk_fp8_f32(v0[0], v0[1], 0, false); lo = __builtin_amdgcn_cvt_pk_fp8_f32(v0[2], v0[3], lo, true);
                    int hi = __builtin_amdgcn_cvt_pk_fp8_f32(v1[0], v1[1], 0, false); hi = __builtin_amdgcn_cvt_pk_fp8_f32(v1[2], v1[3], hi, true);
                    typedef unsigned u32x2s __attribute__((ext_vector_type(2))); *(u32x2s*)(O + off) = (u32x2s){(unsigned)lo, (unsigned)hi}; }
            __builtin_amdgcn_sched_barrier(0); }
    }
};
template <bool XB_BF16>
struct EpiResid {
    static constexpr bool PERM = true, AFTER_DRAIN = false, HAS_MID = false;
    const void* XB; bf16_t* XO; const float* gvec; float fo0, fo1;
    __device__ __forceinline__ void operator()(const f32x4 (&acc)[2][2][4][2], const Unit& u, int wr, int wc, int fr, int fq) const {
        const int row0 = u.pm * BM + wr * 64 + fr, c0 = u.pn * BM + wc * 32 + 8 * fq; const float* gp = gvec + (size_t)(u.pm >> 5) * 12288;
        const float fo = (u.pm >> 5) ? fo1 : fo0;
#pragma unroll
        for (int bj = 0; bj < 2; ++bj) { const int col = c0 + bj * HALF; const f32x4 g0 = *(const f32x4*)(gp + col) * fo, g1 = *(const f32x4*)(gp + col + 4) * fo;
#pragma unroll
            for (int ai = 0; ai < 2; ++ai) { f32x4 xa[4], xb[4]; u32x4 xq[4];
#pragma unroll
                for (int m = 0; m < 4; ++m) { const size_t off = (size_t)(row0 + ai * HALF + m * 16) * 2048 + col;
                    if constexpr (XB_BF16) xq[m] = *(const u32x4*)((const bf16_t*)XB + off); else { xa[m] = *(const f32x4*)((const float*)XB + off); xb[m] = *(const f32x4*)((const float*)XB + off + 4); } }
                __builtin_amdgcn_sched_barrier(0);
#pragma unroll
                for (int m = 0; m < 4; ++m) { const size_t off = (size_t)(row0 + ai * HALF + m * 16) * 2048 + col;
                    if constexpr (XB_BF16) { xa[m] = (f32x4){blo(xq[m].x), bhi(xq[m].x), blo(xq[m].y), bhi(xq[m].y)}; xb[m] = (f32x4){blo(xq[m].z), bhi(xq[m].z), blo(xq[m].w), bhi(xq[m].w)}; }
                    *(u32x4*)(XO + off) = pack8(xa[m] + g0 * acc[ai][bj][m][0], xb[m] + g1 * acc[ai][bj][m][1]); }
                __builtin_amdgcn_sched_barrier(0); } }
    }
};
typedef _Float16 f16x8 __attribute__((ext_vector_type(8)));
struct EpiF16 {
    static constexpr bool PERM = true, AFTER_DRAIN = false, HAS_MID = false;
    _Float16* O; int ldc;
    __device__ __forceinline__ void operator()(const f32x4 (&acc)[2][2][4][2], const Unit& u, int wr, int wc, int fr, int fq) const {
        const int row0 = u.pm * BM + wr * 64 + fr, c0 = u.pn * BM + wc * 32 + 8 * fq;
#pragma unroll
        for (int ai = 0; ai < 2; ++ai)
#pragma unroll
            for (int m = 0; m < 4; ++m)
#pragma unroll
                for (int bj = 0; bj < 2; ++bj) { const f32x4 v0 = acc[ai][bj][m][0], v1 = acc[ai][bj][m][1];
                    const f16x8 h = {(_Float16)v0[0], (_Float16)v0[1], (_Float16)v0[2], (_Float16)v0[3], (_Float16)v1[0], (_Float16)v1[1], (_Float16)v1[2], (_Float16)v1[3]};
                    *(f16x8*)(O + (size_t)(row0 + ai * HALF + m * 16) * ldc + c0 + bj * HALF) = h; }
    }
};
}

#define XB_TMO      128
#define XB_XCNT(j)  (256  + 64 * (j))
#define XB_XSUB(j)  (1280 + 64 * (j))
#define XB_XGEN(j)  (2304 + 64 * (j))
#define XB_TOP      3328
#define XB_TOPGEN   3392
#define XCD_BAR_WORDS 3456
#define XB_SPIN_CAP (1u << 18)

__device__ __forceinline__ unsigned xb_ld(unsigned* p)              { return __hip_atomic_load(p, __ATOMIC_RELAXED, __HIP_MEMORY_SCOPE_AGENT); }
__device__ __forceinline__ unsigned xb_add(unsigned* p, unsigned v) { return __hip_atomic_fetch_add(p, v, __ATOMIC_RELAXED, __HIP_MEMORY_SCOPE_AGENT); }
__device__ __forceinline__ unsigned xb_xcc_id() { return (unsigned)__builtin_amdgcn_s_getreg((3 << 11) | 20) & 0xFu; }
#define XB_SPIN(cond, bar) do { unsigned _sp = 0; while (cond) { __builtin_amdgcn_s_sleep(1); \
    if ((++_sp & 255u) == 0u) { if (xb_ld(&(bar)[XB_TMO])) break; if (_sp > XB_SPIN_CAP) { atomicAdd(&(bar)[XB_TMO], 1u); break; } } } } while (0)

struct XcdBarrier {
    unsigned* bar; unsigned x;
    volatile LAS unsigned* st;
};

__device__ __forceinline__ XcdBarrier xcd_barrier_post(unsigned* bar, volatile LAS unsigned* st) {
    XcdBarrier b; b.bar = bar; b.x = xb_xcc_id(); b.st = st;
    if (threadIdx.x == 0) (void)xb_add(&bar[XB_XCNT(b.x)], 1u);
    return b;
}
__device__ __forceinline__ void xcd_barrier_complete(unsigned* bar, unsigned x, unsigned& nloc, unsigned& nx) {
    const unsigned G = gridDim.x * gridDim.y * gridDim.z;
    unsigned sum, cnt, mine, sp = 0u;
    for (;;) {
        sum = 0u; cnt = 0u; mine = 0u;
#pragma unroll
        for (unsigned j = 0; j < 16; ++j) { const unsigned c = xb_ld(&bar[XB_XCNT(j)]); sum += c; cnt += (c > 0u) ? 1u : 0u; mine = (j == x) ? c : mine; }
        if (sum == G) break;
        __builtin_amdgcn_s_sleep(1);
        if ((++sp & 255u) == 0u) { if (xb_ld(&bar[XB_TMO])) break; if (sp > XB_SPIN_CAP) { atomicAdd(&bar[XB_TMO], 1u); break; } }
    }
    nloc = mine > 0u ? mine : 1u; nx = cnt > 0u ? cnt : 1u;
}

__device__ __forceinline__ void xcd_barrier(const XcdBarrier& b) {
    asm volatile("s_waitcnt vmcnt(0)" ::: "memory");
    __syncthreads();
    if (threadIdx.x == 0) {
        unsigned* bar = b.bar;
        __builtin_amdgcn_s_waitcnt(0);
        unsigned nloc = b.st[0], nx = b.st[1];
        if (nloc == 0u) { xcd_barrier_complete(bar, b.x, nloc, nx); b.st[0] = nloc; b.st[1] = nx; }
        const unsigned old = xb_add(&bar[XB_XSUB(b.x)], 1u);
        const unsigned gen = old / nloc;
        if (old + 1u == (gen + 1u) * nloc) {
            __builtin_amdgcn_fence(__ATOMIC_RELEASE, "agent");
            asm volatile("s_waitcnt vmcnt(0)" ::: "memory");
            const unsigned og = xb_add(&bar[XB_TOP], 1u);
            const unsigned tg = og / nx;
            if (og + 1u == (tg + 1u) * nx) xb_add(&bar[XB_TOPGEN], 1u);
            else XB_SPIN(xb_ld(&bar[XB_TOPGEN]) == tg, bar);
            __builtin_amdgcn_fence(__ATOMIC_ACQUIRE, "agent");
            xb_add(&bar[XB_XGEN(b.x)], 1u);
            asm volatile("s_waitcnt vmcnt(0)" ::: "memory");
        } else {
            XB_SPIN(xb_ld(&bar[XB_XGEN(b.x)]) == gen, bar);
            __builtin_amdgcn_fence(__ATOMIC_ACQUIRE, "agent");
            asm volatile("s_waitcnt vmcnt(0)" ::: "memory");
        }
    }
    __syncthreads();
}

struct Args { const float* in[N_IN]; float* out; unsigned char* ws; int ph_lo, ph_hi; };
struct Frame {
    LAS unsigned char* lds; volatile LAS unsigned* MISC; gu32* ctl;
    int tid, lane, wave, vcu, G;
    const Args* A; float* out; unsigned char* ws;
};
#define WSP(T_, off) ((T_*)(F.ws + (off)))
#define PHASE_TID(F) do { int t_ = threadIdx.x; asm volatile("" : "+v"(t_)); (F).tid = t_; (F).lane = t_ & 63; (F).wave = __builtin_amdgcn_readfirstlane(t_ >> 6); } while (0)

__device__ __forceinline__ int glu_row(int n) { return n < 2048 ? (((n & 1023) >> 7) * 256 + (n >> 10) * 128 + (n & 127)) : n; }
template <int MODE>
__device__ __forceinline__ void tr_item(const float* W, int N, bf16* WT, int dstride, int koff, LAS float* scr, int kb, int nb, int lane) {
    const int k0 = 64 * kb, n0 = 32 * nb;
    f32x4 v[8];
#pragma unroll
    for (int i = 0; i < 8; ++i) v[i] = *(const f32x4*)(W + (size_t)(k0 + (lane >> 3) + 8 * i) * N + n0 + (lane & 7) * 4);
#pragma unroll
    for (int i = 0; i < 8; ++i) { LAS float* d = scr + ((lane >> 3) + 8 * i) * 33 + (lane & 7) * 4; d[0] = v[i].x; d[1] = v[i].y; d[2] = v[i].z; d[3] = v[i].w; }
    LDS_WAIT(); asm volatile("" ::: "memory");
    const int c = lane & 7;
#pragma unroll
    for (int j = 0; j < 4; ++j) { const int n = (lane >> 3) + 8 * j; const LAS float* s = scr + (8 * c) * 33 + n;
        v4u o; o.x = pk2(s[0 * 33], s[1 * 33]); o.y = pk2(s[2 * 33], s[3 * 33]); o.z = pk2(s[4 * 33], s[5 * 33]); o.w = pk2(s[6 * 33], s[7 * 33]);
        const int nn = n0 + n, row = MODE == 1 ? glu_row(nn) : nn;
        *(v4u*)(WT + (size_t)row * dstride + koff + k0 + 8 * c) = o; }
    LDS_WAIT(); asm volatile("" ::: "memory");
}
__device__ __forceinline__ void wmax_item(Frame& F, int it) {
    const int l = it >> 5, kc = it & 31; const float* W = F.A->in[I_WIN] + ((size_t)l * 2048 + kc * 64) * IN_DIM; float mx = 0.f;
#pragma unroll 4
    for (int k = 0; k < 64; ++k)
#pragma unroll
        for (int j = 0; j < 4; ++j) { const int c4 = F.tid + NTHR * j; if (c4 < IN_DIM / 4) { const f32x4 v = *(const f32x4*)(W + (size_t)k * IN_DIM + 4 * c4); mx = fmaxf(mx, fmaxf(fmaxf(fabsf(v.x), fabsf(v.y)), fmaxf(fabsf(v.z), fabsf(v.w)))); } }
#pragma unroll
    for (int o = 1; o < 64; o <<= 1) mx = fmaxf(mx, __shfl_xor(mx, o));
    if (F.lane == 0) __hip_atomic_fetch_max(F.ctl + CW_WMAX + l, __float_as_uint(mx), __ATOMIC_RELAXED, __HIP_MEMORY_SCOPE_AGENT);
}
__device__ __forceinline__ void wmax2_item(Frame& F, int it) {
    const int lh = it >> 3, kc = it & 7, l = lh >> 1, h = lh & 1; const float* W = F.A->in[h ? I_WAO : I_WCO] + ((size_t)l * 1024 + kc * 128) * 2048 + 4 * F.tid; float mx = 0.f;
#pragma unroll 8
    for (int k = 0; k < 128; ++k) { const f32x4 v = *(const f32x4*)(W + (size_t)k * 2048); mx = fmaxf(mx, fmaxf(fmaxf(fabsf(v.x), fabsf(v.y)), fmaxf(fabsf(v.z), fabsf(v.w)))); }
#pragma unroll
    for (int o = 1; o < 64; o <<= 1) mx = fmaxf(mx, __shfl_xor(mx, o));
    if (F.lane == 0) __hip_atomic_fetch_max(F.ctl + CW_WMAX2 + lh, __float_as_uint(mx), __ATOMIC_RELAXED, __HIP_MEMORY_SCOPE_AGENT);
}
__device__ __forceinline__ void wmax3_item(Frame& F, int it) {
    const int l = it >> 4, kc = it & 15; const float* W = F.A->in[I_WOUT] + ((size_t)l * 2048 + kc * 128) * 2048 + 4 * F.tid; float mx = 0.f;
#pragma unroll 8
    for (int k = 0; k < 128; ++k) { const f32x4 v = *(const f32x4*)(W + (size_t)k * 2048); mx = fmaxf(mx, fmaxf(fmaxf(fabsf(v.x), fabsf(v.y)), fmaxf(fabsf(v.z), fabsf(v.w)))); }
#pragma unroll
    for (int o = 1; o < 64; o <<= 1) mx = fmaxf(mx, __shfl_xor(mx, o));
    if (F.lane == 0) __hip_atomic_fetch_max(F.ctl + CW_WMAX3 + l, __float_as_uint(mx), __ATOMIC_RELAXED, __HIP_MEMORY_SCOPE_AGENT);
}
template <bool GLU>
__device__ __forceinline__ void tr8_item(const float* W, int N, unsigned char* WT, int koff, float inv, LAS float* scr, int kb, int nb, int lane) {
    const int k0 = 64 * kb, n0 = 32 * nb;
    f32x4 v[8];
#pragma unroll
    for (int i = 0; i < 8; ++i) v[i] = *(const f32x4*)(W + (size_t)(k0 + (lane >> 3) + 8 * i) * N + n0 + (lane & 7) * 4);
#pragma unroll
    for (int i = 0; i < 8; ++i) { LAS float* d = scr + ((lane >> 3) + 8 * i) * 33 + (lane & 7) * 4; d[0] = v[i].x * inv; d[1] = v[i].y * inv; d[2] = v[i].z * inv; d[3] = v[i].w * inv; }
    LDS_WAIT(); asm volatile("" ::: "memory");
    const int c = lane & 7;
#pragma unroll
    for (int j = 0; j < 4; ++j) { const int n = (lane >> 3) + 8 * j; const LAS float* s = scr + (8 * c) * 33 + n;
        int lo = __builtin_amdgcn_cvt_pk_fp8_f32(s[0 * 33], s[1 * 33], 0, false); lo = __builtin_amdgcn_cvt_pk_fp8_f32(s[2 * 33], s[3 * 33], lo, true);
        int hi = __builtin_amdgcn_cvt_pk_fp8_f32(s[4 * 33], s[5 * 33], 0, false); hi = __builtin_amdgcn_cvt_pk_fp8_f32(s[6 * 33], s[7 * 33], hi, true);
        v2u o; o.x = (unsigned)lo; o.y = (unsigned)hi;
        *(v2u*)(WT + (size_t)(GLU ? glu_row(n0 + n) : n0 + n) * 2048 + koff + k0 + 8 * c) = o; }
    LDS_WAIT(); asm volatile("" ::: "memory");
}
__device__ __forceinline__ void win8_phase(Frame& F) {
    PHASE_TID(F);
    LAS float* scr = (LAS float*)(F.lds + F.wave * 16384);
    if (F.tid == 0) F.MISC[0] = __hip_atomic_fetch_add(F.ctl + CW_QUEUE2, 1u, __ATOMIC_RELAXED, __HIP_MEMORY_SCOPE_AGENT);
    for (int par = 0;; par ^= 1) {
        __syncthreads();
        const int it = (int)F.MISC[par];
        if (F.tid == 0) F.MISC[par ^ 1] = __hip_atomic_fetch_add(F.ctl + CW_QUEUE2, 1u, __ATOMIC_RELAXED, __HIP_MEMORY_SCOPE_AGENT);
        if (it >= 2 * 960 + 4 * 128 + 2 * 256) break;
        if (it < 2 * 960) { const int l = it >= 960, r = it - l * 960, wi = r * 8 + F.wave;
            const float wmax = __uint_as_float(__hip_atomic_load(F.ctl + CW_WMAX + l, __ATOMIC_RELAXED, __HIP_MEMORY_SCOPE_AGENT)), inv = wmax > 0.f ? 440.0f / wmax : 1.0f;
            tr8_item<true>(F.A->in[I_WIN] + (size_t)l * 2048 * IN_DIM, IN_DIM, WSP(unsigned char, WS_WIN) + (size_t)l * IN_DIM * 2048, 0, inv, scr, wi / 240, wi % 240, F.lane); }
        else if (it >= 2 * 960 + 4 * 128) { const int r0 = it - 2 * 960 - 4 * 128, l = r0 >> 8, wi = (r0 & 255) * 8 + F.wave;
            const float wmax = __uint_as_float(__hip_atomic_load(F.ctl + CW_WMAX3 + l, __ATOMIC_RELAXED, __HIP_MEMORY_SCOPE_AGENT)), inv = wmax > 0.f ? 440.0f / wmax : 1.0f;
            tr8_item<false>(F.A->in[I_WOUT] + (size_t)l * 2048 * 2048, 2048, WSP(unsigned char, WS_WO) + (size_t)l * 2048 * 2048, 0, inv, scr, wi / 64, wi % 64, F.lane); }
        else { const int r0 = it - 2 * 960, lh = r0 >> 7, l = lh >> 1, h = lh & 1, wi = (r0 & 127) * 8 + F.wave;
            const float wmax = __uint_as_float(__hip_atomic_load(F.ctl + CW_WMAX2 + lh, __ATOMIC_RELAXED, __HIP_MEMORY_SCOPE_AGENT)), inv = wmax > 0.f ? 440.0f / wmax : 1.0f;
            tr8_item<false>(F.A->in[h ? I_WAO : I_WCO] + (size_t)l * 1024 * 2048, 2048, WSP(unsigned char, WS_WM) + (size_t)l * 2048 * 2048, h * 1024, inv, scr, wi / 64, wi % 64, F.lane); }
    }
}
__device__ __forceinline__ void ada_item(Frame& F, int a) {
    LAS float* csl = (LAS float*)F.lds;
    LAS f32x4* red = (LAS f32x4*)(F.lds + 16384);
    const float* c = F.A->in[I_C];
    for (int i = F.tid; i < 4096; i += NTHR) { const float v = c[i]; csl[i] = v / (1.0f + __expf(-v)); }
    __syncthreads();
    const int l = a / 48, j0 = (a % 48) * 256 + 4 * F.lane;
    const float* wp = F.A->in[I_ADAW] + ((size_t)l * 2048 + F.wave * 256) * 12288 + j0;
    f32x4 a0 = {0.f, 0.f, 0.f, 0.f}, a1 = {0.f, 0.f, 0.f, 0.f};
#pragma unroll 16
    for (int k = 0; k < 256; ++k) { const f32x4 w = *(const f32x4*)(wp + (size_t)k * 12288); const float c0 = csl[F.wave * 256 + k], c1 = csl[2048 + F.wave * 256 + k]; a0 += w * c0; a1 += w * c1; }
    red[(F.wave * 2 + 0) * 64 + F.lane] = a0; red[(F.wave * 2 + 1) * 64 + F.lane] = a1;
    __syncthreads();
    if (F.wave < 2) { const int b = F.wave; f32x4 s = *(const f32x4*)(F.A->in[I_ADAB] + l * 12288 + j0);
#pragma unroll
        for (int w = 0; w < 8; ++w) s += red[(w * 2 + b) * 64 + F.lane];
        *(f32x4*)(WSP(float, WS_MOD) + (size_t)(l * 2 + b) * 12288 + j0) = s; }
    __syncthreads();
}
__device__ __forceinline__ void fold_item(Frame& F, int it) {
    const int l = it >> 8, hp = (it >> 4) & 15, nq = (it >> 2) & 3, kc = it & 3;
    LAS f32x4* skl = (LAS f32x4*)F.lds;
    const f32x4* sk = (const f32x4*)(F.A->in[I_SK] + ((size_t)(l * 16 + hp) * 128 + nq * 32) * 128);
    for (int i = F.tid; i < 1024; i += NTHR) skl[i] = sk[i];
    __syncthreads();
    const int k = kc * 512 + F.tid;
    const f32x4* wrow = (const f32x4*)(F.A->in[I_WPQ] + ((size_t)l * 2048 + k) * 2048 + hp * 128);
    f32x4 w[32];
#pragma unroll
    for (int i = 0; i < 32; ++i) w[i] = wrow[i];
    bf16* dst = WSP(bf16, WS_WP) + (size_t)l * 2048 * 2048 + (size_t)(hp * 128 + nq * 32) * 2048 + k;
    for (int n = 0; n < 32; ++n) { float a0 = 0.f, a1 = 0.f, a2 = 0.f, a3 = 0.f;
#pragma unroll
        for (int i = 0; i < 32; ++i) { const f32x4 s = skl[n * 32 + i]; a0 += w[i].x * s.x; a1 += w[i].y * s.y; a2 += w[i].z * s.z; a3 += w[i].w * s.w; }
        dst[(size_t)n * 2048] = (bf16)f2bf((a0 + a1) + (a2 + a3)); }
    __syncthreads();
}
__device__ __forceinline__ void cvt_item(Frame& F, int it) {
    const int which = it >> 10, chunk = it & 1023;
    const float* src = F.A->in[which ? I_PV : I_PU]; unsigned char* dst = WSP(unsigned char, which ? WS_PV : WS_PU); float* scl = WSP(float, WS_SCL) + which * 2 * NEXP;
    constexpr int VROW = 2048 + 8;
    LAS unsigned char* vt = F.lds;
    for (int i = 0; i < 4; i += 2) {
        f32x4 a[2][4], b[2][4]; float mx[2] = {0.f, 0.f};
#pragma unroll
        for (int r = 0; r < 2; ++r) { const int row = chunk * 32 + F.wave * 4 + i + r;
#pragma unroll
            for (int m = 0; m < 4; ++m) { const int col = 512 * m + 8 * F.lane; a[r][m] = *(const f32x4*)(src + (size_t)row * D + col); b[r][m] = *(const f32x4*)(src + (size_t)row * D + col + 4); } }
#pragma unroll
        for (int r = 0; r < 2; ++r) {
#pragma unroll
            for (int m = 0; m < 4; ++m) { mx[r] = fmaxf(mx[r], fmaxf(fmaxf(fabsf(a[r][m].x), fabsf(a[r][m].y)), fmaxf(fabsf(a[r][m].z), fabsf(a[r][m].w)))); mx[r] = fmaxf(mx[r], fmaxf(fmaxf(fabsf(b[r][m].x), fabsf(b[r][m].y)), fmaxf(fabsf(b[r][m].z), fabsf(b[r][m].w)))); } }
#pragma unroll
        for (int o = 1; o < 64; o <<= 1) { mx[0] = fmaxf(mx[0], __shfl_xor(mx[0], o)); mx[1] = fmaxf(mx[1], __shfl_xor(mx[1], o)); }
#pragma unroll
        for (int r = 0; r < 2; ++r) { const int row = chunk * 32 + F.wave * 4 + i + r, l = row >> 14, e = row & (NEXP - 1);
            const float sc = mx[r] > 0.f ? mx[r] * (1.0f / 440.0f) : 1.0f, inv = 1.0f / sc;
            if (F.lane == 0) scl[l * NEXP + e] = sc;
#pragma unroll
            for (int m = 0; m < 4; ++m) { const int col = 512 * m + 8 * F.lane;
                int lo = __builtin_amdgcn_cvt_pk_fp8_f32(a[r][m].x * inv, a[r][m].y * inv, 0, false); lo = __builtin_amdgcn_cvt_pk_fp8_f32(a[r][m].z * inv, a[r][m].w * inv, lo, true);
                int hi = __builtin_amdgcn_cvt_pk_fp8_f32(b[r][m].x * inv, b[r][m].y * inv, 0, false); hi = __builtin_amdgcn_cvt_pk_fp8_f32(b[r][m].z * inv, b[r][m].w * inv, hi, true);
                v2u o; o.x = (unsigned)lo; o.y = (unsigned)hi;
                if (which) *(LAS v2u*)(vt + (F.wave * 4 + i + r) * VROW + col) = o;
                else *(v2u*)(dst + ((size_t)(l * NSL + (col >> 7)) * NEXP + e) * SLW + (col & 127)) = o; } }
    }
    if (which) {
        __syncthreads();
        const int row0 = chunk * 32, l = row0 >> 14, e0 = row0 & (NEXP - 1);
#pragma unroll 4
        for (int i = 0; i < 16; ++i) { const int idx = i * NTHR + F.tid, j = idx >> 5, r = idx & 31;
            *(v2u*)(dst + ((size_t)(l * 256 + j) * NEXP + e0 + r) * 8) = *(const LAS v2u*)(vt + r * VROW + 8 * j); }
        __syncthreads();
    }
}
__device__ __forceinline__ void bias_item(Frame& F) {
    for (int i = F.tid; i < 2048; i += NTHR) { const int h = i >> 7, d = i & 127; int bk;
        if (d < 16) bk = d; else { bk = 16 + (int)(logf((float)d / 16.0f) / logf(8.0f) * 16.0f); bk = bk > 31 ? 31 : bk; }
        WSP(float, WS_BIAS)[i] = F.A->in[I_RELB][bk * 16 + h]; }
}
constexpr int IT_FOLD = 512, IT_ADA = 96, IT_WMAX = 64 + 32 + 32, IT_CVT = 2048;
constexpr int IT0_ADA = 0, IT0_BIAS = IT0_ADA + IT_ADA, IT0_WMAX = IT0_BIAS + 1, IT0_CVT = IT0_WMAX + IT_WMAX, N_OTHER = IT0_CVT + IT_CVT, N_ITEMS = N_OTHER + IT_FOLD, FOLD_EVERY = 5;
static_assert((IT_FOLD - 1) * FOLD_EVERY < N_ITEMS, "fold tickets inside the item range");
__device__ __forceinline__ void p0_prologue(Frame& F) {
    PHASE_TID(F);
    if (F.tid == 0) F.MISC[0] = __hip_atomic_fetch_add(F.ctl + CW_QUEUE, 1u, __ATOMIC_RELAXED, __HIP_MEMORY_SCOPE_AGENT);
    for (int par = 0;; par ^= 1) {
        __syncthreads();
        const int it = (int)F.MISC[par];
        if (F.tid == 0) F.MISC[par ^ 1] = __hip_atomic_fetch_add(F.ctl + CW_QUEUE, 1u, __ATOMIC_RELAXED, __HIP_MEMORY_SCOPE_AGENT);
        if (it >= N_ITEMS) break;
        const int fq = it / FOLD_EVERY; const bool is_fold = (it % FOLD_EVERY == 0) && fq < IT_FOLD;
        const int ot = it - (fq + 1 < IT_FOLD ? fq + 1 : IT_FOLD);
        if (is_fold) fold_item(F, fq);
        else if (ot < IT0_BIAS) ada_item(F, ot - IT0_ADA);
        else if (ot < IT0_WMAX) bias_item(F);
        else if (ot < IT0_WMAX + 64) wmax_item(F, ot - IT0_WMAX);
        else if (ot < IT0_WMAX + 96) wmax2_item(F, ot - IT0_WMAX - 64);
        else if (ot < IT0_CVT) wmax3_item(F, ot - IT0_WMAX - 96);
        else cvt_item(F, ot - IT0_CVT);
    }
}

__device__ __forceinline__ void row_to_fp8(const f32x4 (&y)[8], unsigned char* hrow, float* sarow, int lane) {
    float mx = 0.f;
#pragma unroll
    for (int j = 0; j < 8; ++j) mx = fmaxf(mx, fmaxf(fmaxf(fabsf(y[j].x), fabsf(y[j].y)), fmaxf(fabsf(y[j].z), fabsf(y[j].w))));
#pragma unroll
    for (int o = 1; o < 64; o <<= 1) mx = fmaxf(mx, __shfl_xor(mx, o));
    const float sc = mx > 0.f ? mx * (1.0f / 440.0f) : 1.0f, inv = 1.0f / sc;
    if (lane == 0) *sarow = sc;
#pragma unroll
    for (int j = 0; j < 8; ++j) { int w = __builtin_amdgcn_cvt_pk_fp8_f32(y[j].x * inv, y[j].y * inv, 0, false); w = __builtin_amdgcn_cvt_pk_fp8_f32(y[j].z * inv, y[j].w * inv, w, true); ((unsigned*)hrow)[lane + 64 * j] = (unsigned)w; }
}
template <bool TO_FP8, bool IN_BF16>
__device__ __forceinline__ void norm_phase(Frame& F, const void* X, bf16* Hd, const float* g, const float* modl, int ish, int isc) {
    PHASE_TID(F);
    const int gw = F.vcu * NWAVES + F.wave, NGW = F.G * NWAVES;
    int curb = -1; f32x4 gs[8], sh[8];
    f32x4 rn[8]; v2u qn[8];
#define NORM_LOAD(m_) do { if constexpr (IN_BF16) { const v2u* xr_ = (const v2u*)((const bf16*)X + (size_t)(m_) * D) + F.lane; _Pragma("unroll") for (int j = 0; j < 8; ++j) qn[j] = xr_[64 * j]; } \
                           else { const f32x4* xr_ = (const f32x4*)((const float*)X + (size_t)(m_) * D) + F.lane; _Pragma("unroll") for (int j = 0; j < 8; ++j) rn[j] = xr_[64 * j]; } } while (0)
    if (gw < T) NORM_LOAD(gw);
    for (int m = gw; m < T; m += NGW) {
        const int b = m >> 13;
        if (b != curb) { curb = b;
#pragma unroll
            for (int j = 0; j < 8; ++j) { const int col = 4 * F.lane + 256 * j; const f32x4 g4 = *(const f32x4*)(g + col), sc4 = *(const f32x4*)(modl + (size_t)b * 12288 + isc * 2048 + col);
                sh[j] = *(const f32x4*)(modl + (size_t)b * 12288 + ish * 2048 + col); gs[j] = g4 * (sc4 + 1.0f); } }
        f32x4 v[8]; float ss = 0.f;
#pragma unroll
        for (int j = 0; j < 8; ++j) { if constexpr (IN_BF16) v[j] = (f32x4){bflo(qn[j].x), bfhi(qn[j].x), bflo(qn[j].y), bfhi(qn[j].y)}; else v[j] = rn[j]; }
        if (m + NGW < T) NORM_LOAD(m + NGW);
        __builtin_amdgcn_sched_barrier(0);
#pragma unroll
        for (int j = 0; j < 8; ++j) ss += (v[j].x * v[j].x + v[j].y * v[j].y) + (v[j].z * v[j].z + v[j].w * v[j].w);
        const float rstd = 1.0f / sqrtf(wave_sum(ss) * (1.0f / D) + EPS);
        if constexpr (TO_FP8) { f32x4 y[8];
#pragma unroll
            for (int j = 0; j < 8; ++j) y[j] = v[j] * rstd * gs[j] + sh[j];
            row_to_fp8(y, (unsigned char*)Hd + (size_t)m * D, WSP(float, WS_SA) + m, F.lane);
        } else {
        v2u* o = (v2u*)(Hd + (size_t)m * D) + F.lane;
#pragma unroll
        for (int j = 0; j < 8; ++j) { const f32x4 y = v[j] * rstd * gs[j] + sh[j]; v2u w; w.x = pk2(y.x, y.y); w.y = pk2(y.z, y.w); o[64 * j] = w; }
        }
    }
#undef NORM_LOAD
}

__device__ __forceinline__ void conv_phase(Frame& F, int l) {
    PHASE_TID(F);
    const float* dw = F.A->in[I_DWW] + (size_t)l * CWID * CONV; const int c0 = 2 * F.tid;
    float w0[CWID], w1[CWID];
#pragma unroll
    for (int j = 0; j < CWID; ++j) { const f32x2 w = *(const f32x2*)(dw + j * CONV + c0); w0[j] = w.x; w1[j] = w.y; }
    const f32x2 cb = *(const f32x2*)(F.A->in[I_DWB] + l * CONV + c0), lg = *(const f32x2*)(F.A->in[I_CLNG] + l * CONV + c0), lb = *(const f32x2*)(F.A->in[I_CLNB] + l * CONV + c0);
    LAS float* red = (LAS float*)F.lds;
    LAS float* stat = red + 256;
    float gmx = fmaxf(fabsf(lg.x), fabsf(lg.y)), bmx = fmaxf(fabsf(lb.x), fabsf(lb.y));
#pragma unroll
    for (int o = 1; o < 64; o <<= 1) { gmx = fmaxf(gmx, __shfl_xor(gmx, o)); bmx = fmaxf(bmx, __shfl_xor(bmx, o)); }
    if (F.lane == 0) { red[F.wave] = gmx; red[8 + F.wave] = bmx; }
    __syncthreads();
    { float g_ = red[0], b_ = red[8];
#pragma unroll
      for (int w = 1; w < 8; ++w) { g_ = fmaxf(g_, red[w]); b_ = fmaxf(b_, red[8 + w]); }
      gmx = g_; bmx = b_; }
    __syncthreads();
    const float Bc = fmaxf(32.0f * gmx + bmx, 1e-20f), cinv = 440.0f / Bc;
    if (blockIdx.x == 0 && F.tid == 0) { __hip_atomic_store(F.ctl + CW_BC + l, __float_as_uint(Bc), __ATOMIC_RELAXED, __HIP_MEMORY_SCOPE_AGENT); __hip_atomic_store(F.ctl + CW_BC2 + l, __float_as_uint(gmx + bmx), __ATOMIC_RELAXED, __HIP_MEMORY_SCOPE_AGENT); }
    const unsigned* Ut = WSP(unsigned, WS_U) + F.tid; unsigned short* AM = WSP(unsigned short, WS_AM);
    for (int tile = F.vcu; tile < T / 64; tile += F.G) {
        const int t0 = tile * 64, bstart = t0 & ~(SEQ - 1);
        for (int grp = 0; grp < 4; ++grp) {
            const int tg = t0 + grp * 16;
            float wa[46], wb[46]; unsigned wp[46];
#pragma unroll
            for (int i = 0; i < 46; ++i) { const int r = tg - 30 + i; wp[i] = Ut[(size_t)(r >= bstart ? r : bstart) * (CONV / 2)]; }
            __builtin_amdgcn_sched_barrier(0);
#pragma unroll
            for (int i = 0; i < 46; ++i) { const int r = tg - 30 + i; const unsigned p = wp[i] & (r >= bstart ? 0xffffffffu : 0u); wa[i] = bflo(p); wb[i] = bfhi(p); }
            float oa[16], ob[16];
#pragma unroll
            for (int i = 0; i < 16; ++i) { float a = cb.x, b = cb.y;
#pragma unroll
                for (int j = 0; j < CWID; ++j) { a += w0[j] * wa[i + j]; b += w1[j] * wb[i + j]; }
                oa[i] = a; ob[i] = b; }
#pragma unroll
            for (int i = 0; i < 16; ++i) { const float s = wave_sum(oa[i] + ob[i]), q = wave_sum(oa[i] * oa[i] + ob[i] * ob[i]); if (F.lane == 0) { red[F.wave * 32 + i] = s; red[F.wave * 32 + 16 + i] = q; } }
            __syncthreads();
            if (F.tid < 32) { float v = 0.f;
#pragma unroll
                for (int w = 0; w < 8; ++w) v += red[w * 32 + F.tid];
                stat[F.tid] = v; }
            __syncthreads();
#pragma unroll
            for (int i = 0; i < 16; ++i) { const float mu = stat[i] * (1.0f / CONV), var = fmaxf(stat[16 + i] * (1.0f / CONV) - mu * mu, 0.0f), rstd = 1.0f / sqrtf(var + EPS);
                const float ya = (oa[i] - mu) * rstd * lg.x + lb.x, yb = (ob[i] - mu) * rstd * lg.y + lb.y;
                AM[(size_t)(tg + i) * (D / 2) + F.tid] = (unsigned short)__builtin_amdgcn_cvt_pk_fp8_f32(ya * sigmoidf_(ya) * cinv, yb * sigmoidf_(yb) * cinv, 0, false); }
        }
    }
}

#define MFMA32(a, b, c) __builtin_amdgcn_mfma_f32_32x32x16_bf16((a), (b), (c), 0, 0, 0)
__device__ __forceinline__ void attn_phase(Frame& F, int l) {
    PHASE_TID(F);
    constexpr int VTS = 260;
    constexpr int KS = 72;
    LAS bf16* VT = (LAS bf16*)F.lds;
    LAS bf16* KL = (LAS bf16*)(F.lds + 34816);
    LAS float* BT = (LAS float*)(F.lds + 34816 + 36864);
    const bf16* Qg = WSP(bf16, WS_Q); const bf16* Kg = WSP(bf16, WS_K); const bf16* Vg = WSP(bf16, WS_V); unsigned char* AM = WSP(unsigned char, WS_AM);
    const float* BIAS = WSP(float, WS_BIAS);
    const int r = F.lane & 31, h = F.lane >> 5;
    for (int unit = F.vcu; unit < 512; unit += F.G) {
        const int b = unit >> 8, blk = (unit >> 2) & 63, kvh = unit & 3, kbase = blk * 128 - 128;
        const float vmx = __uint_as_float(__hip_atomic_load(F.ctl + CW_VMAX + 2 * l + b, __ATOMIC_RELAXED, __HIP_MEMORY_SCOPE_AGENT)), ainv = vmx > 0.f ? 440.0f / (1.02f * vmx) : 1.0f;
        for (int c = F.tid; c < 2048; c += NTHR) { const int key = c >> 3, d0 = (c & 7) * 8, kpos = kbase + key; v4u v = {0u, 0u, 0u, 0u}, kq = {0u, 0u, 0u, 0u};
            if (kpos >= 0) { v = *(const v4u*)(Vg + (size_t)(b * SEQ + kpos) * KVD + kvh * HD + d0); kq = *(const v4u*)(Kg + (size_t)(b * SEQ + kpos) * KVD + kvh * HD + d0); }
            *(LAS v4u*)(KL + key * KS + d0) = kq;
            LAS bf16* dst = VT + d0 * VTS + key;
            dst[0 * VTS] = (bf16)v.x; dst[1 * VTS] = (bf16)(v.x >> 16); dst[2 * VTS] = (bf16)v.y; dst[3 * VTS] = (bf16)(v.y >> 16);
            dst[4 * VTS] = (bf16)v.z; dst[5 * VTS] = (bf16)(v.z >> 16); dst[6 * VTS] = (bf16)v.w; dst[7 * VTS] = (bf16)(v.w >> 16); }
        BT[F.tid] = BIAS[(kvh * 4 + (F.tid >> 7)) * 128 + (F.tid & 127)];
        __syncthreads();
        for (int tk = 0; tk < 2; ++tk) {
            const int task = F.wave * 2 + tk, g = task >> 2, qs = task & 3, head = kvh * 4 + g;
            const size_t trow = (size_t)b * SEQ + blk * 128 + qs * 32 + r;
            bf16x8 qf[4];
#pragma unroll
            for (int s = 0; s < 4; ++s) qf[s] = *(const bf16x8*)(Qg + trow * ATT + head * HD + 16 * s + 8 * h);
            const float sink = F.A->in[I_SINK][l * NHEAD + head];
            float mx = sink, lsum = 0.f;
            f32x16 o[2];
#pragma unroll
            for (int i = 0; i < 16; ++i) { o[0][i] = 0.f; o[1][i] = 0.f; }
#pragma unroll 1
            for (int j = 0; j < 5; ++j) { f32x16 a;
#pragma unroll
                for (int i = 0; i < 16; ++i) a[i] = 0.f;
#pragma unroll
                for (int s = 0; s < 4; ++s) { const bf16x8 kf = *(const LAS bf16x8*)(KL + (qs * 32 + 32 * j + r) * KS + 16 * s + 8 * h); a = MFMA32(kf, qf[s], a); }
                float tmax = -INFINITY;
#pragma unroll
                for (int i = 0; i < 16; ++i) { const int kr = 32 * j + (i & 3) + 8 * (i >> 2) + 4 * h, dist = 128 + r - kr; const bool ok = dist >= 0 && dist < 128 && (kbase + qs * 32 + kr) >= 0;
                    const float sv = ok ? a[i] + BT[g * 128 + (dist & 127)] : -INFINITY; a[i] = sv; tmax = fmaxf(tmax, sv); }
                tmax = fmaxf(tmax, __shfl_xor(tmax, 32));
                const float mnew = fmaxf(mx, tmax), alpha = __expf(mx - mnew); mx = mnew; lsum *= alpha;
#pragma unroll
                for (int i = 0; i < 16; ++i) { o[0][i] *= alpha; o[1][i] *= alpha; const float p = __expf(a[i] - mx); a[i] = p; lsum += p; }
#pragma unroll
                for (int s2 = 0; s2 < 2; ++s2) { v4u pp; pp.x = pk2(a[8 * s2 + 0], a[8 * s2 + 1]); pp.y = pk2(a[8 * s2 + 2], a[8 * s2 + 3]); pp.z = pk2(a[8 * s2 + 4], a[8 * s2 + 5]); pp.w = pk2(a[8 * s2 + 6], a[8 * s2 + 7]);
                    const bf16x8 pf = __builtin_bit_cast(bf16x8, pp);
#pragma unroll
                    for (int dt = 0; dt < 2; ++dt) { const LAS bf16* vp = VT + (32 * dt + r) * VTS + qs * 32 + 32 * j + 16 * s2 + 4 * h; const v2u lo = *(const LAS v2u*)vp, hi = *(const LAS v2u*)(vp + 8);
                        v4u vv; vv.x = lo.x; vv.y = lo.y; vv.z = hi.x; vv.w = hi.y; o[dt] = MFMA32(__builtin_bit_cast(bf16x8, vv), pf, o[dt]); } }
            }
            lsum += __shfl_xor(lsum, 32);
            const float inv = ainv / (lsum + __expf(sink - mx));
#pragma unroll
            for (int dt = 0; dt < 2; ++dt)
#pragma unroll
                for (int g4 = 0; g4 < 4; ++g4) { int w = __builtin_amdgcn_cvt_pk_fp8_f32(o[dt][4 * g4 + 0] * inv, o[dt][4 * g4 + 1] * inv, 0, false); w = __builtin_amdgcn_cvt_pk_fp8_f32(o[dt][4 * g4 + 2] * inv, o[dt][4 * g4 + 3] * inv, w, true);
                    *(unsigned*)(AM + trow * D + ATT + head * HD + 32 * dt + 8 * g4 + 4 * h) = (unsigned)w; }
        }
        __syncthreads();
    }
}

__device__ __forceinline__ unsigned f2key(float f) { const unsigned u = __float_as_uint(f); return (u & 0x80000000u) ? ~u : (u | 0x80000000u); }
__device__ __forceinline__ float key2f(unsigned k) { const unsigned u = (k & 0x80000000u) ? (k & 0x7fffffffu) : ~k; return __uint_as_float(u); }
#define INSERT16(L, x_) do { unsigned x__ = (x_); _Pragma("unroll") for (int q_ = 0; q_ < 16; ++q_) { const unsigned hi_ = L[q_] > x__ ? L[q_] : x__; x__ = L[q_] > x__ ? x__ : L[q_]; L[q_] = hi_; } } while (0)
__device__ __forceinline__ void topk_phase(Frame& F) {
    PHASE_TID(F);
    const _Float16* S = WSP(_Float16, WS_GC); int* IDX = WSP(int, WS_U); float* GATE = WSP(float, WS_U + 8 * MiB);
    const int gw = F.vcu * NWAVES + F.wave, NGW = F.G * NWAVES;
    for (int grp = gw; grp < T * PHEADS / 64; grp += NGW) {
        const int item = grp * 64 + F.lane, t = item >> 3, hh = item & 7;
        const pg8::f16x8* srow = (const pg8::f16x8*)(S + (size_t)t * D + hh * 256);
        unsigned L1[16], L2[16];
#pragma unroll
        for (int q = 0; q < 16; ++q) { L1[q] = 0u; L2[q] = 0u; }
#pragma unroll 2
        for (int c = 0; c < 16; ++c) { const pg8::f16x8 v = srow[c];
#pragma unroll
            for (int e = 0; e < 8; ++e) { const unsigned key = (f2key((float)v[e]) & ~127u) | (unsigned)(127 - (8 * c + e)); INSERT16(L1, key); } }
#pragma unroll 2
        for (int c = 0; c < 16; ++c) { const pg8::f16x8 v = srow[16 + c];
#pragma unroll
            for (int e = 0; e < 8; ++e) { const unsigned key = (f2key((float)v[e]) & ~127u) | (unsigned)(127 - (8 * c + e)); INSERT16(L2, key); } }
        float v1[16], v2[16];
#pragma unroll
        for (int q = 0; q < 16; ++q) { v1[q] = key2f(L1[q] & ~127u); v2[q] = key2f(L2[q] & ~127u); }
        unsigned B[16];
#pragma unroll
        for (int q = 0; q < 16; ++q) B[q] = 0u;
#pragma unroll
        for (int i = 0; i < 16; ++i)
#pragma unroll
            for (int j = 0; j < 16; ++j) if ((i + 1) * (j + 1) <= 16) { const unsigned key = (f2key(v1[i] + v2[j]) & ~255u) | (unsigned)(255 - (i * 16 + j)); INSERT16(B, key); }
        const float b0 = key2f(B[0] & ~255u); float e[16], es = 0.f;
#pragma unroll
        for (int q = 0; q < 16; ++q) { e[q] = __expf(key2f(B[q] & ~255u) - b0); es += e[q]; }
        const float einv = 1.0f / es;
        int ex[16];
#pragma unroll
        for (int q = 0; q < 16; ++q) { const int code = 255 - (int)(B[q] & 255u), ii = code >> 4, jj = code & 15; unsigned s1 = L1[0], s2 = L2[0];
#pragma unroll
            for (int z = 1; z < 16; ++z) { s1 = (ii == z) ? L1[z] : s1; s2 = (jj == z) ? L2[z] : s2; }
            ex[q] = (127 - (int)(s1 & 127u)) * 128 + (127 - (int)(s2 & 127u)); e[q] *= einv; }
        int* ip = IDX + (size_t)t * 128 + hh * 16; float* gp = GATE + (size_t)t * 128 + hh * 16;
#pragma unroll
        for (int q = 0; q < 4; ++q) { *(int4*)(ip + 4 * q) = make_int4(ex[4 * q], ex[4 * q + 1], ex[4 * q + 2], ex[4 * q + 3]); *(f32x4*)(gp + 4 * q) = (f32x4){e[4 * q], e[4 * q + 1], e[4 * q + 2], e[4 * q + 3]}; }
    }
}

#define FP8LO(w_) __builtin_amdgcn_cvt_pk_f32_fp8((int)(w_), false)
#define FP8HI(w_) __builtin_amdgcn_cvt_pk_f32_fp8((int)(w_), true)
__device__ __forceinline__ void pa_issue(v4u (&rr)[16], int id0, int id1, const unsigned char* tab, int g) {
#pragma unroll
    for (int i = 0; i < 16; ++i) { const int e = __shfl(i < 8 ? id0 : id1, ((8 * i) & 63) + g); rr[i] = *(const v4u*)(tab + (size_t)e * SLW); }
}
__device__ __forceinline__ void pa_compute(const v4u (&rr)[16], const v4u ha, const v4u hb, float o0, float o1, float* d0, float* d1, int lane) {
    f32x2 hf[8];
    hf[0] = (f32x2){bflo(ha.x), bfhi(ha.x)}; hf[1] = (f32x2){bflo(ha.y), bfhi(ha.y)}; hf[2] = (f32x2){bflo(ha.z), bfhi(ha.z)}; hf[3] = (f32x2){bflo(ha.w), bfhi(ha.w)};
    hf[4] = (f32x2){bflo(hb.x), bfhi(hb.x)}; hf[5] = (f32x2){bflo(hb.y), bfhi(hb.y)}; hf[6] = (f32x2){bflo(hb.z), bfhi(hb.z)}; hf[7] = (f32x2){bflo(hb.w), bfhi(hb.w)};
    float p[16];
#pragma unroll
    for (int i = 0; i < 16; ++i) { f32x2 a = FP8LO(rr[i].x) * hf[0];
        a = __builtin_elementwise_fma(FP8HI(rr[i].x), hf[1], a); a = __builtin_elementwise_fma(FP8LO(rr[i].y), hf[2], a); a = __builtin_elementwise_fma(FP8HI(rr[i].y), hf[3], a);
        a = __builtin_elementwise_fma(FP8LO(rr[i].z), hf[4], a); a = __builtin_elementwise_fma(FP8HI(rr[i].z), hf[5], a); a = __builtin_elementwise_fma(FP8LO(rr[i].w), hf[6], a); a = __builtin_elementwise_fma(FP8HI(rr[i].w), hf[7], a);
        p[i] = a.x + a.y; }
    float q8[8], q4[4], q2[2];
    { const bool bt = (lane & 1) != 0;
#pragma unroll
      for (int i = 0; i < 8; ++i) { const float snd = bt ? p[i] : p[i + 8], kp = bt ? p[i + 8] : p[i]; q8[i] = kp + lane_xor1(snd); } }
    { const bool bt = (lane & 2) != 0;
#pragma unroll
      for (int i = 0; i < 4; ++i) { const float snd = bt ? q8[i] : q8[i + 4], kp = bt ? q8[i + 4] : q8[i]; q4[i] = kp + lane_xor2(snd); } }
    { const bool bt = (lane & 4) != 0;
#pragma unroll
      for (int i = 0; i < 2; ++i) { const float snd = bt ? q4[i] : q4[i + 2], kp = bt ? q4[i + 2] : q4[i]; q2[i] = kp + lane_xor4(snd); } }
    *d0 = o0 + q2[0]; *d1 = o1 + q2[1];
}
__device__ __forceinline__ void peer_act_phase(Frame& F, int l) {
    PHASE_TID(F);
    const int lane = F.lane, g = lane >> 3, j = lane & 7;
    const int x = blockIdx.x & 7, bpg = F.G >> 3, wpg = bpg * NWAVES, wgi = (blockIdx.x >> 3) * NWAVES + F.wave;
    const int* IDX = WSP(int, WS_U); const bf16* Hb = WSP(bf16, WS_H);
    float* actp = WSP(float, WS_AM) + (size_t)x * T * 128;
    const int irev = 8 * (j & 1) + 4 * ((j >> 1) & 1) + 2 * (j >> 2), k0 = 8 * irev + g, k1 = k0 + 8;
    const int NT = (T - wgi + wpg - 1) / wpg;
    for (int s = 0; s < 2; ++s) {
        const int sl = 2 * x + s; const unsigned char* tab = WSP(unsigned char, WS_PU) + (size_t)(l * NSL + sl) * NEXP * SLW + 16 * j;
        const bf16* hcol = Hb + sl * SLW + 16 * j;
#define PA_PREF(n_, i0, i1, h0, h1, q0, q1) do { const int t_ = wgi + (n_) * wpg; if ((n_) < NT) { i0 = IDX[(size_t)t_ * 128 + lane]; i1 = IDX[(size_t)t_ * 128 + 64 + lane]; h0 = *(const v4u*)(hcol + (size_t)t_ * D); h1 = *(const v4u*)(hcol + (size_t)t_ * D + 8); \
            if (s > 0) { q0 = actp[(size_t)t_ * 128 + k0]; q1 = actp[(size_t)t_ * 128 + k1]; } } } while (0)
        int ia0 = 0, ia1 = 0, ib0 = 0, ib1 = 0; v4u ha0 = {0u, 0u, 0u, 0u}, ha1 = ha0, hb0 = ha0, hb1 = ha0; float oa0 = 0.f, oa1 = 0.f, ob0 = 0.f, ob1 = 0.f;
        v4u rA[16], rB[16];
        PA_PREF(0, ia0, ia1, ha0, ha1, oa0, oa1); PA_PREF(1, ib0, ib1, hb0, hb1, ob0, ob1);
        if (0 < NT) pa_issue(rA, ia0, ia1, tab, g);
        for (int n = 0; n < NT; n += 2) {
            const v4u ca0 = ha0, ca1 = ha1; const float pa0 = oa0, pa1 = oa1;
            if (n + 1 < NT) pa_issue(rB, ib0, ib1, tab, g);
            PA_PREF(n + 2, ia0, ia1, ha0, ha1, oa0, oa1);
            __builtin_amdgcn_sched_barrier(0);
            { const size_t t_ = (size_t)(wgi + n * wpg); pa_compute(rA, ca0, ca1, pa0, pa1, actp + t_ * 128 + k0, actp + t_ * 128 + k1, lane); }
            __builtin_amdgcn_sched_barrier(0);
            if (n + 1 < NT) {
                const v4u cb0 = hb0, cb1 = hb1; const float pb0 = ob0, pb1 = ob1;
                if (n + 2 < NT) pa_issue(rA, ia0, ia1, tab, g);
                PA_PREF(n + 3, ib0, ib1, hb0, hb1, ob0, ob1);
                __builtin_amdgcn_sched_barrier(0);
                { const size_t t_ = (size_t)(wgi + (n + 1) * wpg); pa_compute(rB, cb0, cb1, pb0, pb1, actp + t_ * 128 + k0, actp + t_ * 128 + k1, lane); }
                __builtin_amdgcn_sched_barrier(0);
            }
        }
#undef PA_PREF
    }
}
__device__ __forceinline__ void peer_w_phase(Frame& F, int l) {
    PHASE_TID(F);
    const int lane = F.lane;
    constexpr int WROW = 136;
    LAS bf16* wl = (LAS bf16*)F.lds; LAS bf16* il = wl + 64 * WROW;
    const int* IDX = WSP(int, WS_U); const float* GATE = WSP(float, WS_U + 8 * MiB); const float* actp = WSP(float, WS_AM);
    bf16* WT = WSP(bf16, WS_Y1); bf16* IT = WSP(bf16, WS_Y1 + 4 * MiB);
    const float* su = WSP(float, WS_SCL) + l * NEXP; const float* sv = WSP(float, WS_SCL) + (2 + l) * NEXP;
    for (int tb = F.vcu; tb < T / 64; tb += F.G) {
#pragma unroll 2
        for (int i = 0; i < 8; ++i) { const int tl = F.wave * 8 + i, t = tb * 64 + tl;
            const int e0 = IDX[(size_t)t * 128 + lane], e1 = IDX[(size_t)t * 128 + 64 + lane];
            float pa[8], pb[8];
#pragma unroll
            for (int xx = 0; xx < 8; ++xx) { pa[xx] = actp[((size_t)xx * T + t) * 128 + lane]; pb[xx] = actp[((size_t)xx * T + t) * 128 + 64 + lane]; }
            const float gt0 = GATE[(size_t)t * 128 + lane], gt1 = GATE[(size_t)t * 128 + 64 + lane];
            const float su0 = su[e0], su1 = su[e1], sv0 = sv[e0], sv1 = sv[e1];
            __builtin_amdgcn_sched_barrier(0);
            float a0 = ((pa[0] + pa[1]) + (pa[2] + pa[3])) + ((pa[4] + pa[5]) + (pa[6] + pa[7])), a1 = ((pb[0] + pb[1]) + (pb[2] + pb[3])) + ((pb[4] + pb[5]) + (pb[6] + pb[7]));
            a0 *= su0; a1 *= su1;
            const float g0 = gt0 * sv0, g1 = gt1 * sv1;
            wl[tl * WROW + lane] = __builtin_bit_cast(bf16, (_Float16)(256.0f * g0 * 0.5f * a0 * (1.0f + erff(a0 * 0.70710678118654752f)))); wl[tl * WROW + 64 + lane] = __builtin_bit_cast(bf16, (_Float16)(256.0f * g1 * 0.5f * a1 * (1.0f + erff(a1 * 0.70710678118654752f))));
            il[tl * WROW + lane] = (bf16)e0; il[tl * WROW + 64 + lane] = (bf16)e1; }
        __syncthreads();
#pragma unroll
        for (int i = 0; i < 2; ++i) { const int p_ = i * NTHR + F.tid, kq = p_ >> 6, tl = p_ & 63; const size_t o = ((size_t)(tb * 16 + kq) * 64 + tl) * 8;
            *(v4u*)(WT + o) = *(const LAS v4u*)(wl + tl * WROW + 8 * kq); *(v4u*)(IT + o) = *(const LAS v4u*)(il + tl * WROW + 8 * kq); }
        __syncthreads();
    }
}
__device__ __forceinline__ void pbl_load(v4u (&iv)[4], v4u (&wv)[4], const bf16* ip, const bf16* wp) {
#pragma unroll
    for (int q = 0; q < 4; ++q) { iv[q] = *(const v4u*)(ip + q * 512); wv[q] = *(const v4u*)(wp + q * 512); }
}
typedef _Float16 h16x2 __attribute__((ext_vector_type(2)));
#define FP8H_LO(w_) __builtin_bit_cast(h16x2, __builtin_amdgcn_cvt_scalef32_pk_f16_fp8((int)(w_), 1.0f, false))
#define FP8H_HI(w_) __builtin_bit_cast(h16x2, __builtin_amdgcn_cvt_scalef32_pk_f16_fp8((int)(w_), 1.0f, true))
__device__ __forceinline__ void pbl_compute(const v4u (&iv)[4], const v4u (&wv)[4], h16x2 (&acc)[4], LAS unsigned char* lds) {
#pragma unroll
    for (int q = 0; q < 4; ++q) { v2u d[8];
#pragma unroll
        for (int ki = 0; ki < 8; ++ki) { const unsigned ipair = iv[q][ki >> 1]; const unsigned idx = (ki & 1) ? (ipair >> 16) : (ipair & 0xffffu); d[ki] = *(const LAS v2u*)(lds + idx * 8); }
        __builtin_amdgcn_sched_barrier(0);
#pragma unroll
        for (int ki = 0; ki < 8; ++ki) { const unsigned wword = wv[q][ki >> 1], wb = (ki & 1) ? (wword >> 16) : (wword & 0xffffu); const h16x2 w2 = __builtin_bit_cast(h16x2, wb | (wb << 16));
            acc[0] = __builtin_elementwise_fma(FP8H_LO(d[ki].x), w2, acc[0]); acc[1] = __builtin_elementwise_fma(FP8H_HI(d[ki].x), w2, acc[1]); acc[2] = __builtin_elementwise_fma(FP8H_LO(d[ki].y), w2, acc[2]); acc[3] = __builtin_elementwise_fma(FP8H_HI(d[ki].y), w2, acc[3]); }
        __builtin_amdgcn_sched_barrier(0); }
}
__device__ __forceinline__ void peer_out_phase(Frame& F, int l) {
    PHASE_TID(F);
    const int lane = F.lane;
    const int x = blockIdx.x & 7, ib = blockIdx.x >> 3, j = 8 * (4 * x + (ib >> 3)) + (ib & 7);
    const bf16* WT = WSP(bf16, WS_Y1); const bf16* IT = WSP(bf16, WS_Y1 + 4 * MiB); bf16* OUT = WSP(bf16, WS_GC);
    for (int jj = (F.G == 256 ? j : (int)blockIdx.x); jj < 256; jj += (F.G == 256 ? 256 : F.G)) {
        const unsigned char* sl = WSP(unsigned char, WS_PV) + (size_t)(l * 256 + jj) * NEXP * 8;
#pragma unroll 4
        for (int i = 0; i < 16; ++i) { const int o = (i * NTHR + F.tid) * 16; *(LAS v4u*)(F.lds + o) = *(const v4u*)(sl + o); }
        __syncthreads();
        constexpr int NCH = 4 * (T / 64 / NWAVES);
#define PBL_PTR(c_, arr_) ((arr_) + ((size_t)(F.wave + NWAVES * ((c_) >> 2)) * 16 * 64 + lane) * 8 + ((c_) & 3) * 4 * 512)
        v4u iA[4], wA[4], iB[4], wB[4], iC[4], wC[4]; h16x2 acc[4];
#define PBL_STEP(X_, Z_, c_) do { const int cc_ = (c_); if (cc_ + 2 < NCH) pbl_load(i##Z_, w##Z_, PBL_PTR(cc_ + 2, IT), PBL_PTR(cc_ + 2, WT)); \
            __builtin_amdgcn_sched_barrier(0); \
            if ((cc_ & 3) == 0) { _Pragma("unroll") for (int q = 0; q < 4; ++q) acc[q] = (h16x2){(_Float16)0.f, (_Float16)0.f}; } \
            pbl_compute(i##X_, w##X_, acc, F.lds); \
            if ((cc_ & 3) == 3) { constexpr float us_ = 1.0f / 256.0f; v4u o; o.x = pk2((float)acc[0].x * us_, (float)acc[0].y * us_); o.y = pk2((float)acc[1].x * us_, (float)acc[1].y * us_); o.z = pk2((float)acc[2].x * us_, (float)acc[2].y * us_); o.w = pk2((float)acc[3].x * us_, (float)acc[3].y * us_); \
                *(v4u*)(OUT + (size_t)((F.wave + NWAVES * (cc_ >> 2)) * 64 + lane) * D + 8 * jj) = o; } \
            __builtin_amdgcn_sched_barrier(0); } while (0)
        pbl_load(iA, wA, PBL_PTR(0, IT), PBL_PTR(0, WT)); pbl_load(iB, wB, PBL_PTR(1, IT), PBL_PTR(1, WT));
#pragma unroll 1
        for (int c = 0; c < NCH; c += 3) {
            PBL_STEP(A, C, c);
            if (c + 1 < NCH) PBL_STEP(B, A, c + 1);
            if (c + 2 < NCH) PBL_STEP(C, B, c + 2);
        }
#undef PBL_STEP
#undef PBL_PTR
        __syncthreads();
    }
}
__device__ __forceinline__ void peer_res_phase(Frame& F, int l, bf16* XO) {
    PHASE_TID(F);
    const bool last = (l == 1);
    const int gw = F.vcu * NWAVES + F.wave, NGW = F.G * NWAVES, lane = F.lane;
    const bf16* XA = WSP(bf16, WS_XA); const bf16* OUTS = WSP(bf16, WS_GC); bf16* Hb = WSP(bf16, WS_H); const float* MOD = WSP(float, WS_MOD);
    int curb = -1; f32x4 g2q[8], gsq[8], shq[8];
    v2u xn[8], on[8];
#define PR_LOAD(t_) do { _Pragma("unroll") for (int jj = 0; jj < 8; ++jj) { const int col = 4 * lane + 256 * jj; xn[jj] = *(const v2u*)(XA + (size_t)(t_) * D + col); on[jj] = *(const v2u*)(OUTS + (size_t)(t_) * D + col); } } while (0)
    if (gw < T) PR_LOAD(gw);
    for (int t = gw; t < T; t += NGW) {
        const int b = t >> 13;
        if (b != curb) { curb = b; const float* g2 = MOD + (size_t)(l * 2 + b) * 12288 + 5 * 2048;
#pragma unroll
            for (int jj = 0; jj < 8; ++jj) g2q[jj] = *(const f32x4*)(g2 + 4 * lane + 256 * jj);
            if (!last) { const float* ng = F.A->in[I_N1G] + (size_t)(l + 1) * D; const float* mn = MOD + (size_t)((l + 1) * 2 + b) * 12288;
#pragma unroll
                for (int jj = 0; jj < 8; ++jj) { const f32x4 g4 = *(const f32x4*)(ng + 4 * lane + 256 * jj), sc4 = *(const f32x4*)(mn + 2048 + 4 * lane + 256 * jj); shq[jj] = *(const f32x4*)(mn + 4 * lane + 256 * jj); gsq[jj] = g4 * (sc4 + 1.0f); }
            } else { const float* fg = F.A->in[I_FG];
#pragma unroll
                for (int jj = 0; jj < 8; ++jj) gsq[jj] = *(const f32x4*)(fg + 4 * lane + 256 * jj); } }
        f32x4 v[8]; float ss = 0.f;
#pragma unroll
        for (int jj = 0; jj < 8; ++jj) { const f32x4 o = {bflo(on[jj].x), bfhi(on[jj].x), bflo(on[jj].y), bfhi(on[jj].y)}; v[jj] = (f32x4){bflo(xn[jj].x), bfhi(xn[jj].x), bflo(xn[jj].y), bfhi(xn[jj].y)};
            v[jj] = v[jj] + g2q[jj] * o; }
        if (t + NGW < T) PR_LOAD(t + NGW);
        __builtin_amdgcn_sched_barrier(0);
#pragma unroll
        for (int jj = 0; jj < 8; ++jj) ss += (v[jj].x * v[jj].x + v[jj].y * v[jj].y) + (v[jj].z * v[jj].z + v[jj].w * v[jj].w);
        const float rstd = 1.0f / sqrtf(wave_sum(ss) * (1.0f / D) + EPS);
        if (!last) {
#pragma unroll
            for (int jj = 0; jj < 8; ++jj) { const int col = 4 * lane + 256 * jj; v2u w; w.x = pk2(v[jj].x, v[jj].y); w.y = pk2(v[jj].z, v[jj].w); *(v2u*)(XO + (size_t)t * D + col) = w; v[jj] = v[jj] * rstd * gsq[jj] + shq[jj]; }
            row_to_fp8(v, (unsigned char*)Hb + (size_t)t * D, WSP(float, WS_SA) + t, lane);
        } else {
#pragma unroll
            for (int jj = 0; jj < 8; ++jj) *(f32x4*)(F.out + (size_t)t * D + 4 * lane + 256 * jj) = v[jj] * rstd * gsq[jj];
        }
    }
#undef PR_LOAD
}

#ifndef MK_ONE_LAUNCH
#define MK_ONE_LAUNCH 1
#endif
#define PG8_ALIGN true
#define PG8_SP2 true
constexpr int PH_PER_LAYER = 13, N_PHASES = 1 + 2 * PH_PER_LAYER;
__global__ void __launch_bounds__(NTHR, 2) fwd(Args args) {
    extern __shared__ __attribute__((aligned(16))) unsigned char lds[];
    Frame F;
    F.lds = (LAS unsigned char*)lds; F.MISC = (volatile LAS unsigned*)(F.lds + MISC_OFF);
    F.tid = threadIdx.x; F.lane = F.tid & 63; F.wave = __builtin_amdgcn_readfirstlane(F.tid >> 6);
    F.G = gridDim.x; { const int bx = blockIdx.x; F.vcu = (F.G % 8 == 0) ? (bx % 8) * (F.G / 8) + bx / 8 : bx; }
    F.A = &args;
    F.out = args.out; F.ws = args.ws; F.ctl = (gu32*)(args.ws + WS_CTL);
    for (int u = F.tid; u < (LDS_BYTES - LDSCTL_OFF) / 4; u += NTHR) ((LAS unsigned*)(F.lds + LDSCTL_OFF))[u] = 0u;
    __syncthreads();
#if MK_ONE_LAUNCH
    XcdBarrier bar = xcd_barrier_post((unsigned*)(F.ctl + CW_BAR), F.MISC + 8);
#define GRID_BAR() xcd_barrier(bar)
#else
#define GRID_BAR() do { } while (0)
#endif
    const int lo = args.ph_lo, hi = args.ph_hi;
#define IN(k) (lo <= (k) && (k) < hi)
#define SEAM(k) do { if (IN(k) && IN((k) + 1)) GRID_BAR(); } while (0)
    float* MOD = WSP(float, WS_MOD);
    pg8::bf16_t* Hb = WSP(pg8::bf16_t, WS_H);

    if (IN(0)) { p0_prologue(F); SEAM(0); }
    for (int l = 0; l < 2; ++l) {
        const int pb = 1 + PH_PER_LAYER * l;
        const float* modl = MOD + (size_t)l * 2 * 12288;
        if (IN(pb + 0) && l == 0) { norm_phase<true, false>(F, F.A->in[I_X], WSP(bf16, WS_H), F.A->in[I_N1G], modl, 0, 1);
            win8_phase(F);
            SEAM(pb + 0); }
        if (IN(pb + 1)) {
            pg8::Gemm g{Hb, (const pg8::bf16_t*)(WSP(unsigned char, WS_WIN) + (size_t)l * IN_DIM * 2048), T, IN_DIM, D / 2, D / 2, D / 2}; pg8::StaticOrder S; S.init(T, IN_DIM, F.G, (int)blockIdx.x);
            const float wmax = __uint_as_float(__hip_atomic_load(F.ctl + CW_WMAX + l, __ATOMIC_RELAXED, __HIP_MEMORY_SCOPE_AGENT));
            pg8::EpiInProj E{WSP(pg8::bf16_t, WS_U), WSP(pg8::bf16_t, WS_Q), WSP(pg8::bf16_t, WS_K), WSP(pg8::bf16_t, WS_V), WSP(pg8::bf16_t, WS_GC), WSP(pg8::bf16_t, WS_GA), WSP(float, WS_SA), wmax > 0.f ? wmax * (1.0f / 440.0f) : 1.0f, (unsigned*)(F.ctl + CW_VMAX + 2 * l)};
            pg8::gemm_phase<pg8::EpiInProj, pg8::StaticOrder, PG8_ALIGN, PG8_SP2, true>(F.lds, g, S, E);
            SEAM(pb + 1);
        }
        if (IN(pb + 2)) { conv_phase(F, l); __syncthreads(); attn_phase(F, l); SEAM(pb + 2); }
        if (IN(pb + 3)) {
            pg8::Gemm g{WSP(pg8::bf16_t, WS_AM), (const pg8::bf16_t*)(WSP(unsigned char, WS_WM) + (size_t)l * 2048 * 2048), T, D, D / 2, D / 2, D / 2}; pg8::StaticOrder S; S.init(T, D, F.G, (int)blockIdx.x);
            const float i440 = 1.0f / 440.0f;
            const float wc_ = __uint_as_float(__hip_atomic_load(F.ctl + CW_WMAX2 + 2 * l, __ATOMIC_RELAXED, __HIP_MEMORY_SCOPE_AGENT)), wa_ = __uint_as_float(__hip_atomic_load(F.ctl + CW_WMAX2 + 2 * l + 1, __ATOMIC_RELAXED, __HIP_MEMORY_SCOPE_AGENT));
            const float bc_ = __uint_as_float(__hip_atomic_load(F.ctl + CW_BC + l, __ATOMIC_RELAXED, __HIP_MEMORY_SCOPE_AGENT));
            const float swc = wc_ > 0.f ? wc_ * i440 : 1.0f, swa = wa_ > 0.f ? wa_ * i440 : 1.0f, sc = bc_ * i440;
            const float vm0 = __uint_as_float(__hip_atomic_load(F.ctl + CW_VMAX + 2 * l, __ATOMIC_RELAXED, __HIP_MEMORY_SCOPE_AGENT)), vm1 = __uint_as_float(__hip_atomic_load(F.ctl + CW_VMAX + 2 * l + 1, __ATOMIC_RELAXED, __HIP_MEMORY_SCOPE_AGENT));
            const float fe0 = (vm0 > 0.f ? 1.02f * vm0 * i440 : 1.0f) * swa, fe1 = (vm1 > 0.f ? 1.02f * vm1 * i440 : 1.0f) * swa;
            const float bc2 = __uint_as_float(__hip_atomic_load(F.ctl + CW_BC2 + l, __ATOMIC_RELAXED, __HIP_MEMORY_SCOPE_AGENT));
            const float bm0 = fmaxf(1024.0f * (bc2 * wc_ + 1.02f * vm0 * wa_), 1e-20f), bm1 = fmaxf(1024.0f * (bc2 * wc_ + 1.02f * vm1 * wa_), 1e-20f);
            pg8::EpiMerge E{WSP(pg8::bf16_t, WS_GC), WSP(pg8::bf16_t, WS_GA), WSP(unsigned char, WS_H), (sc * swc) / fe0, (sc * swc) / fe1, fe0 * (440.0f / bm0), fe1 * (440.0f / bm1)};
            pg8::gemm_phase<pg8::EpiMerge, pg8::StaticOrder, PG8_ALIGN, PG8_SP2, true>(F.lds, g, S, E);
            SEAM(pb + 3);
        }
        if (IN(pb + 5)) {
            pg8::Gemm g{Hb, (const pg8::bf16_t*)(WSP(unsigned char, WS_WO) + (size_t)l * 2048 * 2048), T, D, D / 2, D / 2, D / 2}; pg8::StaticOrder S; S.init(T, D, F.G, (int)blockIdx.x);
            const float i440 = 1.0f / 440.0f;
            const float wc_ = __uint_as_float(__hip_atomic_load(F.ctl + CW_WMAX2 + 2 * l, __ATOMIC_RELAXED, __HIP_MEMORY_SCOPE_AGENT)), wa_ = __uint_as_float(__hip_atomic_load(F.ctl + CW_WMAX2 + 2 * l + 1, __ATOMIC_RELAXED, __HIP_MEMORY_SCOPE_AGENT));
            const float wo_ = __uint_as_float(__hip_atomic_load(F.ctl + CW_WMAX3 + l, __ATOMIC_RELAXED, __HIP_MEMORY_SCOPE_AGENT)), swo = wo_ > 0.f ? wo_ * i440 : 1.0f;
            const float bc2 = __uint_as_float(__hip_atomic_load(F.ctl + CW_BC2 + l, __ATOMIC_RELAXED, __HIP_MEMORY_SCOPE_AGENT));
            const float vm0 = __uint_as_float(__hip_atomic_load(F.ctl + CW_VMAX + 2 * l, __ATOMIC_RELAXED, __HIP_MEMORY_SCOPE_AGENT)), vm1 = __uint_as_float(__hip_atomic_load(F.ctl + CW_VMAX + 2 * l + 1, __ATOMIC_RELAXED, __HIP_MEMORY_SCOPE_AGENT));
            const float bm0 = fmaxf(1024.0f * (bc2 * wc_ + 1.02f * vm0 * wa_), 1e-20f), bm1 = fmaxf(1024.0f * (bc2 * wc_ + 1.02f * vm1 * wa_), 1e-20f);
            if (l == 0) { pg8::EpiResid<false> E{F.A->in[I_X], WSP(pg8::bf16_t, WS_XA), modl + 2 * 2048, bm0 * i440 * swo, bm1 * i440 * swo};
                pg8::gemm_phase<pg8::EpiResid<false>, pg8::StaticOrder, PG8_ALIGN, PG8_SP2, true>(F.lds, g, S, E); }
            else { pg8::EpiResid<true> E{WSP(pg8::bf16_t, WS_XA), WSP(pg8::bf16_t, WS_XA), modl + 2 * 2048, bm0 * i440 * swo, bm1 * i440 * swo};
                pg8::gemm_phase<pg8::EpiResid<true>, pg8::StaticOrder, PG8_ALIGN, PG8_SP2, true>(F.lds, g, S, E); }
            SEAM(pb + 5);
        }
        if (IN(pb + 6)) { norm_phase<false, true>(F, WSP(bf16, WS_XA), WSP(bf16, WS_H), F.A->in[I_N2G] + (size_t)l * D, modl, 3, 4); SEAM(pb + 6); }
        if (IN(pb + 7)) {
            pg8::Gemm g{Hb, WSP(pg8::bf16_t, WS_WP) + (size_t)l * 2048 * 2048, T, D, D, D, D}; pg8::StaticOrder S; S.init(T, D, F.G, (int)blockIdx.x);
            pg8::EpiF16 E{WSP(_Float16, WS_GC), D};
            pg8::gemm_phase<pg8::EpiF16, pg8::StaticOrder, PG8_ALIGN, PG8_SP2>(F.lds, g, S, E);
            SEAM(pb + 7);
        }
        if (IN(pb + 8)) { topk_phase(F); SEAM(pb + 8); }
        if (IN(pb + 9)) { peer_act_phase(F, l); SEAM(pb + 9); }
        if (IN(pb + 10)) { peer_w_phase(F, l); SEAM(pb + 10); }
        if (IN(pb + 11)) { peer_out_phase(F, l); SEAM(pb + 11); }
        if (IN(pb + 12)) { peer_res_phase(F, l, WSP(bf16, WS_XA)); SEAM(pb + 12); }
    }
#undef IN
#undef SEAM
}

extern "C" void kernel_launch(void* const* d_in, const int* in_sizes, int n_in, void* d_out, int out_size, void* d_ws, size_t ws_size, hipStream_t stream) {
    static int grid = 0;
    if (grid == 0) {
        if (n_in != N_IN || out_size != T * D || ws_size < WS_END) { fprintf(stderr, "kernel_launch: unexpected problem: n_in %d out %d ws %zu (need %zu)\n", n_in, out_size, ws_size, (size_t)WS_END); grid = -1; return; }
        int dev = 0, cus = 0, per_cu = 0;
        if (hipGetDevice(&dev) != hipSuccess || hipDeviceGetAttribute(&cus, hipDeviceAttributeMultiprocessorCount, dev) != hipSuccess) { grid = -1; return; }
        if (hipFuncSetAttribute((const void*)fwd, hipFuncAttributeMaxDynamicSharedMemorySize, LDS_BYTES) != hipSuccess) { fprintf(stderr, "kernel_launch: hipFuncSetAttribute failed\n"); grid = -1; return; }
        if (hipOccupancyMaxActiveBlocksPerMultiprocessor(&per_cu, (const void*)fwd, NTHR, LDS_BYTES) != hipSuccess || per_cu < 1) fprintf(stderr, "kernel_launch: occupancy query reports %d\n", per_cu);
        (void)hipGetLastError();
        grid = cus;
    }
    if (grid < 0) return;
    (void)in_sizes;
    if (hipMemsetAsync((char*)d_ws + WS_CTL, 0, CTL_ZERO_BYTES, stream) != hipSuccess) return;
    Args a{};
    for (int i = 0; i < N_IN; ++i) a.in[i] = (const float*)d_in[i];
    a.out = (float*)d_out; a.ws = (unsigned char*)d_ws;
#if MK_ONE_LAUNCH
    a.ph_lo = 0; a.ph_hi = N_PHASES;
    hipLaunchKernelGGL(fwd, dim3(grid), dim3(NTHR), LDS_BYTES, stream, a);
#else
    for (int p = 0; p < N_PHASES; ++p) {
        if (p == 1 + PH_PER_LAYER) continue;
        a.ph_lo = p; a.ph_hi = p + 1;
        hipLaunchKernelGGL(fwd, dim3(grid), dim3(NTHR), LDS_BYTES, stream, a);
    }
#endif
}
```

```cpp
#include <hip/hip_runtime.h>
#include <cstdio>
#include <cstdint>
namespace pg8 {
#define PG8_LAS __attribute__((address_space(3)))
typedef unsigned short bf16_t;
typedef short bf16x8 __attribute__((ext_vector_type(8)));
typedef float f32x4 __attribute__((ext_vector_type(4)));
typedef unsigned u32x4 __attribute__((ext_vector_type(4)));
typedef int i32x4 __attribute__((ext_vector_type(4)));
typedef int i32x8 __attribute__((ext_vector_type(8)));
__device__ __forceinline__ i32x8 cat8(const bf16x8& a, const bf16x8& b) { const i32x4 x = __builtin_bit_cast(i32x4, a), y = __builtin_bit_cast(i32x4, b); return (i32x8){x[0], x[1], x[2], x[3], y[0], y[1], y[2], y[3]}; }
constexpr int BM = 256, BK = 64, HALF = 128, HTB = HALF * BK * 2  , STAGE_BYTES = 8 * HTB, NXCD = 8, WGM = 4;

__host__ __device__ __forceinline__ int lds_byte(int r, int c) { const int st = (r >> 4) * 2 + (c >> 5), rr = r & 15, cc = c & 31, ob = rr * 64 + cc * 2; return st * 1024 + (ob ^ (((ob >> 9) & 1) << 5)); }
__host__ __device__ __forceinline__ void stage_rc(int b, int& R, int& C) { const int st = b / 1024, sb = b % 1024, swz = sb ^ (((sb >> 9) & 1) << 5); R = (st >> 1) * 16 + swz / 64; C = (st & 1) * 32 + (swz % 64) / 2; }
__host__ __device__ __forceinline__ int perm32(int rho) { const int n = rho >> 4, i = rho & 15; return 8 * (i >> 2) + 4 * n + (i & 3); }

struct Unit { int pm, pn; };
struct Gemm { const bf16_t* A; const bf16_t* Bt; int M, N, K, lda, ldb; };

struct StaticOrder {
    int nM, nN, nwg, G, c, wgm;
    __host__ __device__ void init(int M, int N, int G_, int c_, int wgm_ = WGM) { nM = M / BM; nN = N / BM; nwg = nM * nN; G = G_; c = c_; wgm = wgm_; }
    __host__ __device__ bool next(int i, Unit& u) const {
        const long L = (long)i * G + c; if (L >= nwg) return false;
        int wgid = (int)L; { const int q = nwg / NXCD, r = nwg % NXCD, xcd = wgid % NXCD, off = wgid / NXCD; wgid = (xcd < r ? xcd * (q + 1) : r * (q + 1) + (xcd - r) * q) + off; }
        const int nig = wgm * nN, gid = wgid / nig, fm = gid * wgm, gsz = (nM - fm) < wgm ? (nM - fm) : wgm;
        u.pm = fm + ((wgid % nig) % gsz); u.pn = (wgid % nig) / gsz; return true;
    }
    __device__ __forceinline__ void a_ready(const Unit&) const {}
    __device__ __forceinline__ void done(const Unit&) const {}
};

__device__ __forceinline__ unsigned cvt_pk_bf16(float lo, float hi) { unsigned r; asm volatile("v_cvt_pk_bf16_f32 %0, %1, %2" : "=v"(r) : "v"(lo), "v"(hi)); return r; }
typedef float f32x2 __attribute__((ext_vector_type(2)));
template <class Epi, class Sched, bool ALIGN_EPI = false, bool SP2 = false, bool FP8 = false>
__device__ __forceinline__ void gemm_phase(PG8_LAS unsigned char* lds, const Gemm g, const Sched& S, const Epi& E) {
    int tid_ = threadIdx.x; asm volatile("" : "+v"(tid_));
    const int tid = tid_, wid = __builtin_amdgcn_readfirstlane(tid >> 6), lane = tid & 63, wr = wid >> 2, wc = wid & 3, fr = lane & 15, fq = lane >> 4;
    const int K = g.K, nt = K / BK;
    unsigned voffA[2], voffB[2];
#pragma unroll
    for (int i = 0; i < 2; ++i) { int R, C; stage_rc(tid * 16 + i * 8192, R, C); const int Rb = Epi::PERM ? ((R & ~31) + perm32(R & 31)) : R;
        voffA[i] = (unsigned)(R * g.lda + C) * 2u; voffB[i] = (unsigned)(Rb * g.ldb + C) * 2u; }
    const size_t kstep = (size_t)(BK * 2);
    const size_t hstepA = (size_t)HALF * g.lda * 2, hstepB = (size_t)HALF * g.ldb * 2;
    const size_t tstepA = 2 * hstepA, tstepB = 2 * hstepB;
    const unsigned ldsw = (unsigned)wid * 1024u;
    const int aoff = lds_byte(wr * 64 + fr, fq * 8), boff = lds_byte(wc * 32 + fr, fq * 8);
#define PG8_SA(b, h) (((b) * 2 + (h)) * HTB)
#define PG8_SB(b, h) ((4 + (b) * 2 + (h)) * HTB)
#define PG8_STAGE(bufoff, gbase, voff) do { _Pragma("unroll") for (int _i = 0; _i < 2; ++_i) \
        __builtin_amdgcn_global_load_lds((const unsigned*)((const char*)(gbase) + (voff)[_i]), (PG8_LAS unsigned*)(lds + (bufoff) + ldsw + _i * 8192), 16, 0, 0); } while (0)
#define PG8_LDA(dst, b, h) do { _Pragma("unroll") for (int m = 0; m < 4; ++m) _Pragma("unroll") for (int k = 0; k < 2; ++k) dst[m][k] = *(const PG8_LAS bf16x8*)(lds + PG8_SA(b, h) + aoff + m * 2048 + k * 1024); } while (0)
#define PG8_LDB(dst, b, h) do { _Pragma("unroll") for (int n = 0; n < 2; ++n) _Pragma("unroll") for (int k = 0; k < 2; ++k) dst[n][k] = *(const PG8_LAS bf16x8*)(lds + PG8_SB(b, h) + boff + n * 2048 + k * 1024); } while (0)
#define PG8_MMA(ai, bj, At, Bt) do { __builtin_amdgcn_s_setprio(1); _Pragma("unroll") for (int m = 0; m < 4; ++m) _Pragma("unroll") for (int n = 0; n < 2; ++n) { \
        if constexpr (FP8) { asm volatile("v_mfma_f32_16x16x128_f8f6f4 %0, %1, %2, %0" : "+v"(acc[ai][bj][m][n]) : "v"(cat8(Bt[n][0], Bt[n][1])), "v"(cat8(At[m][0], At[m][1]))); } \
        else { _Pragma("unroll") for (int k = 0; k < 2; ++k) acc[ai][bj][m][n] = __builtin_amdgcn_mfma_f32_16x16x32_bf16(Bt[n][k], At[m][k], acc[ai][bj][m][n], 0, 0, 0); } } __builtin_amdgcn_s_setprio(0); } while (0)
#define PG8_WAIT_V(n) asm volatile("s_waitcnt vmcnt(" #n ")" ::: "memory")
#define PG8_WAIT_L(n) asm volatile("s_waitcnt lgkmcnt(" #n ")" ::: "memory")
#define PG8_BAR __builtin_amdgcn_s_barrier()
#define PG8_SCHED __builtin_amdgcn_sched_barrier(0)
    Unit cur, nxt; int ui = 0;
    if (!S.next(0, cur)) return;
    f32x4 acc[2][2][4][2];
#pragma unroll
    for (int a = 0; a < 2; ++a)
#pragma unroll
        for (int b = 0; b < 2; ++b)
#pragma unroll
            for (int m = 0; m < 4; ++m)
#pragma unroll
                for (int n = 0; n < 2; ++n) acc[a][b][m][n] = (f32x4){0.f, 0.f, 0.f, 0.f};
    bf16x8 At[4][2], B0[2][2], B1[2][2];
    const char* cA = (const char*)g.A + (size_t)cur.pm * tstepA; const char* cB = (const char*)g.Bt + (size_t)cur.pn * tstepB;
    S.a_ready(cur);
    if constexpr (SP2) {
        PG8_STAGE(PG8_SB(0, 0), cB, voffB); PG8_STAGE(PG8_SB(0, 1), cB + hstepB, voffB); PG8_STAGE(PG8_SA(0, 0), cA, voffA); PG8_STAGE(PG8_SA(0, 1), cA + hstepA, voffA);
        if (wr == 1) PG8_BAR;
        PG8_WAIT_V(2); PG8_BAR;
        PG8_STAGE(PG8_SB(1, 0), cB + kstep, voffB); PG8_STAGE(PG8_SA(1, 0), cA + kstep, voffA); PG8_STAGE(PG8_SB(1, 1), cB + hstepB + kstep, voffB);
        PG8_WAIT_V(6); PG8_BAR;
    } else {
        PG8_STAGE(PG8_SB(0, 0), cB, voffB); PG8_STAGE(PG8_SA(0, 0), cA, voffA); PG8_STAGE(PG8_SB(0, 1), cB + hstepB, voffB); PG8_STAGE(PG8_SA(0, 1), cA + hstepA, voffA);
        if (wr == 1) PG8_BAR;
        PG8_WAIT_V(4); PG8_BAR;
        PG8_STAGE(PG8_SB(1, 0), cB + kstep, voffB); PG8_STAGE(PG8_SA(1, 0), cA + kstep, voffA); PG8_STAGE(PG8_SB(1, 1), cB + hstepB + kstep, voffB);
        PG8_WAIT_V(6); PG8_BAR;
    }
    for (;;) {
        const bool has_next = S.next(ui + 1, nxt);
        const char* nA = has_next ? (const char*)g.A + (size_t)nxt.pm * tstepA : cA; const char* nB = has_next ? (const char*)g.Bt + (size_t)nxt.pn * tstepB : cB;
        for (int t = 0; t < nt; t += 2) {
            if constexpr (Epi::HAS_MID) { if (t == (nt >> 1)) { if constexpr (FP8) { asm volatile("s_nop 15\n\ts_nop 15" ::: "memory"); }
                E.mid(acc, cur, wr, wc, fr, fq); } }
            const bool last = (t == nt - 2);
            const char* a1 = cA + (size_t)(t + 1) * kstep;
            const char* a2 = last ? nA : cA + (size_t)(t + 2) * kstep; const char* b2 = last ? nB : cB + (size_t)(t + 2) * kstep;
            const char* a3 = a2 + kstep; const char* b3 = b2 + kstep;
            if (last && has_next) S.a_ready(nxt);
            if constexpr (SP2) {
            PG8_LDB(B0, 0, 0); PG8_LDB(B1, 0, 1); PG8_SCHED; PG8_LDA(At, 0, 0); PG8_STAGE(PG8_SA(1, 1), a1 + hstepA, voffA);
            PG8_WAIT_V(8); PG8_WAIT_L(0); PG8_BAR; PG8_MMA(0, 0, At, B0); PG8_MMA(0, 1, At, B1); PG8_BAR; PG8_SCHED;
            PG8_LDA(At, 0, 1); PG8_STAGE(PG8_SB(0, 0), b2, voffB); PG8_STAGE(PG8_SB(0, 1), b2 + hstepB, voffB); PG8_STAGE(PG8_SA(0, 0), a2, voffA);
            PG8_WAIT_V(8); PG8_WAIT_L(0); PG8_BAR; PG8_MMA(1, 0, At, B0); PG8_MMA(1, 1, At, B1); PG8_BAR; PG8_SCHED;
            PG8_LDB(B0, 1, 0); PG8_LDB(B1, 1, 1); PG8_SCHED; PG8_LDA(At, 1, 0); PG8_STAGE(PG8_SA(0, 1), a2 + hstepA, voffA);
            PG8_WAIT_V(8); PG8_WAIT_L(0); PG8_BAR; PG8_MMA(0, 0, At, B0); PG8_MMA(0, 1, At, B1); PG8_BAR; PG8_SCHED;
            PG8_LDA(At, 1, 1); PG8_STAGE(PG8_SB(1, 0), b3, voffB); PG8_STAGE(PG8_SB(1, 1), b3 + hstepB, voffB); PG8_STAGE(PG8_SA(1, 0), a3, voffA);
            PG8_WAIT_V(8); PG8_WAIT_L(0); PG8_BAR; PG8_MMA(1, 0, At, B0); PG8_MMA(1, 1, At, B1); PG8_BAR; PG8_SCHED;
            } else {
            PG8_LDB(B0, 0, 0); PG8_SCHED; PG8_LDA(At, 0, 0); PG8_STAGE(PG8_SA(1, 1), a1 + hstepA, voffA);
            PG8_WAIT_L(8); PG8_BAR; PG8_WAIT_L(0); PG8_MMA(0, 0, At, B0); PG8_BAR; PG8_SCHED;
            PG8_LDB(B1, 0, 1); PG8_STAGE(PG8_SB(0, 0), b2, voffB);
            PG8_BAR; PG8_WAIT_L(0); PG8_MMA(0, 1, At, B1); PG8_BAR;
            PG8_LDA(At, 0, 1); PG8_STAGE(PG8_SA(0, 0), a2, voffA);
            PG8_BAR; PG8_WAIT_L(0); PG8_MMA(1, 0, At, B0); PG8_BAR; PG8_SCHED;
            PG8_STAGE(PG8_SB(0, 1), b2 + hstepB, voffB);
            PG8_WAIT_V(6); PG8_BAR; PG8_MMA(1, 1, At, B1); PG8_BAR;
            PG8_LDB(B0, 1, 0); PG8_SCHED; PG8_LDA(At, 1, 0); PG8_STAGE(PG8_SA(0, 1), a2 + hstepA, voffA);
            PG8_WAIT_L(8); PG8_BAR; PG8_WAIT_L(0); PG8_MMA(0, 0, At, B0); PG8_BAR; PG8_SCHED;
            PG8_LDB(B1, 1, 1); PG8_STAGE(PG8_SB(1, 0), b3, voffB);
            PG8_BAR; PG8_WAIT_L(0); PG8_MMA(0, 1, At, B1); PG8_BAR;
            PG8_LDA(At, 1, 1); PG8_STAGE(PG8_SA(1, 0), a3, voffA);
            PG8_BAR; PG8_WAIT_L(0); PG8_MMA(1, 0, At, B0); PG8_BAR; PG8_SCHED;
            PG8_STAGE(PG8_SB(1, 1), b3 + hstepB, voffB);
            PG8_WAIT_V(6); PG8_BAR; PG8_MMA(1, 1, At, B1); PG8_BAR;
            }
        }
        if constexpr (FP8) { asm volatile("s_nop 15\n\ts_nop 15" ::: "memory"); }
        if constexpr (ALIGN_EPI) { if (wr == 0) PG8_BAR; }
        if constexpr (!Epi::AFTER_DRAIN) { E(acc, cur, wr, wc, fr, fq); S.done(cur); }
        if (!has_next) break;
#pragma unroll
        for (int a = 0; a < 2; ++a)
#pragma unroll
            for (int b = 0; b < 2; ++b)
#pragma unroll
                for (int m = 0; m < 4; ++m)
#pragma unroll
                    for (int n = 0; n < 2; ++n) acc[a][b][m][n] = (f32x4){0.f, 0.f, 0.f, 0.f};
        cur = nxt; cA = nA; cB = nB; ++ui;
        if constexpr (ALIGN_EPI) { if (wr == 1) PG8_BAR; }
    }
    PG8_WAIT_V(0);
    if constexpr (!ALIGN_EPI) { if (wr == 0) PG8_BAR; }
    PG8_BAR;
    if constexpr (Epi::AFTER_DRAIN) { E.fused(acc, cur, wr, wc, fr, fq, lds, wid, lane); S.done(cur); }
#undef PG8_SA
#undef PG8_SB
#undef PG8_STAGE
#undef PG8_LDA
#undef PG8_LDB
#undef PG8_MMA
#undef PG8_WAIT_V
#undef PG8_WAIT_L
#undef PG8_BAR
#undef PG8_SCHED
}
}

constexpr int T = 16384, D = 2048, SEQ = 8192, CONV = 1024, CWID = 31, NHEAD = 16, NKVH = 4, HD = 64, ATT = 1024, KVD = 256, IN_DIM = 7680, NEXP = 16384, PHEADS = 8, TOPK = 16;
constexpr float EPS = 1e-6f;
constexpr int NSL = 16, SLW = 128;
constexpr int NWAVES = 8, NTHR = NWAVES * 64;
enum { I_X = 0, I_C, I_RELB, I_ADAW, I_ADAB, I_N1G, I_WIN, I_DWW, I_DWB, I_CLNG, I_CLNB, I_WCO, I_SINK, I_WAO, I_WOUT, I_N2G, I_WPQ, I_SK, I_PU, I_PV, I_FG, N_IN };

constexpr size_t MiB = 1u << 20;
constexpr size_t WS_CTL = 0, CTL_ZERO_BYTES = 1 * MiB;
constexpr size_t WS_MOD = 1 * MiB;
constexpr size_t WS_BIAS = 1 * MiB + 512 * 1024;
constexpr size_t WS_SCL = 1 * MiB + 640 * 1024;
constexpr size_t WS_WIN = 2 * MiB;
constexpr size_t WS_SA = 1 * MiB + 896 * 1024;
constexpr size_t WS_WM = 62 * MiB;
constexpr size_t WS_WO = 78 * MiB;
constexpr size_t WS_WP = 94 * MiB;
constexpr size_t WS_PU = 110 * MiB;
constexpr size_t WS_PV = 238 * MiB;
constexpr size_t WS_H = 366 * MiB;
constexpr size_t WS_U = 430 * MiB;
constexpr size_t WS_Q = 462 * MiB;
constexpr size_t WS_K = 494 * MiB;
constexpr size_t WS_V = 502 * MiB;
constexpr size_t WS_GC = 510 * MiB;
constexpr size_t WS_GA = 574 * MiB;
constexpr size_t WS_AM = 638 * MiB;
constexpr size_t WS_Y1 = 702 * MiB;
constexpr size_t WS_XA = 766 * MiB;
constexpr size_t WS_END = 894 * MiB;
constexpr int CW_TMO = 0, CW_QUEUE = 64, CW_QUEUE2 = 128, CW_WMAX = 192, CW_WMAX2 = 194, CW_WMAX3 = 198, CW_VMAX = 200, CW_BC = 204, CW_BC2 = 206, CW_BAR = 4096;

constexpr int RING_BYTES = 131072, LDSCTL_OFF = RING_BYTES, MISC_OFF = LDSCTL_OFF + 320, LDS_BYTES = 147456;

#define GAS __attribute__((address_space(1)))
#define LAS __attribute__((address_space(3)))
typedef unsigned short bf16;
typedef unsigned v4u __attribute__((ext_vector_type(4)));
typedef unsigned v2u __attribute__((ext_vector_type(2)));
typedef float f32x4 __attribute__((ext_vector_type(4)));
typedef float f32x2 __attribute__((ext_vector_type(2)));
typedef float f32x16 __attribute__((ext_vector_type(16)));
typedef short bf16x8 __attribute__((ext_vector_type(8)));
typedef __bf16 bf16x2v __attribute__((ext_vector_type(2)));
typedef GAS unsigned gu32;
#define LDS_WAIT() asm volatile("s_waitcnt lgkmcnt(0)" ::: "memory")
#define VM_WAIT() asm volatile("s_waitcnt vmcnt(0)" ::: "memory")
__device__ __forceinline__ unsigned f2bf(float f) { unsigned u = __builtin_bit_cast(unsigned, f); return (u + 0x7fffu + ((u >> 16) & 1u)) >> 16; }
__device__ __forceinline__ unsigned pk2(float lo, float hi) { f32x2 v = {lo, hi}; bf16x2v b = __builtin_convertvector(v, bf16x2v); return __builtin_bit_cast(unsigned, b); }
__device__ __forceinline__ float bflo(unsigned p) { return __uint_as_float(p << 16); }
__device__ __forceinline__ float bfhi(unsigned p) { return __uint_as_float(p & 0xffff0000u); }
__device__ __forceinline__ float sigmoidf_(float x) { return __builtin_amdgcn_rcpf(1.0f + __expf(-x)); }
__device__ __forceinline__ float dot2bf(unsigned a, unsigned b, float c) { return __builtin_amdgcn_fdot2_f32_bf16(__builtin_bit_cast(bf16x2v, a), __builtin_bit_cast(bf16x2v, b), c, false); }
__device__ __forceinline__ float wave_sum(float v) {
#pragma unroll
    for (int o = 1; o < 64; o <<= 1) v += __shfl_xor(v, o);
    return v;
}

template <int CTRL> __device__ __forceinline__ float dpp_mov(float v) { return __builtin_bit_cast(float, __builtin_amdgcn_update_dpp(0, __builtin_bit_cast(int, v), CTRL, 0xf, 0xf, true)); }
__device__ __forceinline__ float lane_xor1(float v) { return dpp_mov<0xB1>(v); }
__device__ __forceinline__ float lane_xor2(float v) { return dpp_mov<0x4E>(v); }
__device__ __forceinline__ float lane_xor4(float v) { return dpp_mov<0x141>(dpp_mov<0x1B>(v)); }
__device__ __forceinline__ float lane_xor8(float v) { return dpp_mov<0x128>(v); }
__device__ __forceinline__ float lane_xor16(float v) { return __builtin_bit_cast(float, __builtin_amdgcn_ds_swizzle(__builtin_bit_cast(int, v), 0x401F)); }

namespace pg8 {
__device__ __forceinline__ float sigm(float x) { return __builtin_amdgcn_rcpf(1.0f + __expf(-x)); }
__device__ __forceinline__ u32x4 pack8(const f32x4& v0, const f32x4& v1) { u32x4 w; w.x = cvt_pk_bf16(v0[0], v0[1]); w.y = cvt_pk_bf16(v0[2], v0[3]); w.z = cvt_pk_bf16(v1[0], v1[1]); w.w = cvt_pk_bf16(v1[2], v1[3]); return w; }
__device__ __forceinline__ float blo(unsigned p) { return __uint_as_float(p << 16); }
__device__ __forceinline__ float bhi(unsigned p) { return __uint_as_float(p & 0xffff0000u); }
struct EpiInProj {
    static constexpr bool PERM = true, AFTER_DRAIN = false, HAS_MID = false;
    bf16_t *U, *Q, *K, *V, *GC, *GA; const float* sa; float sw; unsigned* vmax;
    __device__ __forceinline__ void operator()(const f32x4 (&acc)[2][2][4][2], const Unit& u, int wr, int wc, int fr, int fq) const {
        const int row0 = u.pm * BM + wr * 64 + fr, cw = wc * 32 + 8 * fq, pn = u.pn;
        float rsv[2][4];
        { const float* sp = sa + row0;
          asm volatile("global_load_dword %0, %8, off\n\tglobal_load_dword %1, %8, off offset:64\n\tglobal_load_dword %2, %8, off offset:128\n\tglobal_load_dword %3, %8, off offset:192\n\t"
                       "global_load_dword %4, %8, off offset:512\n\tglobal_load_dword %5, %8, off offset:576\n\tglobal_load_dword %6, %8, off offset:640\n\tglobal_load_dword %7, %8, off offset:704\n\ts_waitcnt vmcnt(0)"
                       : "=&v"(rsv[0][0]), "=&v"(rsv[0][1]), "=&v"(rsv[0][2]), "=&v"(rsv[0][3]), "=&v"(rsv[1][0]), "=&v"(rsv[1][1]), "=&v"(rsv[1][2]), "=&v"(rsv[1][3]) : "v"(sp) : "memory"); }
        if (pn < 8) {
#pragma unroll
            for (int ai = 0; ai < 2; ++ai)
#pragma unroll
                for (int m = 0; m < 4; ++m) { bf16_t* p = U + (size_t)(row0 + ai * HALF + m * 16) * 1024 + pn * 128 + cw; const float rs = rsv[ai][m] * sw;
                    f32x4 a0 = acc[ai][0][m][0] * rs, a1 = acc[ai][0][m][1] * rs; const f32x4 b0 = acc[ai][1][m][0] * rs, b1 = acc[ai][1][m][1] * rs;
#pragma unroll
                    for (int i = 0; i < 4; ++i) { a0[i] *= sigm(b0[i]); a1[i] *= sigm(b1[i]); }
                    *(u32x4*)p = pack8(a0, a1); }
        } else {
            bf16_t* base; int ld, cb, mode;
            if (pn < 12) { base = Q; ld = 1024; cb = (pn - 8) * 256; mode = 0; }
            else if (pn == 12) { base = K; ld = 256; cb = 0; mode = 1; }
            else if (pn == 13) { base = V; ld = 256; cb = 0; mode = 1; }
            else if (pn < 22) { base = GC; ld = 2048; cb = (pn - 14) * 256; mode = 2; }
            else { base = GA; ld = 2048; cb = (pn - 22) * 256; mode = 2; }
            float vm = 0.f;
#pragma unroll
            for (int ai = 0; ai < 2; ++ai)
#pragma unroll
                for (int m = 0; m < 4; ++m) { bf16_t* p = base + (size_t)(row0 + ai * HALF + m * 16) * ld + cb + cw; const float rs = rsv[ai][m] * sw;
#pragma unroll
                    for (int bj = 0; bj < 2; ++bj) { f32x4 v0 = acc[ai][bj][m][0] * rs, v1 = acc[ai][bj][m][1] * rs;
                        if (pn == 13) vm = fmaxf(vm, fmaxf(fmaxf(fmaxf(fabsf(v0[0]), fabsf(v0[1])), fmaxf(fabsf(v0[2]), fabsf(v0[3]))), fmaxf(fmaxf(fabsf(v1[0]), fabsf(v1[1])), fmaxf(fabsf(v1[2]), fabsf(v1[3])))));
                        if (mode == 0) { v0 = v0 * 0.125f; v1 = v1 * 0.125f; }
                        else if (mode == 2) {
#pragma unroll
                            for (int i = 0; i < 4; ++i) { v0[i] = sigm(v0[i]); v1[i] = sigm(v1[i]); } }
                        *(u32x4*)(p + bj * HALF) = pack8(v0, v1); } }
            if (pn == 13) {
#pragma unroll
                for (int o = 1; o < 64; o <<= 1) vm = fmaxf(vm, __shfl_xor(vm, o));
                if ((threadIdx.x & 63) == 0) __hip_atomic_fetch_max(vmax + (u.pm >> 5), __float_as_uint(vm), __ATOMIC_RELAXED, __HIP_MEMORY_SCOPE_AGENT); }
        }
    }
};
struct EpiMerge {
    static constexpr bool PERM = true, AFTER_DRAIN = false, HAS_MID = true;
    const bf16_t* GC; const bf16_t* GA; unsigned char* O; float fmid0, fmid1, fend0, fend1;
    __device__ __forceinline__ void mid(f32x4 (&acc)[2][2][4][2], const Unit& u, int wr, int wc, int fr, int fq) const {
        int row0 = u.pm * BM + wr * 64 + fr, c0 = u.pn * BM + wc * 32 + 8 * fq; const float fmd = (u.pm >> 5) ? fmid1 : fmid0;
        asm volatile("" : "+v"(row0), "+v"(c0));
#pragma unroll
        for (int ai = 0; ai < 2; ++ai)
#pragma unroll
            for (int mh = 0; mh < 2; ++mh) { u32x4 gc[2][2], ga[2][2];
#pragma unroll
                for (int mm = 0; mm < 2; ++mm)
#pragma unroll
                    for (int bj = 0; bj < 2; ++bj) { const size_t off = (size_t)(row0 + ai * HALF + (2 * mh + mm) * 16) * 2048 + c0 + bj * HALF; gc[mm][bj] = *(const u32x4*)(GC + off); ga[mm][bj] = *(const u32x4*)(GA + off); }
                __builtin_amdgcn_sched_barrier(0);
#pragma unroll
                for (int mm = 0; mm < 2; ++mm)
#pragma unroll
                    for (int bj = 0; bj < 2; ++bj) { const int m = 2 * mh + mm; const u32x4 c = gc[mm][bj], a = ga[mm][bj];
#define RT_(cw_, aw_, HI_) ((HI_ ? bhi(cw_) : blo(cw_)) * fmd * __builtin_amdgcn_rcpf(fmaxf(HI_ ? bhi(aw_) : blo(aw_), 1e-30f)))
                        acc[ai][bj][m][0][0] *= RT_(c.x, a.x, 0); acc[ai][bj][m][0][1] *= RT_(c.x, a.x, 1); acc[ai][bj][m][0][2] *= RT_(c.y, a.y, 0); acc[ai][bj][m][0][3] *= RT_(c.y, a.y, 1);
                        acc[ai][bj][m][1][0] *= RT_(c.z, a.z, 0); acc[ai][bj][m][1][1] *= RT_(c.z, a.z, 1); acc[ai][bj][m][1][2] *= RT_(c.w, a.w, 0); acc[ai][bj][m][1][3] *= RT_(c.w, a.w, 1);
#undef RT_
                    }
                __builtin_amdgcn_sched_barrier(0); }
    }
    __device__ __forceinline__ void operator()(const f32x4 (&acc)[2][2][4][2], const Unit& u, int wr, int wc, int fr, int fq) const {
        const int row0 = u.pm * BM + wr * 64 + fr, c0 = u.pn * BM + wc * 32 + 8 * fq; const float fe = (u.pm >> 5) ? fend1 : fend0;
#pragma unroll
        for (int ai = 0; ai < 2; ++ai) { u32x4 g[4][2];
#pragma unroll
            for (int m = 0; m < 4; ++m)
#pragma unroll
                for (int bj = 0; bj < 2; ++bj) g[m][bj] = *(const u32x4*)(GA + (size_t)(row0 + ai * HALF + m * 16) * 2048 + c0 + bj * HALF);
            __builtin_amdgcn_sched_barrier(0);
#pragma unroll
            for (int m = 0; m < 4; ++m)
#pragma unroll
                for (int bj = 0; bj < 2; ++bj) { const size_t off = (size_t)(row0 + ai * HALF + m * 16) * 2048 + c0 + bj * HALF; const u32x4 gg = g[m][bj]; f32x4 v0 = acc[ai][bj][m][0], v1 = acc[ai][bj][m][1];
                    v0[0] *= fmaxf(blo(gg.x), 1e-30f) * fe; v0[1] *= fmaxf(bhi(gg.x), 1e-30f) * fe; v0[2] *= fmaxf(blo(gg.y), 1e-30f) * fe; v0[3] *= fmaxf(bhi(gg.y), 1e-30f) * fe;
                    v1[0] *= fmaxf(blo(gg.z), 1e-30f) * fe; v1[1] *= fmaxf(bhi(gg.z), 1e-30f) * fe; v1[2] *= fmaxf(blo(gg.w), 1e-30f) * fe; v1[3] *= fmaxf(bhi(gg.w), 1e-30f) * fe;
                    int lo = __builtin_amdgcn_cvt_pk_fp8_f32(v0[0], v0[1], 0, false); lo = __builtin_amdgcn_cvt_pk_fp8_f32(v0[2], v0[3], lo, true);
                    int hi = __builtin_amdgcn_cvt_pk_fp8_f32(v1[0], v1[1], 0, false); hi = __builtin_amdgcn_cvt_pk_fp8_f32(v1[2], v1[3], hi, true);
                    typedef unsigned u32x2s __attribute__((ext_vector_type(2))); *(u32x2s*)(O + off) = (u32x2s){(unsigned)lo, (unsigned)hi}; }
            __builtin_amdgcn_sched_barrier(0); }
    }
};
template <bool XB_BF16>
struct EpiResid {
    static constexpr bool PERM = true, AFTER_DRAIN = false, HAS_MID = false;
    const void* XB; bf16_t* XO; const float* gvec; float fo0, fo1;
    __device__ __forceinline__ void operator()(const f32x4 (&acc)[2][2][4][2], const Unit& u, int wr, int wc, int fr, int fq) const {
        const int row0 = u.pm * BM + wr * 64 + fr, c0 = u.pn * BM + wc * 32 + 8 * fq; const float* gp = gvec + (size_t)(u.pm >> 5) * 12288;
        const float fo = (u.pm >> 5) ? fo1 : fo0;
#pragma unroll
        for (int bj = 0; bj < 2; ++bj) { const int col = c0 + bj * HALF; const f32x4 g0 = *(const f32x4*)(gp + col) * fo, g1 = *(const f32x4*)(gp + col + 4) * fo;
#pragma unroll
            for (int ai = 0; ai < 2; ++ai) { f32x4 xa[4], xb[4]; u32x4 xq[4];
#pragma unroll
                for (int m = 0; m < 4; ++m) { const size_t off = (size_t)(row0 + ai * HALF + m * 16) * 2048 + col;
                    if constexpr (XB_BF16) xq[m] = *(const u32x4*)((const bf16_t*)XB + off); else { xa[m] = *(const f32x4*)((const float*)XB + off); xb[m] = *(const f32x4*)((const float*)XB + off + 4); } }
                __builtin_amdgcn_sched_barrier(0);
#pragma unroll
                for (int m = 0; m < 4; ++m) { const size_t off = (size_t)(row0 + ai * HALF + m * 16) * 2048 + col;
                    if constexpr (XB_BF16) { xa[m] = (f32x4){blo(xq[m].x), bhi(xq[m].x), blo(xq[m].y), bhi(xq[m].y)}; xb[m] = (f32x4){blo(xq[m].z), bhi(xq[m].z), blo(xq[m].w), bhi(xq[m].w)}; }
                    *(u32x4*)(XO + off) = pack8(xa[m] + g0 * acc[ai][bj][m][0], xb[m] + g1 * acc[ai][bj][m][1]); }
                __builtin_amdgcn_sched_barrier(0); } }
    }
};
typedef _Float16 f16x8 __attribute__((ext_vector_type(8)));
struct EpiF16 {
    static constexpr bool PERM = true, AFTER_DRAIN = false, HAS_MID = false;
    _Float16* O; int ldc;
    __device__ __forceinline__ void operator()(const f32x4 (&acc)[2][2][4][2], const Unit& u, int wr, int wc, int fr, int fq) const {
        const int row0 = u.pm * BM + wr * 64 + fr, c0 = u.pn * BM + wc * 32 + 8 * fq;
#pragma unroll
        for (int ai = 0; ai < 2; ++ai)
#pragma unroll
            for (int m = 0; m < 4; ++m)
#pragma unroll
                for (int bj = 0; bj < 2; ++bj) { const f32x4 v0 = acc[ai][bj][m][0], v1 = acc[ai][bj][m][1];
                    const f16x8 h = {(_Float16)v0[0], (_Float16)v0[1], (_Float16)v0[2], (_Float16)v0[3], (_Float16)v1[0], (_Float16)v1[1], (_Float16)v1[2], (_Float16)v1[3]};
                    *(f16x8*)(O + (size_t)(row0 + ai * HALF + m * 16) * ldc + c0 + bj * HALF) = h; }
    }
};
}

#define XB_TMO      128
#define XB_XCNT(j)  (256  + 64 * (j))
#define XB_XSUB(j)  (1280 + 64 * (j))
#define XB_XGEN(j)  (2304 + 64 * (j))
#define XB_TOP      3328
#define XB_TOPGEN   3392
#define XCD_BAR_WORDS 3456
#define XB_SPIN_CAP (1u << 18)

__device__ __forceinline__ unsigned xb_ld(unsigned* p)              { return __hip_atomic_load(p, __ATOMIC_RELAXED, __HIP_MEMORY_SCOPE_AGENT); }
__device__ __forceinline__ unsigned xb_add(unsigned* p, unsigned v) { return __hip_atomic_fetch_add(p, v, __ATOMIC_RELAXED, __HIP_MEMORY_SCOPE_AGENT); }
__device__ __forceinline__ unsigned xb_xcc_id() { return (unsigned)__builtin_amdgcn_s_getreg((3 << 11) | 20) & 0xFu; }
#define XB_SPIN(cond, bar) do { unsigned _sp = 0; while (cond) { __builtin_amdgcn_s_sleep(1); \
    if ((++_sp & 255u) == 0u) { if (xb_ld(&(bar)[XB_TMO])) break; if (_sp > XB_SPIN_CAP) { atomicAdd(&(bar)[XB_TMO], 1u); break; } } } } while (0)

struct XcdBarrier {
    unsigned* bar; unsigned x;
    volatile LAS unsigned* st;
};

__device__ __forceinline__ XcdBarrier xcd_barrier_post(unsigned* bar, volatile LAS unsigned* st) {
    XcdBarrier b; b.bar = bar; b.x = xb_xcc_id(); b.st = st;
    if (threadIdx.x == 0) (void)xb_add(&bar[XB_XCNT(b.x)], 1u);
    return b;
}
__device__ __forceinline__ void xcd_barrier_complete(unsigned* bar, unsigned x, unsigned& nloc, unsigned& nx) {
    const unsigned G = gridDim.x * gridDim.y * gridDim.z;
    unsigned sum, cnt, mine, sp = 0u;
    for (;;) {
        sum = 0u; cnt = 0u; mine = 0u;
#pragma unroll
        for (unsigned j = 0; j < 16; ++j) { const unsigned c = xb_ld(&bar[XB_XCNT(j)]); sum += c; cnt += (c > 0u) ? 1u : 0u; mine = (j == x) ? c : mine; }
        if (sum == G) break;
        __builtin_amdgcn_s_sleep(1);
        if ((++sp & 255u) == 0u) { if (xb_ld(&bar[XB_TMO])) break; if (sp > XB_SPIN_CAP) { atomicAdd(&bar[XB_TMO], 1u); break; } }
    }
    nloc = mine > 0u ? mine : 1u; nx = cnt > 0u ? cnt : 1u;
}

__device__ __forceinline__ void xcd_barrier(const XcdBarrier& b) {
    asm volatile("s_waitcnt vmcnt(0)" ::: "memory");
    __syncthreads();
    if (threadIdx.x == 0) {
        unsigned* bar = b.bar;
        __builtin_amdgcn_s_waitcnt(0);
        unsigned nloc = b.st[0], nx = b.st[1];
        if (nloc == 0u) { xcd_barrier_complete(bar, b.x, nloc, nx); b.st[0] = nloc; b.st[1] = nx; }
        const unsigned old = xb_add(&bar[XB_XSUB(b.x)], 1u);
        const unsigned gen = old / nloc;
        if (old + 1u == (gen + 1u) * nloc) {
            __builtin_amdgcn_fence(__ATOMIC_RELEASE, "agent");
            asm volatile("s_waitcnt vmcnt(0)" ::: "memory");
            const unsigned og = xb_add(&bar[XB_TOP], 1u);
            const unsigned tg = og / nx;
            if (og + 1u == (tg + 1u) * nx) xb_add(&bar[XB_TOPGEN], 1u);
            else XB_SPIN(xb_ld(&bar[XB_TOPGEN]) == tg, bar);
            __builtin_amdgcn_fence(__ATOMIC_ACQUIRE, "agent");
            xb_add(&bar[XB_XGEN(b.x)], 1u);
            asm volatile("s_waitcnt vmcnt(0)" ::: "memory");
        } else {
            XB_SPIN(xb_ld(&bar[XB_XGEN(b.x)]) == gen, bar);
            __builtin_amdgcn_fence(__ATOMIC_ACQUIRE, "agent");
            asm volatile("s_waitcnt vmcnt(0)" ::: "memory");
        }
    }
    __syncthreads();
}

struct Args { const float* in[N_IN]; float* out; unsigned char* ws; int ph_lo, ph_hi; };
struct Frame {
    LAS unsigned char* lds; volatile LAS unsigned* MISC; gu32* ctl;
    int tid, lane, wave, vcu, G;
    const Args* A; float* out; unsigned char* ws;
};
#define WSP(T_, off) ((T_*)(F.ws + (off)))
#define PHASE_TID(F) do { int t_ = threadIdx.x; asm volatile("" : "+v"(t_)); (F).tid = t_; (F).lane = t_ & 63; (F).wave = __builtin_amdgcn_readfirstlane(t_ >> 6); } while (0)

__device__ __forceinline__ int glu_row(int n) { return n < 2048 ? (((n & 1023) >> 7) * 256 + (n >> 10) * 128 + (n & 127)) : n; }
template <int MODE>
__device__ __forceinline__ void tr_item(const float* W, int N, bf16* WT, int dstride, int koff, LAS float* scr, int kb, int nb, int lane) {
    const int k0 = 64 * kb, n0 = 32 * nb;
    f32x4 v[8];
#pragma unroll
    for (int i = 0; i < 8; ++i) v[i] = *(const f32x4*)(W + (size_t)(k0 + (lane >> 3) + 8 * i) * N + n0 + (lane & 7) * 4);
#pragma unroll
    for (int i = 0; i < 8; ++i) { LAS float* d = scr + ((lane >> 3) + 8 * i) * 33 + (lane & 7) * 4; d[0] = v[i].x; d[1] = v[i].y; d[2] = v[i].z; d[3] = v[i].w; }
    LDS_WAIT(); asm volatile("" ::: "memory");
    const int c = lane & 7;
#pragma unroll
    for (int j = 0; j < 4; ++j) { const int n = (lane >> 3) + 8 * j; const LAS float* s = scr + (8 * c) * 33 + n;
        v4u o; o.x = pk2(s[0 * 33], s[1 * 33]); o.y = pk2(s[2 * 33], s[3 * 33]); o.z = pk2(s[4 * 33], s[5 * 33]); o.w = pk2(s[6 * 33], s[7 * 33]);
        const int nn = n0 + n, row = MODE == 1 ? glu_row(nn) : nn;
        *(v4u*)(WT + (size_t)row * dstride + koff + k0 + 8 * c) = o; }
    LDS_WAIT(); asm volatile("" ::: "memory");
}
__device__ __forceinline__ void wmax_item(Frame& F, int it) {
    const int l = it >> 5, kc = it & 31; const float* W = F.A->in[I_WIN] + ((size_t)l * 2048 + kc * 64) * IN_DIM; float mx = 0.f;
#pragma unroll 4
    for (int k = 0; k < 64; ++k)
#pragma unroll
        for (int j = 0; j < 4; ++j) { const int c4 = F.tid + NTHR * j; if (c4 < IN_DIM / 4) { const f32x4 v = *(const f32x4*)(W + (size_t)k * IN_DIM + 4 * c4); mx = fmaxf(mx, fmaxf(fmaxf(fabsf(v.x), fabsf(v.y)), fmaxf(fabsf(v.z), fabsf(v.w)))); } }
#pragma unroll
    for (int o = 1; o < 64; o <<= 1) mx = fmaxf(mx, __shfl_xor(mx, o));
    if (F.lane == 0) __hip_atomic_fetch_max(F.ctl + CW_WMAX + l, __float_as_uint(mx), __ATOMIC_RELAXED, __HIP_MEMORY_SCOPE_AGENT);
}
__device__ __forceinline__ void wmax2_item(Frame& F, int it) {
    const int lh = it >> 3, kc = it & 7, l = lh >> 1, h = lh & 1; const float* W = F.A->in[h ? I_WAO : I_WCO] + ((size_t)l * 1024 + kc * 128) * 2048 + 4 * F.tid; float mx = 0.f;
#pragma unroll 8
    for (int k = 0; k < 128; ++k) { const f32x4 v = *(const f32x4*)(W + (size_t)k * 2048); mx = fmaxf(mx, fmaxf(fmaxf(fabsf(v.x), fabsf(v.y)), fmaxf(fabsf(v.z), fabsf(v.w)))); }
#pragma unroll
    for (int o = 1; o < 64; o <<= 1) mx = fmaxf(mx, __shfl_xor(mx, o));
    if (F.lane == 0) __hip_atomic_fetch_max(F.ctl + CW_WMAX2 + lh, __float_as_uint(mx), __ATOMIC_RELAXED, __HIP_MEMORY_SCOPE_AGENT);
}
__device__ __forceinline__ void wmax3_item(Frame& F, int it) {
    const int l = it >> 4, kc = it & 15; const float* W = F.A->in[I_WOUT] + ((size_t)l * 2048 + kc * 128) * 2048 + 4 * F.tid; float mx = 0.f;
#pragma unroll 8
    for (int k = 0; k < 128; ++k) { const f32x4 v = *(const f32x4*)(W + (size_t)k * 2048); mx = fmaxf(mx, fmaxf(fmaxf(fabsf(v.x), fabsf(v.y)), fmaxf(fabsf(v.z), fabsf(v.w)))); }
#pragma unroll
    for (int o = 1; o < 64; o <<= 1) mx = fmaxf(mx, __shfl_xor(mx, o));
    if (F.lane == 0) __hip_atomic_fetch_max(F.ctl + CW_WMAX3 + l, __float_as_uint(mx), __ATOMIC_RELAXED, __HIP_MEMORY_SCOPE_AGENT);
}
template <bool GLU>
__device__ __forceinline__ void tr8_item(const float* W, int N, unsigned char* WT, int koff, float inv, LAS float* scr, int kb, int nb, int lane) {
    const int k0 = 64 * kb, n0 = 32 * nb;
    f32x4 v[8];
#pragma unroll
    for (int i = 0; i < 8; ++i) v[i] = *(const f32x4*)(W + (size_t)(k0 + (lane >> 3) + 8 * i) * N + n0 + (lane & 7) * 4);
#pragma unroll
    for (int i = 0; i < 8; ++i) { LAS float* d = scr + ((lane >> 3) + 8 * i) * 33 + (lane & 7) * 4; d[0] = v[i].x * inv; d[1] = v[i].y * inv; d[2] = v[i].z * inv; d[3] = v[i].w * inv; }
    LDS_WAIT(); asm volatile("" ::: "memory");
    const int c = lane & 7;
#pragma unroll
    for (int j = 0; j < 4; ++j) { const int n = (lane >> 3) + 8 * j; const LAS float* s = scr + (8 * c) * 33 + n;
        int lo = __builtin_amdgcn_cvt_pk_fp8_f32(s[0 * 33], s[1 * 33], 0, false); lo = __builtin_amdgcn_cvt_pk_fp8_f32(s[2 * 33], s[3 * 33], lo, true);
        int hi = __builtin_amdgcn_cvt_pk_fp8_f32(s[4 * 33], s[5 * 33], 0, false); hi = __builtin_amdgcn_cvt_pk_fp8_f32(s[6 * 33], s[7 * 33], hi, true);
        v2u o; o.x = (unsigned)lo; o.y = (unsigned)hi;
        *(v2u*)(WT + (size_t)(GLU ? glu_row(n0 + n) : n0 + n) * 2048 + koff + k0 + 8 * c) = o; }
    LDS_WAIT(); asm volatile("" ::: "memory");
}
__device__ __forceinline__ void win8_phase(Frame& F) {
    PHASE_TID(F);
    LAS float* scr = (LAS float*)(F.lds + F.wave * 16384);
    if (F.tid == 0) F.MISC[0] = __hip_atomic_fetch_add(F.ctl + CW_QUEUE2, 1u, __ATOMIC_RELAXED, __HIP_MEMORY_SCOPE_AGENT);
    for (int par = 0;; par ^= 1) {
        __syncthreads();
        const int it = (int)F.MISC[par];
        if (F.tid == 0) F.MISC[par ^ 1] = __hip_atomic_fetch_add(F.ctl + CW_QUEUE2, 1u, __ATOMIC_RELAXED, __HIP_MEMORY_SCOPE_AGENT);
        if (it >= 2 * 960 + 4 * 128 + 2 * 256) break;
        if (it < 2 * 960) { const int l = it >= 960, r = it - l * 960, wi = r * 8 + F.wave;
            const float wmax = __uint_as_float(__hip_atomic_load(F.ctl + CW_WMAX + l, __ATOMIC_RELAXED, __HIP_MEMORY_SCOPE_AGENT)), inv = wmax > 0.f ? 440.0f / wmax : 1.0f;
            tr8_item<true>(F.A->in[I_WIN] + (size_t)l * 2048 * IN_DIM, IN_DIM, WSP(unsigned char, WS_WIN) + (size_t)l * IN_DIM * 2048, 0, inv, scr, wi / 240, wi % 240, F.lane); }
        else if (it >= 2 * 960 + 4 * 128) { const int r0 = it - 2 * 960 - 4 * 128, l = r0 >> 8, wi = (r0 & 255) * 8 + F.wave;
            const float wmax = __uint_as_float(__hip_atomic_load(F.ctl + CW_WMAX3 + l, __ATOMIC_RELAXED, __HIP_MEMORY_SCOPE_AGENT)), inv = wmax > 0.f ? 440.0f / wmax : 1.0f;
            tr8_item<false>(F.A->in[I_WOUT] + (size_t)l * 2048 * 2048, 2048, WSP(unsigned char, WS_WO) + (size_t)l * 2048 * 2048, 0, inv, scr, wi / 64, wi % 64, F.lane); }
        else { const int r0 = it - 2 * 960, lh = r0 >> 7, l = lh >> 1, h = lh & 1, wi = (r0 & 127) * 8 + F.wave;
            const float wmax = __uint_as_float(__hip_atomic_load(F.ctl + CW_WMAX2 + lh, __ATOMIC_RELAXED, __HIP_MEMORY_SCOPE_AGENT)), inv = wmax > 0.f ? 440.0f / wmax : 1.0f;
            tr8_item<false>(F.A->in[h ? I_WAO : I_WCO] + (size_t)l * 1024 * 2048, 2048, WSP(unsigned char, WS_WM) + (size_t)l * 2048 * 2048, h * 1024, inv, scr, wi / 64, wi % 64, F.lane); }
    }
}
__device__ __forceinline__ void ada_item(Frame& F, int a) {
    LAS float* csl = (LAS float*)F.lds;
    LAS f32x4* red = (LAS f32x4*)(F.lds + 16384);
    const float* c = F.A->in[I_C];
    for (int i = F.tid; i < 4096; i += NTHR) { const float v = c[i]; csl[i] = v / (1.0f + __expf(-v)); }
    __syncthreads();
    const int l = a / 48, j0 = (a % 48) * 256 + 4 * F.lane;
    const float* wp = F.A->in[I_ADAW] + ((size_t)l * 2048 + F.wave * 256) * 12288 + j0;
    f32x4 a0 = {0.f, 0.f, 0.f, 0.f}, a1 = {0.f, 0.f, 0.f, 0.f};
#pragma unroll 16
    for (int k = 0; k < 256; ++k) { const f32x4 w = *(const f32x4*)(wp + (size_t)k * 12288); const float c0 = csl[F.wave * 256 + k], c1 = csl[2048 + F.wave * 256 + k]; a0 += w * c0; a1 += w * c1; }
    red[(F.wave * 2 + 0) * 64 + F.lane] = a0; red[(F.wave * 2 + 1) * 64 + F.lane] = a1;
    __syncthreads();
    if (F.wave < 2) { const int b = F.wave; f32x4 s = *(const f32x4*)(F.A->in[I_ADAB] + l * 12288 + j0);
#pragma unroll
        for (int w = 0; w < 8; ++w) s += red[(w * 2 + b) * 64 + F.lane];
        *(f32x4*)(WSP(float, WS_MOD) + (size_t)(l * 2 + b) * 12288 + j0) = s; }
    __syncthreads();
}
__device__ __forceinline__ void fold_item(Frame& F, int it) {
    const int l = it >> 7, hp = (it >> 3) & 15, kb = it & 7, lane = F.lane, fr = lane & 15, fq = lane >> 4;
    constexpr int SKS = 136;
    LAS bf16* skh = (LAS bf16*)F.lds; LAS bf16* skl = skh + 128 * SKS;
    const float* wbase = F.A->in[I_WPQ] + ((size_t)l * 2048 + kb * 256 + F.wave * 32 + fr) * 2048 + hp * 128 + 8 * fq;
    f32x4 wv[2][4][2];
#pragma unroll
    for (int kt = 0; kt < 2; ++kt)
#pragma unroll
        for (int s2 = 0; s2 < 4; ++s2) { wv[kt][s2][0] = *(const f32x4*)(wbase + (size_t)kt * 16 * 2048 + 32 * s2); wv[kt][s2][1] = *(const f32x4*)(wbase + (size_t)kt * 16 * 2048 + 32 * s2 + 4); }
    { const f32x4* sk = (const f32x4*)(F.A->in[I_SK] + (size_t)(l * 16 + hp) * 128 * 128);
      f32x4 v[8];
#pragma unroll
      for (int i = 0; i < 8; ++i) v[i] = sk[i * NTHR + F.tid];
#pragma unroll
      for (int i = 0; i < 8; ++i) { const int f = i * NTHR + F.tid, n = f >> 5, d = (f & 31) * 4;
          const unsigned h0 = pk2(v[i].x, v[i].y), h1 = pk2(v[i].z, v[i].w);
          const unsigned l0 = pk2(v[i].x - bflo(h0), v[i].y - bfhi(h0)), l1 = pk2(v[i].z - bflo(h1), v[i].w - bfhi(h1));
          v2u ho; ho.x = h0; ho.y = h1; v2u lo; lo.x = l0; lo.y = l1;
          *(LAS v2u*)(skh + n * SKS + d) = ho; *(LAS v2u*)(skl + n * SKS + d) = lo; } }
    __syncthreads();
    bf16x8 wh[2][4], wl[2][4];
#pragma unroll
    for (int kt = 0; kt < 2; ++kt)
#pragma unroll
        for (int s2 = 0; s2 < 4; ++s2) { const f32x4 a = wv[kt][s2][0], b = wv[kt][s2][1];
            v4u h, lo; h.x = pk2(a.x, a.y); h.y = pk2(a.z, a.w); h.z = pk2(b.x, b.y); h.w = pk2(b.z, b.w);
            lo.x = pk2(a.x - bflo(h.x), a.y - bfhi(h.x)); lo.y = pk2(a.z - bflo(h.y), a.w - bfhi(h.y)); lo.z = pk2(b.x - bflo(h.z), b.y - bfhi(h.z)); lo.w = pk2(b.z - bflo(h.w), b.w - bfhi(h.w));
            wh[kt][s2] = __builtin_bit_cast(bf16x8, h); wl[kt][s2] = __builtin_bit_cast(bf16x8, lo); }
    bf16* dst = WSP(bf16, WS_WP) + (size_t)l * 2048 * 2048 + (size_t)(hp * 128 + fr) * 2048 + kb * 256 + F.wave * 32 + 4 * fq;
#pragma unroll 2
    for (int nt = 0; nt < 8; ++nt) { f32x4 acc[2] = {{0.f, 0.f, 0.f, 0.f}, {0.f, 0.f, 0.f, 0.f}};
#pragma unroll
        for (int s2 = 0; s2 < 4; ++s2) { const bf16x8 sh = *(const LAS bf16x8*)(skh + (nt * 16 + fr) * SKS + 32 * s2 + 8 * fq), sl = *(const LAS bf16x8*)(skl + (nt * 16 + fr) * SKS + 32 * s2 + 8 * fq);
#pragma unroll
            for (int kt = 0; kt < 2; ++kt) { acc[kt] = __builtin_amdgcn_mfma_f32_16x16x32_bf16(wh[kt][s2], sh, acc[kt], 0, 0, 0); acc[kt] = __builtin_amdgcn_mfma_f32_16x16x32_bf16(wl[kt][s2], sh, acc[kt], 0, 0, 0);
                acc[kt] = __builtin_amdgcn_mfma_f32_16x16x32_bf16(wh[kt][s2], sl, acc[kt], 0, 0, 0); } }
#pragma unroll
        for (int kt = 0; kt < 2; ++kt) { v2u o; o.x = pk2(acc[kt].x, acc[kt].y); o.y = pk2(acc[kt].z, acc[kt].w); *(v2u*)(dst + (size_t)nt * 16 * 2048 + kt * 16) = o; } }
    __syncthreads();
}
__device__ __forceinline__ void cvt_item(Frame& F, int it) {
    const int which = it >> 10, chunk = it & 1023;
    const float* src = F.A->in[which ? I_PV : I_PU]; unsigned char* dst = WSP(unsigned char, which ? WS_PV : WS_PU); float* scl = WSP(float, WS_SCL) + which * 2 * NEXP;
    constexpr int VROW = 2048 + 8;
    LAS unsigned char* vt = F.lds;
    for (int i = 0; i < 4; i += 2) {
        f32x4 a[2][4], b[2][4]; float mx[2] = {0.f, 0.f};
#pragma unroll
        for (int r = 0; r < 2; ++r) { const int row = chunk * 32 + F.wave * 4 + i + r;
#pragma unroll
            for (int m = 0; m < 4; ++m) { const int col = 512 * m + 8 * F.lane; a[r][m] = *(const f32x4*)(src + (size_t)row * D + col); b[r][m] = *(const f32x4*)(src + (size_t)row * D + col + 4); } }
#pragma unroll
        for (int r = 0; r < 2; ++r) {
#pragma unroll
            for (int m = 0; m < 4; ++m) { mx[r] = fmaxf(mx[r], fmaxf(fmaxf(fabsf(a[r][m].x), fabsf(a[r][m].y)), fmaxf(fabsf(a[r][m].z), fabsf(a[r][m].w)))); mx[r] = fmaxf(mx[r], fmaxf(fmaxf(fabsf(b[r][m].x), fabsf(b[r][m].y)), fmaxf(fabsf(b[r][m].z), fabsf(b[r][m].w)))); } }
#pragma unroll
        for (int o = 1; o < 64; o <<= 1) { mx[0] = fmaxf(mx[0], __shfl_xor(mx[0], o)); mx[1] = fmaxf(mx[1], __shfl_xor(mx[1], o)); }
#pragma unroll
        for (int r = 0; r < 2; ++r) { const int row = chunk * 32 + F.wave * 4 + i + r, l = row >> 14, e = row & (NEXP - 1);
            const float sc = mx[r] > 0.f ? mx[r] * (1.0f / 440.0f) : 1.0f, inv = 1.0f / sc;
            if (F.lane == 0) scl[l * NEXP + e] = sc;
#pragma unroll
            for (int m = 0; m < 4; ++m) { const int col = 512 * m + 8 * F.lane;
                int lo = __builtin_amdgcn_cvt_pk_fp8_f32(a[r][m].x * inv, a[r][m].y * inv, 0, false); lo = __builtin_amdgcn_cvt_pk_fp8_f32(a[r][m].z * inv, a[r][m].w * inv, lo, true);
                int hi = __builtin_amdgcn_cvt_pk_fp8_f32(b[r][m].x * inv, b[r][m].y * inv, 0, false); hi = __builtin_amdgcn_cvt_pk_fp8_f32(b[r][m].z * inv, b[r][m].w * inv, hi, true);
                v2u o; o.x = (unsigned)lo; o.y = (unsigned)hi;
                if (which) *(LAS v2u*)(vt + (F.wave * 4 + i + r) * VROW + col) = o;
                else *(v2u*)(dst + ((size_t)(l * NSL + (col >> 7)) * NEXP + e) * SLW + (col & 127)) = o; } }
    }
    if (which) {
        __syncthreads();
        const int row0 = chunk * 32, l = row0 >> 14, e0 = row0 & (NEXP - 1);
#pragma unroll 4
        for (int i = 0; i < 16; ++i) { const int idx = i * NTHR + F.tid, j = idx >> 5, r = idx & 31;
            *(v2u*)(dst + ((size_t)(l * 256 + j) * NEXP + e0 + r) * 8) = *(const LAS v2u*)(vt + r * VROW + 8 * j); }
        __syncthreads();
    }
}
__device__ __forceinline__ void bias_item(Frame& F) {
    for (int i = F.tid; i < 2048; i += NTHR) { const int h = i >> 7, d = i & 127; int bk;
        if (d < 16) bk = d; else { bk = 16 + (int)(logf((float)d / 16.0f) / logf(8.0f) * 16.0f); bk = bk > 31 ? 31 : bk; }
        WSP(float, WS_BIAS)[i] = F.A->in[I_RELB][bk * 16 + h]; }
}
constexpr int IT_FOLD = 256, IT_ADA = 96, IT_WMAX = 64 + 32 + 32, IT_CVT = 2048;
constexpr int IT0_ADA = 0, IT0_BIAS = IT0_ADA + IT_ADA, IT0_WMAX = IT0_BIAS + 1, IT0_CVT = IT0_WMAX + IT_WMAX, N_OTHER = IT0_CVT + IT_CVT, N_ITEMS = N_OTHER + IT_FOLD, FOLD_EVERY = 9;
static_assert((IT_FOLD - 1) * FOLD_EVERY < N_ITEMS, "fold tickets inside the item range");
__device__ __forceinline__ void p0_prologue(Frame& F) {
    PHASE_TID(F);
    if (F.tid == 0) F.MISC[0] = __hip_atomic_fetch_add(F.ctl + CW_QUEUE, 1u, __ATOMIC_RELAXED, __HIP_MEMORY_SCOPE_AGENT);
    for (int par = 0;; par ^= 1) {
        __syncthreads();
        const int it = (int)F.MISC[par];
        if (F.tid == 0) F.MISC[par ^ 1] = __hip_atomic_fetch_add(F.ctl + CW_QUEUE, 1u, __ATOMIC_RELAXED, __HIP_MEMORY_SCOPE_AGENT);
        if (it >= N_ITEMS) break;
        const int fq = it / FOLD_EVERY; const bool is_fold = (it % FOLD_EVERY == 0) && fq < IT_FOLD;
        const int ot = it - (fq + 1 < IT_FOLD ? fq + 1 : IT_FOLD);
        if (is_fold) fold_item(F, fq);
        else if (ot < IT0_BIAS) ada_item(F, ot - IT0_ADA);
        else if (ot < IT0_WMAX) bias_item(F);
        else if (ot < IT0_WMAX + 64) wmax_item(F, ot - IT0_WMAX);
        else if (ot < IT0_WMAX + 96) wmax2_item(F, ot - IT0_WMAX - 64);
        else if (ot < IT0_CVT) wmax3_item(F, ot - IT0_WMAX - 96);
        else cvt_item(F, ot - IT0_CVT);
    }
}

__device__ __forceinline__ void row_to_fp8(const f32x4 (&y)[8], unsigned char* hrow, float* sarow, int lane) {
    float mx = 0.f;
#pragma unroll
    for (int j = 0; j < 8; ++j) mx = fmaxf(mx, fmaxf(fmaxf(fabsf(y[j].x), fabsf(y[j].y)), fmaxf(fabsf(y[j].z), fabsf(y[j].w))));
#pragma unroll
    for (int o = 1; o < 64; o <<= 1) mx = fmaxf(mx, __shfl_xor(mx, o));
    const float sc = mx > 0.f ? mx * (1.0f / 440.0f) : 1.0f, inv = 1.0f / sc;
    if (lane == 0) *sarow = sc;
#pragma unroll
    for (int j = 0; j < 8; ++j) { int w = __builtin_amdgcn_cvt_pk_fp8_f32(y[j].x * inv, y[j].y * inv, 0, false); w = __builtin_amdgcn_cvt_pk_fp8_f32(y[j].z * inv, y[j].w * inv, w, true); ((unsigned*)hrow)[lane + 64 * j] = (unsigned)w; }
}
template <bool TO_FP8, bool IN_BF16>
__device__ __forceinline__ void norm_phase(Frame& F, const void* X, bf16* Hd, const float* g, const float* modl, int ish, int isc) {
    PHASE_TID(F);
    const int gw = F.vcu * NWAVES + F.wave, NGW = F.G * NWAVES;
    int curb = -1; f32x4 gs[8], sh[8];
    for (int m = gw; m < T; m += NGW) {
        const int b = m >> 13;
        if (b != curb) { curb = b;
#pragma unroll
            for (int j = 0; j < 8; ++j) { const int col = 4 * F.lane + 256 * j; const f32x4 g4 = *(const f32x4*)(g + col), sc4 = *(const f32x4*)(modl + (size_t)b * 12288 + isc * 2048 + col);
                sh[j] = *(const f32x4*)(modl + (size_t)b * 12288 + ish * 2048 + col); gs[j] = g4 * (sc4 + 1.0f); } }
        f32x4 v[8]; float ss = 0.f;
        if constexpr (IN_BF16) { const v2u* xr = (const v2u*)((const bf16*)X + (size_t)m * D) + F.lane; v2u q[8];
#pragma unroll
            for (int j = 0; j < 8; ++j) q[j] = xr[64 * j];
            __builtin_amdgcn_sched_barrier(0);
#pragma unroll
            for (int j = 0; j < 8; ++j) v[j] = (f32x4){bflo(q[j].x), bfhi(q[j].x), bflo(q[j].y), bfhi(q[j].y)};
        } else { const f32x4* xr = (const f32x4*)((const float*)X + (size_t)m * D) + F.lane;
#pragma unroll
            for (int j = 0; j < 8; ++j) v[j] = xr[64 * j];
            __builtin_amdgcn_sched_barrier(0); }
#pragma unroll
        for (int j = 0; j < 8; ++j) ss += (v[j].x * v[j].x + v[j].y * v[j].y) + (v[j].z * v[j].z + v[j].w * v[j].w);
        const float rstd = 1.0f / sqrtf(wave_sum(ss) * (1.0f / D) + EPS);
        if constexpr (TO_FP8) { f32x4 y[8];
#pragma unroll
            for (int j = 0; j < 8; ++j) y[j] = v[j] * rstd * gs[j] + sh[j];
            row_to_fp8(y, (unsigned char*)Hd + (size_t)m * D, WSP(float, WS_SA) + m, F.lane);
        } else {
        v2u* o = (v2u*)(Hd + (size_t)m * D) + F.lane;
#pragma unroll
        for (int j = 0; j < 8; ++j) { const f32x4 y = v[j] * rstd * gs[j] + sh[j]; v2u w; w.x = pk2(y.x, y.y); w.y = pk2(y.z, y.w); o[64 * j] = w; }
        }
    }
}

__device__ __forceinline__ void conv_phase(Frame& F, int l) {
    PHASE_TID(F);
    const float* dw = F.A->in[I_DWW] + (size_t)l * CWID * CONV; const int c0 = 2 * F.tid;
    float w0[CWID], w1[CWID];
#pragma unroll
    for (int j = 0; j < CWID; ++j) { const f32x2 w = *(const f32x2*)(dw + j * CONV + c0); w0[j] = w.x; w1[j] = w.y; }
    const f32x2 cb = *(const f32x2*)(F.A->in[I_DWB] + l * CONV + c0), lg = *(const f32x2*)(F.A->in[I_CLNG] + l * CONV + c0), lb = *(const f32x2*)(F.A->in[I_CLNB] + l * CONV + c0);
    LAS float* red = (LAS float*)F.lds;
    LAS float* stat = red + 256;
    float gmx = fmaxf(fabsf(lg.x), fabsf(lg.y)), bmx = fmaxf(fabsf(lb.x), fabsf(lb.y));
#pragma unroll
    for (int o = 1; o < 64; o <<= 1) { gmx = fmaxf(gmx, __shfl_xor(gmx, o)); bmx = fmaxf(bmx, __shfl_xor(bmx, o)); }
    if (F.lane == 0) { red[F.wave] = gmx; red[8 + F.wave] = bmx; }
    __syncthreads();
    { float g_ = red[0], b_ = red[8];
#pragma unroll
      for (int w = 1; w < 8; ++w) { g_ = fmaxf(g_, red[w]); b_ = fmaxf(b_, red[8 + w]); }
      gmx = g_; bmx = b_; }
    __syncthreads();
    const float Bc = fmaxf(32.0f * gmx + bmx, 1e-20f), cinv = 440.0f / Bc;
    if (blockIdx.x == 0 && F.tid == 0) { __hip_atomic_store(F.ctl + CW_BC + l, __float_as_uint(Bc), __ATOMIC_RELAXED, __HIP_MEMORY_SCOPE_AGENT); __hip_atomic_store(F.ctl + CW_BC2 + l, __float_as_uint(gmx + bmx), __ATOMIC_RELAXED, __HIP_MEMORY_SCOPE_AGENT); }
    const unsigned* Ut = WSP(unsigned, WS_U) + F.tid; unsigned short* AM = WSP(unsigned short, WS_AM);
    for (int tile = F.vcu; tile < T / 64; tile += F.G) {
        const int t0 = tile * 64, bstart = t0 & ~(SEQ - 1);
        for (int grp = 0; grp < 4; ++grp) {
            const int tg = t0 + grp * 16;
            float wa[46], wb[46]; unsigned wp[46];
#pragma unroll
            for (int i = 0; i < 46; ++i) { const int r = tg - 30 + i; wp[i] = Ut[(size_t)(r >= bstart ? r : bstart) * (CONV / 2)]; }
            __builtin_amdgcn_sched_barrier(0);
#pragma unroll
            for (int i = 0; i < 46; ++i) { const int r = tg - 30 + i; const unsigned p = wp[i] & (r >= bstart ? 0xffffffffu : 0u); wa[i] = bflo(p); wb[i] = bfhi(p); }
            float oa[16], ob[16];
#pragma unroll
            for (int i = 0; i < 16; ++i) { float a = cb.x, b = cb.y;
#pragma unroll
                for (int j = 0; j < CWID; ++j) { a += w0[j] * wa[i + j]; b += w1[j] * wb[i + j]; }
                oa[i] = a; ob[i] = b; }
#pragma unroll
            for (int i = 0; i < 16; ++i) { const float s = wave_sum(oa[i] + ob[i]), q = wave_sum(oa[i] * oa[i] + ob[i] * ob[i]); if (F.lane == 0) { red[F.wave * 32 + i] = s; red[F.wave * 32 + 16 + i] = q; } }
            __syncthreads();
            if (F.tid < 32) { float v = 0.f;
#pragma unroll
                for (int w = 0; w < 8; ++w) v += red[w * 32 + F.tid];
                stat[F.tid] = v; }
            __syncthreads();
#pragma unroll
            for (int i = 0; i < 16; ++i) { const float mu = stat[i] * (1.0f / CONV), var = fmaxf(stat[16 + i] * (1.0f / CONV) - mu * mu, 0.0f), rstd = 1.0f / sqrtf(var + EPS);
                const float ya = (oa[i] - mu) * rstd * lg.x + lb.x, yb = (ob[i] - mu) * rstd * lg.y + lb.y;
                AM[(size_t)(tg + i) * (D / 2) + F.tid] = (unsigned short)__builtin_amdgcn_cvt_pk_fp8_f32(ya * sigmoidf_(ya) * cinv, yb * sigmoidf_(yb) * cinv, 0, false); }
        }
    }
}

#define MFMA32(a, b, c) __builtin_amdgcn_mfma_f32_32x32x16_bf16((a), (b), (c), 0, 0, 0)
__device__ __forceinline__ void attn_phase(Frame& F, int l) {
    PHASE_TID(F);
    constexpr int VTS = 260;
    constexpr int KS = 72;
    LAS bf16* VT = (LAS bf16*)F.lds;
    LAS bf16* KL = (LAS bf16*)(F.lds + 34816);
    LAS float* BT = (LAS float*)(F.lds + 34816 + 36864);
    const bf16* Qg = WSP(bf16, WS_Q); const bf16* Kg = WSP(bf16, WS_K); const bf16* Vg = WSP(bf16, WS_V); unsigned char* AM = WSP(unsigned char, WS_AM);
    const float* BIAS = WSP(float, WS_BIAS);
    const int r = F.lane & 31, h = F.lane >> 5;
    for (int unit = F.vcu; unit < 512; unit += F.G) {
        const int b = unit >> 8, blk = (unit >> 2) & 63, kvh = unit & 3, kbase = blk * 128 - 128;
        const float vmx = __uint_as_float(__hip_atomic_load(F.ctl + CW_VMAX + 2 * l + b, __ATOMIC_RELAXED, __HIP_MEMORY_SCOPE_AGENT)), ainv = vmx > 0.f ? 440.0f / (1.02f * vmx) : 1.0f;
        for (int c = F.tid; c < 2048; c += NTHR) { const int key = c >> 3, d0 = (c & 7) * 8, kpos = kbase + key; v4u v = {0u, 0u, 0u, 0u}, kq = {0u, 0u, 0u, 0u};
            if (kpos >= 0) { v = *(const v4u*)(Vg + (size_t)(b * SEQ + kpos) * KVD + kvh * HD + d0); kq = *(const v4u*)(Kg + (size_t)(b * SEQ + kpos) * KVD + kvh * HD + d0); }
            *(LAS v4u*)(KL + key * KS + d0) = kq;
            LAS bf16* dst = VT + d0 * VTS + key;
            dst[0 * VTS] = (bf16)v.x; dst[1 * VTS] = (bf16)(v.x >> 16); dst[2 * VTS] = (bf16)v.y; dst[3 * VTS] = (bf16)(v.y >> 16);
            dst[4 * VTS] = (bf16)v.z; dst[5 * VTS] = (bf16)(v.z >> 16); dst[6 * VTS] = (bf16)v.w; dst[7 * VTS] = (bf16)(v.w >> 16); }
        BT[F.tid] = BIAS[(kvh * 4 + (F.tid >> 7)) * 128 + (F.tid & 127)];
        __syncthreads();
        for (int tk = 0; tk < 2; ++tk) {
            const int task = F.wave * 2 + tk, g = task >> 2, qs = task & 3, head = kvh * 4 + g;
            const size_t trow = (size_t)b * SEQ + blk * 128 + qs * 32 + r;
            bf16x8 qf[4];
#pragma unroll
            for (int s = 0; s < 4; ++s) qf[s] = *(const bf16x8*)(Qg + trow * ATT + head * HD + 16 * s + 8 * h);
            const float sink = F.A->in[I_SINK][l * NHEAD + head];
            float mx = sink, lsum = 0.f;
            f32x16 o[2];
#pragma unroll
            for (int i = 0; i < 16; ++i) { o[0][i] = 0.f; o[1][i] = 0.f; }
#pragma unroll 1
            for (int j = 0; j < 5; ++j) { f32x16 a;
#pragma unroll
                for (int i = 0; i < 16; ++i) a[i] = 0.f;
#pragma unroll
                for (int s = 0; s < 4; ++s) { const bf16x8 kf = *(const LAS bf16x8*)(KL + (qs * 32 + 32 * j + r) * KS + 16 * s + 8 * h); a = MFMA32(kf, qf[s], a); }
                float tmax = -INFINITY;
#pragma unroll
                for (int i = 0; i < 16; ++i) { const int kr = 32 * j + (i & 3) + 8 * (i >> 2) + 4 * h, dist = 128 + r - kr; const bool ok = dist >= 0 && dist < 128 && (kbase + qs * 32 + kr) >= 0;
                    const float sv = ok ? a[i] + BT[g * 128 + (dist & 127)] : -INFINITY; a[i] = sv; tmax = fmaxf(tmax, sv); }
                tmax = fmaxf(tmax, __shfl_xor(tmax, 32));
                const float mnew = fmaxf(mx, tmax), alpha = __expf(mx - mnew); mx = mnew; lsum *= alpha;
#pragma unroll
                for (int i = 0; i < 16; ++i) { o[0][i] *= alpha; o[1][i] *= alpha; const float p = __expf(a[i] - mx); a[i] = p; lsum += p; }
#pragma unroll
                for (int s2 = 0; s2 < 2; ++s2) { v4u pp; pp.x = pk2(a[8 * s2 + 0], a[8 * s2 + 1]); pp.y = pk2(a[8 * s2 + 2], a[8 * s2 + 3]); pp.z = pk2(a[8 * s2 + 4], a[8 * s2 + 5]); pp.w = pk2(a[8 * s2 + 6], a[8 * s2 + 7]);
                    const bf16x8 pf = __builtin_bit_cast(bf16x8, pp);
#pragma unroll
                    for (int dt = 0; dt < 2; ++dt) { const LAS bf16* vp = VT + (32 * dt + r) * VTS + qs * 32 + 32 * j + 16 * s2 + 4 * h; const v2u lo = *(const LAS v2u*)vp, hi = *(const LAS v2u*)(vp + 8);
                        v4u vv; vv.x = lo.x; vv.y = lo.y; vv.z = hi.x; vv.w = hi.y; o[dt] = MFMA32(__builtin_bit_cast(bf16x8, vv), pf, o[dt]); } }
            }
            lsum += __shfl_xor(lsum, 32);
            const float inv = ainv / (lsum + __expf(sink - mx));
#pragma unroll
            for (int dt = 0; dt < 2; ++dt)
#pragma unroll
                for (int g4 = 0; g4 < 4; ++g4) { int w = __builtin_amdgcn_cvt_pk_fp8_f32(o[dt][4 * g4 + 0] * inv, o[dt][4 * g4 + 1] * inv, 0, false); w = __builtin_amdgcn_cvt_pk_fp8_f32(o[dt][4 * g4 + 2] * inv, o[dt][4 * g4 + 3] * inv, w, true);
                    *(unsigned*)(AM + trow * D + ATT + head * HD + 32 * dt + 8 * g4 + 4 * h) = (unsigned)w; }
        }
        __syncthreads();
    }
}

__device__ __forceinline__ unsigned f2key(float f) { const unsigned u = __float_as_uint(f); return (u & 0x80000000u) ? ~u : (u | 0x80000000u); }
__device__ __forceinline__ float key2f(unsigned k) { const unsigned u = (k & 0x80000000u) ? (k & 0x7fffffffu) : ~k; return __uint_as_float(u); }
#define INSERT16(L, x_) do { unsigned x__ = (x_); _Pragma("unroll") for (int q_ = 0; q_ < 16; ++q_) { const unsigned hi_ = L[q_] > x__ ? L[q_] : x__; x__ = L[q_] > x__ ? x__ : L[q_]; L[q_] = hi_; } } while (0)
__device__ __forceinline__ void topk_phase(Frame& F) {
    PHASE_TID(F);
    const _Float16* S = WSP(_Float16, WS_GC); int* IDX = WSP(int, WS_U); float* GATE = WSP(float, WS_U + 8 * MiB);
    const int gw = F.vcu * NWAVES + F.wave, NGW = F.G * NWAVES;
    for (int grp = gw; grp < T * PHEADS / 64; grp += NGW) {
        const int item = grp * 64 + F.lane, t = item >> 3, hh = item & 7;
        const pg8::f16x8* srow = (const pg8::f16x8*)(S + (size_t)t * D + hh * 256);
        unsigned L1[16], L2[16];
#pragma unroll
        for (int q = 0; q < 16; ++q) { L1[q] = 0u; L2[q] = 0u; }
#pragma unroll 2
        for (int c = 0; c < 16; ++c) { const pg8::f16x8 v = srow[c];
#pragma unroll
            for (int e = 0; e < 8; ++e) { const unsigned key = (f2key((float)v[e]) & ~127u) | (unsigned)(127 - (8 * c + e)); INSERT16(L1, key); } }
#pragma unroll 2
        for (int c = 0; c < 16; ++c) { const pg8::f16x8 v = srow[16 + c];
#pragma unroll
            for (int e = 0; e < 8; ++e) { const unsigned key = (f2key((float)v[e]) & ~127u) | (unsigned)(127 - (8 * c + e)); INSERT16(L2, key); } }
        float v1[16], v2[16];
#pragma unroll
        for (int q = 0; q < 16; ++q) { v1[q] = key2f(L1[q] & ~127u); v2[q] = key2f(L2[q] & ~127u); }
        unsigned B[16];
#pragma unroll
        for (int q = 0; q < 16; ++q) B[q] = 0u;
#pragma unroll
        for (int i = 0; i < 16; ++i)
#pragma unroll
            for (int j = 0; j < 16; ++j) if ((i + 1) * (j + 1) <= 16) { const unsigned key = (f2key(v1[i] + v2[j]) & ~255u) | (unsigned)(255 - (i * 16 + j)); INSERT16(B, key); }
        const float b0 = key2f(B[0] & ~255u); float e[16], es = 0.f;
#pragma unroll
        for (int q = 0; q < 16; ++q) { e[q] = __expf(key2f(B[q] & ~255u) - b0); es += e[q]; }
        const float einv = 1.0f / es;
        int ex[16];
#pragma unroll
        for (int q = 0; q < 16; ++q) { const int code = 255 - (int)(B[q] & 255u), ii = code >> 4, jj = code & 15; unsigned s1 = L1[0], s2 = L2[0];
#pragma unroll
            for (int z = 1; z < 16; ++z) { s1 = (ii == z) ? L1[z] : s1; s2 = (jj == z) ? L2[z] : s2; }
            ex[q] = (127 - (int)(s1 & 127u)) * 128 + (127 - (int)(s2 & 127u)); e[q] *= einv; }
        int* ip = IDX + (size_t)t * 128 + hh * 16; float* gp = GATE + (size_t)t * 128 + hh * 16;
#pragma unroll
        for (int q = 0; q < 4; ++q) { *(int4*)(ip + 4 * q) = make_int4(ex[4 * q], ex[4 * q + 1], ex[4 * q + 2], ex[4 * q + 3]); *(f32x4*)(gp + 4 * q) = (f32x4){e[4 * q], e[4 * q + 1], e[4 * q + 2], e[4 * q + 3]}; }
    }
}

#define FP8LO(w_) __builtin_amdgcn_cvt_pk_f32_fp8((int)(w_), false)
#define FP8HI(w_) __builtin_amdgcn_cvt_pk_f32_fp8((int)(w_), true)
__device__ __forceinline__ void pa_issue(v4u (&rr)[16], int id0, int id1, const unsigned char* tab, int g) {
#pragma unroll
    for (int i = 0; i < 16; ++i) { const int e = __shfl(i < 8 ? id0 : id1, ((8 * i) & 63) + g); rr[i] = *(const v4u*)(tab + (size_t)e * SLW); }
}
__device__ __forceinline__ void pa_compute(const v4u (&rr)[16], const v4u ha, const v4u hb, float o0, float o1, float* d0, float* d1, int lane) {
    f32x2 hf[8];
    hf[0] = (f32x2){bflo(ha.x), bfhi(ha.x)}; hf[1] = (f32x2){bflo(ha.y), bfhi(ha.y)}; hf[2] = (f32x2){bflo(ha.z), bfhi(ha.z)}; hf[3] = (f32x2){bflo(ha.w), bfhi(ha.w)};
    hf[4] = (f32x2){bflo(hb.x), bfhi(hb.x)}; hf[5] = (f32x2){bflo(hb.y), bfhi(hb.y)}; hf[6] = (f32x2){bflo(hb.z), bfhi(hb.z)}; hf[7] = (f32x2){bflo(hb.w), bfhi(hb.w)};
    float p[16];
#pragma unroll
    for (int i = 0; i < 16; ++i) { f32x2 a = FP8LO(rr[i].x) * hf[0];
        a = __builtin_elementwise_fma(FP8HI(rr[i].x), hf[1], a); a = __builtin_elementwise_fma(FP8LO(rr[i].y), hf[2], a); a = __builtin_elementwise_fma(FP8HI(rr[i].y), hf[3], a);
        a = __builtin_elementwise_fma(FP8LO(rr[i].z), hf[4], a); a = __builtin_elementwise_fma(FP8HI(rr[i].z), hf[5], a); a = __builtin_elementwise_fma(FP8LO(rr[i].w), hf[6], a); a = __builtin_elementwise_fma(FP8HI(rr[i].w), hf[7], a);
        p[i] = a.x + a.y; }
    float q8[8], q4[4], q2[2];
    { const bool bt = (lane & 1) != 0;
#pragma unroll
      for (int i = 0; i < 8; ++i) { const float snd = bt ? p[i] : p[i + 8], kp = bt ? p[i + 8] : p[i]; q8[i] = kp + lane_xor1(snd); } }
    { const bool bt = (lane & 2) != 0;
#pragma unroll
      for (int i = 0; i < 4; ++i) { const float snd = bt ? q8[i] : q8[i + 4], kp = bt ? q8[i + 4] : q8[i]; q4[i] = kp + lane_xor2(snd); } }
    { const bool bt = (lane & 4) != 0;
#pragma unroll
      for (int i = 0; i < 2; ++i) { const float snd = bt ? q4[i] : q4[i + 2], kp = bt ? q4[i + 2] : q4[i]; q2[i] = kp + lane_xor4(snd); } }
    *d0 = o0 + q2[0]; *d1 = o1 + q2[1];
}
__device__ __forceinline__ void peer_act_phase(Frame& F, int l) {
    PHASE_TID(F);
    const int lane = F.lane, g = lane >> 3, j = lane & 7;
    const int x = blockIdx.x & 7, bpg = F.G >> 3, wpg = bpg * NWAVES, wgi = (blockIdx.x >> 3) * NWAVES + F.wave;
    const int* IDX = WSP(int, WS_U); const bf16* Hb = WSP(bf16, WS_H);
    float* actp = WSP(float, WS_AM) + (size_t)x * T * 128;
    const int irev = 8 * (j & 1) + 4 * ((j >> 1) & 1) + 2 * (j >> 2), k0 = 8 * irev + g, k1 = k0 + 8;
    const int NT = (T - wgi + wpg - 1) / wpg;
    for (int s = 0; s < 2; ++s) {
        const int sl = 2 * x + s; const unsigned char* tab = WSP(unsigned char, WS_PU) + (size_t)(l * NSL + sl) * NEXP * SLW + 16 * j;
        const bf16* hcol = Hb + sl * SLW + 16 * j;
#define PA_PREF(n_, i0, i1, h0, h1, q0, q1) do { const int t_ = wgi + (n_) * wpg; if ((n_) < NT) { i0 = IDX[(size_t)t_ * 128 + lane]; i1 = IDX[(size_t)t_ * 128 + 64 + lane]; h0 = *(const v4u*)(hcol + (size_t)t_ * D); h1 = *(const v4u*)(hcol + (size_t)t_ * D + 8); \
            if (s > 0) { q0 = actp[(size_t)t_ * 128 + k0]; q1 = actp[(size_t)t_ * 128 + k1]; } } } while (0)
        int ia0 = 0, ia1 = 0, ib0 = 0, ib1 = 0; v4u ha0 = {0u, 0u, 0u, 0u}, ha1 = ha0, hb0 = ha0, hb1 = ha0; float oa0 = 0.f, oa1 = 0.f, ob0 = 0.f, ob1 = 0.f;
        v4u rA[16], rB[16];
        PA_PREF(0, ia0, ia1, ha0, ha1, oa0, oa1); PA_PREF(1, ib0, ib1, hb0, hb1, ob0, ob1);
        if (0 < NT) pa_issue(rA, ia0, ia1, tab, g);
        for (int n = 0; n < NT; n += 2) {
            const v4u ca0 = ha0, ca1 = ha1; const float pa0 = oa0, pa1 = oa1;
            if (n + 1 < NT) pa_issue(rB, ib0, ib1, tab, g);
            PA_PREF(n + 2, ia0, ia1, ha0, ha1, oa0, oa1);
            __builtin_amdgcn_sched_barrier(0);
            { const size_t t_ = (size_t)(wgi + n * wpg); pa_compute(rA, ca0, ca1, pa0, pa1, actp + t_ * 128 + k0, actp + t_ * 128 + k1, lane); }
            __builtin_amdgcn_sched_barrier(0);
            if (n + 1 < NT) {
                const v4u cb0 = hb0, cb1 = hb1; const float pb0 = ob0, pb1 = ob1;
                if (n + 2 < NT) pa_issue(rA, ia0, ia1, tab, g);
                PA_PREF(n + 3, ib0, ib1, hb0, hb1, ob0, ob1);
                __builtin_amdgcn_sched_barrier(0);
                { const size_t t_ = (size_t)(wgi + (n + 1) * wpg); pa_compute(rB, cb0, cb1, pb0, pb1, actp + t_ * 128 + k0, actp + t_ * 128 + k1, lane); }
                __builtin_amdgcn_sched_barrier(0);
            }
        }
#undef PA_PREF
    }
}
__device__ __forceinline__ void peer_w_phase(Frame& F, int l) {
    PHASE_TID(F);
    const int lane = F.lane;
    constexpr int WROW = 136;
    LAS bf16* wl = (LAS bf16*)F.lds; LAS bf16* il = wl + 64 * WROW;
    const int* IDX = WSP(int, WS_U); const float* GATE = WSP(float, WS_U + 8 * MiB); const float* actp = WSP(float, WS_AM);
    bf16* WT = WSP(bf16, WS_Y1); bf16* IT = WSP(bf16, WS_Y1 + 4 * MiB);
    const float* su = WSP(float, WS_SCL) + l * NEXP; const float* sv = WSP(float, WS_SCL) + (2 + l) * NEXP;
    for (int tb = F.vcu; tb < T / 64; tb += F.G) {
#pragma unroll 2
        for (int i = 0; i < 8; ++i) { const int tl = F.wave * 8 + i, t = tb * 64 + tl;
            const int e0 = IDX[(size_t)t * 128 + lane], e1 = IDX[(size_t)t * 128 + 64 + lane];
            float pa[8], pb[8];
#pragma unroll
            for (int xx = 0; xx < 8; ++xx) { pa[xx] = actp[((size_t)xx * T + t) * 128 + lane]; pb[xx] = actp[((size_t)xx * T + t) * 128 + 64 + lane]; }
            const float gt0 = GATE[(size_t)t * 128 + lane], gt1 = GATE[(size_t)t * 128 + 64 + lane];
            const float su0 = su[e0], su1 = su[e1], sv0 = sv[e0], sv1 = sv[e1];
            __builtin_amdgcn_sched_barrier(0);
            float a0 = ((pa[0] + pa[1]) + (pa[2] + pa[3])) + ((pa[4] + pa[5]) + (pa[6] + pa[7])), a1 = ((pb[0] + pb[1]) + (pb[2] + pb[3])) + ((pb[4] + pb[5]) + (pb[6] + pb[7]));
            a0 *= su0; a1 *= su1;
            const float g0 = gt0 * sv0, g1 = gt1 * sv1;
            wl[tl * WROW + lane] = __builtin_bit_cast(bf16, (_Float16)(256.0f * g0 * 0.5f * a0 * (1.0f + erff(a0 * 0.70710678118654752f)))); wl[tl * WROW + 64 + lane] = __builtin_bit_cast(bf16, (_Float16)(256.0f * g1 * 0.5f * a1 * (1.0f + erff(a1 * 0.70710678118654752f))));
            il[tl * WROW + lane] = (bf16)e0; il[tl * WROW + 64 + lane] = (bf16)e1; }
        __syncthreads();
#pragma unroll
        for (int i = 0; i < 2; ++i) { const int p_ = i * NTHR + F.tid, kq = p_ >> 6, tl = p_ & 63; const size_t o = ((size_t)(tb * 16 + kq) * 64 + tl) * 8;
            *(v4u*)(WT + o) = *(const LAS v4u*)(wl + tl * WROW + 8 * kq); *(v4u*)(IT + o) = *(const LAS v4u*)(il + tl * WROW + 8 * kq); }
        __syncthreads();
    }
}
__device__ __forceinline__ void pbl_load(v4u (&iv)[4], v4u (&wv)[4], const bf16* ip, const bf16* wp) {
#pragma unroll
    for (int q = 0; q < 4; ++q) { iv[q] = *(const v4u*)(ip + q * 512); wv[q] = *(const v4u*)(wp + q * 512); }
}
typedef _Float16 h16x2 __attribute__((ext_vector_type(2)));
#define FP8H_LO(w_) __builtin_bit_cast(h16x2, __builtin_amdgcn_cvt_scalef32_pk_f16_fp8((int)(w_), 1.0f, false))
#define FP8H_HI(w_) __builtin_bit_cast(h16x2, __builtin_amdgcn_cvt_scalef32_pk_f16_fp8((int)(w_), 1.0f, true))
__device__ __forceinline__ void pbl_compute(const v4u (&iv)[4], const v4u (&wv)[4], h16x2 (&acc)[4], LAS unsigned char* lds) {
#pragma unroll
    for (int q = 0; q < 4; ++q) { v2u d[8];
#pragma unroll
        for (int ki = 0; ki < 8; ++ki) { const unsigned ipair = iv[q][ki >> 1]; const unsigned idx = (ki & 1) ? (ipair >> 16) : (ipair & 0xffffu); d[ki] = *(const LAS v2u*)(lds + idx * 8); }
        __builtin_amdgcn_sched_barrier(0);
#pragma unroll
        for (int ki = 0; ki < 8; ++ki) { const unsigned wword = wv[q][ki >> 1], wb = (ki & 1) ? (wword >> 16) : (wword & 0xffffu); const h16x2 w2 = __builtin_bit_cast(h16x2, wb | (wb << 16));
            acc[0] = __builtin_elementwise_fma(FP8H_LO(d[ki].x), w2, acc[0]); acc[1] = __builtin_elementwise_fma(FP8H_HI(d[ki].x), w2, acc[1]); acc[2] = __builtin_elementwise_fma(FP8H_LO(d[ki].y), w2, acc[2]); acc[3] = __builtin_elementwise_fma(FP8H_HI(d[ki].y), w2, acc[3]); }
        __builtin_amdgcn_sched_barrier(0); }
}
__device__ __forceinline__ void peer_out_phase(Frame& F, int l) {
    PHASE_TID(F);
    const int lane = F.lane;
    const int x = blockIdx.x & 7, ib = blockIdx.x >> 3, j = 8 * (4 * x + (ib >> 3)) + (ib & 7);
    const bf16* WT = WSP(bf16, WS_Y1); const bf16* IT = WSP(bf16, WS_Y1 + 4 * MiB); bf16* OUT = WSP(bf16, WS_GC);
    for (int jj = (F.G == 256 ? j : (int)blockIdx.x); jj < 256; jj += (F.G == 256 ? 256 : F.G)) {
        const unsigned char* sl = WSP(unsigned char, WS_PV) + (size_t)(l * 256 + jj) * NEXP * 8;
#pragma unroll 4
        for (int i = 0; i < 16; ++i) { const int o = (i * NTHR + F.tid) * 16; *(LAS v4u*)(F.lds + o) = *(const v4u*)(sl + o); }
        __syncthreads();
        constexpr int NCH = 4 * (T / 64 / NWAVES);
#define PBL_PTR(c_, arr_) ((arr_) + ((size_t)(F.wave + NWAVES * ((c_) >> 2)) * 16 * 64 + lane) * 8 + ((c_) & 3) * 4 * 512)
        v4u iA[4], wA[4], iB[4], wB[4], iC[4], wC[4]; h16x2 acc[4];
#define PBL_STEP(X_, Z_, c_) do { const int cc_ = (c_); if (cc_ + 2 < NCH) pbl_load(i##Z_, w##Z_, PBL_PTR(cc_ + 2, IT), PBL_PTR(cc_ + 2, WT)); \
            __builtin_amdgcn_sched_barrier(0); \
            if ((cc_ & 3) == 0) { _Pragma("unroll") for (int q = 0; q < 4; ++q) acc[q] = (h16x2){(_Float16)0.f, (_Float16)0.f}; } \
            pbl_compute(i##X_, w##X_, acc, F.lds); \
            if ((cc_ & 3) == 3) { constexpr float us_ = 1.0f / 256.0f; v4u o; o.x = pk2((float)acc[0].x * us_, (float)acc[0].y * us_); o.y = pk2((float)acc[1].x * us_, (float)acc[1].y * us_); o.z = pk2((float)acc[2].x * us_, (float)acc[2].y * us_); o.w = pk2((float)acc[3].x * us_, (float)acc[3].y * us_); \
                *(v4u*)(OUT + (size_t)((F.wave + NWAVES * (cc_ >> 2)) * 64 + lane) * D + 8 * jj) = o; } \
            __builtin_amdgcn_sched_barrier(0); } while (0)
        pbl_load(iA, wA, PBL_PTR(0, IT), PBL_PTR(0, WT)); pbl_load(iB, wB, PBL_PTR(1, IT), PBL_PTR(1, WT));
#pragma unroll 1
        for (int c = 0; c < NCH; c += 3) {
            PBL_STEP(A, C, c);
            if (c + 1 < NCH) PBL_STEP(B, A, c + 1);
            if (c + 2 < NCH) PBL_STEP(C, B, c + 2);
        }
#undef PBL_STEP
#undef PBL_PTR
        __syncthreads();
    }
}
__device__ __forceinline__ void peer_res_phase(Frame& F, int l, bf16* XO) {
    PHASE_TID(F);
    const bool last = (l == 1);
    const int gw = F.vcu * NWAVES + F.wave, NGW = F.G * NWAVES, lane = F.lane;
    const bf16* XA = WSP(bf16, WS_XA); const bf16* OUTS = WSP(bf16, WS_GC); bf16* Hb = WSP(bf16, WS_H); const float* MOD = WSP(float, WS_MOD);
    for (int t = gw; t < T; t += NGW) {
        const int b = t >> 13; const float* g2 = MOD + (size_t)(l * 2 + b) * 12288 + 5 * 2048;
        f32x4 v[8], gq[8]; v2u oq[8], xq[8]; float ss = 0.f;
#pragma unroll
        for (int jj = 0; jj < 8; ++jj) { const int col = 4 * lane + 256 * jj; xq[jj] = *(const v2u*)(XA + (size_t)t * D + col); gq[jj] = *(const f32x4*)(g2 + col); oq[jj] = *(const v2u*)(OUTS + (size_t)t * D + col); }
        __builtin_amdgcn_sched_barrier(0);
#pragma unroll
        for (int jj = 0; jj < 8; ++jj) { const f32x4 o = {bflo(oq[jj].x), bfhi(oq[jj].x), bflo(oq[jj].y), bfhi(oq[jj].y)}; v[jj] = (f32x4){bflo(xq[jj].x), bfhi(xq[jj].x), bflo(xq[jj].y), bfhi(xq[jj].y)};
            v[jj] = v[jj] + gq[jj] * o; ss += (v[jj].x * v[jj].x + v[jj].y * v[jj].y) + (v[jj].z * v[jj].z + v[jj].w * v[jj].w); }
        const float rstd = 1.0f / sqrtf(wave_sum(ss) * (1.0f / D) + EPS);
        if (!last) {
            const float* ng = F.A->in[I_N1G] + (size_t)(l + 1) * D; const float* mn = MOD + (size_t)((l + 1) * 2 + b) * 12288;
#pragma unroll
            for (int jj = 0; jj < 8; ++jj) gq[jj] = *(const f32x4*)(ng + 4 * lane + 256 * jj);
            f32x4 shq[8], scq[8];
#pragma unroll
            for (int jj = 0; jj < 8; ++jj) { scq[jj] = *(const f32x4*)(mn + 2048 + 4 * lane + 256 * jj); shq[jj] = *(const f32x4*)(mn + 4 * lane + 256 * jj); }
            __builtin_amdgcn_sched_barrier(0);
#pragma unroll
            for (int jj = 0; jj < 8; ++jj) gq[jj] = gq[jj] * (scq[jj] + 1.0f);
#pragma unroll
            for (int jj = 0; jj < 8; ++jj) { const int col = 4 * lane + 256 * jj; v2u w; w.x = pk2(v[jj].x, v[jj].y); w.y = pk2(v[jj].z, v[jj].w); *(v2u*)(XO + (size_t)t * D + col) = w; v[jj] = v[jj] * rstd * gq[jj] + shq[jj]; }
            row_to_fp8(v, (unsigned char*)Hb + (size_t)t * D, WSP(float, WS_SA) + t, lane);
        } else {
            const float* fg = F.A->in[I_FG];
#pragma unroll
            for (int jj = 0; jj < 8; ++jj) gq[jj] = *(const f32x4*)(fg + 4 * lane + 256 * jj);
            __builtin_amdgcn_sched_barrier(0);
#pragma unroll
            for (int jj = 0; jj < 8; ++jj) *(f32x4*)(F.out + (size_t)t * D + 4 * lane + 256 * jj) = v[jj] * rstd * gq[jj];
        }
    }
}

#ifndef MK_ONE_LAUNCH
#define MK_ONE_LAUNCH 1
#endif
#define PG8_ALIGN true
#define PG8_SP2 true
constexpr int PH_PER_LAYER = 13, N_PHASES = 1 + 2 * PH_PER_LAYER;
__global__ void __launch_bounds__(NTHR, 2) fwd(Args args) {
    extern __shared__ __attribute__((aligned(16))) unsigned char lds[];
    Frame F;
    F.lds = (LAS unsigned char*)lds; F.MISC = (volatile LAS unsigned*)(F.lds + MISC_OFF);
    F.tid = threadIdx.x; F.lane = F.tid & 63; F.wave = __builtin_amdgcn_readfirstlane(F.tid >> 6);
    F.G = gridDim.x; { const int bx = blockIdx.x; F.vcu = (F.G % 8 == 0) ? (bx % 8) * (F.G / 8) + bx / 8 : bx; }
    F.A = &args;
    F.out = args.out; F.ws = args.ws; F.ctl = (gu32*)(args.ws + WS_CTL);
    for (int u = F.tid; u < (LDS_BYTES - LDSCTL_OFF) / 4; u += NTHR) ((LAS unsigned*)(F.lds + LDSCTL_OFF))[u] = 0u;
    __syncthreads();
#if MK_ONE_LAUNCH
    XcdBarrier bar = xcd_barrier_post((unsigned*)(F.ctl + CW_BAR), F.MISC + 8);
#define GRID_BAR() xcd_barrier(bar)
#else
#define GRID_BAR() do { } while (0)
#endif
    const int lo = args.ph_lo, hi = args.ph_hi;
#define IN(k) (lo <= (k) && (k) < hi)
#define SEAM(k) do { if (IN(k) && IN((k) + 1)) GRID_BAR(); } while (0)
    float* MOD = WSP(float, WS_MOD);
    pg8::bf16_t* Hb = WSP(pg8::bf16_t, WS_H);

    if (IN(0)) { p0_prologue(F); SEAM(0); }
    for (int l = 0; l < 2; ++l) {
        const int pb = 1 + PH_PER_LAYER * l;
        const float* modl = MOD + (size_t)l * 2 * 12288;
        if (IN(pb + 0) && l == 0) { norm_phase<true, false>(F, F.A->in[I_X], WSP(bf16, WS_H), F.A->in[I_N1G], modl, 0, 1);
            win8_phase(F);
            SEAM(pb + 0); }
        if (IN(pb + 1)) {
            pg8::Gemm g{Hb, (const pg8::bf16_t*)(WSP(unsigned char, WS_WIN) + (size_t)l * IN_DIM * 2048), T, IN_DIM, D / 2, D / 2, D / 2}; pg8::StaticOrder S; S.init(T, IN_DIM, F.G, (int)blockIdx.x);
            const float wmax = __uint_as_float(__hip_atomic_load(F.ctl + CW_WMAX + l, __ATOMIC_RELAXED, __HIP_MEMORY_SCOPE_AGENT));
            pg8::EpiInProj E{WSP(pg8::bf16_t, WS_U), WSP(pg8::bf16_t, WS_Q), WSP(pg8::bf16_t, WS_K), WSP(pg8::bf16_t, WS_V), WSP(pg8::bf16_t, WS_GC), WSP(pg8::bf16_t, WS_GA), WSP(float, WS_SA), wmax > 0.f ? wmax * (1.0f / 440.0f) : 1.0f, (unsigned*)(F.ctl + CW_VMAX + 2 * l)};
            pg8::gemm_phase<pg8::EpiInProj, pg8::StaticOrder, PG8_ALIGN, PG8_SP2, true>(F.lds, g, S, E);
            SEAM(pb + 1);
        }
        if (IN(pb + 2)) { conv_phase(F, l); __syncthreads(); attn_phase(F, l); SEAM(pb + 2); }
        if (IN(pb + 3)) {
            pg8::Gemm g{WSP(pg8::bf16_t, WS_AM), (const pg8::bf16_t*)(WSP(unsigned char, WS_WM) + (size_t)l * 2048 * 2048), T, D, D / 2, D / 2, D / 2}; pg8::StaticOrder S; S.init(T, D, F.G, (int)blockIdx.x);
            const float i440 = 1.0f / 440.0f;
            const float wc_ = __uint_as_float(__hip_atomic_load(F.ctl + CW_WMAX2 + 2 * l, __ATOMIC_RELAXED, __HIP_MEMORY_SCOPE_AGENT)), wa_ = __uint_as_float(__hip_atomic_load(F.ctl + CW_WMAX2 + 2 * l + 1, __ATOMIC_RELAXED, __HIP_MEMORY_SCOPE_AGENT));
            const float bc_ = __uint_as_float(__hip_atomic_load(F.ctl + CW_BC + l, __ATOMIC_RELAXED, __HIP_MEMORY_SCOPE_AGENT));
            const float swc = wc_ > 0.f ? wc_ * i440 : 1.0f, swa = wa_ > 0.f ? wa_ * i440 : 1.0f, sc = bc_ * i440;
            const float vm0 = __uint_as_float(__hip_atomic_load(F.ctl + CW_VMAX + 2 * l, __ATOMIC_RELAXED, __HIP_MEMORY_SCOPE_AGENT)), vm1 = __uint_as_float(__hip_atomic_load(F.ctl + CW_VMAX + 2 * l + 1, __ATOMIC_RELAXED, __HIP_MEMORY_SCOPE_AGENT));
            const float fe0 = (vm0 > 0.f ? 1.02f * vm0 * i440 : 1.0f) * swa, fe1 = (vm1 > 0.f ? 1.02f * vm1 * i440 : 1.0f) * swa;
            const float bc2 = __uint_as_float(__hip_atomic_load(F.ctl + CW_BC2 + l, __ATOMIC_RELAXED, __HIP_MEMORY_SCOPE_AGENT));
            const float bm0 = fmaxf(1024.0f * (bc2 * wc_ + 1.02f * vm0 * wa_), 1e-20f), bm1 = fmaxf(1024.0f * (bc2 * wc_ + 1.02f * vm1 * wa_), 1e-20f);
            pg8::EpiMerge E{WSP(pg8::bf16_t, WS_GC), WSP(pg8::bf16_t, WS_GA), WSP(unsigned char, WS_H), (sc * swc) / fe0, (sc * swc) / fe1, fe0 * (440.0f / bm0), fe1 * (440.0f / bm1)};
            pg8::gemm_phase<pg8::EpiMerge, pg8::StaticOrder, PG8_ALIGN, PG8_SP2, true>(F.lds, g, S, E);
            SEAM(pb + 3);
        }
        if (IN(pb + 5)) {
            pg8::Gemm g{Hb, (const pg8::bf16_t*)(WSP(unsigned char, WS_WO) + (size_t)l * 2048 * 2048), T, D, D / 2, D / 2, D / 2}; pg8::StaticOrder S; S.init(T, D, F.G, (int)blockIdx.x);
            const float i440 = 1.0f / 440.0f;
            const float wc_ = __uint_as_float(__hip_atomic_load(F.ctl + CW_WMAX2 + 2 * l, __ATOMIC_RELAXED, __HIP_MEMORY_SCOPE_AGENT)), wa_ = __uint_as_float(__hip_atomic_load(F.ctl + CW_WMAX2 + 2 * l + 1, __ATOMIC_RELAXED, __HIP_MEMORY_SCOPE_AGENT));
            const float wo_ = __uint_as_float(__hip_atomic_load(F.ctl + CW_WMAX3 + l, __ATOMIC_RELAXED, __HIP_MEMORY_SCOPE_AGENT)), swo = wo_ > 0.f ? wo_ * i440 : 1.0f;
            const float bc2 = __uint_as_float(__hip_atomic_load(F.ctl + CW_BC2 + l, __ATOMIC_RELAXED, __HIP_MEMORY_SCOPE_AGENT));
            const float vm0 = __uint_as_float(__hip_atomic_load(F.ctl + CW_VMAX + 2 * l, __ATOMIC_RELAXED, __HIP_MEMORY_SCOPE_AGENT)), vm1 = __uint_as_float(__hip_atomic_load(F.ctl + CW_VMAX + 2 * l + 1, __ATOMIC_RELAXED, __HIP_MEMORY_SCOPE_AGENT));
            const float bm0 = fmaxf(1024.0f * (bc2 * wc_ + 1.02f * vm0 * wa_), 1e-20f), bm1 = fmaxf(1024.0f * (bc2 * wc_ + 1.02f * vm1 * wa_), 1e-20f);
            if (l == 0) { pg8::EpiResid<false> E{F.A->in[I_X], WSP(pg8::bf16_t, WS_XA), modl + 2 * 2048, bm0 * i440 * swo, bm1 * i440 * swo};
                pg8::gemm_phase<pg8::EpiResid<false>, pg8::StaticOrder, PG8_ALIGN, PG8_SP2, true>(F.lds, g, S, E); }
            else { pg8::EpiResid<true> E{WSP(pg8::bf16_t, WS_XA), WSP(pg8::bf16_t, WS_XA), modl + 2 * 2048, bm0 * i440 * swo, bm1 * i440 * swo};
                pg8::gemm_phase<pg8::EpiResid<true>, pg8::StaticOrder, PG8_ALIGN, PG8_SP2, true>(F.lds, g, S, E); }
            SEAM(pb + 5);
        }
        if (IN(pb + 6)) { norm_phase<false, true>(F, WSP(bf16, WS_XA), WSP(bf16, WS_H), F.A->in[I_N2G] + (size_t)l * D, modl, 3, 4); SEAM(pb + 6); }
        if (IN(pb + 7)) {
            pg8::Gemm g{Hb, WSP(pg8::bf16_t, WS_WP) + (size_t)l * 2048 * 2048, T, D, D, D, D}; pg8::StaticOrder S; S.init(T, D, F.G, (int)blockIdx.x);
            pg8::EpiF16 E{WSP(_Float16, WS_GC), D};
            pg8::gemm_phase<pg8::EpiF16, pg8::StaticOrder, PG8_ALIGN, PG8_SP2>(F.lds, g, S, E);
            SEAM(pb + 7);
        }
        if (IN(pb + 8)) { topk_phase(F); SEAM(pb + 8); }
        if (IN(pb + 9)) { peer_act_phase(F, l); SEAM(pb + 9); }
        if (IN(pb + 10)) { peer_w_phase(F, l); SEAM(pb + 10); }
        if (IN(pb + 11)) { peer_out_phase(F, l); SEAM(pb + 11); }
        if (IN(pb + 12)) { peer_res_phase(F, l, WSP(bf16, WS_XA)); SEAM(pb + 12); }
    }
#undef IN
#undef SEAM
}

extern "C" void kernel_launch(void* const* d_in, const int* in_sizes, int n_in, void* d_out, int out_size, void* d_ws, size_t ws_size, hipStream_t stream) {
    static int grid = 0;
    if (grid == 0) {
        if (n_in != N_IN || out_size != T * D || ws_size < WS_END) { fprintf(stderr, "kernel_launch: unexpected problem: n_in %d out %d ws %zu (need %zu)\n", n_in, out_size, ws_size, (size_t)WS_END); grid = -1; return; }
        int dev = 0, cus = 0, per_cu = 0;
        if (hipGetDevice(&dev) != hipSuccess || hipDeviceGetAttribute(&cus, hipDeviceAttributeMultiprocessorCount, dev) != hipSuccess) { grid = -1; return; }
        if (hipFuncSetAttribute((const void*)fwd, hipFuncAttributeMaxDynamicSharedMemorySize, LDS_BYTES) != hipSuccess) { fprintf(stderr, "kernel_launch: hipFuncSetAttribute failed\n"); grid = -1; return; }
        if (hipOccupancyMaxActiveBlocksPerMultiprocessor(&per_cu, (const void*)fwd, NTHR, LDS_BYTES) != hipSuccess || per_cu < 1) fprintf(stderr, "kernel_launch: occupancy query reports %d\n", per_cu);
        (void)hipGetLastError();
        grid = cus;
    }
    if (grid < 0) return;
    (void)in_sizes;
    if (hipMemsetAsync((char*)d_ws + WS_CTL, 0, CTL_ZERO_BYTES, stream) != hipSuccess) return;
    Args a{};
    for (int i = 0; i < N_IN; ++i) a.in[i] = (const float*)d_in[i];
    a.out = (float*)d_out; a.ws = (unsigned char*)d_ws;
#if MK_ONE_LAUNCH
    a.ph_lo = 0; a.ph_hi = N_PHASES;
    hipLaunchKernelGGL(fwd, dim3(grid), dim3(NTHR), LDS_BYTES, stream, a);
#else
    for (int p = 0; p < N_PHASES; ++p) {
        if (p == 1 + PH_PER_LAYER) continue;
        a.ph_lo = p; a.ph_hi = p + 1;
        hipLaunchKernelGGL(fwd, dim3(grid), dim3(NTHR), LDS_BYTES, stream, a);
    }
#endif
}
```

```cpp
#include <hip/hip_runtime.h>
#include <cstdio>
#include <cstdint>
namespace pg8 {
#define PG8_LAS __attribute__((address_space(3)))
typedef unsigned short bf16_t;
typedef short bf16x8 __attribute__((ext_vector_type(8)));
typedef float f32x4 __attribute__((ext_vector_type(4)));
typedef unsigned u32x4 __attribute__((ext_vector_type(4)));
typedef int i32x4 __attribute__((ext_vector_type(4)));
typedef int i32x8 __attribute__((ext_vector_type(8)));
__device__ __forceinline__ i32x8 cat8(const bf16x8& a, const bf16x8& b) { const i32x4 x = __builtin_bit_cast(i32x4, a), y = __builtin_bit_cast(i32x4, b); return (i32x8){x[0], x[1], x[2], x[3], y[0], y[1], y[2], y[3]}; }
constexpr int BM = 256, BK = 64, HALF = 128, HTB = HALF * BK * 2  , STAGE_BYTES = 8 * HTB, NXCD = 8, WGM = 4;

__host__ __device__ __forceinline__ int lds_byte(int r, int c) { const int st = (r >> 4) * 2 + (c >> 5), rr = r & 15, cc = c & 31, ob = rr * 64 + cc * 2; return st * 1024 + (ob ^ (((ob >> 9) & 1) << 5)); }
__host__ __device__ __forceinline__ void stage_rc(int b, int& R, int& C) { const int st = b / 1024, sb = b % 1024, swz = sb ^ (((sb >> 9) & 1) << 5); R = (st >> 1) * 16 + swz / 64; C = (st & 1) * 32 + (swz % 64) / 2; }
__host__ __device__ __forceinline__ int perm32(int rho) { const int n = rho >> 4, i = rho & 15; return 8 * (i >> 2) + 4 * n + (i & 3); }

struct Unit { int pm, pn; };
struct Gemm { const bf16_t* A; const bf16_t* Bt; int M, N, K, lda, ldb; };

struct StaticOrder {
    int nM, nN, nwg, G, c, wgm;
    __host__ __device__ void init(int M, int N, int G_, int c_, int wgm_ = WGM) { nM = M / BM; nN = N / BM; nwg = nM * nN; G = G_; c = c_; wgm = wgm_; }
    __host__ __device__ bool next(int i, Unit& u) const {
        const long L = (long)i * G + c; if (L >= nwg) return false;
        int wgid = (int)L; { const int q = nwg / NXCD, r = nwg % NXCD, xcd = wgid % NXCD, off = wgid / NXCD; wgid = (xcd < r ? xcd * (q + 1) : r * (q + 1) + (xcd - r) * q) + off; }
        const int nig = wgm * nN, gid = wgid / nig, fm = gid * wgm, gsz = (nM - fm) < wgm ? (nM - fm) : wgm;
        u.pm = fm + ((wgid % nig) % gsz); u.pn = (wgid % nig) / gsz; return true;
    }
    __device__ __forceinline__ void a_ready(const Unit&) const {}
    __device__ __forceinline__ void done(const Unit&) const {}
};

__device__ __forceinline__ unsigned cvt_pk_bf16(float lo, float hi) { unsigned r; asm volatile("v_cvt_pk_bf16_f32 %0, %1, %2" : "=v"(r) : "v"(lo), "v"(hi)); return r; }
typedef float f32x2 __attribute__((ext_vector_type(2)));
template <class Epi, class Sched, bool ALIGN_EPI = false, bool SP2 = false, bool FP8 = false>
__device__ __forceinline__ void gemm_phase(PG8_LAS unsigned char* lds, const Gemm g, const Sched& S, const Epi& E) {
    int tid_ = threadIdx.x; asm volatile("" : "+v"(tid_));
    const int tid = tid_, wid = __builtin_amdgcn_readfirstlane(tid >> 6), lane = tid & 63, wr = wid >> 2, wc = wid & 3, fr = lane & 15, fq = lane >> 4;
    const int K = g.K, nt = K / BK;
    unsigned voffA[2], voffB[2];
#pragma unroll
    for (int i = 0; i < 2; ++i) { int R, C; stage_rc(tid * 16 + i * 8192, R, C); const int Rb = Epi::PERM ? ((R & ~31) + perm32(R & 31)) : R;
        voffA[i] = (unsigned)(R * g.lda + C) * 2u; voffB[i] = (unsigned)(Rb * g.ldb + C) * 2u; }
    const size_t kstep = (size_t)(BK * 2);
    const size_t hstepA = (size_t)HALF * g.lda * 2, hstepB = (size_t)HALF * g.ldb * 2;
    const size_t tstepA = 2 * hstepA, tstepB = 2 * hstepB;
    const unsigned ldsw = (unsigned)wid * 1024u;
    const int aoff = lds_byte(wr * 64 + fr, fq * 8), boff = lds_byte(wc * 32 + fr, fq * 8);
#define PG8_SA(b, h) (((b) * 2 + (h)) * HTB)
#define PG8_SB(b, h) ((4 + (b) * 2 + (h)) * HTB)
#define PG8_STAGE(bufoff, gbase, voff) do { _Pragma("unroll") for (int _i = 0; _i < 2; ++_i) \
        __builtin_amdgcn_global_load_lds((const unsigned*)((const char*)(gbase) + (voff)[_i]), (PG8_LAS unsigned*)(lds + (bufoff) + ldsw + _i * 8192), 16, 0, 0); } while (0)
#define PG8_LDA(dst, b, h) do { _Pragma("unroll") for (int m = 0; m < 4; ++m) _Pragma("unroll") for (int k = 0; k < 2; ++k) dst[m][k] = *(const PG8_LAS bf16x8*)(lds + PG8_SA(b, h) + aoff + m * 2048 + k * 1024); } while (0)
#define PG8_LDB(dst, b, h) do { _Pragma("unroll") for (int n = 0; n < 2; ++n) _Pragma("unroll") for (int k = 0; k < 2; ++k) dst[n][k] = *(const PG8_LAS bf16x8*)(lds + PG8_SB(b, h) + boff + n * 2048 + k * 1024); } while (0)
#define PG8_MMA(ai, bj, At, Bt) do { __builtin_amdgcn_s_setprio(1); _Pragma("unroll") for (int m = 0; m < 4; ++m) _Pragma("unroll") for (int n = 0; n < 2; ++n) { \
        if constexpr (FP8) { asm volatile("v_mfma_f32_16x16x128_f8f6f4 %0, %1, %2, %0" : "+v"(acc[ai][bj][m][n]) : "v"(cat8(Bt[n][0], Bt[n][1])), "v"(cat8(At[m][0], At[m][1]))); } \
        else { _Pragma("unroll") for (int k = 0; k < 2; ++k) acc[ai][bj][m][n] = __builtin_amdgcn_mfma_f32_16x16x32_bf16(Bt[n][k], At[m][k], acc[ai][bj][m][n], 0, 0, 0); } } __builtin_amdgcn_s_setprio(0); } while (0)
#define PG8_WAIT_V(n) asm volatile("s_waitcnt vmcnt(" #n ")" ::: "memory")
#define PG8_WAIT_L(n) asm volatile("s_waitcnt lgkmcnt(" #n ")" ::: "memory")
#define PG8_BAR __builtin_amdgcn_s_barrier()
#define PG8_SCHED __builtin_amdgcn_sched_barrier(0)
    Unit cur, nxt; int ui = 0;
    if (!S.next(0, cur)) return;
    f32x4 acc[2][2][4][2];
#pragma unroll
    for (int a = 0; a < 2; ++a)
#pragma unroll
        for (int b = 0; b < 2; ++b)
#pragma unroll
            for (int m = 0; m < 4; ++m)
#pragma unroll
                for (int n = 0; n < 2; ++n) acc[a][b][m][n] = (f32x4){0.f, 0.f, 0.f, 0.f};
    bf16x8 At[4][2], B0[2][2], B1[2][2];
    const char* cA = (const char*)g.A + (size_t)cur.pm * tstepA; const char* cB = (const char*)g.Bt + (size_t)cur.pn * tstepB;
    S.a_ready(cur);
    if constexpr (SP2) {
        PG8_STAGE(PG8_SB(0, 0), cB, voffB); PG8_STAGE(PG8_SB(0, 1), cB + hstepB, voffB); PG8_STAGE(PG8_SA(0, 0), cA, voffA); PG8_STAGE(PG8_SA(0, 1), cA + hstepA, voffA);
        if (wr == 1) PG8_BAR;
        PG8_WAIT_V(2); PG8_BAR;
        PG8_STAGE(PG8_SB(1, 0), cB + kstep, voffB); PG8_STAGE(PG8_SA(1, 0), cA + kstep, voffA); PG8_STAGE(PG8_SB(1, 1), cB + hstepB + kstep, voffB);
        PG8_WAIT_V(6); PG8_BAR;
    } else {
        PG8_STAGE(PG8_SB(0, 0), cB, voffB); PG8_STAGE(PG8_SA(0, 0), cA, voffA); PG8_STAGE(PG8_SB(0, 1), cB + hstepB, voffB); PG8_STAGE(PG8_SA(0, 1), cA + hstepA, voffA);
        if (wr == 1) PG8_BAR;
        PG8_WAIT_V(4); PG8_BAR;
        PG8_STAGE(PG8_SB(1, 0), cB + kstep, voffB); PG8_STAGE(PG8_SA(1, 0), cA + kstep, voffA); PG8_STAGE(PG8_SB(1, 1), cB + hstepB + kstep, voffB);
        PG8_WAIT_V(6); PG8_BAR;
    }
    for (;;) {
        const bool has_next = S.next(ui + 1, nxt);
        const char* nA = has_next ? (const char*)g.A + (size_t)nxt.pm * tstepA : cA; const char* nB = has_next ? (const char*)g.Bt + (size_t)nxt.pn * tstepB : cB;
        for (int t = 0; t < nt; t += 2) {
            if constexpr (Epi::HAS_MID) { if (t == (nt >> 1)) { if constexpr (FP8) { asm volatile("s_nop 15\n\ts_nop 15" ::: "memory"); }
                E.mid(acc, cur, wr, wc, fr, fq); } }
            const bool last = (t == nt - 2);
            const char* a1 = cA + (size_t)(t + 1) * kstep;
            const char* a2 = last ? nA : cA + (size_t)(t + 2) * kstep; const char* b2 = last ? nB : cB + (size_t)(t + 2) * kstep;
            const char* a3 = a2 + kstep; const char* b3 = b2 + kstep;
            if (last && has_next) S.a_ready(nxt);
            if constexpr (SP2) {
            PG8_LDB(B0, 0, 0); PG8_LDB(B1, 0, 1); PG8_SCHED; PG8_LDA(At, 0, 0); PG8_STAGE(PG8_SA(1, 1), a1 + hstepA, voffA);
            PG8_WAIT_V(8); PG8_WAIT_L(0); PG8_BAR; PG8_MMA(0, 0, At, B0); PG8_MMA(0, 1, At, B1); PG8_BAR; PG8_SCHED;
            PG8_LDA(At, 0, 1); PG8_STAGE(PG8_SB(0, 0), b2, voffB); PG8_STAGE(PG8_SB(0, 1), b2 + hstepB, voffB); PG8_STAGE(PG8_SA(0, 0), a2, voffA);
            PG8_WAIT_V(8); PG8_WAIT_L(0); PG8_BAR; PG8_MMA(1, 0, At, B0); PG8_MMA(1, 1, At, B1); PG8_BAR; PG8_SCHED;
            PG8_LDB(B0, 1, 0); PG8_LDB(B1, 1, 1); PG8_SCHED; PG8_LDA(At, 1, 0); PG8_STAGE(PG8_SA(0, 1), a2 + hstepA, voffA);
            PG8_WAIT_V(8); PG8_WAIT_L(0); PG8_BAR; PG8_MMA(0, 0, At, B0); PG8_MMA(0, 1, At, B1); PG8_BAR; PG8_SCHED;
            PG8_LDA(At, 1, 1); PG8_STAGE(PG8_SB(1, 0), b3, voffB); PG8_STAGE(PG8_SB(1, 1), b3 + hstepB, voffB); PG8_STAGE(PG8_SA(1, 0), a3, voffA);
            PG8_WAIT_V(8); PG8_WAIT_L(0); PG8_BAR; PG8_MMA(1, 0, At, B0); PG8_MMA(1, 1, At, B1); PG8_BAR; PG8_SCHED;
            } else {
            PG8_LDB(B0, 0, 0); PG8_SCHED; PG8_LDA(At, 0, 0); PG8_STAGE(PG8_SA(1, 1), a1 + hstepA, voffA);
            PG8_WAIT_L(8); PG8_BAR; PG8_WAIT_L(0); PG8_MMA(0, 0, At, B0); PG8_BAR; PG8_SCHED;
            PG8_LDB(B1, 0, 1); PG8_STAGE(PG8_SB(0, 0), b2, voffB);
            PG8_BAR; PG8_WAIT_L(0); PG8_MMA(0, 1, At, B1); PG8_BAR;
            PG8_LDA(At, 0, 1); PG8_STAGE(PG8_SA(0, 0), a2, voffA);
            PG8_BAR; PG8_WAIT_L(0); PG8_MMA(1, 0, At, B0); PG8_BAR; PG8_SCHED;
            PG8_STAGE(PG8_SB(0, 1), b2 + hstepB, voffB);
            PG8_WAIT_V(6); PG8_BAR; PG8_MMA(1, 1, At, B1); PG8_BAR;
            PG8_LDB(B0, 1, 0); PG8_SCHED; PG8_LDA(At, 1, 0); PG8_STAGE(PG8_SA(0, 1), a2 + hstepA, voffA);
            PG8_WAIT_L(8); PG8_BAR; PG8_WAIT_L(0); PG8_MMA(0, 0, At, B0); PG8_BAR; PG8_SCHED;
            PG8_LDB(B1, 1, 1); PG8_STAGE(PG8_SB(1, 0), b3, voffB);
            PG8_BAR; PG8_WAIT_L(0); PG8_MMA(0, 1, At, B1); PG8_BAR;
            PG8_LDA(At, 1, 1); PG8_STAGE(PG8_SA(1, 0), a3, voffA);
            PG8_BAR; PG8_WAIT_L(0); PG8_MMA(1, 0, At, B0); PG8_BAR; PG8_SCHED;
            PG8_STAGE(PG8_SB(1, 1), b3 + hstepB, voffB);
            PG8_WAIT_V(6); PG8_BAR; PG8_MMA(1, 1, At, B1); PG8_BAR;
            }
        }
        if constexpr (FP8) { asm volatile("s_nop 15\n\ts_nop 15" ::: "memory"); }
        if constexpr (ALIGN_EPI) { if (wr == 0) PG8_BAR; }
        if constexpr (!Epi::AFTER_DRAIN) { E(acc, cur, wr, wc, fr, fq); S.done(cur); }
        if (!has_next) break;
#pragma unroll
        for (int a = 0; a < 2; ++a)
#pragma unroll
            for (int b = 0; b < 2; ++b)
#pragma unroll
                for (int m = 0; m < 4; ++m)
#pragma unroll
                    for (int n = 0; n < 2; ++n) acc[a][b][m][n] = (f32x4){0.f, 0.f, 0.f, 0.f};
        cur = nxt; cA = nA; cB = nB; ++ui;
        if constexpr (ALIGN_EPI) { if (wr == 1) PG8_BAR; }
    }
    PG8_WAIT_V(0);
    if constexpr (!ALIGN_EPI) { if (wr == 0) PG8_BAR; }
    PG8_BAR;
    if constexpr (Epi::AFTER_DRAIN) { E.fused(acc, cur, wr, wc, fr, fq, lds, wid, lane); S.done(cur); }
#undef PG8_SA
#undef PG8_SB
#undef PG8_STAGE
#undef PG8_LDA
#undef PG8_LDB
#undef PG8_MMA
#undef PG8_WAIT_V
#undef PG8_WAIT_L
#undef PG8_BAR
#undef PG8_SCHED
}
}

constexpr int T = 16384, D = 2048, SEQ = 8192, CONV = 1024, CWID = 31, NHEAD = 16, NKVH = 4, HD = 64, ATT = 1024, KVD = 256, IN_DIM = 7680, NEXP = 16384, PHEADS = 8, TOPK = 16;
constexpr float EPS = 1e-6f;
constexpr int NSL = 16, SLW = 128;
constexpr int NWAVES = 8, NTHR = NWAVES * 64;
enum { I_X = 0, I_C, I_RELB, I_ADAW, I_ADAB, I_N1G, I_WIN, I_DWW, I_DWB, I_CLNG, I_CLNB, I_WCO, I_SINK, I_WAO, I_WOUT, I_N2G, I_WPQ, I_SK, I_PU, I_PV, I_FG, N_IN };

constexpr size_t MiB = 1u << 20;
constexpr size_t WS_CTL = 0, CTL_ZERO_BYTES = 1 * MiB;
constexpr size_t WS_MOD = 1 * MiB;
constexpr size_t WS_BIAS = 1 * MiB + 512 * 1024;
constexpr size_t WS_SCL = 1 * MiB + 640 * 1024;
constexpr size_t WS_WIN = 2 * MiB;
constexpr size_t WS_SA = 1 * MiB + 896 * 1024;
constexpr size_t WS_WM = 62 * MiB;
constexpr size_t WS_WO = 78 * MiB;
constexpr size_t WS_WP = 94 * MiB;
constexpr size_t WS_PU = 110 * MiB;
constexpr size_t WS_PV = 238 * MiB;
constexpr size_t WS_H = 366 * MiB;
constexpr size_t WS_U = 430 * MiB;
constexpr size_t WS_Q = 462 * MiB;
constexpr size_t WS_K = 494 * MiB;
constexpr size_t WS_V = 502 * MiB;
constexpr size_t WS_GC = 510 * MiB;
constexpr size_t WS_GA = 574 * MiB;
constexpr size_t WS_AM = 638 * MiB;
constexpr size_t WS_Y1 = 702 * MiB;
constexpr size_t WS_XA = 766 * MiB;
constexpr size_t WS_END = 894 * MiB;
constexpr int CW_TMO = 0, CW_QUEUE = 64, CW_QUEUE2 = 128, CW_WMAX = 192, CW_WMAX2 = 194, CW_WMAX3 = 198, CW_VMAX = 200, CW_BC = 204, CW_BC2 = 206, CW_BAR = 4096;

constexpr int RING_BYTES = 131072, LDSCTL_OFF = RING_BYTES, MISC_OFF = LDSCTL_OFF + 320, LDS_BYTES = 147456;

#define GAS __attribute__((address_space(1)))
#define LAS __attribute__((address_space(3)))
typedef unsigned short bf16;
typedef unsigned v4u __attribute__((ext_vector_type(4)));
typedef unsigned v2u __attribute__((ext_vector_type(2)));
typedef float f32x4 __attribute__((ext_vector_type(4)));
typedef float f32x2 __attribute__((ext_vector_type(2)));
typedef float f32x16 __attribute__((ext_vector_type(16)));
typedef short bf16x8 __attribute__((ext_vector_type(8)));
typedef __bf16 bf16x2v __attribute__((ext_vector_type(2)));
typedef GAS unsigned gu32;
#define LDS_WAIT() asm volatile("s_waitcnt lgkmcnt(0)" ::: "memory")
#define VM_WAIT() asm volatile("s_waitcnt vmcnt(0)" ::: "memory")
__device__ __forceinline__ unsigned f2bf(float f) { unsigned u = __builtin_bit_cast(unsigned, f); return (u + 0x7fffu + ((u >> 16) & 1u)) >> 16; }
__device__ __forceinline__ unsigned pk2(float lo, float hi) { f32x2 v = {lo, hi}; bf16x2v b = __builtin_convertvector(v, bf16x2v); return __builtin_bit_cast(unsigned, b); }
__device__ __forceinline__ float bflo(unsigned p) { return __uint_as_float(p << 16); }
__device__ __forceinline__ float bfhi(unsigned p) { return __uint_as_float(p & 0xffff0000u); }
__device__ __forceinline__ float sigmoidf_(float x) { return __builtin_amdgcn_rcpf(1.0f + __expf(-x)); }
__device__ __forceinline__ float dot2bf(unsigned a, unsigned b, float c) { return __builtin_amdgcn_fdot2_f32_bf16(__builtin_bit_cast(bf16x2v, a), __builtin_bit_cast(bf16x2v, b), c, false); }
__device__ __forceinline__ float wave_sum(float v) {
#pragma unroll
    for (int o = 1; o < 64; o <<= 1) v += __shfl_xor(v, o);
    return v;
}

template <int CTRL> __device__ __forceinline__ float dpp_mov(float v) { return __builtin_bit_cast(float, __builtin_amdgcn_update_dpp(0, __builtin_bit_cast(int, v), CTRL, 0xf, 0xf, true)); }
__device__ __forceinline__ float lane_xor1(float v) { return dpp_mov<0xB1>(v); }
__device__ __forceinline__ float lane_xor2(float v) { return dpp_mov<0x4E>(v); }
__device__ __forceinline__ float lane_xor4(float v) { return dpp_mov<0x141>(dpp_mov<0x1B>(v)); }
__device__ __forceinline__ float lane_xor8(float v) { return dpp_mov<0x128>(v); }
__device__ __forceinline__ float lane_xor16(float v) { return __builtin_bit_cast(float, __builtin_amdgcn_ds_swizzle(__builtin_bit_cast(int, v), 0x401F)); }

namespace pg8 {
__device__ __forceinline__ float sigm(float x) { return __builtin_amdgcn_rcpf(1.0f + __expf(-x)); }
__device__ __forceinline__ u32x4 pack8(const f32x4& v0, const f32x4& v1) { u32x4 w; w.x = cvt_pk_bf16(v0[0], v0[1]); w.y = cvt_pk_bf16(v0[2], v0[3]); w.z = cvt_pk_bf16(v1[0], v1[1]); w.w = cvt_pk_bf16(v1[2], v1[3]); return w; }
__device__ __forceinline__ float blo(unsigned p) { return __uint_as_float(p << 16); }
__device__ __forceinline__ float bhi(unsigned p) { return __uint_as_float(p & 0xffff0000u); }
struct EpiInProj {
    static constexpr bool PERM = true, AFTER_DRAIN = false, HAS_MID = false;
    bf16_t *U, *Q, *K, *V, *GC, *GA; const float* sa; float sw; unsigned* vmax;
    __device__ __forceinline__ void operator()(const f32x4 (&acc)[2][2][4][2], const Unit& u, int wr, int wc, int fr, int fq) const {
        const int row0 = u.pm * BM + wr * 64 + fr, cw = wc * 32 + 8 * fq, pn = u.pn;
        float rsv[2][4];
        { const float* sp = sa + row0;
          asm volatile("global_load_dword %0, %8, off\n\tglobal_load_dword %1, %8, off offset:64\n\tglobal_load_dword %2, %8, off offset:128\n\tglobal_load_dword %3, %8, off offset:192\n\t"
                       "global_load_dword %4, %8, off offset:512\n\tglobal_load_dword %5, %8, off offset:576\n\tglobal_load_dword %6, %8, off offset:640\n\tglobal_load_dword %7, %8, off offset:704\n\ts_waitcnt vmcnt(0)"
                       : "=&v"(rsv[0][0]), "=&v"(rsv[0][1]), "=&v"(rsv[0][2]), "=&v"(rsv[0][3]), "=&v"(rsv[1][0]), "=&v"(rsv[1][1]), "=&v"(rsv[1][2]), "=&v"(rsv[1][3]) : "v"(sp) : "memory"); }
        if (pn < 8) {
#pragma unroll
            for (int ai = 0; ai < 2; ++ai)
#pragma unroll
                for (int m = 0; m < 4; ++m) { bf16_t* p = U + (size_t)(row0 + ai * HALF + m * 16) * 1024 + pn * 128 + cw; const float rs = rsv[ai][m] * sw;
                    f32x4 a0 = acc[ai][0][m][0] * rs, a1 = acc[ai][0][m][1] * rs; const f32x4 b0 = acc[ai][1][m][0] * rs, b1 = acc[ai][1][m][1] * rs;
#pragma unroll
                    for (int i = 0; i < 4; ++i) { a0[i] *= sigm(b0[i]); a1[i] *= sigm(b1[i]); }
                    *(u32x4*)p = pack8(a0, a1); }
        } else {
            bf16_t* base; int ld, cb, mode;
            if (pn < 12) { base = Q; ld = 1024; cb = (pn - 8) * 256; mode = 0; }
            else if (pn == 12) { base = K; ld = 256; cb = 0; mode = 1; }
            else if (pn == 13) { base = V; ld = 256; cb = 0; mode = 1; }
            else if (pn < 22) { base = GC; ld = 2048; cb = (pn - 14) * 256; mode = 2; }
            else { base = GA; ld = 2048; cb = (pn - 22) * 256; mode = 2; }
            float vm = 0.f;
#pragma unroll
            for (int ai = 0; ai < 2; ++ai)
#pragma unroll
                for (int m = 0; m < 4; ++m) { bf16_t* p = base + (size_t)(row0 + ai * HALF + m * 16) * ld + cb + cw; const float rs = rsv[ai][m] * sw;
#pragma unroll
                    for (int bj = 0; bj < 2; ++bj) { f32x4 v0 = acc[ai][bj][m][0] * rs, v1 = acc[ai][bj][m][1] * rs;
                        if (pn == 13) vm = fmaxf(vm, fmaxf(fmaxf(fmaxf(fabsf(v0[0]), fabsf(v0[1])), fmaxf(fabsf(v0[2]), fabsf(v0[3]))), fmaxf(fmaxf(fabsf(v1[0]), fabsf(v1[1])), fmaxf(fabsf(v1[2]), fabsf(v1[3])))));
                        if (mode == 0) { v0 = v0 * 0.125f; v1 = v1 * 0.125f; }
                        else if (mode == 2) {
#pragma unroll
                            for (int i = 0; i < 4; ++i) { v0[i] = sigm(v0[i]); v1[i] = sigm(v1[i]); } }
                        *(u32x4*)(p + bj * HALF) = pack8(v0, v1); } }
            if (pn == 13) {
#pragma unroll
                for (int o = 1; o < 64; o <<= 1) vm = fmaxf(vm, __shfl_xor(vm, o));
                if ((threadIdx.x & 63) == 0) __hip_atomic_fetch_max(vmax + (u.pm >> 5), __float_as_uint(vm), __ATOMIC_RELAXED, __HIP_MEMORY_SCOPE_AGENT); }
        }
    }
};
struct EpiMerge {
    static constexpr bool PERM = true, AFTER_DRAIN = false, HAS_MID = true;
    const bf16_t* GC; const bf16_t* GA; unsigned char* O; float fmid0, fmid1, fend0, fend1;
    __device__ __forceinline__ void mid(f32x4 (&acc)[2][2][4][2], const Unit& u, int wr, int wc, int fr, int fq) const {
        int row0 = u.pm * BM + wr * 64 + fr, c0 = u.pn * BM + wc * 32 + 8 * fq; const float fmd = (u.pm >> 5) ? fmid1 : fmid0;
        asm volatile("" : "+v"(row0), "+v"(c0));
#pragma unroll
        for (int ai = 0; ai < 2; ++ai)
#pragma unroll
            for (int mh = 0; mh < 2; ++mh) { u32x4 gc[2][2], ga[2][2];
#pragma unroll
                for (int mm = 0; mm < 2; ++mm)
#pragma unroll
                    for (int bj = 0; bj < 2; ++bj) { const size_t off = (size_t)(row0 + ai * HALF + (2 * mh + mm) * 16) * 2048 + c0 + bj * HALF; gc[mm][bj] = *(const u32x4*)(GC + off); ga[mm][bj] = *(const u32x4*)(GA + off); }
                __builtin_amdgcn_sched_barrier(0);
#pragma unroll
                for (int mm = 0; mm < 2; ++mm)
#pragma unroll
                    for (int bj = 0; bj < 2; ++bj) { const int m = 2 * mh + mm; const u32x4 c = gc[mm][bj], a = ga[mm][bj];
#define RT_(cw_, aw_, HI_) ((HI_ ? bhi(cw_) : blo(cw_)) * fmd * __builtin_amdgcn_rcpf(fmaxf(HI_ ? bhi(aw_) : blo(aw_), 1e-30f)))
                        acc[ai][bj][m][0][0] *= RT_(c.x, a.x, 0); acc[ai][bj][m][0][1] *= RT_(c.x, a.x, 1); acc[ai][bj][m][0][2] *= RT_(c.y, a.y, 0); acc[ai][bj][m][0][3] *= RT_(c.y, a.y, 1);
                        acc[ai][bj][m][1][0] *= RT_(c.z, a.z, 0); acc[ai][bj][m][1][1] *= RT_(c.z, a.z, 1); acc[ai][bj][m][1][2] *= RT_(c.w, a.w, 0); acc[ai][bj][m][1][3] *= RT_(c.w, a.w, 1);
#undef RT_
                    }
                __builtin_amdgcn_sched_barrier(0); }
    }
    __device__ __forceinline__ void operator()(const f32x4 (&acc)[2][2][4][2], const Unit& u, int wr, int wc, int fr, int fq) const {
        const int row0 = u.pm * BM + wr * 64 + fr, c0 = u.pn * BM + wc * 32 + 8 * fq; const float fe = (u.pm >> 5) ? fend1 : fend0;
#pragma unroll
        for (int ai = 0; ai < 2; ++ai) { u32x4 g[4][2];
#pragma unroll
            for (int m = 0; m < 4; ++m)
#pragma unroll
                for (int bj = 0; bj < 2; ++bj) g[m][bj] = *(const u32x4*)(GA + (size_t)(row0 + ai * HALF + m * 16) * 2048 + c0 + bj * HALF);
            __builtin_amdgcn_sched_barrier(0);
#pragma unroll
            for (int m = 0; m < 4; ++m)
#pragma unroll
                for (int bj = 0; bj < 2; ++bj) { const size_t off = (size_t)(row0 + ai * HALF + m * 16) * 2048 + c0 + bj * HALF; const u32x4 gg = g[m][bj]; f32x4 v0 = acc[ai][bj][m][0], v1 = acc[ai][bj][m][1];
                    v0[0] *= fmaxf(blo(gg.x), 1e-30f) * fe; v0[1] *= fmaxf(bhi(gg.x), 1e-30f) * fe; v0[2] *= fmaxf(blo(gg.y), 1e-30f) * fe; v0[3] *= fmaxf(bhi(gg.y), 1e-30f) * fe;
                    v1[0] *= fmaxf(blo(gg.z), 1e-30f) * fe; v1[1] *= fmaxf(bhi(gg.z), 1e-30f) * fe; v1[2] *= fmaxf(blo(gg.w), 1e-30f) * fe; v1[3] *= fmaxf(bhi(gg.w), 1e-30f) * fe;
                    int lo = __builtin_amdgcn_cvt_pk_fp8_f32(v0[0], v0[1], 0, false); lo = __builtin_amdgcn_cvt_pk_fp8_f32(v0[2], v0[3], lo, true);
                    int hi = __builtin_amdgcn_cvt_pk_fp8_f32(v1[0], v1[1], 0, false); hi = __builtin_amdgcn_cvt_pk_fp8_f32(v1[2], v1[3], hi, true);
                    typedef unsigned u32x2s __attribute__((ext_vector_type(2))); *(u32x2s*)(O + off) = (u32x2s){(unsigned)lo, (unsigned)hi}; }
            __builtin_amdgcn_sched_barrier(0); }
    }
};
template <bool XB_BF16>
struct EpiResid {
    static constexpr bool PERM = true, AFTER_DRAIN = false, HAS_MID = false;
    const void* XB; bf16_t* XO; const float* gvec; float fo0, fo1;
    __device__ __forceinline__ void operator()(const f32x4 (&acc)[2][2][4][2], const Unit& u, int wr, int wc, int fr, int fq) const {
        const int row0 = u.pm * BM + wr * 64 + fr, c0 = u.pn * BM + wc * 32 + 8 * fq; const float* gp = gvec + (size_t)(u.pm >> 5) * 12288;
        const float fo = (u.pm >> 5) ? fo1 : fo0;
#pragma unroll
        for (int bj = 0; bj < 2; ++bj) { const int col = c0 + bj * HALF; const f32x4 g0 = *(const f32x4*)(gp + col) * fo, g1 = *(const f32x4*)(gp + col + 4) * fo;
#pragma unroll
            for (int ai = 0; ai < 2; ++ai) { f32x4 xa[4], xb[4]; u32x4 xq[4];
#pragma unroll
                for (int m = 0; m < 4; ++m) { const size_t off = (size_t)(row0 + ai * HALF + m * 16) * 2048 + col;
                    if constexpr (XB_BF16) xq[m] = *(const u32x4*)((const bf16_t*)XB + off); else { xa[m] = *(const f32x4*)((const float*)XB + off); xb[m] = *(const f32x4*)((const float*)XB + off + 4); } }
                __builtin_amdgcn_sched_barrier(0);
#pragma unroll
                for (int m = 0; m < 4; ++m) { const size_t off = (size_t)(row0 + ai * HALF + m * 16) * 2048 + col;
                    if constexpr (XB_BF16) { xa[m] = (f32x4){blo(xq[m].x), bhi(xq[m].x), blo(xq[m].y), bhi(xq[m].y)}; xb[m] = (f32x4){blo(xq[m].z), bhi(xq[m].z), blo(xq[m].w), bhi(xq[m].w)}; }
                    *(u32x4*)(XO + off) = pack8(xa[m] + g0 * acc[ai][bj][m][0], xb[m] + g1 * acc[ai][bj][m][1]); }
                __builtin_amdgcn_sched_barrier(0); } }
    }
};
typedef _Float16 f16x8 __attribute__((ext_vector_type(8)));
struct EpiF16 {
    static constexpr bool PERM = true, AFTER_DRAIN = false, HAS_MID = false;
    _Float16* O; int ldc;
    __device__ __forceinline__ void operator()(const f32x4 (&acc)[2][2][4][2], const Unit& u, int wr, int wc, int fr, int fq) const {
        const int row0 = u.pm * BM + wr * 64 + fr, c0 = u.pn * BM + wc * 32 + 8 * fq;
#pragma unroll
        for (int ai = 0; ai < 2; ++ai)
#pragma unroll
            for (int m = 0; m < 4; ++m)
#pragma unroll
                for (int bj = 0; bj < 2; ++bj) { const f32x4 v0 = acc[ai][bj][m][0], v1 = acc[ai][bj][m][1];
                    const f16x8 h = {(_Float16)v0[0], (_Float16)v0[1], (_Float16)v0[2], (_Float16)v0[3], (_Float16)v1[0], (_Float16)v1[1], (_Float16)v1[2], (_Float16)v1[3]};
                    *(f16x8*)(O + (size_t)(row0 + ai * HALF + m * 16) * ldc + c0 + bj * HALF) = h; }
    }
};
}

#define XB_TMO      128
#define XB_XCNT(j)  (256  + 64 * (j))
#define XB_XSUB(j)  (1280 + 64 * (j))
#define XB_XGEN(j)  (2304 + 64 * (j))
#define XB_TOP      3328
#define XB_TOPGEN   3392
#define XCD_BAR_WORDS 3456
#define XB_SPIN_CAP (1u << 18)

__device__ __forceinline__ unsigned xb_ld(unsigned* p)              { return __hip_atomic_load(p, __ATOMIC_RELAXED, __HIP_MEMORY_SCOPE_AGENT); }
__device__ __forceinline__ unsigned xb_add(unsigned* p, unsigned v) { return __hip_atomic_fetch_add(p, v, __ATOMIC_RELAXED, __HIP_MEMORY_SCOPE_AGENT); }
__device__ __forceinline__ unsigned xb_xcc_id() { return (unsigned)__builtin_amdgcn_s_getreg((3 << 11) | 20) & 0xFu; }
#define XB_SPIN(cond, bar) do { unsigned _sp = 0; while (cond) { __builtin_amdgcn_s_sleep(1); \
    if ((++_sp & 255u) == 0u) { if (xb_ld(&(bar)[XB_TMO])) break; if (_sp > XB_SPIN_CAP) { atomicAdd(&(bar)[XB_TMO], 1u); break; } } } } while (0)

struct XcdBarrier {
    unsigned* bar; unsigned x;
    volatile LAS unsigned* st;
};

__device__ __forceinline__ XcdBarrier xcd_barrier_post(unsigned* bar, volatile LAS unsigned* st) {
    XcdBarrier b; b.bar = bar; b.x = xb_xcc_id(); b.st = st;
    if (threadIdx.x == 0) (void)xb_add(&bar[XB_XCNT(b.x)], 1u);
    return b;
}
__device__ __forceinline__ void xcd_barrier_complete(unsigned* bar, unsigned x, unsigned& nloc, unsigned& nx) {
    const unsigned G = gridDim.x * gridDim.y * gridDim.z;
    unsigned sum, cnt, mine, sp = 0u;
    for (;;) {
        sum = 0u; cnt = 0u; mine = 0u;
#pragma unroll
        for (unsigned j = 0; j < 16; ++j) { const unsigned c = xb_ld(&bar[XB_XCNT(j)]); sum += c; cnt += (c > 0u) ? 1u : 0u; mine = (j == x) ? c : mine; }
        if (sum == G) break;
        __builtin_amdgcn_s_sleep(1);
        if ((++sp & 255u) == 0u) { if (xb_ld(&bar[XB_TMO])) break; if (sp > XB_SPIN_CAP) { atomicAdd(&bar[XB_TMO], 1u); break; } }
    }
    nloc = mine > 0u ? mine : 1u; nx = cnt > 0u ? cnt : 1u;
}

__device__ __forceinline__ void xcd_barrier(const XcdBarrier& b) {
    asm volatile("s_waitcnt vmcnt(0)" ::: "memory");
    __syncthreads();
    if (threadIdx.x == 0) {
        unsigned* bar = b.bar;
        __builtin_amdgcn_s_waitcnt(0);
        unsigned nloc = b.st[0], nx = b.st[1];
        if (nloc == 0u) { xcd_barrier_complete(bar, b.x, nloc, nx); b.st[0] = nloc; b.st[1] = nx; }
        const unsigned old = xb_add(&bar[XB_XSUB(b.x)], 1u);
        const unsigned gen = old / nloc;
        if (old + 1u == (gen + 1u) * nloc) {
            __builtin_amdgcn_fence(__ATOMIC_RELEASE, "agent");
            asm volatile("s_waitcnt vmcnt(0)" ::: "memory");
            const unsigned og = xb_add(&bar[XB_TOP], 1u);
            const unsigned tg = og / nx;
            if (og + 1u == (tg + 1u) * nx) xb_add(&bar[XB_TOPGEN], 1u);
            else XB_SPIN(xb_ld(&bar[XB_TOPGEN]) == tg, bar);
            __builtin_amdgcn_fence(__ATOMIC_ACQUIRE, "agent");
            xb_add(&bar[XB_XGEN(b.x)], 1u);
            asm volatile("s_waitcnt vmcnt(0)" ::: "memory");
        } else {
            XB_SPIN(xb_ld(&bar[XB_XGEN(b.x)]) == gen, bar);
            __builtin_amdgcn_fence(__ATOMIC_ACQUIRE, "agent");
            asm volatile("s_waitcnt vmcnt(0)" ::: "memory");
        }
    }
    __syncthreads();
}

struct Args { const float* in[N_IN]; float* out; unsigned char* ws; int ph_lo, ph_hi; };
struct Frame {
    LAS unsigned char* lds; volatile LAS unsigned* MISC; gu32* ctl;
    int tid, lane, wave, vcu, G;
    const Args* A; float* out; unsigned char* ws;
};
#define WSP(T_, off) ((T_*)(F.ws + (off)))
#define PHASE_TID(F) do { int t_ = threadIdx.x; asm volatile("" : "+v"(t_)); (F).tid = t_; (F).lane = t_ & 63; (F).wave = __builtin_amdgcn_readfirstlane(t_ >> 6); } while (0)

__device__ __forceinline__ int glu_row(int n) { return n < 2048 ? (((n & 1023) >> 7) * 256 + (n >> 10) * 128 + (n & 127)) : n; }
template <int MODE>
__device__ __forceinline__ void tr_item(const float* W, int N, bf16* WT, int dstride, int koff, LAS float* scr, int kb, int nb, int lane) {
    const int k0 = 64 * kb, n0 = 32 * nb;
    f32x4 v[8];
#pragma unroll
    for (int i = 0; i < 8; ++i) v[i] = *(const f32x4*)(W + (size_t)(k0 + (lane >> 3) + 8 * i) * N + n0 + (lane & 7) * 4);
#pragma unroll
    for (int i = 0; i < 8; ++i) { LAS float* d = scr + ((lane >> 3) + 8 * i) * 33 + (lane & 7) * 4; d[0] = v[i].x; d[1] = v[i].y; d[2] = v[i].z; d[3] = v[i].w; }
    LDS_WAIT(); asm volatile("" ::: "memory");
    const int c = lane & 7;
#pragma unroll
    for (int j = 0; j < 4; ++j) { const int n = (lane >> 3) + 8 * j; const LAS float* s = scr + (8 * c) * 33 + n;
        v4u o; o.x = pk2(s[0 * 33], s[1 * 33]); o.y = pk2(s[2 * 33], s[3 * 33]); o.z = pk2(s[4 * 33], s[5 * 33]); o.w = pk2(s[6 * 33], s[7 * 33]);
        const int nn = n0 + n, row = MODE == 1 ? glu_row(nn) : nn;
        *(v4u*)(WT + (size_t)row * dstride + koff + k0 + 8 * c) = o; }
    LDS_WAIT(); asm volatile("" ::: "memory");
}
__device__ __forceinline__ void wmax_item(Frame& F, int it) {
    const int l = it >> 5, kc = it & 31; const float* W = F.A->in[I_WIN] + ((size_t)l * 2048 + kc * 64) * IN_DIM; float mx = 0.f;
#pragma unroll 4
    for (int k = 0; k < 64; ++k)
#pragma unroll
        for (int j = 0; j < 4; ++j) { const int c4r = F.tid + NTHR * j, c4 = c4r < IN_DIM / 4 ? c4r : IN_DIM / 4 - 1;
            const f32x4 v = *(const f32x4*)(W + (size_t)k * IN_DIM + 4 * c4); mx = fmaxf(mx, fmaxf(fmaxf(fabsf(v.x), fabsf(v.y)), fmaxf(fabsf(v.z), fabsf(v.w)))); }
#pragma unroll
    for (int o = 1; o < 64; o <<= 1) mx = fmaxf(mx, __shfl_xor(mx, o));
    if (F.lane == 0) __hip_atomic_fetch_max(F.ctl + CW_WMAX + l, __float_as_uint(mx), __ATOMIC_RELAXED, __HIP_MEMORY_SCOPE_AGENT);
}
__device__ __forceinline__ void wmax2_item(Frame& F, int it) {
    const int lh = it >> 3, kc = it & 7, l = lh >> 1, h = lh & 1; const float* W = F.A->in[h ? I_WAO : I_WCO] + ((size_t)l * 1024 + kc * 128) * 2048 + 4 * F.tid; float mx = 0.f;
#pragma unroll 8
    for (int k = 0; k < 128; ++k) { const f32x4 v = *(const f32x4*)(W + (size_t)k * 2048); mx = fmaxf(mx, fmaxf(fmaxf(fabsf(v.x), fabsf(v.y)), fmaxf(fabsf(v.z), fabsf(v.w)))); }
#pragma unroll
    for (int o = 1; o < 64; o <<= 1) mx = fmaxf(mx, __shfl_xor(mx, o));
    if (F.lane == 0) __hip_atomic_fetch_max(F.ctl + CW_WMAX2 + lh, __float_as_uint(mx), __ATOMIC_RELAXED, __HIP_MEMORY_SCOPE_AGENT);
}
__device__ __forceinline__ void wmax3_item(Frame& F, int it) {
    const int l = it >> 4, kc = it & 15; const float* W = F.A->in[I_WOUT] + ((size_t)l * 2048 + kc * 128) * 2048 + 4 * F.tid; float mx = 0.f;
#pragma unroll 8
    for (int k = 0; k < 128; ++k) { const f32x4 v = *(const f32x4*)(W + (size_t)k * 2048); mx = fmaxf(mx, fmaxf(fmaxf(fabsf(v.x), fabsf(v.y)), fmaxf(fabsf(v.z), fabsf(v.w)))); }
#pragma unroll
    for (int o = 1; o < 64; o <<= 1) mx = fmaxf(mx, __shfl_xor(mx, o));
    if (F.lane == 0) __hip_atomic_fetch_max(F.ctl + CW_WMAX3 + l, __float_as_uint(mx), __ATOMIC_RELAXED, __HIP_MEMORY_SCOPE_AGENT);
}
template <bool GLU>
__device__ __forceinline__ void tr8_item(const float* W, int N, unsigned char* WT, int koff, float inv, LAS float* scr, int kb, int nb, int lane) {
    const int k0 = 64 * kb, n0 = 32 * nb;
    f32x4 v[8];
#pragma unroll
    for (int i = 0; i < 8; ++i) v[i] = *(const f32x4*)(W + (size_t)(k0 + (lane >> 3) + 8 * i) * N + n0 + (lane & 7) * 4);
#pragma unroll
    for (int i = 0; i < 8; ++i) { LAS float* d = scr + ((lane >> 3) + 8 * i) * 33 + (lane & 7) * 4; d[0] = v[i].x * inv; d[1] = v[i].y * inv; d[2] = v[i].z * inv; d[3] = v[i].w * inv; }
    LDS_WAIT(); asm volatile("" ::: "memory");
    const int c = lane & 7;
#pragma unroll
    for (int j = 0; j < 4; ++j) { const int n = (lane >> 3) + 8 * j; const LAS float* s = scr + (8 * c) * 33 + n;
        int lo = __builtin_amdgcn_cvt_pk_fp8_f32(s[0 * 33], s[1 * 33], 0, false); lo = __builtin_amdgcn_cvt_pk_fp8_f32(s[2 * 33], s[3 * 33], lo, true);
        int hi = __builtin_amdgcn_cvt_pk_fp8_f32(s[4 * 33], s[5 * 33], 0, false); hi = __builtin_amdgcn_cvt_pk_fp8_f32(s[6 * 33], s[7 * 33], hi, true);
        v2u o; o.x = (unsigned)lo; o.y = (unsigned)hi;
        *(v2u*)(WT + (size_t)(GLU ? glu_row(n0 + n) : n0 + n) * 2048 + koff + k0 + 8 * c) = o; }
    LDS_WAIT(); asm volatile("" ::: "memory");
}
__device__ __forceinline__ void win8_phase(Frame& F) {
    PHASE_TID(F);
    LAS float* scr = (LAS float*)(F.lds + F.wave * 16384);
    if (F.tid == 0) F.MISC[0] = __hip_atomic_fetch_add(F.ctl + CW_QUEUE2, 1u, __ATOMIC_RELAXED, __HIP_MEMORY_SCOPE_AGENT);
    for (int par = 0;; par ^= 1) {
        __syncthreads();
        const int it = (int)F.MISC[par];
        if (F.tid == 0) F.MISC[par ^ 1] = __hip_atomic_fetch_add(F.ctl + CW_QUEUE2, 1u, __ATOMIC_RELAXED, __HIP_MEMORY_SCOPE_AGENT);
        if (it >= 2 * 960 + 4 * 128 + 2 * 256) break;
        if (it < 2 * 960) { const int l = it >= 960, r = it - l * 960, wi = r * 8 + F.wave;
            const float wmax = __uint_as_float(__hip_atomic_load(F.ctl + CW_WMAX + l, __ATOMIC_RELAXED, __HIP_MEMORY_SCOPE_AGENT)), inv = wmax > 0.f ? 440.0f / wmax : 1.0f;
            tr8_item<true>(F.A->in[I_WIN] + (size_t)l * 2048 * IN_DIM, IN_DIM, WSP(unsigned char, WS_WIN) + (size_t)l * IN_DIM * 2048, 0, inv, scr, wi / 240, wi % 240, F.lane); }
        else if (it >= 2 * 960 + 4 * 128) { const int r0 = it - 2 * 960 - 4 * 128, l = r0 >> 8, wi = (r0 & 255) * 8 + F.wave;
            const float wmax = __uint_as_float(__hip_atomic_load(F.ctl + CW_WMAX3 + l, __ATOMIC_RELAXED, __HIP_MEMORY_SCOPE_AGENT)), inv = wmax > 0.f ? 440.0f / wmax : 1.0f;
            tr8_item<false>(F.A->in[I_WOUT] + (size_t)l * 2048 * 2048, 2048, WSP(unsigned char, WS_WO) + (size_t)l * 2048 * 2048, 0, inv, scr, wi / 64, wi % 64, F.lane); }
        else { const int r0 = it - 2 * 960, lh = r0 >> 7, l = lh >> 1, h = lh & 1, wi = (r0 & 127) * 8 + F.wave;
            const float wmax = __uint_as_float(__hip_atomic_load(F.ctl + CW_WMAX2 + lh, __ATOMIC_RELAXED, __HIP_MEMORY_SCOPE_AGENT)), inv = wmax > 0.f ? 440.0f / wmax : 1.0f;
            tr8_item<false>(F.A->in[h ? I_WAO : I_WCO] + (size_t)l * 1024 * 2048, 2048, WSP(unsigned char, WS_WM) + (size_t)l * 2048 * 2048, h * 1024, inv, scr, wi / 64, wi % 64, F.lane); }
    }
}
__device__ __forceinline__ void ada_item(Frame& F, int a) {
    LAS float* csl = (LAS float*)F.lds;
    LAS f32x4* red = (LAS f32x4*)(F.lds + 16384);
    const float* c = F.A->in[I_C];
    { float cv[8];
#pragma unroll
      for (int i = 0; i < 8; ++i) cv[i] = c[i * NTHR + F.tid];
      __builtin_amdgcn_sched_barrier(0);
#pragma unroll
      for (int i = 0; i < 8; ++i) csl[i * NTHR + F.tid] = cv[i] / (1.0f + __expf(-cv[i])); }
    __syncthreads();
    const int l = a / 48, j0 = (a % 48) * 256 + 4 * F.lane;
    const float* wp = F.A->in[I_ADAW] + ((size_t)l * 2048 + F.wave * 256) * 12288 + j0;
    f32x4 a0 = {0.f, 0.f, 0.f, 0.f}, a1 = {0.f, 0.f, 0.f, 0.f};
#define ADA_LD(dst_, k0_) do { _Pragma("unroll") for (int i_ = 0; i_ < 8; ++i_) dst_[i_] = *(const f32x4*)(wp + (size_t)((k0_) + i_) * 12288); } while (0)
#define ADA_USE(src_, k0_) do { _Pragma("unroll") for (int i_ = 0; i_ < 8; ++i_) { const float c0 = csl[F.wave * 256 + (k0_) + i_], c1 = csl[2048 + F.wave * 256 + (k0_) + i_]; a0 += src_[i_] * c0; a1 += src_[i_] * c1; } } while (0)
    f32x4 wA[8], wB[8];
    ADA_LD(wA, 0);
#pragma unroll 1
    for (int kb = 0; kb < 256; kb += 16) {
        ADA_LD(wB, kb + 8); __builtin_amdgcn_sched_barrier(0); ADA_USE(wA, kb); __builtin_amdgcn_sched_barrier(0);
        if (kb + 16 < 256) ADA_LD(wA, kb + 16);
        __builtin_amdgcn_sched_barrier(0); ADA_USE(wB, kb + 8); __builtin_amdgcn_sched_barrier(0);
    }
#undef ADA_LD
#undef ADA_USE
    red[(F.wave * 2 + 0) * 64 + F.lane] = a0; red[(F.wave * 2 + 1) * 64 + F.lane] = a1;
    __syncthreads();
    if (F.wave < 2) { const int b = F.wave; f32x4 s = *(const f32x4*)(F.A->in[I_ADAB] + l * 12288 + j0);
#pragma unroll
        for (int w = 0; w < 8; ++w) s += red[(w * 2 + b) * 64 + F.lane];
        *(f32x4*)(WSP(float, WS_MOD) + (size_t)(l * 2 + b) * 12288 + j0) = s; }
    __syncthreads();
}
__device__ __forceinline__ void fold_item(Frame& F, int it) {
    const int l = it >> 7, hp = (it >> 3) & 15, kb = it & 7, lane = F.lane, fr = lane & 15, fq = lane >> 4;
    constexpr int SKS = 136;
    LAS bf16* skh = (LAS bf16*)F.lds; LAS bf16* skl = skh + 128 * SKS;
    const float* wbase = F.A->in[I_WPQ] + ((size_t)l * 2048 + kb * 256 + F.wave * 32 + fr) * 2048 + hp * 128 + 8 * fq;
    f32x4 wv[2][4][2];
#pragma unroll
    for (int kt = 0; kt < 2; ++kt)
#pragma unroll
        for (int s2 = 0; s2 < 4; ++s2) { wv[kt][s2][0] = *(const f32x4*)(wbase + (size_t)kt * 16 * 2048 + 32 * s2); wv[kt][s2][1] = *(const f32x4*)(wbase + (size_t)kt * 16 * 2048 + 32 * s2 + 4); }
    { const f32x4* sk = (const f32x4*)(F.A->in[I_SK] + (size_t)(l * 16 + hp) * 128 * 128);
      f32x4 v[8];
#pragma unroll
      for (int i = 0; i < 8; ++i) v[i] = sk[i * NTHR + F.tid];
#pragma unroll
      for (int i = 0; i < 8; ++i) { const int f = i * NTHR + F.tid, n = f >> 5, d = (f & 31) * 4;
          const unsigned h0 = pk2(v[i].x, v[i].y), h1 = pk2(v[i].z, v[i].w);
          const unsigned l0 = pk2(v[i].x - bflo(h0), v[i].y - bfhi(h0)), l1 = pk2(v[i].z - bflo(h1), v[i].w - bfhi(h1));
          v2u ho; ho.x = h0; ho.y = h1; v2u lo; lo.x = l0; lo.y = l1;
          *(LAS v2u*)(skh + n * SKS + d) = ho; *(LAS v2u*)(skl + n * SKS + d) = lo; } }
    __syncthreads();
    bf16x8 wh[2][4], wl[2][4];
#pragma unroll
    for (int kt = 0; kt < 2; ++kt)
#pragma unroll
        for (int s2 = 0; s2 < 4; ++s2) { const f32x4 a = wv[kt][s2][0], b = wv[kt][s2][1];
            v4u h, lo; h.x = pk2(a.x, a.y); h.y = pk2(a.z, a.w); h.z = pk2(b.x, b.y); h.w = pk2(b.z, b.w);
            lo.x = pk2(a.x - bflo(h.x), a.y - bfhi(h.x)); lo.y = pk2(a.z - bflo(h.y), a.w - bfhi(h.y)); lo.z = pk2(b.x - bflo(h.z), b.y - bfhi(h.z)); lo.w = pk2(b.z - bflo(h.w), b.w - bfhi(h.w));
            wh[kt][s2] = __builtin_bit_cast(bf16x8, h); wl[kt][s2] = __builtin_bit_cast(bf16x8, lo); }
    bf16* dst = WSP(bf16, WS_WP) + (size_t)l * 2048 * 2048 + (size_t)(hp * 128 + fr) * 2048 + kb * 256 + F.wave * 32 + 4 * fq;
#pragma unroll 2
    for (int nt = 0; nt < 8; ++nt) { f32x4 acc[2] = {{0.f, 0.f, 0.f, 0.f}, {0.f, 0.f, 0.f, 0.f}};
#pragma unroll
        for (int s2 = 0; s2 < 4; ++s2) { const bf16x8 sh = *(const LAS bf16x8*)(skh + (nt * 16 + fr) * SKS + 32 * s2 + 8 * fq), sl = *(const LAS bf16x8*)(skl + (nt * 16 + fr) * SKS + 32 * s2 + 8 * fq);
#pragma unroll
            for (int kt = 0; kt < 2; ++kt) { acc[kt] = __builtin_amdgcn_mfma_f32_16x16x32_bf16(wh[kt][s2], sh, acc[kt], 0, 0, 0); acc[kt] = __builtin_amdgcn_mfma_f32_16x16x32_bf16(wl[kt][s2], sh, acc[kt], 0, 0, 0);
                acc[kt] = __builtin_amdgcn_mfma_f32_16x16x32_bf16(wh[kt][s2], sl, acc[kt], 0, 0, 0); } }
#pragma unroll
        for (int kt = 0; kt < 2; ++kt) { v2u o; o.x = pk2(acc[kt].x, acc[kt].y); o.y = pk2(acc[kt].z, acc[kt].w); *(v2u*)(dst + (size_t)nt * 16 * 2048 + kt * 16) = o; } }
    __syncthreads();
}
__device__ __forceinline__ void cvt_item(Frame& F, int it) {
    const int which = it >> 10, chunk = it & 1023;
    const float* src = F.A->in[which ? I_PV : I_PU]; unsigned char* dst = WSP(unsigned char, which ? WS_PV : WS_PU); float* scl = WSP(float, WS_SCL) + which * 2 * NEXP;
    constexpr int VROW = 2048 + 8;
    LAS unsigned char* vt = F.lds;
    for (int i = 0; i < 4; i += 2) {
        f32x4 a[2][4], b[2][4]; float mx[2] = {0.f, 0.f};
#pragma unroll
        for (int r = 0; r < 2; ++r) { const int row = chunk * 32 + F.wave * 4 + i + r;
#pragma unroll
            for (int m = 0; m < 4; ++m) { const int col = 512 * m + 8 * F.lane; a[r][m] = *(const f32x4*)(src + (size_t)row * D + col); b[r][m] = *(const f32x4*)(src + (size_t)row * D + col + 4); } }
#pragma unroll
        for (int r = 0; r < 2; ++r) {
#pragma unroll
            for (int m = 0; m < 4; ++m) { mx[r] = fmaxf(mx[r], fmaxf(fmaxf(fabsf(a[r][m].x), fabsf(a[r][m].y)), fmaxf(fabsf(a[r][m].z), fabsf(a[r][m].w)))); mx[r] = fmaxf(mx[r], fmaxf(fmaxf(fabsf(b[r][m].x), fabsf(b[r][m].y)), fmaxf(fabsf(b[r][m].z), fabsf(b[r][m].w)))); } }
#pragma unroll
        for (int o = 1; o < 64; o <<= 1) { mx[0] = fmaxf(mx[0], __shfl_xor(mx[0], o)); mx[1] = fmaxf(mx[1], __shfl_xor(mx[1], o)); }
#pragma unroll
        for (int r = 0; r < 2; ++r) { const int row = chunk * 32 + F.wave * 4 + i + r, l = row >> 14, e = row & (NEXP - 1);
            const float sc = mx[r] > 0.f ? mx[r] * (1.0f / 440.0f) : 1.0f, inv = 1.0f / sc;
            if (F.lane == 0) scl[l * NEXP + e] = sc;
#pragma unroll
            for (int m = 0; m < 4; ++m) { const int col = 512 * m + 8 * F.lane;
                int lo = __builtin_amdgcn_cvt_pk_fp8_f32(a[r][m].x * inv, a[r][m].y * inv, 0, false); lo = __builtin_amdgcn_cvt_pk_fp8_f32(a[r][m].z * inv, a[r][m].w * inv, lo, true);
                int hi = __builtin_amdgcn_cvt_pk_fp8_f32(b[r][m].x * inv, b[r][m].y * inv, 0, false); hi = __builtin_amdgcn_cvt_pk_fp8_f32(b[r][m].z * inv, b[r][m].w * inv, hi, true);
                v2u o; o.x = (unsigned)lo; o.y = (unsigned)hi;
                if (which) *(LAS v2u*)(vt + (F.wave * 4 + i + r) * VROW + col) = o;
                else *(v2u*)(dst + ((size_t)(l * NSL + (col >> 7)) * NEXP + e) * SLW + (col & 127)) = o; } }
    }
    if (which) {
        __syncthreads();
        const int row0 = chunk * 32, l = row0 >> 14, e0 = row0 & (NEXP - 1);
#pragma unroll 4
        for (int i = 0; i < 16; ++i) { const int idx = i * NTHR + F.tid, j = idx >> 5, r = idx & 31;
            *(v2u*)(dst + ((size_t)(l * 256 + j) * NEXP + e0 + r) * 8) = *(const LAS v2u*)(vt + r * VROW + 8 * j); }
        __syncthreads();
    }
}
__device__ __forceinline__ void bias_item(Frame& F) {
    for (int i = F.tid; i < 2048; i += NTHR) { const int h = i >> 7, d = i & 127; int bk;
        if (d < 16) bk = d; else { bk = 16 + (int)(logf((float)d / 16.0f) / logf(8.0f) * 16.0f); bk = bk > 31 ? 31 : bk; }
        WSP(float, WS_BIAS)[i] = F.A->in[I_RELB][bk * 16 + h]; }
}
constexpr int IT_FOLD = 256, IT_ADA = 96, IT_WMAX = 64 + 32 + 32, IT_CVT = 2048;
constexpr int IT0_ADA = 0, IT0_BIAS = IT0_ADA + IT_ADA, IT0_WMAX = IT0_BIAS + 1, IT0_CVT = IT0_WMAX + IT_WMAX, N_OTHER = IT0_CVT + IT_CVT, N_ITEMS = N_OTHER + IT_FOLD, FOLD_EVERY = 9;
static_assert((IT_FOLD - 1) * FOLD_EVERY < N_ITEMS, "fold tickets inside the item range");
__device__ __forceinline__ void p0_prologue(Frame& F) {
    PHASE_TID(F);
    if (F.tid == 0) F.MISC[0] = __hip_atomic_fetch_add(F.ctl + CW_QUEUE, 1u, __ATOMIC_RELAXED, __HIP_MEMORY_SCOPE_AGENT);
    for (int par = 0;; par ^= 1) {
        __syncthreads();
        const int it = (int)F.MISC[par];
        if (F.tid == 0) F.MISC[par ^ 1] = __hip_atomic_fetch_add(F.ctl + CW_QUEUE, 1u, __ATOMIC_RELAXED, __HIP_MEMORY_SCOPE_AGENT);
        if (it >= N_ITEMS) break;
        const int fq = it / FOLD_EVERY; const bool is_fold = (it % FOLD_EVERY == 0) && fq < IT_FOLD;
        const int ot = it - (fq + 1 < IT_FOLD ? fq + 1 : IT_FOLD);
        if (is_fold) fold_item(F, fq);
        else if (ot < IT0_BIAS) ada_item(F, ot - IT0_ADA);
        else if (ot < IT0_WMAX) bias_item(F);
        else if (ot < IT0_WMAX + 64) wmax_item(F, ot - IT0_WMAX);
        else if (ot < IT0_WMAX + 96) wmax2_item(F, ot - IT0_WMAX - 64);
        else if (ot < IT0_CVT) wmax3_item(F, ot - IT0_WMAX - 96);
        else cvt_item(F, ot - IT0_CVT);
    }
}

__device__ __forceinline__ void row_to_fp8(const f32x4 (&y)[8], unsigned char* hrow, float* sarow, int lane) {
    float mx = 0.f;
#pragma unroll
    for (int j = 0; j < 8; ++j) mx = fmaxf(mx, fmaxf(fmaxf(fabsf(y[j].x), fabsf(y[j].y)), fmaxf(fabsf(y[j].z), fabsf(y[j].w))));
#pragma unroll
    for (int o = 1; o < 64; o <<= 1) mx = fmaxf(mx, __shfl_xor(mx, o));
    const float sc = mx > 0.f ? mx * (1.0f / 440.0f) : 1.0f, inv = 1.0f / sc;
    if (lane == 0) *sarow = sc;
#pragma unroll
    for (int j = 0; j < 8; ++j) { int w = __builtin_amdgcn_cvt_pk_fp8_f32(y[j].x * inv, y[j].y * inv, 0, false); w = __builtin_amdgcn_cvt_pk_fp8_f32(y[j].z * inv, y[j].w * inv, w, true); ((unsigned*)hrow)[lane + 64 * j] = (unsigned)w; }
}
template <bool TO_FP8, bool IN_BF16>
__device__ __forceinline__ void norm_phase(Frame& F, const void* X, bf16* Hd, const float* g, const float* modl, int ish, int isc) {
    PHASE_TID(F);
    const int gw = F.vcu * NWAVES + F.wave, NGW = F.G * NWAVES;
    int curb = -1; f32x4 gs[8], sh[8];
    for (int m = gw; m < T; m += NGW) {
        const int b = m >> 13;
        if (b != curb) { curb = b;
#pragma unroll
            for (int j = 0; j < 8; ++j) { const int col = 4 * F.lane + 256 * j; const f32x4 g4 = *(const f32x4*)(g + col), sc4 = *(const f32x4*)(modl + (size_t)b * 12288 + isc * 2048 + col);
                sh[j] = *(const f32x4*)(modl + (size_t)b * 12288 + ish * 2048 + col); gs[j] = g4 * (sc4 + 1.0f); } }
        f32x4 v[8]; float ss = 0.f;
        if constexpr (IN_BF16) { const v2u* xr = (const v2u*)((const bf16*)X + (size_t)m * D) + F.lane; v2u q[8];
#pragma unroll
            for (int j = 0; j < 8; ++j) q[j] = xr[64 * j];
            __builtin_amdgcn_sched_barrier(0);
#pragma unroll
            for (int j = 0; j < 8; ++j) v[j] = (f32x4){bflo(q[j].x), bfhi(q[j].x), bflo(q[j].y), bfhi(q[j].y)};
        } else { const f32x4* xr = (const f32x4*)((const float*)X + (size_t)m * D) + F.lane;
#pragma unroll
            for (int j = 0; j < 8; ++j) v[j] = xr[64 * j];
            __builtin_amdgcn_sched_barrier(0); }
#pragma unroll
        for (int j = 0; j < 8; ++j) ss += (v[j].x * v[j].x + v[j].y * v[j].y) + (v[j].z * v[j].z + v[j].w * v[j].w);
        const float rstd = 1.0f / sqrtf(wave_sum(ss) * (1.0f / D) + EPS);
        if constexpr (TO_FP8) { f32x4 y[8];
#pragma unroll
            for (int j = 0; j < 8; ++j) y[j] = v[j] * rstd * gs[j] + sh[j];
            row_to_fp8(y, (unsigned char*)Hd + (size_t)m * D, WSP(float, WS_SA) + m, F.lane);
        } else {
        v2u* o = (v2u*)(Hd + (size_t)m * D) + F.lane;
#pragma unroll
        for (int j = 0; j < 8; ++j) { const f32x4 y = v[j] * rstd * gs[j] + sh[j]; v2u w; w.x = pk2(y.x, y.y); w.y = pk2(y.z, y.w); o[64 * j] = w; }
        }
    }
}

__device__ __forceinline__ void conv_phase(Frame& F, int l) {
    PHASE_TID(F);
    const float* dw = F.A->in[I_DWW] + (size_t)l * CWID * CONV; const int c0 = 2 * F.tid;
    float w0[CWID], w1[CWID];
#pragma unroll
    for (int j = 0; j < CWID; ++j) { const f32x2 w = *(const f32x2*)(dw + j * CONV + c0); w0[j] = w.x; w1[j] = w.y; }
    const f32x2 cb = *(const f32x2*)(F.A->in[I_DWB] + l * CONV + c0), lg = *(const f32x2*)(F.A->in[I_CLNG] + l * CONV + c0), lb = *(const f32x2*)(F.A->in[I_CLNB] + l * CONV + c0);
    LAS float* red = (LAS float*)F.lds;
    LAS float* stat = red + 256;
    float gmx = fmaxf(fabsf(lg.x), fabsf(lg.y)), bmx = fmaxf(fabsf(lb.x), fabsf(lb.y));
#pragma unroll
    for (int o = 1; o < 64; o <<= 1) { gmx = fmaxf(gmx, __shfl_xor(gmx, o)); bmx = fmaxf(bmx, __shfl_xor(bmx, o)); }
    if (F.lane == 0) { red[F.wave] = gmx; red[8 + F.wave] = bmx; }
    __syncthreads();
    { float g_ = red[0], b_ = red[8];
#pragma unroll
      for (int w = 1; w < 8; ++w) { g_ = fmaxf(g_, red[w]); b_ = fmaxf(b_, red[8 + w]); }
      gmx = g_; bmx = b_; }
    __syncthreads();
    const float Bc = fmaxf(32.0f * gmx + bmx, 1e-20f), cinv = 440.0f / Bc;
    if (blockIdx.x == 0 && F.tid == 0) { __hip_atomic_store(F.ctl + CW_BC + l, __float_as_uint(Bc), __ATOMIC_RELAXED, __HIP_MEMORY_SCOPE_AGENT); __hip_atomic_store(F.ctl + CW_BC2 + l, __float_as_uint(gmx + bmx), __ATOMIC_RELAXED, __HIP_MEMORY_SCOPE_AGENT); }
    const unsigned* Ut = WSP(unsigned, WS_U) + F.tid; unsigned short* AM = WSP(unsigned short, WS_AM);
    for (int tile = F.vcu; tile < T / 64; tile += F.G) {
        const int t0 = tile * 64, bstart = t0 & ~(SEQ - 1);
        for (int grp = 0; grp < 4; ++grp) {
            const int tg = t0 + grp * 16;
            float wa[46], wb[46]; unsigned wp[46];
#pragma unroll
            for (int i = 0; i < 46; ++i) { const int r = tg - 30 + i; wp[i] = Ut[(size_t)(r >= bstart ? r : bstart) * (CONV / 2)]; }
            __builtin_amdgcn_sched_barrier(0);
#pragma unroll
            for (int i = 0; i < 46; ++i) { const int r = tg - 30 + i; const unsigned p = wp[i] & (r >= bstart ? 0xffffffffu : 0u); wa[i] = bflo(p); wb[i] = bfhi(p); }
            float oa[16], ob[16];
#pragma unroll
            for (int i = 0; i < 16; ++i) { float a = cb.x, b = cb.y;
#pragma unroll
                for (int j = 0; j < CWID; ++j) { a += w0[j] * wa[i + j]; b += w1[j] * wb[i + j]; }
                oa[i] = a; ob[i] = b; }
#pragma unroll
            for (int i = 0; i < 16; ++i) { const float s = wave_sum(oa[i] + ob[i]), q = wave_sum(oa[i] * oa[i] + ob[i] * ob[i]); if (F.lane == 0) { red[F.wave * 32 + i] = s; red[F.wave * 32 + 16 + i] = q; } }
            __syncthreads();
            if (F.tid < 32) { float v = 0.f;
#pragma unroll
                for (int w = 0; w < 8; ++w) v += red[w * 32 + F.tid];
                stat[F.tid] = v; }
            __syncthreads();
#pragma unroll
            for (int i = 0; i < 16; ++i) { const float mu = stat[i] * (1.0f / CONV), var = fmaxf(stat[16 + i] * (1.0f / CONV) - mu * mu, 0.0f), rstd = 1.0f / sqrtf(var + EPS);
                const float ya = (oa[i] - mu) * rstd * lg.x + lb.x, yb = (ob[i] - mu) * rstd * lg.y + lb.y;
                AM[(size_t)(tg + i) * (D / 2) + F.tid] = (unsigned short)__builtin_amdgcn_cvt_pk_fp8_f32(ya * sigmoidf_(ya) * cinv, yb * sigmoidf_(yb) * cinv, 0, false); }
        }
    }
}

#define MFMA32(a, b, c) __builtin_amdgcn_mfma_f32_32x32x16_bf16((a), (b), (c), 0, 0, 0)
__device__ __forceinline__ void attn_phase(Frame& F, int l) {
    PHASE_TID(F);
    constexpr int VTS = 260;
    constexpr int KS = 72;
    LAS bf16* VT = (LAS bf16*)F.lds;
    LAS bf16* KL = (LAS bf16*)(F.lds + 34816);
    LAS float* BT = (LAS float*)(F.lds + 34816 + 36864);
    const bf16* Qg = WSP(bf16, WS_Q); const bf16* Kg = WSP(bf16, WS_K); const bf16* Vg = WSP(bf16, WS_V); unsigned char* AM = WSP(unsigned char, WS_AM);
    const float* BIAS = WSP(float, WS_BIAS);
    const int r = F.lane & 31, h = F.lane >> 5;
    for (int unit = F.vcu; unit < 512; unit += F.G) {
        const int b = unit >> 8, blk = (unit >> 2) & 63, kvh = unit & 3, kbase = blk * 128 - 128;
        const float vmx = __uint_as_float(__hip_atomic_load(F.ctl + CW_VMAX + 2 * l + b, __ATOMIC_RELAXED, __HIP_MEMORY_SCOPE_AGENT)), ainv = vmx > 0.f ? 440.0f / (1.02f * vmx) : 1.0f;
        for (int c = F.tid; c < 2048; c += NTHR) { const int key = c >> 3, d0 = (c & 7) * 8, kpos = kbase + key; v4u v = {0u, 0u, 0u, 0u}, kq = {0u, 0u, 0u, 0u};
            if (kpos >= 0) { v = *(const v4u*)(Vg + (size_t)(b * SEQ + kpos) * KVD + kvh * HD + d0); kq = *(const v4u*)(Kg + (size_t)(b * SEQ + kpos) * KVD + kvh * HD + d0); }
            *(LAS v4u*)(KL + key * KS + d0) = kq;
            LAS bf16* dst = VT + d0 * VTS + key;
            dst[0 * VTS] = (bf16)v.x; dst[1 * VTS] = (bf16)(v.x >> 16); dst[2 * VTS] = (bf16)v.y; dst[3 * VTS] = (bf16)(v.y >> 16);
            dst[4 * VTS] = (bf16)v.z; dst[5 * VTS] = (bf16)(v.z >> 16); dst[6 * VTS] = (bf16)v.w; dst[7 * VTS] = (bf16)(v.w >> 16); }
        BT[F.tid] = BIAS[(kvh * 4 + (F.tid >> 7)) * 128 + (F.tid & 127)];
        __syncthreads();
        for (int tk = 0; tk < 2; ++tk) {
            const int task = F.wave * 2 + tk, g = task >> 2, qs = task & 3, head = kvh * 4 + g;
            const size_t trow = (size_t)b * SEQ + blk * 128 + qs * 32 + r;
            bf16x8 qf[4];
#pragma unroll
            for (int s = 0; s < 4; ++s) qf[s] = *(const bf16x8*)(Qg + trow * ATT + head * HD + 16 * s + 8 * h);
            const float sink = F.A->in[I_SINK][l * NHEAD + head];
            float mx = sink, lsum = 0.f;
            f32x16 o[2];
#pragma unroll
            for (int i = 0; i < 16; ++i) { o[0][i] = 0.f; o[1][i] = 0.f; }
#pragma unroll 1
            for (int j = 0; j < 5; ++j) { f32x16 a;
#pragma unroll
                for (int i = 0; i < 16; ++i) a[i] = 0.f;
#pragma unroll
                for (int s = 0; s < 4; ++s) { const bf16x8 kf = *(const LAS bf16x8*)(KL + (qs * 32 + 32 * j + r) * KS + 16 * s + 8 * h); a = MFMA32(kf, qf[s], a); }
                float tmax = -INFINITY;
#pragma unroll
                for (int i = 0; i < 16; ++i) { const int kr = 32 * j + (i & 3) + 8 * (i >> 2) + 4 * h, dist = 128 + r - kr; const bool ok = dist >= 0 && dist < 128 && (kbase + qs * 32 + kr) >= 0;
                    const float sv = ok ? a[i] + BT[g * 128 + (dist & 127)] : -INFINITY; a[i] = sv; tmax = fmaxf(tmax, sv); }
                tmax = fmaxf(tmax, __shfl_xor(tmax, 32));
                const float mnew = fmaxf(mx, tmax), alpha = __expf(mx - mnew); mx = mnew; lsum *= alpha;
#pragma unroll
                for (int i = 0; i < 16; ++i) { o[0][i] *= alpha; o[1][i] *= alpha; const float p = __expf(a[i] - mx); a[i] = p; lsum += p; }
#pragma unroll
                for (int s2 = 0; s2 < 2; ++s2) { v4u pp; pp.x = pk2(a[8 * s2 + 0], a[8 * s2 + 1]); pp.y = pk2(a[8 * s2 + 2], a[8 * s2 + 3]); pp.z = pk2(a[8 * s2 + 4], a[8 * s2 + 5]); pp.w = pk2(a[8 * s2 + 6], a[8 * s2 + 7]);
                    const bf16x8 pf = __builtin_bit_cast(bf16x8, pp);
#pragma unroll
                    for (int dt = 0; dt < 2; ++dt) { const LAS bf16* vp = VT + (32 * dt + r) * VTS + qs * 32 + 32 * j + 16 * s2 + 4 * h; const v2u lo = *(const LAS v2u*)vp, hi = *(const LAS v2u*)(vp + 8);
                        v4u vv; vv.x = lo.x; vv.y = lo.y; vv.z = hi.x; vv.w = hi.y; o[dt] = MFMA32(__builtin_bit_cast(bf16x8, vv), pf, o[dt]); } }
            }
            lsum += __shfl_xor(lsum, 32);
            const float inv = ainv / (lsum + __expf(sink - mx));
#pragma unroll
            for (int dt = 0; dt < 2; ++dt)
#pragma unroll
                for (int g4 = 0; g4 < 4; ++g4) { int w = __builtin_amdgcn_cvt_pk_fp8_f32(o[dt][4 * g4 + 0] * inv, o[dt][4 * g4 + 1] * inv, 0, false); w = __builtin_amdgcn_cvt_pk_fp8_f32(o[dt][4 * g4 + 2] * inv, o[dt][4 * g4 + 3] * inv, w, true);
                    *(unsigned*)(AM + trow * D + ATT + head * HD + 32 * dt + 8 * g4 + 4 * h) = (unsigned)w; }
        }
        __syncthreads();
    }
}

__device__ __forceinline__ unsigned f2key(float f) { const unsigned u = __float_as_uint(f); return (u & 0x80000000u) ? ~u : (u | 0x80000000u); }
__device__ __forceinline__ float key2f(unsigned k) { const unsigned u = (k & 0x80000000u) ? (k & 0x7fffffffu) : ~k; return __uint_as_float(u); }
#define INSERT16(L, x_) do { unsigned x__ = (x_); _Pragma("unroll") for (int q_ = 0; q_ < 16; ++q_) { const unsigned hi_ = L[q_] > x__ ? L[q_] : x__; x__ = L[q_] > x__ ? x__ : L[q_]; L[q_] = hi_; } } while (0)
__device__ __forceinline__ void topk_phase(Frame& F) {
    PHASE_TID(F);
    const _Float16* S = WSP(_Float16, WS_GC); int* IDX = WSP(int, WS_U); float* GATE = WSP(float, WS_U + 8 * MiB);
    const int gw = F.vcu * NWAVES + F.wave, NGW = F.G * NWAVES;
    constexpr int TKS = 256; LAS unsigned char* lw = F.lds + F.wave * (64 * TKS); const LAS unsigned char* lrow = lw + F.lane * TKS;
    for (int grp = gw; grp < T * PHEADS / 64; grp += NGW) {
        const int item = grp * 64 + F.lane, t = item >> 3, hh = item & 7;
        const unsigned char* sg = (const unsigned char*)(S + (size_t)grp * 8 * D) + (size_t)(F.lane >> 4) * 512 + (F.lane & 15) * 16;
        v4u r0[16], r1[16];
#pragma unroll
        for (int i = 0; i < 16; ++i) r0[i] = *(const v4u*)(sg + (size_t)(i >> 1) * 4096 + (i & 1) * 2048);
#pragma unroll
        for (int i = 0; i < 16; ++i) r1[i] = *(const v4u*)(sg + (size_t)(i >> 1) * 4096 + (i & 1) * 2048 + 256);
        __builtin_amdgcn_sched_barrier(0);
#pragma unroll
        for (int i = 0; i < 16; ++i) *(LAS v4u*)(lw + (4 * i + (F.lane >> 4)) * TKS + (((F.lane & 15) ^ ((4 * i + (F.lane >> 4)) & 15)) << 4)) = r0[i];
        __builtin_amdgcn_sched_barrier(0);
        unsigned L1[16], L2[16];
#pragma unroll
        for (int q = 0; q < 16; ++q) { L1[q] = 0u; L2[q] = 0u; }
#pragma unroll 2
        for (int c = 0; c < 16; ++c) { const pg8::f16x8 v = *(const LAS pg8::f16x8*)(lrow + ((c ^ (F.lane & 15)) << 4));
#pragma unroll
            for (int e = 0; e < 8; ++e) { const unsigned key = (f2key((float)v[e]) & ~127u) | (unsigned)(127 - (8 * c + e)); INSERT16(L1, key); } }
        __builtin_amdgcn_sched_barrier(0);
#pragma unroll
        for (int i = 0; i < 16; ++i) *(LAS v4u*)(lw + (4 * i + (F.lane >> 4)) * TKS + (((F.lane & 15) ^ ((4 * i + (F.lane >> 4)) & 15)) << 4)) = r1[i];
        __builtin_amdgcn_sched_barrier(0);
#pragma unroll 2
        for (int c = 0; c < 16; ++c) { const pg8::f16x8 v = *(const LAS pg8::f16x8*)(lrow + ((c ^ (F.lane & 15)) << 4));
#pragma unroll
            for (int e = 0; e < 8; ++e) { const unsigned key = (f2key((float)v[e]) & ~127u) | (unsigned)(127 - (8 * c + e)); INSERT16(L2, key); } }
        float v1[16], v2[16];
#pragma unroll
        for (int q = 0; q < 16; ++q) { v1[q] = key2f(L1[q] & ~127u); v2[q] = key2f(L2[q] & ~127u); }
        unsigned B[16];
#pragma unroll
        for (int q = 0; q < 16; ++q) B[q] = 0u;
#pragma unroll
        for (int i = 0; i < 16; ++i)
#pragma unroll
            for (int j = 0; j < 16; ++j) if ((i + 1) * (j + 1) <= 16) { const unsigned key = (f2key(v1[i] + v2[j]) & ~255u) | (unsigned)(255 - (i * 16 + j)); INSERT16(B, key); }
        const float b0 = key2f(B[0] & ~255u); float e[16], es = 0.f;
#pragma unroll
        for (int q = 0; q < 16; ++q) { e[q] = __expf(key2f(B[q] & ~255u) - b0); es += e[q]; }
        const float einv = 1.0f / es;
        int ex[16];
#pragma unroll
        for (int q = 0; q < 16; ++q) { const int code = 255 - (int)(B[q] & 255u), ii = code >> 4, jj = code & 15; unsigned s1 = L1[0], s2 = L2[0];
#pragma unroll
            for (int z = 1; z < 16; ++z) { s1 = (ii == z) ? L1[z] : s1; s2 = (jj == z) ? L2[z] : s2; }
            ex[q] = (127 - (int)(s1 & 127u)) * 128 + (127 - (int)(s2 & 127u)); e[q] *= einv; }
        int* ip = IDX + (size_t)t * 128 + hh * 16; float* gp = GATE + (size_t)t * 128 + hh * 16;
#pragma unroll
        for (int q = 0; q < 4; ++q) { *(int4*)(ip + 4 * q) = make_int4(ex[4 * q], ex[4 * q + 1], ex[4 * q + 2], ex[4 * q + 3]); *(f32x4*)(gp + 4 * q) = (f32x4){e[4 * q], e[4 * q + 1], e[4 * q + 2], e[4 * q + 3]}; }
    }
}

#define FP8LO(w_) __builtin_amdgcn_cvt_pk_f32_fp8((int)(w_), false)
#define FP8HI(w_) __builtin_amdgcn_cvt_pk_f32_fp8((int)(w_), true)
__device__ __forceinline__ void pa_issue(v4u (&rr)[16], int id0, int id1, const unsigned char* tab, int g) {
#pragma unroll
    for (int i = 0; i < 16; ++i) { const int e = __shfl(i < 8 ? id0 : id1, ((8 * i) & 63) + g); rr[i] = *(const v4u*)(tab + (size_t)e * SLW); }
}
__device__ __forceinline__ void pa_compute(const v4u (&rr)[16], const v4u ha, const v4u hb, float o0, float o1, float* d0, float* d1, int lane) {
    f32x2 hf[8];
    hf[0] = (f32x2){bflo(ha.x), bfhi(ha.x)}; hf[1] = (f32x2){bflo(ha.y), bfhi(ha.y)}; hf[2] = (f32x2){bflo(ha.z), bfhi(ha.z)}; hf[3] = (f32x2){bflo(ha.w), bfhi(ha.w)};
    hf[4] = (f32x2){bflo(hb.x), bfhi(hb.x)}; hf[5] = (f32x2){bflo(hb.y), bfhi(hb.y)}; hf[6] = (f32x2){bflo(hb.z), bfhi(hb.z)}; hf[7] = (f32x2){bflo(hb.w), bfhi(hb.w)};
    float p[16];
#pragma unroll
    for (int i = 0; i < 16; ++i) { f32x2 a = FP8LO(rr[i].x) * hf[0];
        a = __builtin_elementwise_fma(FP8HI(rr[i].x), hf[1], a); a = __builtin_elementwise_fma(FP8LO(rr[i].y), hf[2], a); a = __builtin_elementwise_fma(FP8HI(rr[i].y), hf[3], a);
        a = __builtin_elementwise_fma(FP8LO(rr[i].z), hf[4], a); a = __builtin_elementwise_fma(FP8HI(rr[i].z), hf[5], a); a = __builtin_elementwise_fma(FP8LO(rr[i].w), hf[6], a); a = __builtin_elementwise_fma(FP8HI(rr[i].w), hf[7], a);
        p[i] = a.x + a.y; }
    float q8[8], q4[4], q2[2];
    { const bool bt = (lane & 1) != 0;
#pragma unroll
      for (int i = 0; i < 8; ++i) { const float snd = bt ? p[i] : p[i + 8], kp = bt ? p[i + 8] : p[i]; q8[i] = kp + lane_xor1(snd); } }
    { const bool bt = (lane & 2) != 0;
#pragma unroll
      for (int i = 0; i < 4; ++i) { const float snd = bt ? q8[i] : q8[i + 4], kp = bt ? q8[i + 4] : q8[i]; q4[i] = kp + lane_xor2(snd); } }
    { const bool bt = (lane & 4) != 0;
#pragma unroll
      for (int i = 0; i < 2; ++i) { const float snd = bt ? q4[i] : q4[i + 2], kp = bt ? q4[i + 2] : q4[i]; q2[i] = kp + lane_xor4(snd); } }
    *d0 = o0 + q2[0]; *d1 = o1 + q2[1];
}
__device__ __forceinline__ void peer_act_phase(Frame& F, int l) {
    PHASE_TID(F);
    const int lane = F.lane, g = lane >> 3, j = lane & 7;
    const int x = blockIdx.x & 7, bpg = F.G >> 3, wpg = bpg * NWAVES, wgi = (blockIdx.x >> 3) * NWAVES + F.wave;
    const int* IDX = WSP(int, WS_U); const bf16* Hb = WSP(bf16, WS_H);
    float* actp = WSP(float, WS_AM) + (size_t)x * T * 128;
    const int irev = 8 * (j & 1) + 4 * ((j >> 1) & 1) + 2 * (j >> 2), k0 = 8 * irev + g, k1 = k0 + 8;
    const int NT = (T - wgi + wpg - 1) / wpg;
    for (int s = 0; s < 2; ++s) {
        const int sl = 2 * x + s; const unsigned char* tab = WSP(unsigned char, WS_PU) + (size_t)(l * NSL + sl) * NEXP * SLW + 16 * j;
        const bf16* hcol = Hb + sl * SLW + 16 * j;
#define PA_PREF(n_, i0, i1, h0, h1, q0, q1) do { const int t_ = wgi + (n_) * wpg; if ((n_) < NT) { i0 = IDX[(size_t)t_ * 128 + lane]; i1 = IDX[(size_t)t_ * 128 + 64 + lane]; h0 = *(const v4u*)(hcol + (size_t)t_ * D); h1 = *(const v4u*)(hcol + (size_t)t_ * D + 8); \
            if (s > 0) { q0 = actp[(size_t)t_ * 128 + k0]; q1 = actp[(size_t)t_ * 128 + k1]; } } } while (0)
        int ia0 = 0, ia1 = 0, ib0 = 0, ib1 = 0; v4u ha0 = {0u, 0u, 0u, 0u}, ha1 = ha0, hb0 = ha0, hb1 = ha0; float oa0 = 0.f, oa1 = 0.f, ob0 = 0.f, ob1 = 0.f;
        v4u rA[16], rB[16];
        PA_PREF(0, ia0, ia1, ha0, ha1, oa0, oa1); PA_PREF(1, ib0, ib1, hb0, hb1, ob0, ob1);
        if (0 < NT) pa_issue(rA, ia0, ia1, tab, g);
        for (int n = 0; n < NT; n += 2) {
            const v4u ca0 = ha0, ca1 = ha1; const float pa0 = oa0, pa1 = oa1;
            if (n + 1 < NT) pa_issue(rB, ib0, ib1, tab, g);
            PA_PREF(n + 2, ia0, ia1, ha0, ha1, oa0, oa1);
            __builtin_amdgcn_sched_barrier(0);
            { const size_t t_ = (size_t)(wgi + n * wpg); pa_compute(rA, ca0, ca1, pa0, pa1, actp + t_ * 128 + k0, actp + t_ * 128 + k1, lane); }
            __builtin_amdgcn_sched_barrier(0);
            if (n + 1 < NT) {
                const v4u cb0 = hb0, cb1 = hb1; const float pb0 = ob0, pb1 = ob1;
                if (n + 2 < NT) pa_issue(rA, ia0, ia1, tab, g);
                PA_PREF(n + 3, ib0, ib1, hb0, hb1, ob0, ob1);
                __builtin_amdgcn_sched_barrier(0);
                { const size_t t_ = (size_t)(wgi + (n + 1) * wpg); pa_compute(rB, cb0, cb1, pb0, pb1, actp + t_ * 128 + k0, actp + t_ * 128 + k1, lane); }
                __builtin_amdgcn_sched_barrier(0);
            }
        }
#undef PA_PREF
    }
}
__device__ __forceinline__ void peer_w_phase(Frame& F, int l) {
    PHASE_TID(F);
    const int lane = F.lane;
    constexpr int WROW = 136;
    LAS bf16* wl = (LAS bf16*)F.lds; LAS bf16* il = wl + 64 * WROW;
    const int* IDX = WSP(int, WS_U); const float* GATE = WSP(float, WS_U + 8 * MiB); const float* actp = WSP(float, WS_AM);
    bf16* WT = WSP(bf16, WS_Y1); bf16* IT = WSP(bf16, WS_Y1 + 4 * MiB);
    const float* su = WSP(float, WS_SCL) + l * NEXP; const float* sv = WSP(float, WS_SCL) + (2 + l) * NEXP;
    for (int tb = F.vcu; tb < T / 64; tb += F.G) {
#pragma unroll 2
        for (int i = 0; i < 8; ++i) { const int tl = F.wave * 8 + i, t = tb * 64 + tl;
            const int e0 = IDX[(size_t)t * 128 + lane], e1 = IDX[(size_t)t * 128 + 64 + lane];
            float pa[8], pb[8];
#pragma unroll
            for (int xx = 0; xx < 8; ++xx) { pa[xx] = actp[((size_t)xx * T + t) * 128 + lane]; pb[xx] = actp[((size_t)xx * T + t) * 128 + 64 + lane]; }
            const float gt0 = GATE[(size_t)t * 128 + lane], gt1 = GATE[(size_t)t * 128 + 64 + lane];
            const float su0 = su[e0], su1 = su[e1], sv0 = sv[e0], sv1 = sv[e1];
            __builtin_amdgcn_sched_barrier(0);
            float a0 = ((pa[0] + pa[1]) + (pa[2] + pa[3])) + ((pa[4] + pa[5]) + (pa[6] + pa[7])), a1 = ((pb[0] + pb[1]) + (pb[2] + pb[3])) + ((pb[4] + pb[5]) + (pb[6] + pb[7]));
            a0 *= su0; a1 *= su1;
            const float g0 = gt0 * sv0, g1 = gt1 * sv1;
            wl[tl * WROW + lane] = __builtin_bit_cast(bf16, (_Float16)(256.0f * g0 * 0.5f * a0 * (1.0f + erff(a0 * 0.70710678118654752f)))); wl[tl * WROW + 64 + lane] = __builtin_bit_cast(bf16, (_Float16)(256.0f * g1 * 0.5f * a1 * (1.0f + erff(a1 * 0.70710678118654752f))));
            il[tl * WROW + lane] = (bf16)e0; il[tl * WROW + 64 + lane] = (bf16)e1; }
        __syncthreads();
#pragma unroll
        for (int i = 0; i < 2; ++i) { const int p_ = i * NTHR + F.tid, kq = p_ >> 6, tl = p_ & 63; const size_t o = ((size_t)(tb * 16 + kq) * 64 + tl) * 8;
            *(v4u*)(WT + o) = *(const LAS v4u*)(wl + tl * WROW + 8 * kq); *(v4u*)(IT + o) = *(const LAS v4u*)(il + tl * WROW + 8 * kq); }
        __syncthreads();
    }
}
__device__ __forceinline__ void pbl_load(v4u (&iv)[4], v4u (&wv)[4], const bf16* ip, const bf16* wp) {
#pragma unroll
    for (int q = 0; q < 4; ++q) { iv[q] = *(const v4u*)(ip + q * 512); wv[q] = *(const v4u*)(wp + q * 512); }
}
typedef _Float16 h16x2 __attribute__((ext_vector_type(2)));
#define FP8H_LO(w_) __builtin_bit_cast(h16x2, __builtin_amdgcn_cvt_scalef32_pk_f16_fp8((int)(w_), 1.0f, false))
#define FP8H_HI(w_) __builtin_bit_cast(h16x2, __builtin_amdgcn_cvt_scalef32_pk_f16_fp8((int)(w_), 1.0f, true))
__device__ __forceinline__ void pbl_compute(const v4u (&iv)[4], const v4u (&wv)[4], h16x2 (&acc)[4], LAS unsigned char* lds) {
#pragma unroll
    for (int q = 0; q < 4; ++q) { v2u d[8];
#pragma unroll
        for (int ki = 0; ki < 8; ++ki) { const unsigned ipair = iv[q][ki >> 1]; const unsigned idx = (ki & 1) ? (ipair >> 16) : (ipair & 0xffffu); d[ki] = *(const LAS v2u*)(lds + idx * 8); }
        __builtin_amdgcn_sched_barrier(0);
#pragma unroll
        for (int ki = 0; ki < 8; ++ki) { const unsigned wword = wv[q][ki >> 1], wb = (ki & 1) ? (wword >> 16) : (wword & 0xffffu); const h16x2 w2 = __builtin_bit_cast(h16x2, wb | (wb << 16));
            acc[0] = __builtin_elementwise_fma(FP8H_LO(d[ki].x), w2, acc[0]); acc[1] = __builtin_elementwise_fma(FP8H_HI(d[ki].x), w2, acc[1]); acc[2] = __builtin_elementwise_fma(FP8H_LO(d[ki].y), w2, acc[2]); acc[3] = __builtin_elementwise_fma(FP8H_HI(d[ki].y), w2, acc[3]); }
        __builtin_amdgcn_sched_barrier(0); }
}
__device__ __forceinline__ void peer_out_phase(Frame& F, int l) {
    PHASE_TID(F);
    const int lane = F.lane;
    const int x = blockIdx.x & 7, ib = blockIdx.x >> 3, j = 8 * (4 * x + (ib >> 3)) + (ib & 7);
    const bf16* WT = WSP(bf16, WS_Y1); const bf16* IT = WSP(bf16, WS_Y1 + 4 * MiB); bf16* OUT = WSP(bf16, WS_GC);
    for (int jj = (F.G == 256 ? j : (int)blockIdx.x); jj < 256; jj += (F.G == 256 ? 256 : F.G)) {
        const unsigned char* sl = WSP(unsigned char, WS_PV) + (size_t)(l * 256 + jj) * NEXP * 8;
        { v4u fr_[16];
#pragma unroll
          for (int i = 0; i < 16; ++i) fr_[i] = *(const v4u*)(sl + (i * NTHR + F.tid) * 16);
          __builtin_amdgcn_sched_barrier(0);
#pragma unroll
          for (int i = 0; i < 16; ++i) *(LAS v4u*)(F.lds + (i * NTHR + F.tid) * 16) = fr_[i]; }
        __syncthreads();
        constexpr int NCH = 4 * (T / 64 / NWAVES);
#define PBL_PTR(c_, arr_) ((arr_) + ((size_t)(F.wave + NWAVES * ((c_) >> 2)) * 16 * 64 + lane) * 8 + ((c_) & 3) * 4 * 512)
        v4u iA[4], wA[4], iB[4], wB[4], iC[4], wC[4]; h16x2 acc[4];
#define PBL_STEP(X_, Z_, c_) do { const int cc_ = (c_); if (cc_ + 2 < NCH) pbl_load(i##Z_, w##Z_, PBL_PTR(cc_ + 2, IT), PBL_PTR(cc_ + 2, WT)); \
            __builtin_amdgcn_sched_barrier(0); \
            if ((cc_ & 3) == 0) { _Pragma("unroll") for (int q = 0; q < 4; ++q) acc[q] = (h16x2){(_Float16)0.f, (_Float16)0.f}; } \
            pbl_compute(i##X_, w##X_, acc, F.lds); \
            if ((cc_ & 3) == 3) { constexpr float us_ = 1.0f / 256.0f; v4u o; o.x = pk2((float)acc[0].x * us_, (float)acc[0].y * us_); o.y = pk2((float)acc[1].x * us_, (float)acc[1].y * us_); o.z = pk2((float)acc[2].x * us_, (float)acc[2].y * us_); o.w = pk2((float)acc[3].x * us_, (float)acc[3].y * us_); \
                *(v4u*)(OUT + (size_t)((F.wave + NWAVES * (cc_ >> 2)) * 64 + lane) * D + 8 * jj) = o; } \
            __builtin_amdgcn_sched_barrier(0); } while (0)
        pbl_load(iA, wA, PBL_PTR(0, IT), PBL_PTR(0, WT)); pbl_load(iB, wB, PBL_PTR(1, IT), PBL_PTR(1, WT));
#pragma unroll 1
        for (int c = 0; c < NCH; c += 3) {
            PBL_STEP(A, C, c);
            if (c + 1 < NCH) PBL_STEP(B, A, c + 1);
            if (c + 2 < NCH) PBL_STEP(C, B, c + 2);
        }
#undef PBL_STEP
#undef PBL_PTR
        __syncthreads();
    }
}
__device__ __forceinline__ void peer_res_phase(Frame& F, int l, bf16* XO) {
    PHASE_TID(F);
    const bool last = (l == 1);
    const int gw = F.vcu * NWAVES + F.wave, NGW = F.G * NWAVES, lane = F.lane;
    const bf16* XA = WSP(bf16, WS_XA); const bf16* OUTS = WSP(bf16, WS_GC); bf16* Hb = WSP(bf16, WS_H); const float* MOD = WSP(float, WS_MOD);
    for (int t = gw; t < T; t += NGW) {
        const int b = t >> 13; const float* g2 = MOD + (size_t)(l * 2 + b) * 12288 + 5 * 2048;
        f32x4 v[8], gq[8]; v2u oq[8], xq[8]; float ss = 0.f;
#pragma unroll
        for (int jj = 0; jj < 8; ++jj) { const int col = 4 * lane + 256 * jj; xq[jj] = *(const v2u*)(XA + (size_t)t * D + col); gq[jj] = *(const f32x4*)(g2 + col); oq[jj] = *(const v2u*)(OUTS + (size_t)t * D + col); }
        __builtin_amdgcn_sched_barrier(0);
#pragma unroll
        for (int jj = 0; jj < 8; ++jj) { const f32x4 o = {bflo(oq[jj].x), bfhi(oq[jj].x), bflo(oq[jj].y), bfhi(oq[jj].y)}; v[jj] = (f32x4){bflo(xq[jj].x), bfhi(xq[jj].x), bflo(xq[jj].y), bfhi(xq[jj].y)};
            v[jj] = v[jj] + gq[jj] * o; ss += (v[jj].x * v[jj].x + v[jj].y * v[jj].y) + (v[jj].z * v[jj].z + v[jj].w * v[jj].w); }
        const float rstd = 1.0f / sqrtf(wave_sum(ss) * (1.0f / D) + EPS);
        if (!last) {
            const float* ng = F.A->in[I_N1G] + (size_t)(l + 1) * D; const float* mn = MOD + (size_t)((l + 1) * 2 + b) * 12288;
#pragma unroll
            for (int jj = 0; jj < 8; ++jj) gq[jj] = *(const f32x4*)(ng + 4 * lane + 256 * jj);
            f32x4 shq[8], scq[8];
#pragma unroll
            for (int jj = 0; jj < 8; ++jj) { scq[jj] = *(const f32x4*)(mn + 2048 + 4 * lane + 256 * jj); shq[jj] = *(const f32x4*)(mn + 4 * lane + 256 * jj); }
            __builtin_amdgcn_sched_barrier(0);
#pragma unroll
            for (int jj = 0; jj < 8; ++jj) gq[jj] = gq[jj] * (scq[jj] + 1.0f);
#pragma unroll
            for (int jj = 0; jj < 8; ++jj) { const int col = 4 * lane + 256 * jj; v2u w; w.x = pk2(v[jj].x, v[jj].y); w.y = pk2(v[jj].z, v[jj].w); *(v2u*)(XO + (size_t)t * D + col) = w; v[jj] = v[jj] * rstd * gq[jj] + shq[jj]; }
            row_to_fp8(v, (unsigned char*)Hb + (size_t)t * D, WSP(float, WS_SA) + t, lane);
        } else {
            const float* fg = F.A->in[I_FG];
#pragma unroll
            for (int jj = 0; jj < 8; ++jj) gq[jj] = *(const f32x4*)(fg + 4 * lane + 256 * jj);
            __builtin_amdgcn_sched_barrier(0);
#pragma unroll
            for (int jj = 0; jj < 8; ++jj) *(f32x4*)(F.out + (size_t)t * D + 4 * lane + 256 * jj) = v[jj] * rstd * gq[jj];
        }
    }
}

#ifndef MK_ONE_LAUNCH
#define MK_ONE_LAUNCH 1
#endif
#define PG8_ALIGN true
#define PG8_SP2 true
constexpr int PH_PER_LAYER = 13, N_PHASES = 1 + 2 * PH_PER_LAYER;
__global__ void __launch_bounds__(NTHR, 2) fwd(Args args) {
    extern __shared__ __attribute__((aligned(16))) unsigned char lds[];
    Frame F;
    F.lds = (LAS unsigned char*)lds; F.MISC = (volatile LAS unsigned*)(F.lds + MISC_OFF);
    F.tid = threadIdx.x; F.lane = F.tid & 63; F.wave = __builtin_amdgcn_readfirstlane(F.tid >> 6);
    F.G = gridDim.x; { const int bx = blockIdx.x; F.vcu = (F.G % 8 == 0) ? (bx % 8) * (F.G / 8) + bx / 8 : bx; }
    F.A = &args;
    F.out = args.out; F.ws = args.ws; F.ctl = (gu32*)(args.ws + WS_CTL);
    for (int u = F.tid; u < (LDS_BYTES - LDSCTL_OFF) / 4; u += NTHR) ((LAS unsigned*)(F.lds + LDSCTL_OFF))[u] = 0u;
    __syncthreads();
#if MK_ONE_LAUNCH
    XcdBarrier bar = xcd_barrier_post((unsigned*)(F.ctl + CW_BAR), F.MISC + 8);
#define GRID_BAR() xcd_barrier(bar)
#else
#define GRID_BAR() do { } while (0)
#endif
    const int lo = args.ph_lo, hi = args.ph_hi;
#define IN(k) (lo <= (k) && (k) < hi)
#define SEAM(k) do { if (IN(k) && IN((k) + 1)) GRID_BAR(); } while (0)
    float* MOD = WSP(float, WS_MOD);
    pg8::bf16_t* Hb = WSP(pg8::bf16_t, WS_H);

    if (IN(0)) { p0_prologue(F); SEAM(0); }
    for (int l = 0; l < 2; ++l) {
        const int pb = 1 + PH_PER_LAYER * l;
        const float* modl = MOD + (size_t)l * 2 * 12288;
        if (IN(pb + 0) && l == 0) { norm_phase<true, false>(F, F.A->in[I_X], WSP(bf16, WS_H), F.A->in[I_N1G], modl, 0, 1);
            win8_phase(F);
            SEAM(pb + 0); }
        if (IN(pb + 1)) {
            pg8::Gemm g{Hb, (const pg8::bf16_t*)(WSP(unsigned char, WS_WIN) + (size_t)l * IN_DIM * 2048), T, IN_DIM, D / 2, D / 2, D / 2}; pg8::StaticOrder S; S.init(T, IN_DIM, F.G, (int)blockIdx.x);
            const float wmax = __uint_as_float(__hip_atomic_load(F.ctl + CW_WMAX + l, __ATOMIC_RELAXED, __HIP_MEMORY_SCOPE_AGENT));
            pg8::EpiInProj E{WSP(pg8::bf16_t, WS_U), WSP(pg8::bf16_t, WS_Q), WSP(pg8::bf16_t, WS_K), WSP(pg8::bf16_t, WS_V), WSP(pg8::bf16_t, WS_GC), WSP(pg8::bf16_t, WS_GA), WSP(float, WS_SA), wmax > 0.f ? wmax * (1.0f / 440.0f) : 1.0f, (unsigned*)(F.ctl + CW_VMAX + 2 * l)};
            pg8::gemm_phase<pg8::EpiInProj, pg8::StaticOrder, PG8_ALIGN, PG8_SP2, true>(F.lds, g, S, E);
            SEAM(pb + 1);
        }
        if (IN(pb + 2)) { conv_phase(F, l); __syncthreads(); attn_phase(F, l); SEAM(pb + 2); }
        if (IN(pb + 3)) {
            pg8::Gemm g{WSP(pg8::bf16_t, WS_AM), (const pg8::bf16_t*)(WSP(unsigned char, WS_WM) + (size_t)l * 2048 * 2048), T, D, D / 2, D / 2, D / 2}; pg8::StaticOrder S; S.init(T, D, F.G, (int)blockIdx.x);
            const float i440 = 1.0f / 440.0f;
            const float wc_ = __uint_as_float(__hip_atomic_load(F.ctl + CW_WMAX2 + 2 * l, __ATOMIC_RELAXED, __HIP_MEMORY_SCOPE_AGENT)), wa_ = __uint_as_float(__hip_atomic_load(F.ctl + CW_WMAX2 + 2 * l + 1, __ATOMIC_RELAXED, __HIP_MEMORY_SCOPE_AGENT));
            const float bc_ = __uint_as_float(__hip_atomic_load(F.ctl + CW_BC + l, __ATOMIC_RELAXED, __HIP_MEMORY_SCOPE_AGENT));
            const float swc = wc_ > 0.f ? wc_ * i440 : 1.0f, swa = wa_ > 0.f ? wa_ * i440 : 1.0f, sc = bc_ * i440;
            const float vm0 = __uint_as_float(__hip_atomic_load(F.ctl + CW_VMAX + 2 * l, __ATOMIC_RELAXED, __HIP_MEMORY_SCOPE_AGENT)), vm1 = __uint_as_float(__hip_atomic_load(F.ctl + CW_VMAX + 2 * l + 1, __ATOMIC_RELAXED, __HIP_MEMORY_SCOPE_AGENT));
            const float fe0 = (vm0 > 0.f ? 1.02f * vm0 * i440 : 1.0f) * swa, fe1 = (vm1 > 0.f ? 1.02f * vm1 * i440 : 1.0f) * swa;
            const float bc2 = __uint_as_float(__hip_atomic_load(F.ctl + CW_BC2 + l, __ATOMIC_RELAXED, __HIP_MEMORY_SCOPE_AGENT));
            const float bm0 = fmaxf(1024.0f * (bc2 * wc_ + 1.02f * vm0 * wa_), 1e-20f), bm1 = fmaxf(1024.0f * (bc2 * wc_ + 1.02f * vm1 * wa_), 1e-20f);
            pg8::EpiMerge E{WSP(pg8::bf16_t, WS_GC), WSP(pg8::bf16_t, WS_GA), WSP(unsigned char, WS_H), (sc * swc) / fe0, (sc * swc) / fe1, fe0 * (440.0f / bm0), fe1 * (440.0f / bm1)};
            pg8::gemm_phase<pg8::EpiMerge, pg8::StaticOrder, PG8_ALIGN, PG8_SP2, true>(F.lds, g, S, E);
            SEAM(pb + 3);
        }
        if (IN(pb + 5)) {
            pg8::Gemm g{Hb, (const pg8::bf16_t*)(WSP(unsigned char, WS_WO) + (size_t)l * 2048 * 2048), T, D, D / 2, D / 2, D / 2}; pg8::StaticOrder S; S.init(T, D, F.G, (int)blockIdx.x);
            const float i440 = 1.0f / 440.0f;
            const float wc_ = __uint_as_float(__hip_atomic_load(F.ctl + CW_WMAX2 + 2 * l, __ATOMIC_RELAXED, __HIP_MEMORY_SCOPE_AGENT)), wa_ = __uint_as_float(__hip_atomic_load(F.ctl + CW_WMAX2 + 2 * l + 1, __ATOMIC_RELAXED, __HIP_MEMORY_SCOPE_AGENT));
            const float wo_ = __uint_as_float(__hip_atomic_load(F.ctl + CW_WMAX3 + l, __ATOMIC_RELAXED, __HIP_MEMORY_SCOPE_AGENT)), swo = wo_ > 0.f ? wo_ * i440 : 1.0f;
            const float bc2 = __uint_as_float(__hip_atomic_load(F.ctl + CW_BC2 + l, __ATOMIC_RELAXED, __HIP_MEMORY_SCOPE_AGENT));
            const float vm0 = __uint_as_float(__hip_atomic_load(F.ctl + CW_VMAX + 2 * l, __ATOMIC_RELAXED, __HIP_MEMORY_SCOPE_AGENT)), vm1 = __uint_as_float(__hip_atomic_load(F.ctl + CW_VMAX + 2 * l + 1, __ATOMIC_RELAXED, __HIP_MEMORY_SCOPE_AGENT));
            const float bm0 = fmaxf(1024.0f * (bc2 * wc_ + 1.02f * vm0 * wa_), 1e-20f), bm1 = fmaxf(1024.0f * (bc2 * wc_ + 1.02f * vm1 * wa_), 1e-20f);
            if (l == 0) { pg8::EpiResid<false> E{F.A->in[I_X], WSP(pg8::bf16_t, WS_XA), modl + 2 * 2048, bm0 * i440 * swo, bm1 * i440 * swo};
                pg8::gemm_phase<pg8::EpiResid<false>, pg8::StaticOrder, PG8_ALIGN, PG8_SP2, true>(F.lds, g, S, E); }
            else { pg8::EpiResid<true> E{WSP(pg8::bf16_t, WS_XA), WSP(pg8::bf16_t, WS_XA), modl + 2 * 2048, bm0 * i440 * swo, bm1 * i440 * swo};
                pg8::gemm_phase<pg8::EpiResid<true>, pg8::StaticOrder, PG8_ALIGN, PG8_SP2, true>(F.lds, g, S, E); }
            SEAM(pb + 5);
        }
        if (IN(pb + 6)) { norm_phase<false, true>(F, WSP(bf16, WS_XA), WSP(bf16, WS_H), F.A->in[I_N2G] + (size_t)l * D, modl, 3, 4); SEAM(pb + 6); }
        if (IN(pb + 7)) {
            pg8::Gemm g{Hb, WSP(pg8::bf16_t, WS_WP) + (size_t)l * 2048 * 2048, T, D, D, D, D}; pg8::StaticOrder S; S.init(T, D, F.G, (int)blockIdx.x);
            pg8::EpiF16 E{WSP(_Float16, WS_GC), D};
            pg8::gemm_phase<pg8::EpiF16, pg8::StaticOrder, PG8_ALIGN, PG8_SP2>(F.lds, g, S, E);
            SEAM(pb + 7);
        }
        if (IN(pb + 8)) { topk_phase(F); SEAM(pb + 8); }
        if (IN(pb + 9)) { peer_act_phase(F, l); SEAM(pb + 9); }
        if (IN(pb + 10)) { peer_w_phase(F, l); SEAM(pb + 10); }
        if (IN(pb + 11)) { peer_out_phase(F, l); SEAM(pb + 11); }
        if (IN(pb + 12)) { peer_res_phase(F, l, WSP(bf16, WS_XA)); SEAM(pb + 12); }
    }
#undef IN
#undef SEAM
}

extern "C" void kernel_launch(void* const* d_in, const int* in_sizes, int n_in, void* d_out, int out_size, void* d_ws, size_t ws_size, hipStream_t stream) {
    static int grid = 0;
    if (grid == 0) {
        if (n_in != N_IN || out_size != T * D || ws_size < WS_END) { fprintf(stderr, "kernel_launch: unexpected problem: n_in %d out %d ws %zu (need %zu)\n", n_in, out_size, ws_size, (size_t)WS_END); grid = -1; return; }
        int dev = 0, cus = 0, per_cu = 0;
        if (hipGetDevice(&dev) != hipSuccess || hipDeviceGetAttribute(&cus, hipDeviceAttributeMultiprocessorCount, dev) != hipSuccess) { grid = -1; return; }
        if (hipFuncSetAttribute((const void*)fwd, hipFuncAttributeMaxDynamicSharedMemorySize, LDS_BYTES) != hipSuccess) { fprintf(stderr, "kernel_launch: hipFuncSetAttribute failed\n"); grid = -1; return; }
        if (hipOccupancyMaxActiveBlocksPerMultiprocessor(&per_cu, (const void*)fwd, NTHR, LDS_BYTES) != hipSuccess || per_cu < 1) fprintf(stderr, "kernel_launch: occupancy query reports %d\n", per_cu);
        (void)hipGetLastError();
        grid = cus;
    }
    if (grid < 0) return;
    (void)in_sizes;
    if (hipMemsetAsync((char*)d_ws + WS_CTL, 0, CTL_ZERO_BYTES, stream) != hipSuccess) return;
    Args a{};
    for (int i = 0; i < N_IN; ++i) a.in[i] = (const float*)d_in[i];
    a.out = (float*)d_out; a.ws = (unsigned char*)d_ws;
#if MK_ONE_LAUNCH
    a.ph_lo = 0; a.ph_hi = N_PHASES;
    hipLaunchKernelGGL(fwd, dim3(grid), dim3(NTHR), LDS_BYTES, stream, a);
#else
    for (int p = 0; p < N_PHASES; ++p) {
        if (p == 1 + PH_PER_LAYER) continue;
        a.ph_lo = p; a.ph_hi = p + 1;
        hipLaunchKernelGGL(fwd, dim3(grid), dim3(NTHR), LDS_BYTES, stream, a);
    }
#endif
}
```

```cpp
#include <hip/hip_runtime.h>
#include <cstdio>
#include <cstdint>
namespace pg8 {
#define PG8_LAS __attribute__((address_space(3)))
typedef unsigned short bf16_t;
typedef short bf16x8 __attribute__((ext_vector_type(8)));
typedef float f32x4 __attribute__((ext_vector_type(4)));
typedef unsigned u32x4 __attribute__((ext_vector_type(4)));
typedef int i32x4 __attribute__((ext_vector_type(4)));
typedef int i32x8 __attribute__((ext_vector_type(8)));
__device__ __forceinline__ i32x8 cat8(const bf16x8& a, const bf16x8& b) { const i32x4 x = __builtin_bit_cast(i32x4, a), y = __builtin_bit_cast(i32x4, b); return (i32x8){x[0], x[1], x[2], x[3], y[0], y[1], y[2], y[3]}; }
constexpr int BM = 256, BK = 64, HALF = 128, HTB = HALF * BK * 2  , STAGE_BYTES = 8 * HTB, NXCD = 8, WGM = 4;

__host__ __device__ __forceinline__ int lds_byte(int r, int c) { const int st = (r >> 4) * 2 + (c >> 5), rr = r & 15, cc = c & 31, ob = rr * 64 + cc * 2; return st * 1024 + (ob ^ (((ob >> 9) & 1) << 5)); }
__host__ __device__ __forceinline__ void stage_rc(int b, int& R, int& C) { const int st = b / 1024, sb = b % 1024, swz = sb ^ (((sb >> 9) & 1) << 5); R = (st >> 1) * 16 + swz / 64; C = (st & 1) * 32 + (swz % 64) / 2; }
__host__ __device__ __forceinline__ int perm32(int rho) { const int n = rho >> 4, i = rho & 15; return 8 * (i >> 2) + 4 * n + (i & 3); }

struct Unit { int pm, pn; };
struct Gemm { const bf16_t* A; const bf16_t* Bt; int M, N, K, lda, ldb; };

struct StaticOrder {
    int nM, nN, nwg, G, c, wgm;
    __host__ __device__ void init(int M, int N, int G_, int c_, int wgm_ = WGM) { nM = M / BM; nN = N / BM; nwg = nM * nN; G = G_; c = c_; wgm = wgm_; }
    __host__ __device__ bool next(int i, Unit& u) const {
        const long L = (long)i * G + c; if (L >= nwg) return false;
        int wgid = (int)L; { const int q = nwg / NXCD, r = nwg % NXCD, xcd = wgid % NXCD, off = wgid / NXCD; wgid = (xcd < r ? xcd * (q + 1) : r * (q + 1) + (xcd - r) * q) + off; }
        const int nig = wgm * nN, gid = wgid / nig, fm = gid * wgm, gsz = (nM - fm) < wgm ? (nM - fm) : wgm;
        u.pm = fm + ((wgid % nig) % gsz); u.pn = (wgid % nig) / gsz; return true;
    }
    __device__ __forceinline__ void a_ready(const Unit&) const {}
    __device__ __forceinline__ void done(const Unit&) const {}
};

__device__ __forceinline__ unsigned cvt_pk_bf16(float lo, float hi) { unsigned r; asm volatile("v_cvt_pk_bf16_f32 %0, %1, %2" : "=v"(r) : "v"(lo), "v"(hi)); return r; }
typedef float f32x2 __attribute__((ext_vector_type(2)));
template <class Epi, class Sched, bool ALIGN_EPI = false, bool SP2 = false, bool FP8 = false>
__device__ __forceinline__ void gemm_phase(PG8_LAS unsigned char* lds, const Gemm g, const Sched& S, const Epi& E) {
    int tid_ = threadIdx.x; asm volatile("" : "+v"(tid_));
    const int tid = tid_, wid = __builtin_amdgcn_readfirstlane(tid >> 6), lane = tid & 63, wr = wid >> 2, wc = wid & 3, fr = lane & 15, fq = lane >> 4;
    const int K = g.K, nt = K / BK;
    unsigned voffA[2], voffB[2];
#pragma unroll
    for (int i = 0; i < 2; ++i) { int R, C; stage_rc(tid * 16 + i * 8192, R, C); const int Rb = Epi::PERM ? ((R & ~31) + perm32(R & 31)) : R;
        voffA[i] = (unsigned)(R * g.lda + C) * 2u; voffB[i] = (unsigned)(Rb * g.ldb + C) * 2u; }
    const size_t kstep = (size_t)(BK * 2);
    const size_t hstepA = (size_t)HALF * g.lda * 2, hstepB = (size_t)HALF * g.ldb * 2;
    const size_t tstepA = 2 * hstepA, tstepB = 2 * hstepB;
    const unsigned ldsw = (unsigned)wid * 1024u;
    const int aoff = lds_byte(wr * 64 + fr, fq * 8), boff = lds_byte(wc * 32 + fr, fq * 8);
#define PG8_SA(b, h) (((b) * 2 + (h)) * HTB)
#define PG8_SB(b, h) ((4 + (b) * 2 + (h)) * HTB)
#define PG8_STAGE(bufoff, gbase, voff) do { _Pragma("unroll") for (int _i = 0; _i < 2; ++_i) \
        __builtin_amdgcn_global_load_lds((const unsigned*)((const char*)(gbase) + (voff)[_i]), (PG8_LAS unsigned*)(lds + (bufoff) + ldsw + _i * 8192), 16, 0, 0); } while (0)
#define PG8_LDA(dst, b, h) do { _Pragma("unroll") for (int m = 0; m < 4; ++m) _Pragma("unroll") for (int k = 0; k < 2; ++k) dst[m][k] = *(const PG8_LAS bf16x8*)(lds + PG8_SA(b, h) + aoff + m * 2048 + k * 1024); } while (0)
#define PG8_LDB(dst, b, h) do { _Pragma("unroll") for (int n = 0; n < 2; ++n) _Pragma("unroll") for (int k = 0; k < 2; ++k) dst[n][k] = *(const PG8_LAS bf16x8*)(lds + PG8_SB(b, h) + boff + n * 2048 + k * 1024); } while (0)
#define PG8_MMA(ai, bj, At, Bt) do { __builtin_amdgcn_s_setprio(1); _Pragma("unroll") for (int m = 0; m < 4; ++m) _Pragma("unroll") for (int n = 0; n < 2; ++n) { \
        if constexpr (FP8) { asm volatile("v_mfma_f32_16x16x128_f8f6f4 %0, %1, %2, %0" : "+v"(acc[ai][bj][m][n]) : "v"(cat8(Bt[n][0], Bt[n][1])), "v"(cat8(At[m][0], At[m][1]))); } \
        else { _Pragma("unroll") for (int k = 0; k < 2; ++k) acc[ai][bj][m][n] = __builtin_amdgcn_mfma_f32_16x16x32_bf16(Bt[n][k], At[m][k], acc[ai][bj][m][n], 0, 0, 0); } } __builtin_amdgcn_s_setprio(0); } while (0)
#define PG8_WAIT_V(n) asm volatile("s_waitcnt vmcnt(" #n ")" ::: "memory")
#define PG8_WAIT_L(n) asm volatile("s_waitcnt lgkmcnt(" #n ")" ::: "memory")
#define PG8_BAR __builtin_amdgcn_s_barrier()
#define PG8_SCHED __builtin_amdgcn_sched_barrier(0)
    Unit cur, nxt; int ui = 0;
    if (!S.next(0, cur)) return;
    f32x4 acc[2][2][4][2];
#pragma unroll
    for (int a = 0; a < 2; ++a)
#pragma unroll
        for (int b = 0; b < 2; ++b)
#pragma unroll
            for (int m = 0; m < 4; ++m)
#pragma unroll
                for (int n = 0; n < 2; ++n) acc[a][b][m][n] = (f32x4){0.f, 0.f, 0.f, 0.f};
    bf16x8 At[4][2], B0[2][2], B1[2][2];
    const char* cA = (const char*)g.A + (size_t)cur.pm * tstepA; const char* cB = (const char*)g.Bt + (size_t)cur.pn * tstepB;
    S.a_ready(cur);
    if constexpr (SP2) {
        PG8_STAGE(PG8_SB(0, 0), cB, voffB); PG8_STAGE(PG8_SB(0, 1), cB + hstepB, voffB); PG8_STAGE(PG8_SA(0, 0), cA, voffA); PG8_STAGE(PG8_SA(0, 1), cA + hstepA, voffA);
        if (wr == 1) PG8_BAR;
        PG8_WAIT_V(2); PG8_BAR;
        PG8_STAGE(PG8_SB(1, 0), cB + kstep, voffB); PG8_STAGE(PG8_SA(1, 0), cA + kstep, voffA); PG8_STAGE(PG8_SB(1, 1), cB + hstepB + kstep, voffB);
        PG8_WAIT_V(6); PG8_BAR;
    } else {
        PG8_STAGE(PG8_SB(0, 0), cB, voffB); PG8_STAGE(PG8_SA(0, 0), cA, voffA); PG8_STAGE(PG8_SB(0, 1), cB + hstepB, voffB); PG8_STAGE(PG8_SA(0, 1), cA + hstepA, voffA);
        if (wr == 1) PG8_BAR;
        PG8_WAIT_V(4); PG8_BAR;
        PG8_STAGE(PG8_SB(1, 0), cB + kstep, voffB); PG8_STAGE(PG8_SA(1, 0), cA + kstep, voffA); PG8_STAGE(PG8_SB(1, 1), cB + hstepB + kstep, voffB);
        PG8_WAIT_V(6); PG8_BAR;
    }
    for (;;) {
        const bool has_next = S.next(ui + 1, nxt);
        const char* nA = has_next ? (const char*)g.A + (size_t)nxt.pm * tstepA : cA; const char* nB = has_next ? (const char*)g.Bt + (size_t)nxt.pn * tstepB : cB;
        for (int t = 0; t < nt; t += 2) {
            if constexpr (Epi::HAS_MID) { if (t == (nt >> 1)) { if constexpr (FP8) { asm volatile("s_nop 15\n\ts_nop 15" ::: "memory"); }
                E.mid(acc, cur, wr, wc, fr, fq); } }
            const bool last = (t == nt - 2);
            const char* a1 = cA + (size_t)(t + 1) * kstep;
            const char* a2 = last ? nA : cA + (size_t)(t + 2) * kstep; const char* b2 = last ? nB : cB + (size_t)(t + 2) * kstep;
            const char* a3 = a2 + kstep; const char* b3 = b2 + kstep;
            if (last && has_next) S.a_ready(nxt);
            if constexpr (SP2) {
            PG8_LDB(B0, 0, 0); PG8_LDB(B1, 0, 1); PG8_SCHED; PG8_LDA(At, 0, 0); PG8_STAGE(PG8_SA(1, 1), a1 + hstepA, voffA);
            PG8_WAIT_V(8); PG8_WAIT_L(0); PG8_BAR; PG8_MMA(0, 0, At, B0); PG8_MMA(0, 1, At, B1); PG8_BAR; PG8_SCHED;
            PG8_LDA(At, 0, 1); PG8_STAGE(PG8_SB(0, 0), b2, voffB); PG8_STAGE(PG8_SB(0, 1), b2 + hstepB, voffB); PG8_STAGE(PG8_SA(0, 0), a2, voffA);
            PG8_WAIT_V(8); PG8_WAIT_L(0); PG8_BAR; PG8_MMA(1, 0, At, B0); PG8_MMA(1, 1, At, B1); PG8_BAR; PG8_SCHED;
            PG8_LDB(B0, 1, 0); PG8_LDB(B1, 1, 1); PG8_SCHED; PG8_LDA(At, 1, 0); PG8_STAGE(PG8_SA(0, 1), a2 + hstepA, voffA);
            PG8_WAIT_V(8); PG8_WAIT_L(0); PG8_BAR; PG8_MMA(0, 0, At, B0); PG8_MMA(0, 1, At, B1); PG8_BAR; PG8_SCHED;
            PG8_LDA(At, 1, 1); PG8_STAGE(PG8_SB(1, 0), b3, voffB); PG8_STAGE(PG8_SB(1, 1), b3 + hstepB, voffB); PG8_STAGE(PG8_SA(1, 0), a3, voffA);
            PG8_WAIT_V(8); PG8_WAIT_L(0); PG8_BAR; PG8_MMA(1, 0, At, B0); PG8_MMA(1, 1, At, B1); PG8_BAR; PG8_SCHED;
            } else {
            PG8_LDB(B0, 0, 0); PG8_SCHED; PG8_LDA(At, 0, 0); PG8_STAGE(PG8_SA(1, 1), a1 + hstepA, voffA);
            PG8_WAIT_L(8); PG8_BAR; PG8_WAIT_L(0); PG8_MMA(0, 0, At, B0); PG8_BAR; PG8_SCHED;
            PG8_LDB(B1, 0, 1); PG8_STAGE(PG8_SB(0, 0), b2, voffB);
            PG8_BAR; PG8_WAIT_L(0); PG8_MMA(0, 1, At, B1); PG8_BAR;
            PG8_LDA(At, 0, 1); PG8_STAGE(PG8_SA(0, 0), a2, voffA);
            PG8_BAR; PG8_WAIT_L(0); PG8_MMA(1, 0, At, B0); PG8_BAR; PG8_SCHED;
            PG8_STAGE(PG8_SB(0, 1), b2 + hstepB, voffB);
            PG8_WAIT_V(6); PG8_BAR; PG8_MMA(1, 1, At, B1); PG8_BAR;
            PG8_LDB(B0, 1, 0); PG8_SCHED; PG8_LDA(At, 1, 0); PG8_STAGE(PG8_SA(0, 1), a2 + hstepA, voffA);
            PG8_WAIT_L(8); PG8_BAR; PG8_WAIT_L(0); PG8_MMA(0, 0, At, B0); PG8_BAR; PG8_SCHED;
            PG8_LDB(B1, 1, 1); PG8_STAGE(PG8_SB(1, 0), b3, voffB);
            PG8_BAR; PG8_WAIT_L(0); PG8_MMA(0, 1, At, B1); PG8_BAR;
            PG8_LDA(At, 1, 1); PG8_STAGE(PG8_SA(1, 0), a3, voffA);
            PG8_BAR; PG8_WAIT_L(0); PG8_MMA(1, 0, At, B0); PG8_BAR; PG8_SCHED;
            PG8_STAGE(PG8_SB(1, 1), b3 + hstepB, voffB);
            PG8_WAIT_V(6); PG8_BAR; PG8_MMA(1, 1, At, B1); PG8_BAR;
            }
        }
        if constexpr (FP8) { asm volatile("s_nop 15\n\ts_nop 15" ::: "memory"); }
        if constexpr (ALIGN_EPI) { if (wr == 0) PG8_BAR; }
        if constexpr (!Epi::AFTER_DRAIN) { E(acc, cur, wr, wc, fr, fq); S.done(cur); }
        if (!has_next) break;
#pragma unroll
        for (int a = 0; a < 2; ++a)
#pragma unroll
            for (int b = 0; b < 2; ++b)
#pragma unroll
                for (int m = 0; m < 4; ++m)
#pragma unroll
                    for (int n = 0; n < 2; ++n) acc[a][b][m][n] = (f32x4){0.f, 0.f, 0.f, 0.f};
        cur = nxt; cA = nA; cB = nB; ++ui;
        if constexpr (ALIGN_EPI) { if (wr == 1) PG8_BAR; }
    }
    PG8_WAIT_V(0);
    if constexpr (!ALIGN_EPI) { if (wr == 0) PG8_BAR; }
    PG8_BAR;
    if constexpr (Epi::AFTER_DRAIN) { E.fused(acc, cur, wr, wc, fr, fq, lds, wid, lane); S.done(cur); }
#undef PG8_SA
#undef PG8_SB
#undef PG8_STAGE
#undef PG8_LDA
#undef PG8_LDB
#undef PG8_MMA
#undef PG8_WAIT_V
#undef PG8_WAIT_L
#undef PG8_BAR
#undef PG8_SCHED
}
}

constexpr int T = 16384, D = 2048, SEQ = 8192, CONV = 1024, CWID = 31, NHEAD = 16, NKVH = 4, HD = 64, ATT = 1024, KVD = 256, IN_DIM = 7680, NEXP = 16384, PHEADS = 8, TOPK = 16;
constexpr float EPS = 1e-6f;
constexpr int NSL = 16, SLW = 128;
constexpr int NWAVES = 8, NTHR = NWAVES * 64;
enum { I_X = 0, I_C, I_RELB, I_ADAW, I_ADAB, I_N1G, I_WIN, I_DWW, I_DWB, I_CLNG, I_CLNB, I_WCO, I_SINK, I_WAO, I_WOUT, I_N2G, I_WPQ, I_SK, I_PU, I_PV, I_FG, N_IN };

constexpr size_t MiB = 1u << 20;
constexpr size_t WS_CTL = 0, CTL_ZERO_BYTES = 1 * MiB;
constexpr size_t WS_MOD = 1 * MiB;
constexpr size_t WS_BIAS = 1 * MiB + 512 * 1024;
constexpr size_t WS_SCL = 1 * MiB + 640 * 1024;
constexpr size_t WS_WIN = 2 * MiB;
constexpr size_t WS_SA = 1 * MiB + 896 * 1024;
constexpr size_t WS_WM = 62 * MiB;
constexpr size_t WS_WO = 78 * MiB;
constexpr size_t WS_WP = 94 * MiB;
constexpr size_t WS_PU = 110 * MiB;
constexpr size_t WS_PV = 238 * MiB;
constexpr size_t WS_H = 366 * MiB;
constexpr size_t WS_U = 430 * MiB;
constexpr size_t WS_Q = 462 * MiB;
constexpr size_t WS_K = 494 * MiB;
constexpr size_t WS_V = 502 * MiB;
constexpr size_t WS_GC = 510 * MiB;
constexpr size_t WS_GA = 574 * MiB;
constexpr size_t WS_AM = 638 * MiB;
constexpr size_t WS_Y1 = 702 * MiB;
constexpr size_t WS_XA = 766 * MiB;
constexpr size_t WS_END = 894 * MiB;
constexpr int CW_TMO = 0, CW_QUEUE = 64, CW_QUEUE2 = 128, CW_WMAX = 192, CW_WMAX2 = 194, CW_WMAX3 = 198, CW_VMAX = 200, CW_BC = 204, CW_BC2 = 206, CW_BAR = 4096;

constexpr int RING_BYTES = 131072, LDSCTL_OFF = RING_BYTES, MISC_OFF = LDSCTL_OFF + 320, LDS_BYTES = 147456;

#define GAS __attribute__((address_space(1)))
#define LAS __attribute__((address_space(3)))
typedef unsigned short bf16;
typedef unsigned v4u __attribute__((ext_vector_type(4)));
typedef unsigned v2u __attribute__((ext_vector_type(2)));
typedef float f32x4 __attribute__((ext_vector_type(4)));
typedef float f32x2 __attribute__((ext_vector_type(2)));
typedef float f32x16 __attribute__((ext_vector_type(16)));
typedef short bf16x8 __attribute__((ext_vector_type(8)));
typedef __bf16 bf16x2v __attribute__((ext_vector_type(2)));
typedef GAS unsigned gu32;
#define LDS_WAIT() asm volatile("s_waitcnt lgkmcnt(0)" ::: "memory")
#define VM_WAIT() asm volatile("s_waitcnt vmcnt(0)" ::: "memory")
__device__ __forceinline__ unsigned f2bf(float f) { unsigned u = __builtin_bit_cast(unsigned, f); return (u + 0x7fffu + ((u >> 16) & 1u)) >> 16; }
__device__ __forceinline__ unsigned pk2(float lo, float hi) { f32x2 v = {lo, hi}; bf16x2v b = __builtin_convertvector(v, bf16x2v); return __builtin_bit_cast(unsigned, b); }
__device__ __forceinline__ float bflo(unsigned p) { return __uint_as_float(p << 16); }
__device__ __forceinline__ float bfhi(unsigned p) { return __uint_as_float(p & 0xffff0000u); }
__device__ __forceinline__ float sigmoidf_(float x) { return __builtin_amdgcn_rcpf(1.0f + __expf(-x)); }
__device__ __forceinline__ float dot2bf(unsigned a, unsigned b, float c) { return __builtin_amdgcn_fdot2_f32_bf16(__builtin_bit_cast(bf16x2v, a), __builtin_bit_cast(bf16x2v, b), c, false); }
__device__ __forceinline__ float wave_sum(float v) {
#pragma unroll
    for (int o = 1; o < 64; o <<= 1) v += __shfl_xor(v, o);
    return v;
}

template <int CTRL> __device__ __forceinline__ float dpp_mov(float v) { return __builtin_bit_cast(float, __builtin_amdgcn_update_dpp(0, __builtin_bit_cast(int, v), CTRL, 0xf, 0xf, true)); }
__device__ __forceinline__ float lane_xor1(float v) { return dpp_mov<0xB1>(v); }
__device__ __forceinline__ float lane_xor2(float v) { return dpp_mov<0x4E>(v); }
__device__ __forceinline__ float lane_xor4(float v) { return dpp_mov<0x141>(dpp_mov<0x1B>(v)); }
__device__ __forceinline__ float lane_xor8(float v) { return dpp_mov<0x128>(v); }
__device__ __forceinline__ float lane_xor16(float v) { return __builtin_bit_cast(float, __builtin_amdgcn_ds_swizzle(__builtin_bit_cast(int, v), 0x401F)); }

namespace pg8 {
__device__ __forceinline__ float sigm(float x) { return __builtin_amdgcn_rcpf(1.0f + __expf(-x)); }
__device__ __forceinline__ u32x4 pack8(const f32x4& v0, const f32x4& v1) { u32x4 w; w.x = cvt_pk_bf16(v0[0], v0[1]); w.y = cvt_pk_bf16(v0[2], v0[3]); w.z = cvt_pk_bf16(v1[0], v1[1]); w.w = cvt_pk_bf16(v1[2], v1[3]); return w; }
__device__ __forceinline__ float blo(unsigned p) { return __uint_as_float(p << 16); }
__device__ __forceinline__ float bhi(unsigned p) { return __uint_as_float(p & 0xffff0000u); }
struct EpiInProj {
    static constexpr bool PERM = true, AFTER_DRAIN = false, HAS_MID = false;
    bf16_t *U, *Q, *K, *V, *GC, *GA; const float* sa; float sw; unsigned* vmax;
    __device__ __forceinline__ void operator()(const f32x4 (&acc)[2][2][4][2], const Unit& u, int wr, int wc, int fr, int fq) const {
        const int row0 = u.pm * BM + wr * 64 + fr, cw = wc * 32 + 8 * fq, pn = u.pn;
        float rsv[2][4];
        { const float* sp = sa + row0;
          asm volatile("global_load_dword %0, %8, off\n\tglobal_load_dword %1, %8, off offset:64\n\tglobal_load_dword %2, %8, off offset:128\n\tglobal_load_dword %3, %8, off offset:192\n\t"
                       "global_load_dword %4, %8, off offset:512\n\tglobal_load_dword %5, %8, off offset:576\n\tglobal_load_dword %6, %8, off offset:640\n\tglobal_load_dword %7, %8, off offset:704\n\ts_waitcnt vmcnt(0)"
                       : "=&v"(rsv[0][0]), "=&v"(rsv[0][1]), "=&v"(rsv[0][2]), "=&v"(rsv[0][3]), "=&v"(rsv[1][0]), "=&v"(rsv[1][1]), "=&v"(rsv[1][2]), "=&v"(rsv[1][3]) : "v"(sp) : "memory"); }
        if (pn < 8) {
#pragma unroll
            for (int ai = 0; ai < 2; ++ai)
#pragma unroll
                for (int m = 0; m < 4; ++m) { bf16_t* p = U + (size_t)(row0 + ai * HALF + m * 16) * 1024 + pn * 128 + cw; const float rs = rsv[ai][m] * sw;
                    f32x4 a0 = acc[ai][0][m][0] * rs, a1 = acc[ai][0][m][1] * rs; const f32x4 b0 = acc[ai][1][m][0] * rs, b1 = acc[ai][1][m][1] * rs;
#pragma unroll
                    for (int i = 0; i < 4; ++i) { a0[i] *= sigm(b0[i]); a1[i] *= sigm(b1[i]); }
                    *(u32x4*)p = pack8(a0, a1); }
        } else {
            bf16_t* base; int ld, cb, mode;
            if (pn < 12) { base = Q; ld = 1024; cb = (pn - 8) * 256; mode = 0; }
            else if (pn == 12) { base = K; ld = 256; cb = 0; mode = 1; }
            else if (pn == 13) { base = V; ld = 256; cb = 0; mode = 1; }
            else if (pn < 22) { base = GC; ld = 2048; cb = (pn - 14) * 256; mode = 2; }
            else { base = GA; ld = 2048; cb = (pn - 22) * 256; mode = 2; }
            float vm = 0.f;
#pragma unroll
            for (int ai = 0; ai < 2; ++ai)
#pragma unroll
                for (int m = 0; m < 4; ++m) { bf16_t* p = base + (size_t)(row0 + ai * HALF + m * 16) * ld + cb + cw; const float rs = rsv[ai][m] * sw;
#pragma unroll
                    for (int bj = 0; bj < 2; ++bj) { f32x4 v0 = acc[ai][bj][m][0] * rs, v1 = acc[ai][bj][m][1] * rs;
                        if (pn == 13) vm = fmaxf(vm, fmaxf(fmaxf(fmaxf(fabsf(v0[0]), fabsf(v0[1])), fmaxf(fabsf(v0[2]), fabsf(v0[3]))), fmaxf(fmaxf(fabsf(v1[0]), fabsf(v1[1])), fmaxf(fabsf(v1[2]), fabsf(v1[3])))));
                        if (mode == 0) { v0 = v0 * 0.125f; v1 = v1 * 0.125f; }
                        else if (mode == 2) {
#pragma unroll
                            for (int i = 0; i < 4; ++i) { v0[i] = sigm(v0[i]); v1[i] = sigm(v1[i]); } }
                        *(u32x4*)(p + bj * HALF) = pack8(v0, v1); } }
            if (pn == 13) {
#pragma unroll
                for (int o = 1; o < 64; o <<= 1) vm = fmaxf(vm, __shfl_xor(vm, o));
                if ((threadIdx.x & 63) == 0) __hip_atomic_fetch_max(vmax + (u.pm >> 5), __float_as_uint(vm), __ATOMIC_RELAXED, __HIP_MEMORY_SCOPE_AGENT); }
        }
    }
};
struct EpiMerge {
    static constexpr bool PERM = true, AFTER_DRAIN = false, HAS_MID = true;
    const bf16_t* GC; const bf16_t* GA; unsigned char* O; float fmid0, fmid1, fend0, fend1;
    __device__ __forceinline__ void mid(f32x4 (&acc)[2][2][4][2], const Unit& u, int wr, int wc, int fr, int fq) const {
        int row0 = u.pm * BM + wr * 64 + fr, c0 = u.pn * BM + wc * 32 + 8 * fq; const float fmd = (u.pm >> 5) ? fmid1 : fmid0;
        asm volatile("" : "+v"(row0), "+v"(c0));
#pragma unroll
        for (int ai = 0; ai < 2; ++ai)
#pragma unroll
            for (int mh = 0; mh < 2; ++mh) { u32x4 gc[2][2], ga[2][2];
#pragma unroll
                for (int mm = 0; mm < 2; ++mm)
#pragma unroll
                    for (int bj = 0; bj < 2; ++bj) { const size_t off = (size_t)(row0 + ai * HALF + (2 * mh + mm) * 16) * 2048 + c0 + bj * HALF; gc[mm][bj] = *(const u32x4*)(GC + off); ga[mm][bj] = *(const u32x4*)(GA + off); }
                __builtin_amdgcn_sched_barrier(0);
#pragma unroll
                for (int mm = 0; mm < 2; ++mm)
#pragma unroll
                    for (int bj = 0; bj < 2; ++bj) { const int m = 2 * mh + mm; const u32x4 c = gc[mm][bj], a = ga[mm][bj];
#define RT_(cw_, aw_, HI_) ((HI_ ? bhi(cw_) : blo(cw_)) * fmd * __builtin_amdgcn_rcpf(fmaxf(HI_ ? bhi(aw_) : blo(aw_), 1e-30f)))
                        acc[ai][bj][m][0][0] *= RT_(c.x, a.x, 0); acc[ai][bj][m][0][1] *= RT_(c.x, a.x, 1); acc[ai][bj][m][0][2] *= RT_(c.y, a.y, 0); acc[ai][bj][m][0][3] *= RT_(c.y, a.y, 1);
                        acc[ai][bj][m][1][0] *= RT_(c.z, a.z, 0); acc[ai][bj][m][1][1] *= RT_(c.z, a.z, 1); acc[ai][bj][m][1][2] *= RT_(c.w, a.w, 0); acc[ai][bj][m][1][3] *= RT_(c.w, a.w, 1);
#undef RT_
                    }
                __builtin_amdgcn_sched_barrier(0); }
    }
    __device__ __forceinline__ void operator()(const f32x4 (&acc)[2][2][4][2], const Unit& u, int wr, int wc, int fr, int fq) const {
        const int row0 = u.pm * BM + wr * 64 + fr, c0 = u.pn * BM + wc * 32 + 8 * fq; const float fe = (u.pm >> 5) ? fend1 : fend0;
#pragma unroll
        for (int ai = 0; ai < 2; ++ai) { u32x4 g[4][2];
#pragma unroll
            for (int m = 0; m < 4; ++m)
#pragma unroll
                for (int bj = 0; bj < 2; ++bj) g[m][bj] = *(const u32x4*)(GA + (size_t)(row0 + ai * HALF + m * 16) * 2048 + c0 + bj * HALF);
            __builtin_amdgcn_sched_barrier(0);
#pragma unroll
            for (int m = 0; m < 4; ++m)
#pragma unroll
                for (int bj = 0; bj < 2; ++bj) { const size_t off = (size_t)(row0 + ai * HALF + m * 16) * 2048 + c0 + bj * HALF; const u32x4 gg = g[m][bj]; f32x4 v0 = acc[ai][bj][m][0], v1 = acc[ai][bj][m][1];
                    v0[0] *= fmaxf(blo(gg.x), 1e-30f) * fe; v0[1] *= fmaxf(bhi(gg.x), 1e-30f) * fe; v0[2] *= fmaxf(blo(gg.y), 1e-30f) * fe; v0[3] *= fmaxf(bhi(gg.y), 1e-30f) * fe;
                    v1[0] *= fmaxf(blo(gg.z), 1e-30f) * fe; v1[1] *= fmaxf(bhi(gg.z), 1e-30f) * fe; v1[2] *= fmaxf(blo(gg.w), 1e-30f) * fe; v1[3] *= fmaxf(bhi(gg.w), 1e-30f) * fe;
                    int lo = __builtin_amdgcn_cvt_pk_fp8_f32(v0[0], v0[1], 0, false); lo = __builtin_amdgcn_cvt_pk_fp8_f32(v0[2], v0[3], lo, true);
                    int hi = __builtin_amdgcn_cvt_pk_fp8_f32(v1[0], v1[1], 0, false); hi = __builtin_amdgcn_cvt_pk_fp8_f32(v1[2], v1[3], hi, true);
                    typedef unsigned u32x2s __attribute__((ext_vector_type(2))); *(u32x2s*)(O + off) = (u32x2s){(unsigned)lo, (unsigned)hi}; }
            __builtin_amdgcn_sched_barrier(0); }
    }
};
template <bool XB_BF16>
struct EpiResid {
    static constexpr bool PERM = true, AFTER_DRAIN = false, HAS_MID = false;
    const void* XB; bf16_t* XO; const float* gvec; float fo0, fo1;
    __device__ __forceinline__ void operator()(const f32x4 (&acc)[2][2][4][2], const Unit& u, int wr, int wc, int fr, int fq) const {
        const int row0 = u.pm * BM + wr * 64 + fr, c0 = u.pn * BM + wc * 32 + 8 * fq; const float* gp = gvec + (size_t)(u.pm >> 5) * 12288;
        const float fo = (u.pm >> 5) ? fo1 : fo0;
#pragma unroll
        for (int bj = 0; bj < 2; ++bj) { const int col = c0 + bj * HALF; const f32x4 g0 = *(const f32x4*)(gp + col) * fo, g1 = *(const f32x4*)(gp + col + 4) * fo;
#pragma unroll
            for (int ai = 0; ai < 2; ++ai) { f32x4 xa[4], xb[4]; u32x4 xq[4];
#pragma unroll
                for (int m = 0; m < 4; ++m) { const size_t off = (size_t)(row0 + ai * HALF + m * 16) * 2048 + col;
                    if constexpr (XB_BF16) xq[m] = *(const u32x4*)((const bf16_t*)XB + off); else { xa[m] = *(const f32x4*)((const float*)XB + off); xb[m] = *(const f32x4*)((const float*)XB + off + 4); } }
                __builtin_amdgcn_sched_barrier(0);
#pragma unroll
                for (int m = 0; m < 4; ++m) { const size_t off = (size_t)(row0 + ai * HALF + m * 16) * 2048 + col;
                    if constexpr (XB_BF16) { xa[m] = (f32x4){blo(xq[m].x), bhi(xq[m].x), blo(xq[m].y), bhi(xq[m].y)}; xb[m] = (f32x4){blo(xq[m].z), bhi(xq[m].z), blo(xq[m].w), bhi(xq[m].w)}; }
                    *(u32x4*)(XO + off) = pack8(xa[m] + g0 * acc[ai][bj][m][0], xb[m] + g1 * acc[ai][bj][m][1]); }
                __builtin_amdgcn_sched_barrier(0); } }
    }
};
typedef _Float16 f16x8 __attribute__((ext_vector_type(8)));
struct EpiF16 {
    static constexpr bool PERM = true, AFTER_DRAIN = false, HAS_MID = false;
    _Float16* O; int ldc;
    __device__ __forceinline__ void operator()(const f32x4 (&acc)[2][2][4][2], const Unit& u, int wr, int wc, int fr, int fq) const {
        const int row0 = u.pm * BM + wr * 64 + fr, c0 = u.pn * BM + wc * 32 + 8 * fq;
#pragma unroll
        for (int ai = 0; ai < 2; ++ai)
#pragma unroll
            for (int m = 0; m < 4; ++m)
#pragma unroll
                for (int bj = 0; bj < 2; ++bj) { const f32x4 v0 = acc[ai][bj][m][0], v1 = acc[ai][bj][m][1];
                    const f16x8 h = {(_Float16)v0[0], (_Float16)v0[1], (_Float16)v0[2], (_Float16)v0[3], (_Float16)v1[0], (_Float16)v1[1], (_Float16)v1[2], (_Float16)v1[3]};
                    *(f16x8*)(O + (size_t)(row0 + ai * HALF + m * 16) * ldc + c0 + bj * HALF) = h; }
    }
};
}

#define XB_TMO      128
#define XB_XCNT(j)  (256  + 64 * (j))
#define XB_XSUB(j)  (1280 + 64 * (j))
#define XB_XGEN(j)  (2304 + 64 * (j))
#define XB_TOP      3328
#define XB_TOPGEN   3392
#define XCD_BAR_WORDS 3456
#define XB_SPIN_CAP (1u << 18)

__device__ __forceinline__ unsigned xb_ld(unsigned* p)              { return __hip_atomic_load(p, __ATOMIC_RELAXED, __HIP_MEMORY_SCOPE_AGENT); }
__device__ __forceinline__ unsigned xb_add(unsigned* p, unsigned v) { return __hip_atomic_fetch_add(p, v, __ATOMIC_RELAXED, __HIP_MEMORY_SCOPE_AGENT); }
__device__ __forceinline__ unsigned xb_xcc_id() { return (unsigned)__builtin_amdgcn_s_getreg((3 << 11) | 20) & 0xFu; }
#define XB_SPIN(cond, bar) do { unsigned _sp = 0; while (cond) { __builtin_amdgcn_s_sleep(1); \
    if ((++_sp & 255u) == 0u) { if (xb_ld(&(bar)[XB_TMO])) break; if (_sp > XB_SPIN_CAP) { atomicAdd(&(bar)[XB_TMO], 1u); break; } } } } while (0)

struct XcdBarrier {
    unsigned* bar; unsigned x;
    volatile LAS unsigned* st;
};

__device__ __forceinline__ XcdBarrier xcd_barrier_post(unsigned* bar, volatile LAS unsigned* st) {
    XcdBarrier b; b.bar = bar; b.x = xb_xcc_id(); b.st = st;
    if (threadIdx.x == 0) (void)xb_add(&bar[XB_XCNT(b.x)], 1u);
    return b;
}
__device__ __forceinline__ void xcd_barrier_complete(unsigned* bar, unsigned x, unsigned& nloc, unsigned& nx) {
    const unsigned G = gridDim.x * gridDim.y * gridDim.z;
    unsigned sum, cnt, mine, sp = 0u;
    for (;;) {
        sum = 0u; cnt = 0u; mine = 0u;
#pragma unroll
        for (unsigned j = 0; j < 16; ++j) { const unsigned c = xb_ld(&bar[XB_XCNT(j)]); sum += c; cnt += (c > 0u) ? 1u : 0u; mine = (j == x) ? c : mine; }
        if (sum == G) break;
        __builtin_amdgcn_s_sleep(1);
        if ((++sp & 255u) == 0u) { if (xb_ld(&bar[XB_TMO])) break; if (sp > XB_SPIN_CAP) { atomicAdd(&bar[XB_TMO], 1u); break; } }
    }
    nloc = mine > 0u ? mine : 1u; nx = cnt > 0u ? cnt : 1u;
}

__device__ __forceinline__ void xcd_barrier(const XcdBarrier& b) {
    asm volatile("s_waitcnt vmcnt(0)" ::: "memory");
    __syncthreads();
    if (threadIdx.x == 0) {
        unsigned* bar = b.bar;
        __builtin_amdgcn_s_waitcnt(0);
        unsigned nloc = b.st[0], nx = b.st[1];
        if (nloc == 0u) { xcd_barrier_complete(bar, b.x, nloc, nx); b.st[0] = nloc; b.st[1] = nx; }
        const unsigned old = xb_add(&bar[XB_XSUB(b.x)], 1u);
        const unsigned gen = old / nloc;
        if (old + 1u == (gen + 1u) * nloc) {
            __builtin_amdgcn_fence(__ATOMIC_RELEASE, "agent");
            asm volatile("s_waitcnt vmcnt(0)" ::: "memory");
            const unsigned og = xb_add(&bar[XB_TOP], 1u);
            const unsigned tg = og / nx;
            if (og + 1u == (tg + 1u) * nx) xb_add(&bar[XB_TOPGEN], 1u);
            else XB_SPIN(xb_ld(&bar[XB_TOPGEN]) == tg, bar);
            __builtin_amdgcn_fence(__ATOMIC_ACQUIRE, "agent");
            xb_add(&bar[XB_XGEN(b.x)], 1u);
            asm volatile("s_waitcnt vmcnt(0)" ::: "memory");
        } else {
            XB_SPIN(xb_ld(&bar[XB_XGEN(b.x)]) == gen, bar);
            __builtin_amdgcn_fence(__ATOMIC_ACQUIRE, "agent");
            asm volatile("s_waitcnt vmcnt(0)" ::: "memory");
        }
    }
    __syncthreads();
}

struct Args { const float* in[N_IN]; float* out; unsigned char* ws; int ph_lo, ph_hi; };
struct Frame {
    LAS unsigned char* lds; volatile LAS unsigned* MISC; gu32* ctl;
    int tid, lane, wave, vcu, G;
    const Args* A; float* out; unsigned char* ws;
};
#define WSP(T_, off) ((T_*)(F.ws + (off)))
#define PHASE_TID(F) do { int t_ = threadIdx.x; asm volatile("" : "+v"(t_)); (F).tid = t_; (F).lane = t_ & 63; (F).wave = __builtin_amdgcn_readfirstlane(t_ >> 6); } while (0)

__device__ __forceinline__ int glu_row(int n) { return n < 2048 ? (((n & 1023) >> 7) * 256 + (n >> 10) * 128 + (n & 127)) : n; }
template <int MODE>
__device__ __forceinline__ void tr_item(const float* W, int N, bf16* WT, int dstride, int koff, LAS float* scr, int kb, int nb, int lane) {
    const int k0 = 64 * kb, n0 = 32 * nb;
    f32x4 v[8];
#pragma unroll
    for (int i = 0; i < 8; ++i) v[i] = *(const f32x4*)(W + (size_t)(k0 + (lane >> 3) + 8 * i) * N + n0 + (lane & 7) * 4);
#pragma unroll
    for (int i = 0; i < 8; ++i) { LAS float* d = scr + ((lane >> 3) + 8 * i) * 33 + (lane & 7) * 4; d[0] = v[i].x; d[1] = v[i].y; d[2] = v[i].z; d[3] = v[i].w; }
    LDS_WAIT(); asm volatile("" ::: "memory");
    const int c = lane & 7;
#pragma unroll
    for (int j = 0; j < 4; ++j) { const int n = (lane >> 3) + 8 * j; const LAS float* s = scr + (8 * c) * 33 + n;
        v4u o; o.x = pk2(s[0 * 33], s[1 * 33]); o.y = pk2(s[2 * 33], s[3 * 33]); o.z = pk2(s[4 * 33], s[5 * 33]); o.w = pk2(s[6 * 33], s[7 * 33]);
        const int nn = n0 + n, row = MODE == 1 ? glu_row(nn) : nn;
        *(v4u*)(WT + (size_t)row * dstride + koff + k0 + 8 * c) = o; }
    LDS_WAIT(); asm volatile("" ::: "memory");
}
__device__ __forceinline__ void wmax_item(Frame& F, int it) {
    const int l = it >> 5, kc = it & 31; const float* W = F.A->in[I_WIN] + ((size_t)l * 2048 + kc * 64) * IN_DIM; float mx = 0.f;
#pragma unroll 4
    for (int k = 0; k < 64; ++k)
#pragma unroll
        for (int j = 0; j < 4; ++j) { const int c4r = F.tid + NTHR * j, c4 = c4r < IN_DIM / 4 ? c4r : IN_DIM / 4 - 1;
            const f32x4 v = *(const f32x4*)(W + (size_t)k * IN_DIM + 4 * c4); mx = fmaxf(mx, fmaxf(fmaxf(fabsf(v.x), fabsf(v.y)), fmaxf(fabsf(v.z), fabsf(v.w)))); }
#pragma unroll
    for (int o = 1; o < 64; o <<= 1) mx = fmaxf(mx, __shfl_xor(mx, o));
    if (F.lane == 0) __hip_atomic_fetch_max(F.ctl + CW_WMAX + l, __float_as_uint(mx), __ATOMIC_RELAXED, __HIP_MEMORY_SCOPE_AGENT);
}
__device__ __forceinline__ void wmax2_item(Frame& F, int it) {
    const int lh = it >> 3, kc = it & 7, l = lh >> 1, h = lh & 1; const float* W = F.A->in[h ? I_WAO : I_WCO] + ((size_t)l * 1024 + kc * 128) * 2048 + 4 * F.tid; float mx = 0.f;
#pragma unroll 8
    for (int k = 0; k < 128; ++k) { const f32x4 v = *(const f32x4*)(W + (size_t)k * 2048); mx = fmaxf(mx, fmaxf(fmaxf(fabsf(v.x), fabsf(v.y)), fmaxf(fabsf(v.z), fabsf(v.w)))); }
#pragma unroll
    for (int o = 1; o < 64; o <<= 1) mx = fmaxf(mx, __shfl_xor(mx, o));
    if (F.lane == 0) __hip_atomic_fetch_max(F.ctl + CW_WMAX2 + lh, __float_as_uint(mx), __ATOMIC_RELAXED, __HIP_MEMORY_SCOPE_AGENT);
}
__device__ __forceinline__ void wmax3_item(Frame& F, int it) {
    const int l = it >> 4, kc = it & 15; const float* W = F.A->in[I_WOUT] + ((size_t)l * 2048 + kc * 128) * 2048 + 4 * F.tid; float mx = 0.f;
#pragma unroll 8
    for (int k = 0; k < 128; ++k) { const f32x4 v = *(const f32x4*)(W + (size_t)k * 2048); mx = fmaxf(mx, fmaxf(fmaxf(fabsf(v.x), fabsf(v.y)), fmaxf(fabsf(v.z), fabsf(v.w)))); }
#pragma unroll
    for (int o = 1; o < 64; o <<= 1) mx = fmaxf(mx, __shfl_xor(mx, o));
    if (F.lane == 0) __hip_atomic_fetch_max(F.ctl + CW_WMAX3 + l, __float_as_uint(mx), __ATOMIC_RELAXED, __HIP_MEMORY_SCOPE_AGENT);
}
template <bool GLU>
__device__ __forceinline__ void tr8_item(const float* W, int N, unsigned char* WT, int koff, float inv, LAS float* scr, int kb, int nb, int lane) {
    const int k0 = 64 * kb, n0 = 32 * nb;
    f32x4 v[8];
#pragma unroll
    for (int i = 0; i < 8; ++i) v[i] = *(const f32x4*)(W + (size_t)(k0 + (lane >> 3) + 8 * i) * N + n0 + (lane & 7) * 4);
#pragma unroll
    for (int i = 0; i < 8; ++i) { LAS float* d = scr + ((lane >> 3) + 8 * i) * 33 + (lane & 7) * 4; d[0] = v[i].x * inv; d[1] = v[i].y * inv; d[2] = v[i].z * inv; d[3] = v[i].w * inv; }
    LDS_WAIT(); asm volatile("" ::: "memory");
    const int c = lane & 7;
#pragma unroll
    for (int j = 0; j < 4; ++j) { const int n = (lane >> 3) + 8 * j; const LAS float* s = scr + (8 * c) * 33 + n;
        int lo = __builtin_amdgcn_cvt_pk_fp8_f32(s[0 * 33], s[1 * 33], 0, false); lo = __builtin_amdgcn_cvt_pk_fp8_f32(s[2 * 33], s[3 * 33], lo, true);
        int hi = __builtin_amdgcn_cvt_pk_fp8_f32(s[4 * 33], s[5 * 33], 0, false); hi = __builtin_amdgcn_cvt_pk_fp8_f32(s[6 * 33], s[7 * 33], hi, true);
        v2u o; o.x = (unsigned)lo; o.y = (unsigned)hi;
        *(v2u*)(WT + (size_t)(GLU ? glu_row(n0 + n) : n0 + n) * 2048 + koff + k0 + 8 * c) = o; }
    LDS_WAIT(); asm volatile("" ::: "memory");
}
__device__ __forceinline__ void win8_phase(Frame& F) {
    PHASE_TID(F);
    LAS float* scr = (LAS float*)(F.lds + F.wave * 16384);
    if (F.tid == 0) F.MISC[0] = __hip_atomic_fetch_add(F.ctl + CW_QUEUE2, 1u, __ATOMIC_RELAXED, __HIP_MEMORY_SCOPE_AGENT);
    for (int par = 0;; par ^= 1) {
        __syncthreads();
        const int it = (int)F.MISC[par];
        if (F.tid == 0) F.MISC[par ^ 1] = __hip_atomic_fetch_add(F.ctl + CW_QUEUE2, 1u, __ATOMIC_RELAXED, __HIP_MEMORY_SCOPE_AGENT);
        if (it >= 2 * 960 + 4 * 128 + 2 * 256) break;
        if (it < 2 * 960) { const int l = it >= 960, r = it - l * 960, wi = r * 8 + F.wave;
            const float wmax = __uint_as_float(__hip_atomic_load(F.ctl + CW_WMAX + l, __ATOMIC_RELAXED, __HIP_MEMORY_SCOPE_AGENT)), inv = wmax > 0.f ? 440.0f / wmax : 1.0f;
            tr8_item<true>(F.A->in[I_WIN] + (size_t)l * 2048 * IN_DIM, IN_DIM, WSP(unsigned char, WS_WIN) + (size_t)l * IN_DIM * 2048, 0, inv, scr, wi / 240, wi % 240, F.lane); }
        else if (it >= 2 * 960 + 4 * 128) { const int r0 = it - 2 * 960 - 4 * 128, l = r0 >> 8, wi = (r0 & 255) * 8 + F.wave;
            const float wmax = __uint_as_float(__hip_atomic_load(F.ctl + CW_WMAX3 + l, __ATOMIC_RELAXED, __HIP_MEMORY_SCOPE_AGENT)), inv = wmax > 0.f ? 440.0f / wmax : 1.0f;
            tr8_item<false>(F.A->in[I_WOUT] + (size_t)l * 2048 * 2048, 2048, WSP(unsigned char, WS_WO) + (size_t)l * 2048 * 2048, 0, inv, scr, wi / 64, wi % 64, F.lane); }
        else { const int r0 = it - 2 * 960, lh = r0 >> 7, l = lh >> 1, h = lh & 1, wi = (r0 & 127) * 8 + F.wave;
            const float wmax = __uint_as_float(__hip_atomic_load(F.ctl + CW_WMAX2 + lh, __ATOMIC_RELAXED, __HIP_MEMORY_SCOPE_AGENT)), inv = wmax > 0.f ? 440.0f / wmax : 1.0f;
            tr8_item<false>(F.A->in[h ? I_WAO : I_WCO] + (size_t)l * 1024 * 2048, 2048, WSP(unsigned char, WS_WM) + (size_t)l * 2048 * 2048, h * 1024, inv, scr, wi / 64, wi % 64, F.lane); }
    }
}
__device__ __forceinline__ void ada_item(Frame& F, int a) {
    LAS float* csl = (LAS float*)F.lds;
    LAS f32x4* red = (LAS f32x4*)(F.lds + 16384);
    const float* c = F.A->in[I_C];
    { float cv[8];
#pragma unroll
      for (int i = 0; i < 8; ++i) cv[i] = c[i * NTHR + F.tid];
      __builtin_amdgcn_sched_barrier(0);
#pragma unroll
      for (int i = 0; i < 8; ++i) csl[i * NTHR + F.tid] = cv[i] / (1.0f + __expf(-cv[i])); }
    __syncthreads();
    const int l = a / 48, j0 = (a % 48) * 256 + 4 * F.lane;
    const float* wp = F.A->in[I_ADAW] + ((size_t)l * 2048 + F.wave * 256) * 12288 + j0;
    f32x4 a0 = {0.f, 0.f, 0.f, 0.f}, a1 = {0.f, 0.f, 0.f, 0.f};
#define ADA_LD(dst_, k0_) do { _Pragma("unroll") for (int i_ = 0; i_ < 8; ++i_) dst_[i_] = *(const f32x4*)(wp + (size_t)((k0_) + i_) * 12288); } while (0)
#define ADA_USE(src_, k0_) do { _Pragma("unroll") for (int i_ = 0; i_ < 8; ++i_) { const float c0 = csl[F.wave * 256 + (k0_) + i_], c1 = csl[2048 + F.wave * 256 + (k0_) + i_]; a0 += src_[i_] * c0; a1 += src_[i_] * c1; } } while (0)
    f32x4 wA[8], wB[8];
    ADA_LD(wA, 0);
#pragma unroll 1
    for (int kb = 0; kb < 256; kb += 16) {
        ADA_LD(wB, kb + 8); __builtin_amdgcn_sched_barrier(0); ADA_USE(wA, kb); __builtin_amdgcn_sched_barrier(0);
        if (kb + 16 < 256) ADA_LD(wA, kb + 16);
        __builtin_amdgcn_sched_barrier(0); ADA_USE(wB, kb + 8); __builtin_amdgcn_sched_barrier(0);
    }
#undef ADA_LD
#undef ADA_USE
    red[(F.wave * 2 + 0) * 64 + F.lane] = a0; red[(F.wave * 2 + 1) * 64 + F.lane] = a1;
    __syncthreads();
    if (F.wave < 2) { const int b = F.wave; f32x4 s = *(const f32x4*)(F.A->in[I_ADAB] + l * 12288 + j0);
#pragma unroll
        for (int w = 0; w < 8; ++w) s += red[(w * 2 + b) * 64 + F.lane];
        *(f32x4*)(WSP(float, WS_MOD) + (size_t)(l * 2 + b) * 12288 + j0) = s; }
    __syncthreads();
}
__device__ __forceinline__ void fold_item(Frame& F, int it) {
    const int l = it >> 7, hp = (it >> 3) & 15, kb = it & 7, lane = F.lane, fr = lane & 15, fq = lane >> 4;
    constexpr int SKS = 136;
    LAS bf16* skh = (LAS bf16*)F.lds; LAS bf16* skl = skh + 128 * SKS;
    const float* wbase = F.A->in[I_WPQ] + ((size_t)l * 2048 + kb * 256 + F.wave * 32 + fr) * 2048 + hp * 128 + 8 * fq;
    f32x4 wv[2][4][2];
#pragma unroll
    for (int kt = 0; kt < 2; ++kt)
#pragma unroll
        for (int s2 = 0; s2 < 4; ++s2) { wv[kt][s2][0] = *(const f32x4*)(wbase + (size_t)kt * 16 * 2048 + 32 * s2); wv[kt][s2][1] = *(const f32x4*)(wbase + (size_t)kt * 16 * 2048 + 32 * s2 + 4); }
    { const f32x4* sk = (const f32x4*)(F.A->in[I_SK] + (size_t)(l * 16 + hp) * 128 * 128);
      f32x4 v[8];
#pragma unroll
      for (int i = 0; i < 8; ++i) v[i] = sk[i * NTHR + F.tid];
#pragma unroll
      for (int i = 0; i < 8; ++i) { const int f = i * NTHR + F.tid, n = f >> 5, d = (f & 31) * 4;
          const unsigned h0 = pk2(v[i].x, v[i].y), h1 = pk2(v[i].z, v[i].w);
          const unsigned l0 = pk2(v[i].x - bflo(h0), v[i].y - bfhi(h0)), l1 = pk2(v[i].z - bflo(h1), v[i].w - bfhi(h1));
          v2u ho; ho.x = h0; ho.y = h1; v2u lo; lo.x = l0; lo.y = l1;
          *(LAS v2u*)(skh + n * SKS + d) = ho; *(LAS v2u*)(skl + n * SKS + d) = lo; } }
    __syncthreads();
    bf16x8 wh[2][4], wl[2][4];
#pragma unroll
    for (int kt = 0; kt < 2; ++kt)
#pragma unroll
        for (int s2 = 0; s2 < 4; ++s2) { const f32x4 a = wv[kt][s2][0], b = wv[kt][s2][1];
            v4u h, lo; h.x = pk2(a.x, a.y); h.y = pk2(a.z, a.w); h.z = pk2(b.x, b.y); h.w = pk2(b.z, b.w);
            lo.x = pk2(a.x - bflo(h.x), a.y - bfhi(h.x)); lo.y = pk2(a.z - bflo(h.y), a.w - bfhi(h.y)); lo.z = pk2(b.x - bflo(h.z), b.y - bfhi(h.z)); lo.w = pk2(b.z - bflo(h.w), b.w - bfhi(h.w));
            wh[kt][s2] = __builtin_bit_cast(bf16x8, h); wl[kt][s2] = __builtin_bit_cast(bf16x8, lo); }
    bf16* dst = WSP(bf16, WS_WP) + (size_t)l * 2048 * 2048 + (size_t)(hp * 128 + fr) * 2048 + kb * 256 + F.wave * 32 + 4 * fq;
#pragma unroll 2
    for (int nt = 0; nt < 8; ++nt) { f32x4 acc[2] = {{0.f, 0.f, 0.f, 0.f}, {0.f, 0.f, 0.f, 0.f}};
#pragma unroll
        for (int s2 = 0; s2 < 4; ++s2) { const bf16x8 sh = *(const LAS bf16x8*)(skh + (nt * 16 + fr) * SKS + 32 * s2 + 8 * fq), sl = *(const LAS bf16x8*)(skl + (nt * 16 + fr) * SKS + 32 * s2 + 8 * fq);
#pragma unroll
            for (int kt = 0; kt < 2; ++kt) { acc[kt] = __builtin_amdgcn_mfma_f32_16x16x32_bf16(wh[kt][s2], sh, acc[kt], 0, 0, 0); acc[kt] = __builtin_amdgcn_mfma_f32_16x16x32_bf16(wl[kt][s2], sh, acc[kt], 0, 0, 0);
                acc[kt] = __builtin_amdgcn_mfma_f32_16x16x32_bf16(wh[kt][s2], sl, acc[kt], 0, 0, 0); } }
#pragma unroll
        for (int kt = 0; kt < 2; ++kt) { v2u o; o.x = pk2(acc[kt].x, acc[kt].y); o.y = pk2(acc[kt].z, acc[kt].w); *(v2u*)(dst + (size_t)nt * 16 * 2048 + kt * 16) = o; } }
    __syncthreads();
}
__device__ __forceinline__ void cvt_item(Frame& F, int it) {
    const int which = it >> 10, chunk = it & 1023;
    const float* src = F.A->in[which ? I_PV : I_PU]; unsigned char* dst = WSP(unsigned char, which ? WS_PV : WS_PU); float* scl = WSP(float, WS_SCL) + which * 2 * NEXP;
    constexpr int VROW = 2048 + 8;
    LAS unsigned char* vt = F.lds;
    for (int i = 0; i < 4; i += 2) {
        f32x4 a[2][4], b[2][4]; float mx[2] = {0.f, 0.f};
#pragma unroll
        for (int r = 0; r < 2; ++r) { const int row = chunk * 32 + F.wave * 4 + i + r;
#pragma unroll
            for (int m = 0; m < 4; ++m) { const int col = 512 * m + 8 * F.lane; a[r][m] = *(const f32x4*)(src + (size_t)row * D + col); b[r][m] = *(const f32x4*)(src + (size_t)row * D + col + 4); } }
#pragma unroll
        for (int r = 0; r < 2; ++r) {
#pragma unroll
            for (int m = 0; m < 4; ++m) { mx[r] = fmaxf(mx[r], fmaxf(fmaxf(fabsf(a[r][m].x), fabsf(a[r][m].y)), fmaxf(fabsf(a[r][m].z), fabsf(a[r][m].w)))); mx[r] = fmaxf(mx[r], fmaxf(fmaxf(fabsf(b[r][m].x), fabsf(b[r][m].y)), fmaxf(fabsf(b[r][m].z), fabsf(b[r][m].w)))); } }
#pragma unroll
        for (int o = 1; o < 64; o <<= 1) { mx[0] = fmaxf(mx[0], __shfl_xor(mx[0], o)); mx[1] = fmaxf(mx[1], __shfl_xor(mx[1], o)); }
#pragma unroll
        for (int r = 0; r < 2; ++r) { const int row = chunk * 32 + F.wave * 4 + i + r, l = row >> 14, e = row & (NEXP - 1);
            const float sc = mx[r] > 0.f ? mx[r] * (1.0f / 440.0f) : 1.0f, inv = 1.0f / sc;
            if (F.lane == 0) scl[l * NEXP + e] = sc;
#pragma unroll
            for (int m = 0; m < 4; ++m) { const int col = 512 * m + 8 * F.lane;
                int lo = __builtin_amdgcn_cvt_pk_fp8_f32(a[r][m].x * inv, a[r][m].y * inv, 0, false); lo = __builtin_amdgcn_cvt_pk_fp8_f32(a[r][m].z * inv, a[r][m].w * inv, lo, true);
                int hi = __builtin_amdgcn_cvt_pk_fp8_f32(b[r][m].x * inv, b[r][m].y * inv, 0, false); hi = __builtin_amdgcn_cvt_pk_fp8_f32(b[r][m].z * inv, b[r][m].w * inv, hi, true);
                v2u o; o.x = (unsigned)lo; o.y = (unsigned)hi;
                if (which) *(LAS v2u*)(vt + (F.wave * 4 + i + r) * VROW + col) = o;
                else *(v2u*)(dst + ((size_t)(l * NSL + (col >> 7)) * NEXP + e) * SLW + (col & 127)) = o; } }
    }
    if (which) {
        __syncthreads();
        const int row0 = chunk * 32, l = row0 >> 14, e0 = row0 & (NEXP - 1);
#pragma unroll 4
        for (int i = 0; i < 16; ++i) { const int idx = i * NTHR + F.tid, j = idx >> 5, r = idx & 31;
            *(v2u*)(dst + ((size_t)(l * 256 + j) * NEXP + e0 + r) * 8) = *(const LAS v2u*)(vt + r * VROW + 8 * j); }
        __syncthreads();
    }
}
__device__ __forceinline__ void bias_item(Frame& F) {
    for (int i = F.tid; i < 2048; i += NTHR) { const int h = i >> 7, d = i & 127; int bk;
        if (d < 16) bk = d; else { bk = 16 + (int)(logf((float)d / 16.0f) / logf(8.0f) * 16.0f); bk = bk > 31 ? 31 : bk; }
        WSP(float, WS_BIAS)[i] = F.A->in[I_RELB][bk * 16 + h]; }
}
constexpr int IT_FOLD = 256, IT_ADA = 96, IT_WMAX = 64 + 32 + 32, IT_CVT = 2048;
constexpr int IT0_ADA = 0, IT0_BIAS = IT0_ADA + IT_ADA, IT0_WMAX = IT0_BIAS + 1, IT0_CVT = IT0_WMAX + IT_WMAX, N_OTHER = IT0_CVT + IT_CVT, N_ITEMS = N_OTHER + IT_FOLD, FOLD_EVERY = 9;
static_assert((IT_FOLD - 1) * FOLD_EVERY < N_ITEMS, "fold tickets inside the item range");
__device__ __forceinline__ void p0_prologue(Frame& F) {
    PHASE_TID(F);
    if (F.tid == 0) F.MISC[0] = __hip_atomic_fetch_add(F.ctl + CW_QUEUE, 1u, __ATOMIC_RELAXED, __HIP_MEMORY_SCOPE_AGENT);
    for (int par = 0;; par ^= 1) {
        __syncthreads();
        const int it = (int)F.MISC[par];
        if (F.tid == 0) F.MISC[par ^ 1] = __hip_atomic_fetch_add(F.ctl + CW_QUEUE, 1u, __ATOMIC_RELAXED, __HIP_MEMORY_SCOPE_AGENT);
        if (it >= N_ITEMS) break;
        const int fq = it / FOLD_EVERY; const bool is_fold = (it % FOLD_EVERY == 0) && fq < IT_FOLD;
        const int ot = it - (fq + 1 < IT_FOLD ? fq + 1 : IT_FOLD);
        if (is_fold) fold_item(F, fq);
        else if (ot < IT0_BIAS) ada_item(F, ot - IT0_ADA);
        else if (ot < IT0_WMAX) bias_item(F);
        else if (ot < IT0_WMAX + 64) wmax_item(F, ot - IT0_WMAX);
        else if (ot < IT0_WMAX + 96) wmax2_item(F, ot - IT0_WMAX - 64);
        else if (ot < IT0_CVT) wmax3_item(F, ot - IT0_WMAX - 96);
        else cvt_item(F, ot - IT0_CVT);
    }
}

__device__ __forceinline__ void row_to_fp8(const f32x4 (&y)[8], unsigned char* hrow, float* sarow, int lane) {
    float mx = 0.f;
#pragma unroll
    for (int j = 0; j < 8; ++j) mx = fmaxf(mx, fmaxf(fmaxf(fabsf(y[j].x), fabsf(y[j].y)), fmaxf(fabsf(y[j].z), fabsf(y[j].w))));
#pragma unroll
    for (int o = 1; o < 64; o <<= 1) mx = fmaxf(mx, __shfl_xor(mx, o));
    const float sc = mx > 0.f ? mx * (1.0f / 440.0f) : 1.0f, inv = 1.0f / sc;
    if (lane == 0) *sarow = sc;
#pragma unroll
    for (int j = 0; j < 8; ++j) { int w = __builtin_amdgcn_cvt_pk_fp8_f32(y[j].x * inv, y[j].y * inv, 0, false); w = __builtin_amdgcn_cvt_pk_fp8_f32(y[j].z * inv, y[j].w * inv, w, true); ((unsigned*)hrow)[lane + 64 * j] = (unsigned)w; }
}
template <bool TO_FP8, bool IN_BF16>
__device__ __forceinline__ void norm_phase(Frame& F, const void* X, bf16* Hd, const float* g, const float* modl, int ish, int isc) {
    PHASE_TID(F);
    const int gw = F.vcu * NWAVES + F.wave, NGW = F.G * NWAVES;
    int curb = -1; f32x4 gs[8], sh[8];
    for (int m = gw; m < T; m += NGW) {
        const int b = m >> 13;
        if (b != curb) { curb = b;
#pragma unroll
            for (int j = 0; j < 8; ++j) { const int col = 4 * F.lane + 256 * j; const f32x4 g4 = *(const f32x4*)(g + col), sc4 = *(const f32x4*)(modl + (size_t)b * 12288 + isc * 2048 + col);
                sh[j] = *(const f32x4*)(modl + (size_t)b * 12288 + ish * 2048 + col); gs[j] = g4 * (sc4 + 1.0f); } }
        f32x4 v[8]; float ss = 0.f;
        if constexpr (IN_BF16) { const v2u* xr = (const v2u*)((const bf16*)X + (size_t)m * D) + F.lane; v2u q[8];
#pragma unroll
            for (int j = 0; j < 8; ++j) q[j] = xr[64 * j];
            __builtin_amdgcn_sched_barrier(0);
#pragma unroll
            for (int j = 0; j < 8; ++j) v[j] = (f32x4){bflo(q[j].x), bfhi(q[j].x), bflo(q[j].y), bfhi(q[j].y)};
        } else { const f32x4* xr = (const f32x4*)((const float*)X + (size_t)m * D) + F.lane;
#pragma unroll
            for (int j = 0; j < 8; ++j) v[j] = xr[64 * j];
            __builtin_amdgcn_sched_barrier(0); }
#pragma unroll
        for (int j = 0; j < 8; ++j) ss += (v[j].x * v[j].x + v[j].y * v[j].y) + (v[j].z * v[j].z + v[j].w * v[j].w);
        const float rstd = 1.0f / sqrtf(wave_sum(ss) * (1.0f / D) + EPS);
        if constexpr (TO_FP8) { f32x4 y[8];
#pragma unroll
            for (int j = 0; j < 8; ++j) y[j] = v[j] * rstd * gs[j] + sh[j];
            row_to_fp8(y, (unsigned char*)Hd + (size_t)m * D, WSP(float, WS_SA) + m, F.lane);
        } else {
        v2u* o = (v2u*)(Hd + (size_t)m * D) + F.lane;
#pragma unroll
        for (int j = 0; j < 8; ++j) { const f32x4 y = v[j] * rstd * gs[j] + sh[j]; v2u w; w.x = pk2(y.x, y.y); w.y = pk2(y.z, y.w); o[64 * j] = w; }
        }
    }
}

__device__ __forceinline__ void conv_phase(Frame& F, int l) {
    PHASE_TID(F);
    const float* dw = F.A->in[I_DWW] + (size_t)l * CWID * CONV; const int c0 = 2 * F.tid;
    float w0[CWID], w1[CWID];
#pragma unroll
    for (int j = 0; j < CWID; ++j) { const f32x2 w = *(const f32x2*)(dw + j * CONV + c0); w0[j] = w.x; w1[j] = w.y; }
    const f32x2 cb = *(const f32x2*)(F.A->in[I_DWB] + l * CONV + c0), lg = *(const f32x2*)(F.A->in[I_CLNG] + l * CONV + c0), lb = *(const f32x2*)(F.A->in[I_CLNB] + l * CONV + c0);
    LAS float* red = (LAS float*)F.lds;
    LAS float* stat = red + 256;
    float gmx = fmaxf(fabsf(lg.x), fabsf(lg.y)), bmx = fmaxf(fabsf(lb.x), fabsf(lb.y));
#pragma unroll
    for (int o = 1; o < 64; o <<= 1) { gmx = fmaxf(gmx, __shfl_xor(gmx, o)); bmx = fmaxf(bmx, __shfl_xor(bmx, o)); }
    if (F.lane == 0) { red[F.wave] = gmx; red[8 + F.wave] = bmx; }
    __syncthreads();
    { float g_ = red[0], b_ = red[8];
#pragma unroll
      for (int w = 1; w < 8; ++w) { g_ = fmaxf(g_, red[w]); b_ = fmaxf(b_, red[8 + w]); }
      gmx = g_; bmx = b_; }
    __syncthreads();
    const float Bc = fmaxf(32.0f * gmx + bmx, 1e-20f), cinv = 440.0f / Bc;
    if (blockIdx.x == 0 && F.tid == 0) { __hip_atomic_store(F.ctl + CW_BC + l, __float_as_uint(Bc), __ATOMIC_RELAXED, __HIP_MEMORY_SCOPE_AGENT); __hip_atomic_store(F.ctl + CW_BC2 + l, __float_as_uint(gmx + bmx), __ATOMIC_RELAXED, __HIP_MEMORY_SCOPE_AGENT); }
    const unsigned* Ut = WSP(unsigned, WS_U) + F.tid; unsigned short* AM = WSP(unsigned short, WS_AM);
    for (int tile = F.vcu; tile < T / 64; tile += F.G) {
        const int t0 = tile * 64, bstart = t0 & ~(SEQ - 1);
        for (int grp = 0; grp < 4; ++grp) {
            const int tg = t0 + grp * 16;
            float wa[46], wb[46]; unsigned wp[46];
#pragma unroll
            for (int i = 0; i < 46; ++i) { const int r = tg - 30 + i; wp[i] = Ut[(size_t)(r >= bstart ? r : bstart) * (CONV / 2)]; }
            __builtin_amdgcn_sched_barrier(0);
#pragma unroll
            for (int i = 0; i < 46; ++i) { const int r = tg - 30 + i; const unsigned p = wp[i] & (r >= bstart ? 0xffffffffu : 0u); wa[i] = bflo(p); wb[i] = bfhi(p); }
            float oa[16], ob[16];
#pragma unroll
            for (int i = 0; i < 16; ++i) { float a = cb.x, b = cb.y;
#pragma unroll
                for (int j = 0; j < CWID; ++j) { a += w0[j] * wa[i + j]; b += w1[j] * wb[i + j]; }
                oa[i] = a; ob[i] = b; }
#pragma unroll
            for (int i = 0; i < 16; ++i) { const float s = wave_sum(oa[i] + ob[i]), q = wave_sum(oa[i] * oa[i] + ob[i] * ob[i]); if (F.lane == 0) { red[F.wave * 32 + i] = s; red[F.wave * 32 + 16 + i] = q; } }
            __syncthreads();
            if (F.tid < 32) { float v = 0.f;
#pragma unroll
                for (int w = 0; w < 8; ++w) v += red[w * 32 + F.tid];
                stat[F.tid] = v; }
            __syncthreads();
#pragma unroll
            for (int i = 0; i < 16; ++i) { const float mu = stat[i] * (1.0f / CONV), var = fmaxf(stat[16 + i] * (1.0f / CONV) - mu * mu, 0.0f), rstd = 1.0f / sqrtf(var + EPS);
                const float ya = (oa[i] - mu) * rstd * lg.x + lb.x, yb = (ob[i] - mu) * rstd * lg.y + lb.y;
                AM[(size_t)(tg + i) * (D / 2) + F.tid] = (unsigned short)__builtin_amdgcn_cvt_pk_fp8_f32(ya * sigmoidf_(ya) * cinv, yb * sigmoidf_(yb) * cinv, 0, false); }
        }
    }
}

#define MFMA32(a, b, c) __builtin_amdgcn_mfma_f32_32x32x16_bf16((a), (b), (c), 0, 0, 0)
__device__ __forceinline__ void attn_phase(Frame& F, int l) {
    PHASE_TID(F);
    constexpr int VTS = 260;
    constexpr int KS = 72;
    LAS bf16* VT = (LAS bf16*)F.lds;
    LAS bf16* KL = (LAS bf16*)(F.lds + 34816);
    LAS float* BT = (LAS float*)(F.lds + 34816 + 36864);
    const bf16* Qg = WSP(bf16, WS_Q); const bf16* Kg = WSP(bf16, WS_K); const bf16* Vg = WSP(bf16, WS_V); unsigned char* AM = WSP(unsigned char, WS_AM);
    const float* BIAS = WSP(float, WS_BIAS);
    const int r = F.lane & 31, h = F.lane >> 5;
    for (int unit = F.vcu; unit < 512; unit += F.G) {
        const int b = unit >> 8, blk = (unit >> 2) & 63, kvh = unit & 3, kbase = blk * 128 - 128;
        const float vmx = __uint_as_float(__hip_atomic_load(F.ctl + CW_VMAX + 2 * l + b, __ATOMIC_RELAXED, __HIP_MEMORY_SCOPE_AGENT)), ainv = vmx > 0.f ? 440.0f / (1.02f * vmx) : 1.0f;
        for (int c = F.tid; c < 2048; c += NTHR) { const int key = c >> 3, d0 = (c & 7) * 8, kpos = kbase + key; v4u v = {0u, 0u, 0u, 0u}, kq = {0u, 0u, 0u, 0u};
            if (kpos >= 0) { v = *(const v4u*)(Vg + (size_t)(b * SEQ + kpos) * KVD + kvh * HD + d0); kq = *(const v4u*)(Kg + (size_t)(b * SEQ + kpos) * KVD + kvh * HD + d0); }
            *(LAS v4u*)(KL + key * KS + d0) = kq;
            LAS bf16* dst = VT + d0 * VTS + key;
            dst[0 * VTS] = (bf16)v.x; dst[1 * VTS] = (bf16)(v.x >> 16); dst[2 * VTS] = (bf16)v.y; dst[3 * VTS] = (bf16)(v.y >> 16);
            dst[4 * VTS] = (bf16)v.z; dst[5 * VTS] = (bf16)(v.z >> 16); dst[6 * VTS] = (bf16)v.w; dst[7 * VTS] = (bf16)(v.w >> 16); }
        BT[F.tid] = BIAS[(kvh * 4 + (F.tid >> 7)) * 128 + (F.tid & 127)];
        __syncthreads();
        for (int tk = 0; tk < 2; ++tk) {
            const int task = F.wave * 2 + tk, g = task >> 2, qs = task & 3, head = kvh * 4 + g;
            const size_t trow = (size_t)b * SEQ + blk * 128 + qs * 32 + r;
            bf16x8 qf[4];
#pragma unroll
            for (int s = 0; s < 4; ++s) qf[s] = *(const bf16x8*)(Qg + trow * ATT + head * HD + 16 * s + 8 * h);
            const float sink = F.A->in[I_SINK][l * NHEAD + head];
            float mx = sink, lsum = 0.f;
            f32x16 o[2];
#pragma unroll
            for (int i = 0; i < 16; ++i) { o[0][i] = 0.f; o[1][i] = 0.f; }
#pragma unroll 1
            for (int j = 0; j < 5; ++j) { f32x16 a;
#pragma unroll
                for (int i = 0; i < 16; ++i) a[i] = 0.f;
#pragma unroll
                for (int s = 0; s < 4; ++s) { const bf16x8 kf = *(const LAS bf16x8*)(KL + (qs * 32 + 32 * j + r) * KS + 16 * s + 8 * h); a = MFMA32(kf, qf[s], a); }
                float tmax = -INFINITY;
#pragma unroll
                for (int i = 0; i < 16; ++i) { const int kr = 32 * j + (i & 3) + 8 * (i >> 2) + 4 * h, dist = 128 + r - kr; const bool ok = dist >= 0 && dist < 128 && (kbase + qs * 32 + kr) >= 0;
                    const float sv = ok ? a[i] + BT[g * 128 + (dist & 127)] : -INFINITY; a[i] = sv; tmax = fmaxf(tmax, sv); }
                tmax = fmaxf(tmax, __shfl_xor(tmax, 32));
                const float mnew = fmaxf(mx, tmax), alpha = __expf(mx - mnew); mx = mnew; lsum *= alpha;
#pragma unroll
                for (int i = 0; i < 16; ++i) { o[0][i] *= alpha; o[1][i] *= alpha; const float p = __expf(a[i] - mx); a[i] = p; lsum += p; }
#pragma unroll
                for (int s2 = 0; s2 < 2; ++s2) { v4u pp; pp.x = pk2(a[8 * s2 + 0], a[8 * s2 + 1]); pp.y = pk2(a[8 * s2 + 2], a[8 * s2 + 3]); pp.z = pk2(a[8 * s2 + 4], a[8 * s2 + 5]); pp.w = pk2(a[8 * s2 + 6], a[8 * s2 + 7]);
                    const bf16x8 pf = __builtin_bit_cast(bf16x8, pp);
#pragma unroll
                    for (int dt = 0; dt < 2; ++dt) { const LAS bf16* vp = VT + (32 * dt + r) * VTS + qs * 32 + 32 * j + 16 * s2 + 4 * h; const v2u lo = *(const LAS v2u*)vp, hi = *(const LAS v2u*)(vp + 8);
                        v4u vv; vv.x = lo.x; vv.y = lo.y; vv.z = hi.x; vv.w = hi.y; o[dt] = MFMA32(__builtin_bit_cast(bf16x8, vv), pf, o[dt]); } }
            }
            lsum += __shfl_xor(lsum, 32);
            const float inv = ainv / (lsum + __expf(sink - mx));
#pragma unroll
            for (int dt = 0; dt < 2; ++dt)
#pragma unroll
                for (int g4 = 0; g4 < 4; ++g4) { int w = __builtin_amdgcn_cvt_pk_fp8_f32(o[dt][4 * g4 + 0] * inv, o[dt][4 * g4 + 1] * inv, 0, false); w = __builtin_amdgcn_cvt_pk_fp8_f32(o[dt][4 * g4 + 2] * inv, o[dt][4 * g4 + 3] * inv, w, true);
                    *(unsigned*)(AM + trow * D + ATT + head * HD + 32 * dt + 8 * g4 + 4 * h) = (unsigned)w; }
        }
        __syncthreads();
    }
}

__device__ __forceinline__ unsigned f2key(float f) { const unsigned u = __float_as_uint(f); return (u & 0x80000000u) ? ~u : (u | 0x80000000u); }
__device__ __forceinline__ float key2f(unsigned k) { const unsigned u = (k & 0x80000000u) ? (k & 0x7fffffffu) : ~k; return __uint_as_float(u); }
#define INSERT16(L, x_) do { unsigned x__ = (x_); _Pragma("unroll") for (int q_ = 0; q_ < 16; ++q_) { const unsigned hi_ = L[q_] > x__ ? L[q_] : x__; x__ = L[q_] > x__ ? x__ : L[q_]; L[q_] = hi_; } } while (0)
__device__ __forceinline__ void topk_phase(Frame& F) {
    PHASE_TID(F);
    const _Float16* S = WSP(_Float16, WS_GC); int* IDX = WSP(int, WS_U); float* GATE = WSP(float, WS_U + 8 * MiB);
    const int gw = F.vcu * NWAVES + F.wave, NGW = F.G * NWAVES;
    constexpr int TKS = 256; LAS unsigned char* lw = F.lds + F.wave * (64 * TKS); const LAS unsigned char* lrow = lw + F.lane * TKS;
    for (int grp = gw; grp < T * PHEADS / 64; grp += NGW) {
        const int item = grp * 64 + F.lane, t = item >> 3, hh = item & 7;
        const unsigned char* sg = (const unsigned char*)(S + (size_t)grp * 8 * D) + (size_t)(F.lane >> 4) * 512 + (F.lane & 15) * 16;
        v4u r0[16], r1[16];
#pragma unroll
        for (int i = 0; i < 16; ++i) r0[i] = *(const v4u*)(sg + (size_t)(i >> 1) * 4096 + (i & 1) * 2048);
#pragma unroll
        for (int i = 0; i < 16; ++i) r1[i] = *(const v4u*)(sg + (size_t)(i >> 1) * 4096 + (i & 1) * 2048 + 256);
        __builtin_amdgcn_sched_barrier(0);
#pragma unroll
        for (int i = 0; i < 16; ++i) *(LAS v4u*)(lw + (4 * i + (F.lane >> 4)) * TKS + (((F.lane & 15) ^ ((4 * i + (F.lane >> 4)) & 15)) << 4)) = r0[i];
        __builtin_amdgcn_sched_barrier(0);
        unsigned L1[16], L2[16];
#pragma unroll
        for (int q = 0; q < 16; ++q) { L1[q] = 0u; L2[q] = 0u; }
#pragma unroll 2
        for (int c = 0; c < 16; ++c) { const pg8::f16x8 v = *(const LAS pg8::f16x8*)(lrow + ((c ^ (F.lane & 15)) << 4));
#pragma unroll
            for (int e = 0; e < 8; ++e) { const unsigned key = (f2key((float)v[e]) & ~127u) | (unsigned)(127 - (8 * c + e)); INSERT16(L1, key); } }
        __builtin_amdgcn_sched_barrier(0);
#pragma unroll
        for (int i = 0; i < 16; ++i) *(LAS v4u*)(lw + (4 * i + (F.lane >> 4)) * TKS + (((F.lane & 15) ^ ((4 * i + (F.lane >> 4)) & 15)) << 4)) = r1[i];
        __builtin_amdgcn_sched_barrier(0);
#pragma unroll 2
        for (int c = 0; c < 16; ++c) { const pg8::f16x8 v = *(const LAS pg8::f16x8*)(lrow + ((c ^ (F.lane & 15)) << 4));
#pragma unroll
            for (int e = 0; e < 8; ++e) { const unsigned key = (f2key((float)v[e]) & ~127u) | (unsigned)(127 - (8 * c + e)); INSERT16(L2, key); } }
        float v1[16], v2[16];
#pragma unroll
        for (int q = 0; q < 16; ++q) { v1[q] = key2f(L1[q] & ~127u); v2[q] = key2f(L2[q] & ~127u); }
        unsigned B[16];
#pragma unroll
        for (int q = 0; q < 16; ++q) B[q] = 0u;
#pragma unroll
        for (int i = 0; i < 16; ++i)
#pragma unroll
            for (int j = 0; j < 16; ++j) if ((i + 1) * (j + 1) <= 16) { const unsigned key = (f2key(v1[i] + v2[j]) & ~255u) | (unsigned)(255 - (i * 16 + j)); INSERT16(B, key); }
        const float b0 = key2f(B[0] & ~255u); float e[16], es = 0.f;
#pragma unroll
        for (int q = 0; q < 16; ++q) { e[q] = __expf(key2f(B[q] & ~255u) - b0); es += e[q]; }
        const float einv = 1.0f / es;
        int ex[16];
#pragma unroll
        for (int q = 0; q < 16; ++q) { const int code = 255 - (int)(B[q] & 255u), ii = code >> 4, jj = code & 15; unsigned s1 = L1[0], s2 = L2[0];
#pragma unroll
            for (int z = 1; z < 16; ++z) { s1 = (ii == z) ? L1[z] : s1; s2 = (jj == z) ? L2[z] : s2; }
            ex[q] = (127 - (int)(s1 & 127u)) * 128 + (127 - (int)(s2 & 127u)); e[q] *= einv; }
        int* ip = IDX + (size_t)t * 128 + hh * 16; float* gp = GATE + (size_t)t * 128 + hh * 16;
#pragma unroll
        for (int q = 0; q < 4; ++q) { *(int4*)(ip + 4 * q) = make_int4(ex[4 * q], ex[4 * q + 1], ex[4 * q + 2], ex[4 * q + 3]); *(f32x4*)(gp + 4 * q) = (f32x4){e[4 * q], e[4 * q + 1], e[4 * q + 2], e[4 * q + 3]}; }
    }
}

#define FP8LO(w_) __builtin_amdgcn_cvt_pk_f32_fp8((int)(w_), false)
#define FP8HI(w_) __builtin_amdgcn_cvt_pk_f32_fp8((int)(w_), true)
__device__ __forceinline__ void pa_issue(v4u (&rr)[16], int id0, int id1, const unsigned char* tab, int g) {
#pragma unroll
    for (int i = 0; i < 16; ++i) { const int e = __shfl(i < 8 ? id0 : id1, ((8 * i) & 63) + g); rr[i] = *(const v4u*)(tab + (size_t)e * SLW); }
}
__device__ __forceinline__ void pa_compute(const v4u (&rr)[16], const v4u ha, const v4u hb, float o0, float o1, float* d0, float* d1, int lane) {
    f32x2 hf[8];
    hf[0] = (f32x2){bflo(ha.x), bfhi(ha.x)}; hf[1] = (f32x2){bflo(ha.y), bfhi(ha.y)}; hf[2] = (f32x2){bflo(ha.z), bfhi(ha.z)}; hf[3] = (f32x2){bflo(ha.w), bfhi(ha.w)};
    hf[4] = (f32x2){bflo(hb.x), bfhi(hb.x)}; hf[5] = (f32x2){bflo(hb.y), bfhi(hb.y)}; hf[6] = (f32x2){bflo(hb.z), bfhi(hb.z)}; hf[7] = (f32x2){bflo(hb.w), bfhi(hb.w)};
    float p[16];
#pragma unroll
    for (int i = 0; i < 16; ++i) { f32x2 a = FP8LO(rr[i].x) * hf[0];
        a = __builtin_elementwise_fma(FP8HI(rr[i].x), hf[1], a); a = __builtin_elementwise_fma(FP8LO(rr[i].y), hf[2], a); a = __builtin_elementwise_fma(FP8HI(rr[i].y), hf[3], a);
        a = __builtin_elementwise_fma(FP8LO(rr[i].z), hf[4], a); a = __builtin_elementwise_fma(FP8HI(rr[i].z), hf[5], a); a = __builtin_elementwise_fma(FP8LO(rr[i].w), hf[6], a); a = __builtin_elementwise_fma(FP8HI(rr[i].w), hf[7], a);
        p[i] = a.x + a.y; }
    float q8[8], q4[4], q2[2];
    { const bool bt = (lane & 1) != 0;
#pragma unroll
      for (int i = 0; i < 8; ++i) { const float snd = bt ? p[i] : p[i + 8], kp = bt ? p[i + 8] : p[i]; q8[i] = kp + lane_xor1(snd); } }
    { const bool bt = (lane & 2) != 0;
#pragma unroll
      for (int i = 0; i < 4; ++i) { const float snd = bt ? q8[i] : q8[i + 4], kp = bt ? q8[i + 4] : q8[i]; q4[i] = kp + lane_xor2(snd); } }
    { const bool bt = (lane & 4) != 0;
#pragma unroll
      for (int i = 0; i < 2; ++i) { const float snd = bt ? q4[i] : q4[i + 2], kp = bt ? q4[i + 2] : q4[i]; q2[i] = kp + lane_xor4(snd); } }
    *d0 = o0 + q2[0]; *d1 = o1 + q2[1];
}
__device__ __forceinline__ void peer_act_phase(Frame& F, int l) {
    PHASE_TID(F);
    const int lane = F.lane, g = lane >> 3, j = lane & 7;
    const int x = blockIdx.x & 7, bpg = F.G >> 3, wpg = bpg * NWAVES, wgi = (blockIdx.x >> 3) * NWAVES + F.wave;
    const int* IDX = WSP(int, WS_U); const bf16* Hb = WSP(bf16, WS_H);
    float* actp = WSP(float, WS_AM) + (size_t)x * T * 128;
    const int irev = 8 * (j & 1) + 4 * ((j >> 1) & 1) + 2 * (j >> 2), k0 = 8 * irev + g, k1 = k0 + 8;
    const int NT = (T - wgi + wpg - 1) / wpg;
    for (int s = 0; s < 2; ++s) {
        const int sl = 2 * x + s; const unsigned char* tab = WSP(unsigned char, WS_PU) + (size_t)(l * NSL + sl) * NEXP * SLW + 16 * j;
        const bf16* hcol = Hb + sl * SLW + 16 * j;
#define PA_PREF(n_, i0, i1, h0, h1, q0, q1) do { const int t_ = wgi + (n_) * wpg; if ((n_) < NT) { i0 = IDX[(size_t)t_ * 128 + lane]; i1 = IDX[(size_t)t_ * 128 + 64 + lane]; h0 = *(const v4u*)(hcol + (size_t)t_ * D); h1 = *(const v4u*)(hcol + (size_t)t_ * D + 8); \
            if (s > 0) { q0 = actp[(size_t)t_ * 128 + k0]; q1 = actp[(size_t)t_ * 128 + k1]; } } } while (0)
        int ia0 = 0, ia1 = 0, ib0 = 0, ib1 = 0; v4u ha0 = {0u, 0u, 0u, 0u}, ha1 = ha0, hb0 = ha0, hb1 = ha0; float oa0 = 0.f, oa1 = 0.f, ob0 = 0.f, ob1 = 0.f;
        v4u rA[16], rB[16];
        PA_PREF(0, ia0, ia1, ha0, ha1, oa0, oa1); PA_PREF(1, ib0, ib1, hb0, hb1, ob0, ob1);
        if (0 < NT) pa_issue(rA, ia0, ia1, tab, g);
        for (int n = 0; n < NT; n += 2) {
            const v4u ca0 = ha0, ca1 = ha1; const float pa0 = oa0, pa1 = oa1;
            if (n + 1 < NT) pa_issue(rB, ib0, ib1, tab, g);
            PA_PREF(n + 2, ia0, ia1, ha0, ha1, oa0, oa1);
            __builtin_amdgcn_sched_barrier(0);
            { const size_t t_ = (size_t)(wgi + n * wpg); pa_compute(rA, ca0, ca1, pa0, pa1, actp + t_ * 128 + k0, actp + t_ * 128 + k1, lane); }
            __builtin_amdgcn_sched_barrier(0);
            if (n + 1 < NT) {
                const v4u cb0 = hb0, cb1 = hb1; const float pb0 = ob0, pb1 = ob1;
                if (n + 2 < NT) pa_issue(rA, ia0, ia1, tab, g);
                PA_PREF(n + 3, ib0, ib1, hb0, hb1, ob0, ob1);
                __builtin_amdgcn_sched_barrier(0);
                { const size_t t_ = (size_t)(wgi + (n + 1) * wpg); pa_compute(rB, cb0, cb1, pb0, pb1, actp + t_ * 128 + k0, actp + t_ * 128 + k1, lane); }
                __builtin_amdgcn_sched_barrier(0);
            }
        }
#undef PA_PREF
    }
}
__device__ __forceinline__ void peer_w_phase(Frame& F, int l) {
    PHASE_TID(F);
    const int lane = F.lane;
    constexpr int WROW = 136;
    LAS bf16* wl = (LAS bf16*)F.lds; LAS bf16* il = wl + 64 * WROW;
    const int* IDX = WSP(int, WS_U); const float* GATE = WSP(float, WS_U + 8 * MiB); const float* actp = WSP(float, WS_AM);
    bf16* WT = WSP(bf16, WS_Y1); bf16* IT = WSP(bf16, WS_Y1 + 4 * MiB);
    const float* su = WSP(float, WS_SCL) + l * NEXP; const float* sv = WSP(float, WS_SCL) + (2 + l) * NEXP;
    for (int tb = F.vcu; tb < T / 64; tb += F.G) {
#pragma unroll 2
        for (int i = 0; i < 8; ++i) { const int tl = F.wave * 8 + i, t = tb * 64 + tl;
            const int e0 = IDX[(size_t)t * 128 + lane], e1 = IDX[(size_t)t * 128 + 64 + lane];
            float pa[8], pb[8];
#pragma unroll
            for (int xx = 0; xx < 8; ++xx) { pa[xx] = actp[((size_t)xx * T + t) * 128 + lane]; pb[xx] = actp[((size_t)xx * T + t) * 128 + 64 + lane]; }
            const float gt0 = GATE[(size_t)t * 128 + lane], gt1 = GATE[(size_t)t * 128 + 64 + lane];
            const float su0 = su[e0], su1 = su[e1], sv0 = sv[e0], sv1 = sv[e1];
            __builtin_amdgcn_sched_barrier(0);
            float a0 = ((pa[0] + pa[1]) + (pa[2] + pa[3])) + ((pa[4] + pa[5]) + (pa[6] + pa[7])), a1 = ((pb[0] + pb[1]) + (pb[2] + pb[3])) + ((pb[4] + pb[5]) + (pb[6] + pb[7]));
            a0 *= su0; a1 *= su1;
            const float g0 = gt0 * sv0, g1 = gt1 * sv1;
            wl[tl * WROW + lane] = __builtin_bit_cast(bf16, (_Float16)(256.0f * g0 * 0.5f * a0 * (1.0f + erff(a0 * 0.70710678118654752f)))); wl[tl * WROW + 64 + lane] = __builtin_bit_cast(bf16, (_Float16)(256.0f * g1 * 0.5f * a1 * (1.0f + erff(a1 * 0.70710678118654752f))));
            il[tl * WROW + lane] = (bf16)e0; il[tl * WROW + 64 + lane] = (bf16)e1; }
        __syncthreads();
#pragma unroll
        for (int i = 0; i < 2; ++i) { const int p_ = i * NTHR + F.tid, kq = p_ >> 6, tl = p_ & 63; const size_t o = ((size_t)(tb * 16 + kq) * 64 + tl) * 8;
            *(v4u*)(WT + o) = *(const LAS v4u*)(wl + tl * WROW + 8 * kq); *(v4u*)(IT + o) = *(const LAS v4u*)(il + tl * WROW + 8 * kq); }
        __syncthreads();
    }
}
__device__ __forceinline__ void pbl_load(v4u (&iv)[4], v4u (&wv)[4], const bf16* ip, const bf16* wp) {
#pragma unroll
    for (int q = 0; q < 4; ++q) { iv[q] = *(const v4u*)(ip + q * 512); wv[q] = *(const v4u*)(wp + q * 512); }
}
typedef _Float16 h16x2 __attribute__((ext_vector_type(2)));
#define FP8H_LO(w_) __builtin_bit_cast(h16x2, __builtin_amdgcn_cvt_scalef32_pk_f16_fp8((int)(w_), 1.0f, false))
#define FP8H_HI(w_) __builtin_bit_cast(h16x2, __builtin_amdgcn_cvt_scalef32_pk_f16_fp8((int)(w_), 1.0f, true))
#define PBL_FMA_LO(acc_, v_, w_) asm("v_pk_fma_f16 %0, %1, %2, %0 op_sel_hi:[1,0,1]" : "+v"(acc_) : "v"(v_), "v"(w_))
#define PBL_FMA_HI(acc_, v_, w_) asm("v_pk_fma_f16 %0, %1, %2, %0 op_sel:[0,1,0] op_sel_hi:[1,1,1]" : "+v"(acc_) : "v"(v_), "v"(w_))
__device__ __forceinline__ void pbl_compute(const v4u (&iv)[4], const v4u (&wv)[4], h16x2 (&acc)[4], LAS unsigned char* lds) {
    const unsigned three = 3u;
#pragma unroll
    for (int q = 0; q < 4; ++q) { v2u d[8];
#pragma unroll
        for (int ki = 0; ki < 8; ++ki) { const unsigned ipair = iv[q][ki >> 1]; unsigned ad;
            if (ki & 1) asm("v_lshlrev_b32_sdwa %0, %1, %2 dst_sel:DWORD dst_unused:UNUSED_PAD src0_sel:DWORD src1_sel:WORD_1" : "=v"(ad) : "s"(three), "v"(ipair));
            else asm("v_lshlrev_b32_sdwa %0, %1, %2 dst_sel:DWORD dst_unused:UNUSED_PAD src0_sel:DWORD src1_sel:WORD_0" : "=v"(ad) : "s"(three), "v"(ipair));
            d[ki] = *(const LAS v2u*)(size_t)ad; }
        __builtin_amdgcn_sched_barrier(0);
#pragma unroll
        for (int ki = 0; ki < 8; ++ki) { const unsigned wword = wv[q][ki >> 1];
            const h16x2 v0 = FP8H_LO(d[ki].x), v1 = FP8H_HI(d[ki].x), v2 = FP8H_LO(d[ki].y), v3 = FP8H_HI(d[ki].y);
            if (ki & 1) { PBL_FMA_HI(acc[0], v0, wword); PBL_FMA_HI(acc[1], v1, wword); PBL_FMA_HI(acc[2], v2, wword); PBL_FMA_HI(acc[3], v3, wword); }
            else { PBL_FMA_LO(acc[0], v0, wword); PBL_FMA_LO(acc[1], v1, wword); PBL_FMA_LO(acc[2], v2, wword); PBL_FMA_LO(acc[3], v3, wword); } }
        __builtin_amdgcn_sched_barrier(0); }
}
__device__ __forceinline__ void peer_out_phase(Frame& F, int l) {
    PHASE_TID(F);
    const int lane = F.lane;
    const int x = blockIdx.x & 7, ib = blockIdx.x >> 3, j = 8 * (4 * x + (ib >> 3)) + (ib & 7);
    const bf16* WT = WSP(bf16, WS_Y1); const bf16* IT = WSP(bf16, WS_Y1 + 4 * MiB); bf16* OUT = WSP(bf16, WS_GC);
    for (int jj = (F.G == 256 ? j : (int)blockIdx.x); jj < 256; jj += (F.G == 256 ? 256 : F.G)) {
        const unsigned char* sl = WSP(unsigned char, WS_PV) + (size_t)(l * 256 + jj) * NEXP * 8;
        { v4u fr_[16];
#pragma unroll
          for (int i = 0; i < 16; ++i) fr_[i] = *(const v4u*)(sl + (i * NTHR + F.tid) * 16);
          __builtin_amdgcn_sched_barrier(0);
#pragma unroll
          for (int i = 0; i < 16; ++i) *(LAS v4u*)(F.lds + (i * NTHR + F.tid) * 16) = fr_[i]; }
        __syncthreads();
        constexpr int NCH = 4 * (T / 64 / NWAVES);
#define PBL_PTR(c_, arr_) ((arr_) + ((size_t)(F.wave + NWAVES * ((c_) >> 2)) * 16 * 64 + lane) * 8 + ((c_) & 3) * 4 * 512)
        v4u iA[4], wA[4], iB[4], wB[4], iC[4], wC[4]; h16x2 acc[4];
#define PBL_STEP(X_, Z_, c_) do { const int cc_ = (c_); if (cc_ + 2 < NCH) pbl_load(i##Z_, w##Z_, PBL_PTR(cc_ + 2, IT), PBL_PTR(cc_ + 2, WT)); \
            __builtin_amdgcn_sched_barrier(0); \
            if ((cc_ & 3) == 0) { _Pragma("unroll") for (int q = 0; q < 4; ++q) acc[q] = (h16x2){(_Float16)0.f, (_Float16)0.f}; } \
            pbl_compute(i##X_, w##X_, acc, F.lds); \
            if ((cc_ & 3) == 3) { constexpr float us_ = 1.0f / 256.0f; v4u o; o.x = pk2((float)acc[0].x * us_, (float)acc[0].y * us_); o.y = pk2((float)acc[1].x * us_, (float)acc[1].y * us_); o.z = pk2((float)acc[2].x * us_, (float)acc[2].y * us_); o.w = pk2((float)acc[3].x * us_, (float)acc[3].y * us_); \
                *(v4u*)(OUT + (size_t)((F.wave + NWAVES * (cc_ >> 2)) * 64 + lane) * D + 8 * jj) = o; } \
            __builtin_amdgcn_sched_barrier(0); } while (0)
        pbl_load(iA, wA, PBL_PTR(0, IT), PBL_PTR(0, WT)); pbl_load(iB, wB, PBL_PTR(1, IT), PBL_PTR(1, WT));
#pragma unroll 1
        for (int c = 0; c < NCH; c += 3) {
            PBL_STEP(A, C, c);
            if (c + 1 < NCH) PBL_STEP(B, A, c + 1);
            if (c + 2 < NCH) PBL_STEP(C, B, c + 2);
        }
#undef PBL_STEP
#undef PBL_PTR
        __syncthreads();
    }
}
__device__ __forceinline__ void peer_res_phase(Frame& F, int l, bf16* XO) {
    PHASE_TID(F);
    const bool last = (l == 1);
    const int gw = F.vcu * NWAVES + F.wave, NGW = F.G * NWAVES, lane = F.lane;
    const bf16* XA = WSP(bf16, WS_XA); const bf16* OUTS = WSP(bf16, WS_GC); bf16* Hb = WSP(bf16, WS_H); const float* MOD = WSP(float, WS_MOD);
    for (int t = gw; t < T; t += NGW) {
        const int b = t >> 13; const float* g2 = MOD + (size_t)(l * 2 + b) * 12288 + 5 * 2048;
        f32x4 v[8], gq[8]; v2u oq[8], xq[8]; float ss = 0.f;
#pragma unroll
        for (int jj = 0; jj < 8; ++jj) { const int col = 4 * lane + 256 * jj; xq[jj] = *(const v2u*)(XA + (size_t)t * D + col); gq[jj] = *(const f32x4*)(g2 + col); oq[jj] = *(const v2u*)(OUTS + (size_t)t * D + col); }
        __builtin_amdgcn_sched_barrier(0);
#pragma unroll
        for (int jj = 0; jj < 8; ++jj) { const f32x4 o = {bflo(oq[jj].x), bfhi(oq[jj].x), bflo(oq[jj].y), bfhi(oq[jj].y)}; v[jj] = (f32x4){bflo(xq[jj].x), bfhi(xq[jj].x), bflo(xq[jj].y), bfhi(xq[jj].y)};
            v[jj] = v[jj] + gq[jj] * o; ss += (v[jj].x * v[jj].x + v[jj].y * v[jj].y) + (v[jj].z * v[jj].z + v[jj].w * v[jj].w); }
        const float rstd = 1.0f / sqrtf(wave_sum(ss) * (1.0f / D) + EPS);
        if (!last) {
            const float* ng = F.A->in[I_N1G] + (size_t)(l + 1) * D; const float* mn = MOD + (size_t)((l + 1) * 2 + b) * 12288;
#pragma unroll
            for (int jj = 0; jj < 8; ++jj) gq[jj] = *(const f32x4*)(ng + 4 * lane + 256 * jj);
            f32x4 shq[8], scq[8];
#pragma unroll
            for (int jj = 0; jj < 8; ++jj) { scq[jj] = *(const f32x4*)(mn + 2048 + 4 * lane + 256 * jj); shq[jj] = *(const f32x4*)(mn + 4 * lane + 256 * jj); }
            __builtin_amdgcn_sched_barrier(0);
#pragma unroll
            for (int jj = 0; jj < 8; ++jj) gq[jj] = gq[jj] * (scq[jj] + 1.0f);
#pragma unroll
            for (int jj = 0; jj < 8; ++jj) { const int col = 4 * lane + 256 * jj; v2u w; w.x = pk2(v[jj].x, v[jj].y); w.y = pk2(v[jj].z, v[jj].w); *(v2u*)(XO + (size_t)t * D + col) = w; v[jj] = v[jj] * rstd * gq[jj] + shq[jj]; }
            row_to_fp8(v, (unsigned char*)Hb + (size_t)t * D, WSP(float, WS_SA) + t, lane);
        } else {
            const float* fg = F.A->in[I_FG];
#pragma unroll
            for (int jj = 0; jj < 8; ++jj) gq[jj] = *(const f32x4*)(fg + 4 * lane + 256 * jj);
            __builtin_amdgcn_sched_barrier(0);
#pragma unroll
            for (int jj = 0; jj < 8; ++jj) *(f32x4*)(F.out + (size_t)t * D + 4 * lane + 256 * jj) = v[jj] * rstd * gq[jj];
        }
    }
}

#ifndef MK_ONE_LAUNCH
#define MK_ONE_LAUNCH 1
#endif
#define PG8_ALIGN true
#define PG8_SP2 true
constexpr int PH_PER_LAYER = 13, N_PHASES = 1 + 2 * PH_PER_LAYER;
__global__ void __launch_bounds__(NTHR, 2) fwd(Args args) {
    extern __shared__ __attribute__((aligned(16))) unsigned char lds[];
    Frame F;
    F.lds = (LAS unsigned char*)lds; F.MISC = (volatile LAS unsigned*)(F.lds + MISC_OFF);
    F.tid = threadIdx.x; F.lane = F.tid & 63; F.wave = __builtin_amdgcn_readfirstlane(F.tid >> 6);
    F.G = gridDim.x; { const int bx = blockIdx.x; F.vcu = (F.G % 8 == 0) ? (bx % 8) * (F.G / 8) + bx / 8 : bx; }
    F.A = &args;
    F.out = args.out; F.ws = args.ws; F.ctl = (gu32*)(args.ws + WS_CTL);
    for (int u = F.tid; u < (LDS_BYTES - LDSCTL_OFF) / 4; u += NTHR) ((LAS unsigned*)(F.lds + LDSCTL_OFF))[u] = 0u;
    __syncthreads();
#if MK_ONE_LAUNCH
    XcdBarrier bar = xcd_barrier_post((unsigned*)(F.ctl + CW_BAR), F.MISC + 8);
#define GRID_BAR() xcd_barrier(bar)
#else
#define GRID_BAR() do { } while (0)
#endif
    const int lo = args.ph_lo, hi = args.ph_hi;
#define IN(k) (lo <= (k) && (k) < hi)
#define SEAM(k) do { if (IN(k) && IN((k) + 1)) GRID_BAR(); } while (0)
    float* MOD = WSP(float, WS_MOD);
    pg8::bf16_t* Hb = WSP(pg8::bf16_t, WS_H);

    if (IN(0)) { p0_prologue(F); SEAM(0); }
    for (int l = 0; l < 2; ++l) {
        const int pb = 1 + PH_PER_LAYER * l;
        const float* modl = MOD + (size_t)l * 2 * 12288;
        if (IN(pb + 0) && l == 0) { norm_phase<true, false>(F, F.A->in[I_X], WSP(bf16, WS_H), F.A->in[I_N1G], modl, 0, 1);
            win8_phase(F);
            SEAM(pb + 0); }
        if (IN(pb + 1)) {
            pg8::Gemm g{Hb, (const pg8::bf16_t*)(WSP(unsigned char, WS_WIN) + (size_t)l * IN_DIM * 2048), T, IN_DIM, D / 2, D / 2, D / 2}; pg8::StaticOrder S; S.init(T, IN_DIM, F.G, (int)blockIdx.x);
            const float wmax = __uint_as_float(__hip_atomic_load(F.ctl + CW_WMAX + l, __ATOMIC_RELAXED, __HIP_MEMORY_SCOPE_AGENT));
            pg8::EpiInProj E{WSP(pg8::bf16_t, WS_U), WSP(pg8::bf16_t, WS_Q), WSP(pg8::bf16_t, WS_K), WSP(pg8::bf16_t, WS_V), WSP(pg8::bf16_t, WS_GC), WSP(pg8::bf16_t, WS_GA), WSP(float, WS_SA), wmax > 0.f ? wmax * (1.0f / 440.0f) : 1.0f, (unsigned*)(F.ctl + CW_VMAX + 2 * l)};
            pg8::gemm_phase<pg8::EpiInProj, pg8::StaticOrder, PG8_ALIGN, PG8_SP2, true>(F.lds, g, S, E);
            SEAM(pb + 1);
        }
        if (IN(pb + 2)) { conv_phase(F, l); __syncthreads(); attn_phase(F, l); SEAM(pb + 2); }
        if (IN(pb + 3)) {
            pg8::Gemm g{WSP(pg8::bf16_t, WS_AM), (const pg8::bf16_t*)(WSP(unsigned char, WS_WM) + (size_t)l * 2048 * 2048), T, D, D / 2, D / 2, D / 2}; pg8::StaticOrder S; S.init(T, D, F.G, (int)blockIdx.x);
            const float i440 = 1.0f / 440.0f;
            const float wc_ = __uint_as_float(__hip_atomic_load(F.ctl + CW_WMAX2 + 2 * l, __ATOMIC_RELAXED, __HIP_MEMORY_SCOPE_AGENT)), wa_ = __uint_as_float(__hip_atomic_load(F.ctl + CW_WMAX2 + 2 * l + 1, __ATOMIC_RELAXED, __HIP_MEMORY_SCOPE_AGENT));
            const float bc_ = __uint_as_float(__hip_atomic_load(F.ctl + CW_BC + l, __ATOMIC_RELAXED, __HIP_MEMORY_SCOPE_AGENT));
            const float swc = wc_ > 0.f ? wc_ * i440 : 1.0f, swa = wa_ > 0.f ? wa_ * i440 : 1.0f, sc = bc_ * i440;
            const float vm0 = __uint_as_float(__hip_atomic_load(F.ctl + CW_VMAX + 2 * l, __ATOMIC_RELAXED, __HIP_MEMORY_SCOPE_AGENT)), vm1 = __uint_as_float(__hip_atomic_load(F.ctl + CW_VMAX + 2 * l + 1, __ATOMIC_RELAXED, __HIP_MEMORY_SCOPE_AGENT));
            const float fe0 = (vm0 > 0.f ? 1.02f * vm0 * i440 : 1.0f) * swa, fe1 = (vm1 > 0.f ? 1.02f * vm1 * i440 : 1.0f) * swa;
            const float bc2 = __uint_as_float(__hip_atomic_load(F.ctl + CW_BC2 + l, __ATOMIC_RELAXED, __HIP_MEMORY_SCOPE_AGENT));
            const float bm0 = fmaxf(1024.0f * (bc2 * wc_ + 1.02f * vm0 * wa_), 1e-20f), bm1 = fmaxf(1024.0f * (bc2 * wc_ + 1.02f * vm1 * wa_), 1e-20f);
            pg8::EpiMerge E{WSP(pg8::bf16_t, WS_GC), WSP(pg8::bf16_t, WS_GA), WSP(unsigned char, WS_H), (sc * swc) / fe0, (sc * swc) / fe1, fe0 * (440.0f / bm0), fe1 * (440.0f / bm1)};
            pg8::gemm_phase<pg8::EpiMerge, pg8::StaticOrder, PG8_ALIGN, PG8_SP2, true>(F.lds, g, S, E);
            SEAM(pb + 3);
        }
        if (IN(pb + 5)) {
            pg8::Gemm g{Hb, (const pg8::bf16_t*)(WSP(unsigned char, WS_WO) + (size_t)l * 2048 * 2048), T, D, D / 2, D / 2, D / 2}; pg8::StaticOrder S; S.init(T, D, F.G, (int)blockIdx.x);
            const float i440 = 1.0f / 440.0f;
            const float wc_ = __uint_as_float(__hip_atomic_load(F.ctl + CW_WMAX2 + 2 * l, __ATOMIC_RELAXED, __HIP_MEMORY_SCOPE_AGENT)), wa_ = __uint_as_float(__hip_atomic_load(F.ctl + CW_WMAX2 + 2 * l + 1, __ATOMIC_RELAXED, __HIP_MEMORY_SCOPE_AGENT));
            const float wo_ = __uint_as_float(__hip_atomic_load(F.ctl + CW_WMAX3 + l, __ATOMIC_RELAXED, __HIP_MEMORY_SCOPE_AGENT)), swo = wo_ > 0.f ? wo_ * i440 : 1.0f;
            const float bc2 = __uint_as_float(__hip_atomic_load(F.ctl + CW_BC2 + l, __ATOMIC_RELAXED, __HIP_MEMORY_SCOPE_AGENT));
            const float vm0 = __uint_as_float(__hip_atomic_load(F.ctl + CW_VMAX + 2 * l, __ATOMIC_RELAXED, __HIP_MEMORY_SCOPE_AGENT)), vm1 = __uint_as_float(__hip_atomic_load(F.ctl + CW_VMAX + 2 * l + 1, __ATOMIC_RELAXED, __HIP_MEMORY_SCOPE_AGENT));
            const float bm0 = fmaxf(1024.0f * (bc2 * wc_ + 1.02f * vm0 * wa_), 1e-20f), bm1 = fmaxf(1024.0f * (bc2 * wc_ + 1.02f * vm1 * wa_), 1e-20f);
            if (l == 0) { pg8::EpiResid<false> E{F.A->in[I_X], WSP(pg8::bf16_t, WS_XA), modl + 2 * 2048, bm0 * i440 * swo, bm1 * i440 * swo};
                pg8::gemm_phase<pg8::EpiResid<false>, pg8::StaticOrder, PG8_ALIGN, PG8_SP2, true>(F.lds, g, S, E); }
            else { pg8::EpiResid<true> E{WSP(pg8::bf16_t, WS_XA), WSP(pg8::bf16_t, WS_XA), modl + 2 * 2048, bm0 * i440 * swo, bm1 * i440 * swo};
                pg8::gemm_phase<pg8::EpiResid<true>, pg8::StaticOrder, PG8_ALIGN, PG8_SP2, true>(F.lds, g, S, E); }
            SEAM(pb + 5);
        }
        if (IN(pb + 6)) { norm_phase<false, true>(F, WSP(bf16, WS_XA), WSP(bf16, WS_H), F.A->in[I_N2G] + (size_t)l * D, modl, 3, 4); SEAM(pb + 6); }
        if (IN(pb + 7)) {
            pg8::Gemm g{Hb, WSP(pg8::bf16_t, WS_WP) + (size_t)l * 2048 * 2048, T, D, D, D, D}; pg8::StaticOrder S; S.init(T, D, F.G, (int)blockIdx.x);
            pg8::EpiF16 E{WSP(_Float16, WS_GC), D};
            pg8::gemm_phase<pg8::EpiF16, pg8::StaticOrder, PG8_ALIGN, PG8_SP2>(F.lds, g, S, E);
            SEAM(pb + 7);
        }
        if (IN(pb + 8)) { topk_phase(F); SEAM(pb + 8); }
        if (IN(pb + 9)) { peer_act_phase(F, l); SEAM(pb + 9); }
        if (IN(pb + 10)) { peer_w_phase(F, l); SEAM(pb + 10); }
        if (IN(pb + 11)) { peer_out_phase(F, l); SEAM(pb + 11); }
        if (IN(pb + 12)) { peer_res_phase(F, l, WSP(bf16, WS_XA)); SEAM(pb + 12); }
    }
#undef IN
#undef SEAM
}

extern "C" void kernel_launch(void* const* d_in, const int* in_sizes, int n_in, void* d_out, int out_size, void* d_ws, size_t ws_size, hipStream_t stream) {
    static int grid = 0;
    if (grid == 0) {
        if (n_in != N_IN || out_size != T * D || ws_size < WS_END) { fprintf(stderr, "kernel_launch: unexpected problem: n_in %d out %d ws %zu (need %zu)\n", n_in, out_size, ws_size, (size_t)WS_END); grid = -1; return; }
        int dev = 0, cus = 0, per_cu = 0;
        if (hipGetDevice(&dev) != hipSuccess || hipDeviceGetAttribute(&cus, hipDeviceAttributeMultiprocessorCount, dev) != hipSuccess) { grid = -1; return; }
        if (hipFuncSetAttribute((const void*)fwd, hipFuncAttributeMaxDynamicSharedMemorySize, LDS_BYTES) != hipSuccess) { fprintf(stderr, "kernel_launch: hipFuncSetAttribute failed\n"); grid = -1; return; }
        if (hipOccupancyMaxActiveBlocksPerMultiprocessor(&per_cu, (const void*)fwd, NTHR, LDS_BYTES) != hipSuccess || per_cu < 1) fprintf(stderr, "kernel_launch: occupancy query reports %d\n", per_cu);
        (void)hipGetLastError();
        grid = cus;
    }
    if (grid < 0) return;
    (void)in_sizes;
    if (hipMemsetAsync((char*)d_ws + WS_CTL, 0, CTL_ZERO_BYTES, stream) != hipSuccess) return;
    Args a{};
    for (int i = 0; i < N_IN; ++i) a.in[i] = (const float*)d_in[i];
    a.out = (float*)d_out; a.ws = (unsigned char*)d_ws;
#if MK_ONE_LAUNCH
    a.ph_lo = 0; a.ph_hi = N_PHASES;
    hipLaunchKernelGGL(fwd, dim3(grid), dim3(NTHR), LDS_BYTES, stream, a);
#else
    for (int p = 0; p < N_PHASES; ++p) {
        if (p == 1 + PH_PER_LAYER) continue;
        a.ph_lo = p; a.ph_hi = p + 1;
        hipLaunchKernelGGL(fwd, dim3(grid), dim3(NTHR), LDS_BYTES, stream, a);
    }
#endif
}
```

```cpp
#include <hip/hip_runtime.h>
#include <cstdio>
#include <cstdint>
namespace pg8 {
#define PG8_LAS __attribute__((address_space(3)))
typedef unsigned short bf16_t;
typedef short bf16x8 __attribute__((ext_vector_type(8)));
typedef float f32x4 __attribute__((ext_vector_type(4)));
typedef unsigned u32x4 __attribute__((ext_vector_type(4)));
typedef int i32x4 __attribute__((ext_vector_type(4)));
typedef int i32x8 __attribute__((ext_vector_type(8)));
__device__ __forceinline__ i32x8 cat8(const bf16x8& a, const bf16x8& b) { const i32x4 x = __builtin_bit_cast(i32x4, a), y = __builtin_bit_cast(i32x4, b); return (i32x8){x[0], x[1], x[2], x[3], y[0], y[1], y[2], y[3]}; }
constexpr int BM = 256, BK = 64, HALF = 128, HTB = HALF * BK * 2  , STAGE_BYTES = 8 * HTB, NXCD = 8, WGM = 4;

__host__ __device__ __forceinline__ int lds_byte(int r, int c) { const int st = (r >> 4) * 2 + (c >> 5), rr = r & 15, cc = c & 31, ob = rr * 64 + cc * 2; return st * 1024 + (ob ^ (((ob >> 9) & 1) << 5)); }
__host__ __device__ __forceinline__ void stage_rc(int b, int& R, int& C) { const int st = b / 1024, sb = b % 1024, swz = sb ^ (((sb >> 9) & 1) << 5); R = (st >> 1) * 16 + swz / 64; C = (st & 1) * 32 + (swz % 64) / 2; }
__host__ __device__ __forceinline__ int perm32(int rho) { const int n = rho >> 4, i = rho & 15; return 8 * (i >> 2) + 4 * n + (i & 3); }

struct Unit { int pm, pn; };
struct Gemm { const bf16_t* A; const bf16_t* Bt; int M, N, K, lda, ldb; };

struct StaticOrder {
    int nM, nN, nwg, G, c, wgm;
    __host__ __device__ void init(int M, int N, int G_, int c_, int wgm_ = WGM) { nM = M / BM; nN = N / BM; nwg = nM * nN; G = G_; c = c_; wgm = wgm_; }
    __host__ __device__ bool next(int i, Unit& u) const {
        const long L = (long)i * G + c; if (L >= nwg) return false;
        int wgid = (int)L; { const int q = nwg / NXCD, r = nwg % NXCD, xcd = wgid % NXCD, off = wgid / NXCD; wgid = (xcd < r ? xcd * (q + 1) : r * (q + 1) + (xcd - r) * q) + off; }
        const int nig = wgm * nN, gid = wgid / nig, fm = gid * wgm, gsz = (nM - fm) < wgm ? (nM - fm) : wgm;
        u.pm = fm + ((wgid % nig) % gsz); u.pn = (wgid % nig) / gsz; return true;
    }
    __device__ __forceinline__ void a_ready(const Unit&) const {}
    __device__ __forceinline__ void done(const Unit&) const {}
};

__device__ __forceinline__ unsigned cvt_pk_bf16(float lo, float hi) { unsigned r; asm volatile("v_cvt_pk_bf16_f32 %0, %1, %2" : "=v"(r) : "v"(lo), "v"(hi)); return r; }
typedef float f32x2 __attribute__((ext_vector_type(2)));
template <class Epi, class Sched, bool ALIGN_EPI = false, bool SP2 = false, bool FP8 = false>
__device__ __forceinline__ void gemm_phase(PG8_LAS unsigned char* lds, const Gemm g, const Sched& S, const Epi& E) {
    int tid_ = threadIdx.x; asm volatile("" : "+v"(tid_));
    const int tid = tid_, wid = __builtin_amdgcn_readfirstlane(tid >> 6), lane = tid & 63, wr = wid >> 2, wc = wid & 3, fr = lane & 15, fq = lane >> 4;
    const int K = g.K, nt = K / BK;
    unsigned voffA[2], voffB[2];
#pragma unroll
    for (int i = 0; i < 2; ++i) { int R, C; stage_rc(tid * 16 + i * 8192, R, C); const int Rb = Epi::PERM ? ((R & ~31) + perm32(R & 31)) : R;
        voffA[i] = (unsigned)(R * g.lda + C) * 2u; voffB[i] = (unsigned)(Rb * g.ldb + C) * 2u; }
    const size_t kstep = (size_t)(BK * 2);
    const size_t hstepA = (size_t)HALF * g.lda * 2, hstepB = (size_t)HALF * g.ldb * 2;
    const size_t tstepA = 2 * hstepA, tstepB = 2 * hstepB;
    const unsigned ldsw = (unsigned)wid * 1024u;
    const int aoff = lds_byte(wr * 64 + fr, fq * 8), boff = lds_byte(wc * 32 + fr, fq * 8);
#define PG8_SA(b, h) (((b) * 2 + (h)) * HTB)
#define PG8_SB(b, h) ((4 + (b) * 2 + (h)) * HTB)
#define PG8_STAGE(bufoff, gbase, voff) do { _Pragma("unroll") for (int _i = 0; _i < 2; ++_i) \
        __builtin_amdgcn_global_load_lds((const unsigned*)((const char*)(gbase) + (voff)[_i]), (PG8_LAS unsigned*)(lds + (bufoff) + ldsw + _i * 8192), 16, 0, 0); } while (0)
#define PG8_LDA(dst, b, h) do { _Pragma("unroll") for (int m = 0; m < 4; ++m) _Pragma("unroll") for (int k = 0; k < 2; ++k) dst[m][k] = *(const PG8_LAS bf16x8*)(lds + PG8_SA(b, h) + aoff + m * 2048 + k * 1024); } while (0)
#define PG8_LDB(dst, b, h) do { _Pragma("unroll") for (int n = 0; n < 2; ++n) _Pragma("unroll") for (int k = 0; k < 2; ++k) dst[n][k] = *(const PG8_LAS bf16x8*)(lds + PG8_SB(b, h) + boff + n * 2048 + k * 1024); } while (0)
#define PG8_MMA(ai, bj, At, Bt) do { __builtin_amdgcn_s_setprio(1); _Pragma("unroll") for (int m = 0; m < 4; ++m) _Pragma("unroll") for (int n = 0; n < 2; ++n) { \
        if constexpr (FP8) { asm volatile("v_mfma_f32_16x16x128_f8f6f4 %0, %1, %2, %0" : "+v"(acc[ai][bj][m][n]) : "v"(cat8(Bt[n][0], Bt[n][1])), "v"(cat8(At[m][0], At[m][1]))); } \
        else { _Pragma("unroll") for (int k = 0; k < 2; ++k) acc[ai][bj][m][n] = __builtin_amdgcn_mfma_f32_16x16x32_bf16(Bt[n][k], At[m][k], acc[ai][bj][m][n], 0, 0, 0); } } __builtin_amdgcn_s_setprio(0); } while (0)
#define PG8_WAIT_V(n) asm volatile("s_waitcnt vmcnt(" #n ")" ::: "memory")
#define PG8_WAIT_L(n) asm volatile("s_waitcnt lgkmcnt(" #n ")" ::: "memory")
#define PG8_BAR __builtin_amdgcn_s_barrier()
#define PG8_SCHED __builtin_amdgcn_sched_barrier(0)
    Unit cur, nxt; int ui = 0;
    if (!S.next(0, cur)) return;
    f32x4 acc[2][2][4][2];
#pragma unroll
    for (int a = 0; a < 2; ++a)
#pragma unroll
        for (int b = 0; b < 2; ++b)
#pragma unroll
            for (int m = 0; m < 4; ++m)
#pragma unroll
                for (int n = 0; n < 2; ++n) acc[a][b][m][n] = (f32x4){0.f, 0.f, 0.f, 0.f};
    bf16x8 At[4][2], B0[2][2], B1[2][2];
    const char* cA = (const char*)g.A + (size_t)cur.pm * tstepA; const char* cB = (const char*)g.Bt + (size_t)cur.pn * tstepB;
    S.a_ready(cur);
    if constexpr (SP2) {
        PG8_STAGE(PG8_SB(0, 0), cB, voffB); PG8_STAGE(PG8_SB(0, 1), cB + hstepB, voffB); PG8_STAGE(PG8_SA(0, 0), cA, voffA); PG8_STAGE(PG8_SA(0, 1), cA + hstepA, voffA);
        if (wr == 1) PG8_BAR;
        PG8_WAIT_V(2); PG8_BAR;
        PG8_STAGE(PG8_SB(1, 0), cB + kstep, voffB); PG8_STAGE(PG8_SA(1, 0), cA + kstep, voffA); PG8_STAGE(PG8_SB(1, 1), cB + hstepB + kstep, voffB);
        PG8_WAIT_V(6); PG8_BAR;
    } else {
        PG8_STAGE(PG8_SB(0, 0), cB, voffB); PG8_STAGE(PG8_SA(0, 0), cA, voffA); PG8_STAGE(PG8_SB(0, 1), cB + hstepB, voffB); PG8_STAGE(PG8_SA(0, 1), cA + hstepA, voffA);
        if (wr == 1) PG8_BAR;
        PG8_WAIT_V(4); PG8_BAR;
        PG8_STAGE(PG8_SB(1, 0), cB + kstep, voffB); PG8_STAGE(PG8_SA(1, 0), cA + kstep, voffA); PG8_STAGE(PG8_SB(1, 1), cB + hstepB + kstep, voffB);
        PG8_WAIT_V(6); PG8_BAR;
    }
    for (;;) {
        const bool has_next = S.next(ui + 1, nxt);
        const char* nA = has_next ? (const char*)g.A + (size_t)nxt.pm * tstepA : cA; const char* nB = has_next ? (const char*)g.Bt + (size_t)nxt.pn * tstepB : cB;
        for (int t = 0; t < nt; t += 2) {
            if constexpr (Epi::HAS_MID) { if (t == (nt >> 1)) { if constexpr (FP8) { asm volatile("s_nop 15\n\ts_nop 15" ::: "memory"); }
                E.mid(acc, cur, wr, wc, fr, fq); } }
            const bool last = (t == nt - 2);
            const char* a1 = cA + (size_t)(t + 1) * kstep;
            const char* a2 = last ? nA : cA + (size_t)(t + 2) * kstep; const char* b2 = last ? nB : cB + (size_t)(t + 2) * kstep;
            const char* a3 = a2 + kstep; const char* b3 = b2 + kstep;
            if (last && has_next) S.a_ready(nxt);
            if constexpr (SP2) {
            PG8_LDB(B0, 0, 0); PG8_LDB(B1, 0, 1); PG8_SCHED; PG8_LDA(At, 0, 0); PG8_STAGE(PG8_SA(1, 1), a1 + hstepA, voffA);
            PG8_WAIT_V(8); PG8_WAIT_L(0); PG8_BAR; PG8_MMA(0, 0, At, B0); PG8_MMA(0, 1, At, B1); PG8_BAR; PG8_SCHED;
            PG8_LDA(At, 0, 1); PG8_STAGE(PG8_SB(0, 0), b2, voffB); PG8_STAGE(PG8_SB(0, 1), b2 + hstepB, voffB); PG8_STAGE(PG8_SA(0, 0), a2, voffA);
            PG8_WAIT_V(8); PG8_WAIT_L(0); PG8_BAR; PG8_MMA(1, 0, At, B0); PG8_MMA(1, 1, At, B1); PG8_BAR; PG8_SCHED;
            PG8_LDB(B0, 1, 0); PG8_LDB(B1, 1, 1); PG8_SCHED; PG8_LDA(At, 1, 0); PG8_STAGE(PG8_SA(0, 1), a2 + hstepA, voffA);
            PG8_WAIT_V(8); PG8_WAIT_L(0); PG8_BAR; PG8_MMA(0, 0, At, B0); PG8_MMA(0, 1, At, B1); PG8_BAR; PG8_SCHED;
            PG8_LDA(At, 1, 1); PG8_STAGE(PG8_SB(1, 0), b3, voffB); PG8_STAGE(PG8_SB(1, 1), b3 + hstepB, voffB); PG8_STAGE(PG8_SA(1, 0), a3, voffA);
            PG8_WAIT_V(8); PG8_WAIT_L(0); PG8_BAR; PG8_MMA(1, 0, At, B0); PG8_MMA(1, 1, At, B1); PG8_BAR; PG8_SCHED;
            } else {
            PG8_LDB(B0, 0, 0); PG8_SCHED; PG8_LDA(At, 0, 0); PG8_STAGE(PG8_SA(1, 1), a1 + hstepA, voffA);
            PG8_WAIT_L(8); PG8_BAR; PG8_WAIT_L(0); PG8_MMA(0, 0, At, B0); PG8_BAR; PG8_SCHED;
            PG8_LDB(B1, 0, 1); PG8_STAGE(PG8_SB(0, 0), b2, voffB);
            PG8_BAR; PG8_WAIT_L(0); PG8_MMA(0, 1, At, B1); PG8_BAR;
            PG8_LDA(At, 0, 1); PG8_STAGE(PG8_SA(0, 0), a2, voffA);
            PG8_BAR; PG8_WAIT_L(0); PG8_MMA(1, 0, At, B0); PG8_BAR; PG8_SCHED;
            PG8_STAGE(PG8_SB(0, 1), b2 + hstepB, voffB);
            PG8_WAIT_V(6); PG8_BAR; PG8_MMA(1, 1, At, B1); PG8_BAR;
            PG8_LDB(B0, 1, 0); PG8_SCHED; PG8_LDA(At, 1, 0); PG8_STAGE(PG8_SA(0, 1), a2 + hstepA, voffA);
            PG8_WAIT_L(8); PG8_BAR; PG8_WAIT_L(0); PG8_MMA(0, 0, At, B0); PG8_BAR; PG8_SCHED;
            PG8_LDB(B1, 1, 1); PG8_STAGE(PG8_SB(1, 0), b3, voffB);
            PG8_BAR; PG8_WAIT_L(0); PG8_MMA(0, 1, At, B1); PG8_BAR;
            PG8_LDA(At, 1, 1); PG8_STAGE(PG8_SA(1, 0), a3, voffA);
            PG8_BAR; PG8_WAIT_L(0); PG8_MMA(1, 0, At, B0); PG8_BAR; PG8_SCHED;
            PG8_STAGE(PG8_SB(1, 1), b3 + hstepB, voffB);
            PG8_WAIT_V(6); PG8_BAR; PG8_MMA(1, 1, At, B1); PG8_BAR;
            }
        }
        if constexpr (FP8) { asm volatile("s_nop 15\n\ts_nop 15" ::: "memory"); }
        if constexpr (ALIGN_EPI) { if (wr == 0) PG8_BAR; }
        if constexpr (!Epi::AFTER_DRAIN) { E(acc, cur, wr, wc, fr, fq); S.done(cur); }
        if (!has_next) break;
#pragma unroll
        for (int a = 0; a < 2; ++a)
#pragma unroll
            for (int b = 0; b < 2; ++b)
#pragma unroll
                for (int m = 0; m < 4; ++m)
#pragma unroll
                    for (int n = 0; n < 2; ++n) acc[a][b][m][n] = (f32x4){0.f, 0.f, 0.f, 0.f};
        cur = nxt; cA = nA; cB = nB; ++ui;
        if constexpr (ALIGN_EPI) { if (wr == 1) PG8_BAR; }
    }
    PG8_WAIT_V(0);
    if constexpr (!ALIGN_EPI) { if (wr == 0) PG8_BAR; }
    PG8_BAR;
    if constexpr (Epi::AFTER_DRAIN) { E.fused(acc, cur, wr, wc, fr, fq, lds, wid, lane); S.done(cur); }
#undef PG8_SA
#undef PG8_SB
#undef PG8_STAGE
#undef PG8_LDA
#undef PG8_LDB
#undef PG8_MMA
#undef PG8_WAIT_V
#undef PG8_WAIT_L
#undef PG8_BAR
#undef PG8_SCHED
}
}

constexpr int T = 16384, D = 2048, SEQ = 8192, CONV = 1024, CWID = 31, NHEAD = 16, NKVH = 4, HD = 64, ATT = 1024, KVD = 256, IN_DIM = 7680, NEXP = 16384, PHEADS = 8, TOPK = 16;
constexpr float EPS = 1e-6f;
constexpr int NSL = 16, SLW = 128;
constexpr int NWAVES = 8, NTHR = NWAVES * 64;
enum { I_X = 0, I_C, I_RELB, I_ADAW, I_ADAB, I_N1G, I_WIN, I_DWW, I_DWB, I_CLNG, I_CLNB, I_WCO, I_SINK, I_WAO, I_WOUT, I_N2G, I_WPQ, I_SK, I_PU, I_PV, I_FG, N_IN };

constexpr size_t MiB = 1u << 20;
constexpr size_t WS_CTL = 0, CTL_ZERO_BYTES = 1 * MiB;
constexpr size_t WS_MOD = 1 * MiB;
constexpr size_t WS_BIAS = 1 * MiB + 512 * 1024;
constexpr size_t WS_SCL = 1 * MiB + 640 * 1024;
constexpr size_t WS_WIN = 2 * MiB;
constexpr size_t WS_SA = 1 * MiB + 896 * 1024;
constexpr size_t WS_WM = 62 * MiB;
constexpr size_t WS_WO = 78 * MiB;
constexpr size_t WS_WP = 94 * MiB;
constexpr size_t WS_PU = 110 * MiB;
constexpr size_t WS_PV = 238 * MiB;
constexpr size_t WS_H = 366 * MiB;
constexpr size_t WS_U = 430 * MiB;
constexpr size_t WS_Q = 462 * MiB;
constexpr size_t WS_K = 494 * MiB;
constexpr size_t WS_V = 502 * MiB;
constexpr size_t WS_GC = 510 * MiB;
constexpr size_t WS_GA = 574 * MiB;
constexpr size_t WS_AM = 638 * MiB;
constexpr size_t WS_Y1 = 702 * MiB;
constexpr size_t WS_XA = 766 * MiB;
constexpr size_t WS_END = 894 * MiB;
constexpr int CW_TMO = 0, CW_QUEUE = 64, CW_QUEUE2 = 128, CW_WMAX = 192, CW_WMAX2 = 194, CW_WMAX3 = 198, CW_VMAX = 200, CW_BC = 204, CW_BC2 = 206, CW_BAR = 4096;

constexpr int RING_BYTES = 131072, LDSCTL_OFF = RING_BYTES, MISC_OFF = LDSCTL_OFF + 320, LDS_BYTES = 147456;

#define GAS __attribute__((address_space(1)))
#define LAS __attribute__((address_space(3)))
typedef unsigned short bf16;
typedef unsigned v4u __attribute__((ext_vector_type(4)));
typedef unsigned v2u __attribute__((ext_vector_type(2)));
typedef float f32x4 __attribute__((ext_vector_type(4)));
typedef float f32x2 __attribute__((ext_vector_type(2)));
typedef float f32x16 __attribute__((ext_vector_type(16)));
typedef short bf16x8 __attribute__((ext_vector_type(8)));
typedef __bf16 bf16x2v __attribute__((ext_vector_type(2)));
typedef GAS unsigned gu32;
#define LDS_WAIT() asm volatile("s_waitcnt lgkmcnt(0)" ::: "memory")
#define VM_WAIT() asm volatile("s_waitcnt vmcnt(0)" ::: "memory")
__device__ __forceinline__ unsigned f2bf(float f) { unsigned u = __builtin_bit_cast(unsigned, f); return (u + 0x7fffu + ((u >> 16) & 1u)) >> 16; }
__device__ __forceinline__ unsigned pk2(float lo, float hi) { f32x2 v = {lo, hi}; bf16x2v b = __builtin_convertvector(v, bf16x2v); return __builtin_bit_cast(unsigned, b); }
__device__ __forceinline__ float bflo(unsigned p) { return __uint_as_float(p << 16); }
__device__ __forceinline__ float bfhi(unsigned p) { return __uint_as_float(p & 0xffff0000u); }
__device__ __forceinline__ float sigmoidf_(float x) { return __builtin_amdgcn_rcpf(1.0f + __expf(-x)); }
__device__ __forceinline__ float dot2bf(unsigned a, unsigned b, float c) { return __builtin_amdgcn_fdot2_f32_bf16(__builtin_bit_cast(bf16x2v, a), __builtin_bit_cast(bf16x2v, b), c, false); }
__device__ __forceinline__ float wave_sum(float v) {
#pragma unroll
    for (int o = 1; o < 64; o <<= 1) v += __shfl_xor(v, o);
    return v;
}

template <int CTRL> __device__ __forceinline__ float dpp_mov(float v) { return __builtin_bit_cast(float, __builtin_amdgcn_update_dpp(0, __builtin_bit_cast(int, v), CTRL, 0xf, 0xf, true)); }
__device__ __forceinline__ float lane_xor1(float v) { return dpp_mov<0xB1>(v); }
__device__ __forceinline__ float lane_xor2(float v) { return dpp_mov<0x4E>(v); }
__device__ __forceinline__ float lane_xor4(float v) { return dpp_mov<0x141>(dpp_mov<0x1B>(v)); }
__device__ __forceinline__ float lane_xor8(float v) { return dpp_mov<0x128>(v); }
__device__ __forceinline__ float lane_xor16(float v) { return __builtin_bit_cast(float, __builtin_amdgcn_ds_swizzle(__builtin_bit_cast(int, v), 0x401F)); }

namespace pg8 {
__device__ __forceinline__ float sigm(float x) { return __builtin_amdgcn_rcpf(1.0f + __expf(-x)); }
__device__ __forceinline__ u32x4 pack8(const f32x4& v0, const f32x4& v1) { u32x4 w; w.x = cvt_pk_bf16(v0[0], v0[1]); w.y = cvt_pk_bf16(v0[2], v0[3]); w.z = cvt_pk_bf16(v1[0], v1[1]); w.w = cvt_pk_bf16(v1[2], v1[3]); return w; }
__device__ __forceinline__ float blo(unsigned p) { return __uint_as_float(p << 16); }
__device__ __forceinline__ float bhi(unsigned p) { return __uint_as_float(p & 0xffff0000u); }
struct EpiInProj {
    static constexpr bool PERM = true, AFTER_DRAIN = false, HAS_MID = false;
    bf16_t *U, *Q, *K, *V, *GC, *GA; const float* sa; float sw; unsigned* vmax;
    __device__ __forceinline__ void operator()(const f32x4 (&acc)[2][2][4][2], const Unit& u, int wr, int wc, int fr, int fq) const {
        const int row0 = u.pm * BM + wr * 64 + fr, cw = wc * 32 + 8 * fq, pn = u.pn;
        float rsv[2][4];
        { const float* sp = sa + row0;
          asm volatile("global_load_dword %0, %8, off\n\tglobal_load_dword %1, %8, off offset:64\n\tglobal_load_dword %2, %8, off offset:128\n\tglobal_load_dword %3, %8, off offset:192\n\t"
                       "global_load_dword %4, %8, off offset:512\n\tglobal_load_dword %5, %8, off offset:576\n\tglobal_load_dword %6, %8, off offset:640\n\tglobal_load_dword %7, %8, off offset:704\n\ts_waitcnt vmcnt(0)"
                       : "=&v"(rsv[0][0]), "=&v"(rsv[0][1]), "=&v"(rsv[0][2]), "=&v"(rsv[0][3]), "=&v"(rsv[1][0]), "=&v"(rsv[1][1]), "=&v"(rsv[1][2]), "=&v"(rsv[1][3]) : "v"(sp) : "memory"); }
        if (pn < 8) {
#pragma unroll
            for (int ai = 0; ai < 2; ++ai)
#pragma unroll
                for (int m = 0; m < 4; ++m) { bf16_t* p = U + (size_t)(row0 + ai * HALF + m * 16) * 1024 + pn * 128 + cw; const float rs = rsv[ai][m] * sw;
                    f32x4 a0 = acc[ai][0][m][0] * rs, a1 = acc[ai][0][m][1] * rs; const f32x4 b0 = acc[ai][1][m][0] * rs, b1 = acc[ai][1][m][1] * rs;
#pragma unroll
                    for (int i = 0; i < 4; ++i) { a0[i] *= sigm(b0[i]); a1[i] *= sigm(b1[i]); }
                    *(u32x4*)p = pack8(a0, a1); }
        } else {
            bf16_t* base; int ld, cb, mode;
            if (pn < 12) { base = Q; ld = 1024; cb = (pn - 8) * 256; mode = 0; }
            else if (pn == 12) { base = K; ld = 256; cb = 0; mode = 1; }
            else if (pn == 13) { base = V; ld = 256; cb = 0; mode = 1; }
            else if (pn < 22) { base = GC; ld = 2048; cb = (pn - 14) * 256; mode = 2; }
            else { base = GA; ld = 2048; cb = (pn - 22) * 256; mode = 2; }
            float vm = 0.f;
#pragma unroll
            for (int ai = 0; ai < 2; ++ai)
#pragma unroll
                for (int m = 0; m < 4; ++m) { bf16_t* p = base + (size_t)(row0 + ai * HALF + m * 16) * ld + cb + cw; const float rs = rsv[ai][m] * sw;
#pragma unroll
                    for (int bj = 0; bj < 2; ++bj) { f32x4 v0 = acc[ai][bj][m][0] * rs, v1 = acc[ai][bj][m][1] * rs;
                        if (pn == 13) vm = fmaxf(vm, fmaxf(fmaxf(fmaxf(fabsf(v0[0]), fabsf(v0[1])), fmaxf(fabsf(v0[2]), fabsf(v0[3]))), fmaxf(fmaxf(fabsf(v1[0]), fabsf(v1[1])), fmaxf(fabsf(v1[2]), fabsf(v1[3])))));
                        if (mode == 0) { v0 = v0 * 0.125f; v1 = v1 * 0.125f; }
                        else if (mode == 2) {
#pragma unroll
                            for (int i = 0; i < 4; ++i) { v0[i] = sigm(v0[i]); v1[i] = sigm(v1[i]); } }
                        *(u32x4*)(p + bj * HALF) = pack8(v0, v1); } }
            if (pn == 13) {
#pragma unroll
                for (int o = 1; o < 64; o <<= 1) vm = fmaxf(vm, __shfl_xor(vm, o));
                if ((threadIdx.x & 63) == 0) __hip_atomic_fetch_max(vmax + (u.pm >> 5), __float_as_uint(vm), __ATOMIC_RELAXED, __HIP_MEMORY_SCOPE_AGENT); }
        }
    }
};
struct EpiMerge {
    static constexpr bool PERM = true, AFTER_DRAIN = false, HAS_MID = true;
    const bf16_t* GC; const bf16_t* GA; unsigned char* O; float fmid0, fmid1, fend0, fend1;
    __device__ __forceinline__ void mid(f32x4 (&acc)[2][2][4][2], const Unit& u, int wr, int wc, int fr, int fq) const {
        int row0 = u.pm * BM + wr * 64 + fr, c0 = u.pn * BM + wc * 32 + 8 * fq; const float fmd = (u.pm >> 5) ? fmid1 : fmid0;
        asm volatile("" : "+v"(row0), "+v"(c0));
#pragma unroll
        for (int ai = 0; ai < 2; ++ai)
#pragma unroll
            for (int mh = 0; mh < 2; ++mh) { u32x4 gc[2][2], ga[2][2];
#pragma unroll
                for (int mm = 0; mm < 2; ++mm)
#pragma unroll
                    for (int bj = 0; bj < 2; ++bj) { const size_t off = (size_t)(row0 + ai * HALF + (2 * mh + mm) * 16) * 2048 + c0 + bj * HALF; gc[mm][bj] = *(const u32x4*)(GC + off); ga[mm][bj] = *(const u32x4*)(GA + off); }
                __builtin_amdgcn_sched_barrier(0);
#pragma unroll
                for (int mm = 0; mm < 2; ++mm)
#pragma unroll
                    for (int bj = 0; bj < 2; ++bj) { const int m = 2 * mh + mm; const u32x4 c = gc[mm][bj], a = ga[mm][bj];
#define RT_(cw_, aw_, HI_) ((HI_ ? bhi(cw_) : blo(cw_)) * fmd * __builtin_amdgcn_rcpf(fmaxf(HI_ ? bhi(aw_) : blo(aw_), 1e-30f)))
                        acc[ai][bj][m][0][0] *= RT_(c.x, a.x, 0); acc[ai][bj][m][0][1] *= RT_(c.x, a.x, 1); acc[ai][bj][m][0][2] *= RT_(c.y, a.y, 0); acc[ai][bj][m][0][3] *= RT_(c.y, a.y, 1);
                        acc[ai][bj][m][1][0] *= RT_(c.z, a.z, 0); acc[ai][bj][m][1][1] *= RT_(c.z, a.z, 1); acc[ai][bj][m][1][2] *= RT_(c.w, a.w, 0); acc[ai][bj][m][1][3] *= RT_(c.w, a.w, 1);
#undef RT_
                    }
                __builtin_amdgcn_sched_barrier(0); }
    }
    __device__ __forceinline__ void operator()(const f32x4 (&acc)[2][2][4][2], const Unit& u, int wr, int wc, int fr, int fq) const {
        const int row0 = u.pm * BM + wr * 64 + fr, c0 = u.pn * BM + wc * 32 + 8 * fq; const float fe = (u.pm >> 5) ? fend1 : fend0;
#pragma unroll
        for (int ai = 0; ai < 2; ++ai) { u32x4 g[4][2];
#pragma unroll
            for (int m = 0; m < 4; ++m)
#pragma unroll
                for (int bj = 0; bj < 2; ++bj) g[m][bj] = *(const u32x4*)(GA + (size_t)(row0 + ai * HALF + m * 16) * 2048 + c0 + bj * HALF);
            __builtin_amdgcn_sched_barrier(0);
#pragma unroll
            for (int m = 0; m < 4; ++m)
#pragma unroll
                for (int bj = 0; bj < 2; ++bj) { const size_t off = (size_t)(row0 + ai * HALF + m * 16) * 2048 + c0 + bj * HALF; const u32x4 gg = g[m][bj]; f32x4 v0 = acc[ai][bj][m][0], v1 = acc[ai][bj][m][1];
                    v0[0] *= fmaxf(blo(gg.x), 1e-30f) * fe; v0[1] *= fmaxf(bhi(gg.x), 1e-30f) * fe; v0[2] *= fmaxf(blo(gg.y), 1e-30f) * fe; v0[3] *= fmaxf(bhi(gg.y), 1e-30f) * fe;
                    v1[0] *= fmaxf(blo(gg.z), 1e-30f) * fe; v1[1] *= fmaxf(bhi(gg.z), 1e-30f) * fe; v1[2] *= fmaxf(blo(gg.w), 1e-30f) * fe; v1[3] *= fmaxf(bhi(gg.w), 1e-30f) * fe;
                    int lo = __builtin_amdgcn_cvt_pk_fp8_f32(v0[0], v0[1], 0, false); lo = __builtin_amdgcn_cvt_pk_fp8_f32(v0[2], v0[3], lo, true);
                    int hi = __builtin_amdgcn_cvt_pk_fp8_f32(v1[0], v1[1], 0, false); hi = __builtin_amdgcn_cvt_pk_fp8_f32(v1[2], v1[3], hi, true);
                    typedef unsigned u32x2s __attribute__((ext_vector_type(2))); *(u32x2s*)(O + off) = (u32x2s){(unsigned)lo, (unsigned)hi}; }
            __builtin_amdgcn_sched_barrier(0); }
    }
};
template <bool XB_BF16>
struct EpiResid {
    static constexpr bool PERM = true, AFTER_DRAIN = false, HAS_MID = false;
    const void* XB; bf16_t* XO; const float* gvec; float fo0, fo1;
    __device__ __forceinline__ void operator()(const f32x4 (&acc)[2][2][4][2], const Unit& u, int wr, int wc, int fr, int fq) const {
        const int row0 = u.pm * BM + wr * 64 + fr, c0 = u.pn * BM + wc * 32 + 8 * fq; const float* gp = gvec + (size_t)(u.pm >> 5) * 12288;
        const float fo = (u.pm >> 5) ? fo1 : fo0;
#pragma unroll
        for (int bj = 0; bj < 2; ++bj) { const int col = c0 + bj * HALF; const f32x4 g0 = *(const f32x4*)(gp + col) * fo, g1 = *(const f32x4*)(gp + col + 4) * fo;
#pragma unroll
            for (int ai = 0; ai < 2; ++ai) { f32x4 xa[4], xb[4]; u32x4 xq[4];
#pragma unroll
                for (int m = 0; m < 4; ++m) { const size_t off = (size_t)(row0 + ai * HALF + m * 16) * 2048 + col;
                    if constexpr (XB_BF16) xq[m] = *(const u32x4*)((const bf16_t*)XB + off); else { xa[m] = *(const f32x4*)((const float*)XB + off); xb[m] = *(const f32x4*)((const float*)XB + off + 4); } }
                __builtin_amdgcn_sched_barrier(0);
#pragma unroll
                for (int m = 0; m < 4; ++m) { const size_t off = (size_t)(row0 + ai * HALF + m * 16) * 2048 + col;
                    if constexpr (XB_BF16) { xa[m] = (f32x4){blo(xq[m].x), bhi(xq[m].x), blo(xq[m].y), bhi(xq[m].y)}; xb[m] = (f32x4){blo(xq[m].z), bhi(xq[m].z), blo(xq[m].w), bhi(xq[m].w)}; }
                    *(u32x4*)(XO + off) = pack8(xa[m] + g0 * acc[ai][bj][m][0], xb[m] + g1 * acc[ai][bj][m][1]); }
                __builtin_amdgcn_sched_barrier(0); } }
    }
};
typedef _Float16 f16x8 __attribute__((ext_vector_type(8)));
struct EpiF16 {
    static constexpr bool PERM = true, AFTER_DRAIN = false, HAS_MID = false;
    _Float16* O; int ldc;
    __device__ __forceinline__ void operator()(const f32x4 (&acc)[2][2][4][2], const Unit& u, int wr, int wc, int fr, int fq) const {
        const int row0 = u.pm * BM + wr * 64 + fr, c0 = u.pn * BM + wc * 32 + 8 * fq;
#pragma unroll
        for (int ai = 0; ai < 2; ++ai)
#pragma unroll
            for (int m = 0; m < 4; ++m)
#pragma unroll
                for (int bj = 0; bj < 2; ++bj) { const f32x4 v0 = acc[ai][bj][m][0], v1 = acc[ai][bj][m][1];
                    const f16x8 h = {(_Float16)v0[0], (_Float16)v0[1], (_Float16)v0[2], (_Float16)v0[3], (_Float16)v1[0], (_Float16)v1[1], (_Float16)v1[2], (_Float16)v1[3]};
                    *(f16x8*)(O + (size_t)(row0 + ai * HALF + m * 16) * ldc + c0 + bj * HALF) = h; }
    }
};
}

#define XB_TMO      128
#define XB_XCNT(j)  (256  + 64 * (j))
#define XB_XSUB(j)  (1280 + 64 * (j))
#define XB_XGEN(j)  (2304 + 64 * (j))
#define XB_TOP      3328
#define XB_TOPGEN   3392
#define XCD_BAR_WORDS 3456
#define XB_SPIN_CAP (1u << 18)

__device__ __forceinline__ unsigned xb_ld(unsigned* p)              { return __hip_atomic_load(p, __ATOMIC_RELAXED, __HIP_MEMORY_SCOPE_AGENT); }
__device__ __forceinline__ unsigned xb_add(unsigned* p, unsigned v) { return __hip_atomic_fetch_add(p, v, __ATOMIC_RELAXED, __HIP_MEMORY_SCOPE_AGENT); }
__device__ __forceinline__ unsigned xb_xcc_id() { return (unsigned)__builtin_amdgcn_s_getreg((3 << 11) | 20) & 0xFu; }
#define XB_SPIN(cond, bar) do { unsigned _sp = 0; while (cond) { __builtin_amdgcn_s_sleep(1); \
    if ((++_sp & 255u) == 0u) { if (xb_ld(&(bar)[XB_TMO])) break; if (_sp > XB_SPIN_CAP) { atomicAdd(&(bar)[XB_TMO], 1u); break; } } } } while (0)

struct XcdBarrier {
    unsigned* bar; unsigned x;
    volatile LAS unsigned* st;
};

__device__ __forceinline__ XcdBarrier xcd_barrier_post(unsigned* bar, volatile LAS unsigned* st) {
    XcdBarrier b; b.bar = bar; b.x = xb_xcc_id(); b.st = st;
    if (threadIdx.x == 0) (void)xb_add(&bar[XB_XCNT(b.x)], 1u);
    return b;
}
__device__ __forceinline__ void xcd_barrier_complete(unsigned* bar, unsigned x, unsigned& nloc, unsigned& nx) {
    const unsigned G = gridDim.x * gridDim.y * gridDim.z;
    unsigned sum, cnt, mine, sp = 0u;
    for (;;) {
        sum = 0u; cnt = 0u; mine = 0u;
#pragma unroll
        for (unsigned j = 0; j < 16; ++j) { const unsigned c = xb_ld(&bar[XB_XCNT(j)]); sum += c; cnt += (c > 0u) ? 1u : 0u; mine = (j == x) ? c : mine; }
        if (sum == G) break;
        __builtin_amdgcn_s_sleep(1);
        if ((++sp & 255u) == 0u) { if (xb_ld(&bar[XB_TMO])) break; if (sp > XB_SPIN_CAP) { atomicAdd(&bar[XB_TMO], 1u); break; } }
    }
    nloc = mine > 0u ? mine : 1u; nx = cnt > 0u ? cnt : 1u;
}

__device__ __forceinline__ void xcd_barrier(const XcdBarrier& b) {
    asm volatile("s_waitcnt vmcnt(0)" ::: "memory");
    __syncthreads();
    if (threadIdx.x == 0) {
        unsigned* bar = b.bar;
        __builtin_amdgcn_s_waitcnt(0);
        unsigned nloc = b.st[0], nx = b.st[1];
        if (nloc == 0u) { xcd_barrier_complete(bar, b.x, nloc, nx); b.st[0] = nloc; b.st[1] = nx; }
        const unsigned old = xb_add(&bar[XB_XSUB(b.x)], 1u);
        const unsigned gen = old / nloc;
        if (old + 1u == (gen + 1u) * nloc) {
            __builtin_amdgcn_fence(__ATOMIC_RELEASE, "agent");
            asm volatile("s_waitcnt vmcnt(0)" ::: "memory");
            const unsigned og = xb_add(&bar[XB_TOP], 1u);
            const unsigned tg = og / nx;
            if (og + 1u == (tg + 1u) * nx) xb_add(&bar[XB_TOPGEN], 1u);
            else XB_SPIN(xb_ld(&bar[XB_TOPGEN]) == tg, bar);
            __builtin_amdgcn_fence(__ATOMIC_ACQUIRE, "agent");
            xb_add(&bar[XB_XGEN(b.x)], 1u);
            asm volatile("s_waitcnt vmcnt(0)" ::: "memory");
        } else {
            XB_SPIN(xb_ld(&bar[XB_XGEN(b.x)]) == gen, bar);
            __builtin_amdgcn_fence(__ATOMIC_ACQUIRE, "agent");
            asm volatile("s_waitcnt vmcnt(0)" ::: "memory");
        }
    }
    __syncthreads();
}

struct Args { const float* in[N_IN]; float* out; unsigned char* ws; int ph_lo, ph_hi; };
struct Frame {
    LAS unsigned char* lds; volatile LAS unsigned* MISC; gu32* ctl;
    int tid, lane, wave, vcu, G;
    const Args* A; float* out; unsigned char* ws;
};
#define WSP(T_, off) ((T_*)(F.ws + (off)))
#define PHASE_TID(F) do { int t_ = threadIdx.x; asm volatile("" : "+v"(t_)); (F).tid = t_; (F).lane = t_ & 63; (F).wave = __builtin_amdgcn_readfirstlane(t_ >> 6); } while (0)

__device__ __forceinline__ int glu_row(int n) { return n < 2048 ? (((n & 1023) >> 7) * 256 + (n >> 10) * 128 + (n & 127)) : n; }
template <int MODE>
__device__ __forceinline__ void tr_item(const float* W, int N, bf16* WT, int dstride, int koff, LAS float* scr, int kb, int nb, int lane) {
    const int k0 = 64 * kb, n0 = 32 * nb;
    f32x4 v[8];
#pragma unroll
    for (int i = 0; i < 8; ++i) v[i] = *(const f32x4*)(W + (size_t)(k0 + (lane >> 3) + 8 * i) * N + n0 + (lane & 7) * 4);
#pragma unroll
    for (int i = 0; i < 8; ++i) { LAS float* d = scr + ((lane >> 3) + 8 * i) * 33 + (lane & 7) * 4; d[0] = v[i].x; d[1] = v[i].y; d[2] = v[i].z; d[3] = v[i].w; }
    LDS_WAIT(); asm volatile("" ::: "memory");
    const int c = lane & 7;
#pragma unroll
    for (int j = 0; j < 4; ++j) { const int n = (lane >> 3) + 8 * j; const LAS float* s = scr + (8 * c) * 33 + n;
        v4u o; o.x = pk2(s[0 * 33], s[1 * 33]); o.y = pk2(s[2 * 33], s[3 * 33]); o.z = pk2(s[4 * 33], s[5 * 33]); o.w = pk2(s[6 * 33], s[7 * 33]);
        const int nn = n0 + n, row = MODE == 1 ? glu_row(nn) : nn;
        *(v4u*)(WT + (size_t)row * dstride + koff + k0 + 8 * c) = o; }
    LDS_WAIT(); asm volatile("" ::: "memory");
}
__device__ __forceinline__ void wmax_item(Frame& F, int it) {
    const int l = it >> 5, kc = it & 31; const float* W = F.A->in[I_WIN] + ((size_t)l * 2048 + kc * 64) * IN_DIM; float mx = 0.f;
#pragma unroll 4
    for (int k = 0; k < 64; ++k)
#pragma unroll
        for (int j = 0; j < 4; ++j) { const int c4r = F.tid + NTHR * j, c4 = c4r < IN_DIM / 4 ? c4r : IN_DIM / 4 - 1;
            const f32x4 v = *(const f32x4*)(W + (size_t)k * IN_DIM + 4 * c4); mx = fmaxf(mx, fmaxf(fmaxf(fabsf(v.x), fabsf(v.y)), fmaxf(fabsf(v.z), fabsf(v.w)))); }
#pragma unroll
    for (int o = 1; o < 64; o <<= 1) mx = fmaxf(mx, __shfl_xor(mx, o));
    if (F.lane == 0) __hip_atomic_fetch_max(F.ctl + CW_WMAX + l, __float_as_uint(mx), __ATOMIC_RELAXED, __HIP_MEMORY_SCOPE_AGENT);
}
__device__ __forceinline__ void wmax2_item(Frame& F, int it) {
    const int lh = it >> 3, kc = it & 7, l = lh >> 1, h = lh & 1; const float* W = F.A->in[h ? I_WAO : I_WCO] + ((size_t)l * 1024 + kc * 128) * 2048 + 4 * F.tid; float mx = 0.f;
#pragma unroll 8
    for (int k = 0; k < 128; ++k) { const f32x4 v = *(const f32x4*)(W + (size_t)k * 2048); mx = fmaxf(mx, fmaxf(fmaxf(fabsf(v.x), fabsf(v.y)), fmaxf(fabsf(v.z), fabsf(v.w)))); }
#pragma unroll
    for (int o = 1; o < 64; o <<= 1) mx = fmaxf(mx, __shfl_xor(mx, o));
    if (F.lane == 0) __hip_atomic_fetch_max(F.ctl + CW_WMAX2 + lh, __float_as_uint(mx), __ATOMIC_RELAXED, __HIP_MEMORY_SCOPE_AGENT);
}
__device__ __forceinline__ void wmax3_item(Frame& F, int it) {
    const int l = it >> 4, kc = it & 15; const float* W = F.A->in[I_WOUT] + ((size_t)l * 2048 + kc * 128) * 2048 + 4 * F.tid; float mx = 0.f;
#pragma unroll 8
    for (int k = 0; k < 128; ++k) { const f32x4 v = *(const f32x4*)(W + (size_t)k * 2048); mx = fmaxf(mx, fmaxf(fmaxf(fabsf(v.x), fabsf(v.y)), fmaxf(fabsf(v.z), fabsf(v.w)))); }
#pragma unroll
    for (int o = 1; o < 64; o <<= 1) mx = fmaxf(mx, __shfl_xor(mx, o));
    if (F.lane == 0) __hip_atomic_fetch_max(F.ctl + CW_WMAX3 + l, __float_as_uint(mx), __ATOMIC_RELAXED, __HIP_MEMORY_SCOPE_AGENT);
}
template <bool GLU>
__device__ __forceinline__ void tr8_item(const float* W, int N, unsigned char* WT, int koff, float inv, LAS float* scr, int kb, int nb, int lane) {
    const int k0 = 64 * kb, n0 = 32 * nb;
    f32x4 v[8];
#pragma unroll
    for (int i = 0; i < 8; ++i) v[i] = *(const f32x4*)(W + (size_t)(k0 + (lane >> 3) + 8 * i) * N + n0 + (lane & 7) * 4);
#pragma unroll
    for (int i = 0; i < 8; ++i) { LAS float* d = scr + ((lane >> 3) + 8 * i) * 33 + (lane & 7) * 4; d[0] = v[i].x * inv; d[1] = v[i].y * inv; d[2] = v[i].z * inv; d[3] = v[i].w * inv; }
    LDS_WAIT(); asm volatile("" ::: "memory");
    const int c = lane & 7;
#pragma unroll
    for (int j = 0; j < 4; ++j) { const int n = (lane >> 3) + 8 * j; const LAS float* s = scr + (8 * c) * 33 + n;
        int lo = __builtin_amdgcn_cvt_pk_fp8_f32(s[0 * 33], s[1 * 33], 0, false); lo = __builtin_amdgcn_cvt_pk_fp8_f32(s[2 * 33], s[3 * 33], lo, true);
        int hi = __builtin_amdgcn_cvt_pk_fp8_f32(s[4 * 33], s[5 * 33], 0, false); hi = __builtin_amdgcn_cvt_pk_fp8_f32(s[6 * 33], s[7 * 33], hi, true);
        v2u o; o.x = (unsigned)lo; o.y = (unsigned)hi;
        *(v2u*)(WT + (size_t)(GLU ? glu_row(n0 + n) : n0 + n) * 2048 + koff + k0 + 8 * c) = o; }
    LDS_WAIT(); asm volatile("" ::: "memory");
}
__device__ __forceinline__ void win8_phase(Frame& F) {
    PHASE_TID(F);
    LAS float* scr = (LAS float*)(F.lds + F.wave * 16384);
    if (F.tid == 0) F.MISC[0] = __hip_atomic_fetch_add(F.ctl + CW_QUEUE2, 1u, __ATOMIC_RELAXED, __HIP_MEMORY_SCOPE_AGENT);
    for (int par = 0;; par ^= 1) {
        __syncthreads();
        const int it = (int)F.MISC[par];
        if (F.tid == 0) F.MISC[par ^ 1] = __hip_atomic_fetch_add(F.ctl + CW_QUEUE2, 1u, __ATOMIC_RELAXED, __HIP_MEMORY_SCOPE_AGENT);
        if (it >= 2 * 960 + 4 * 128 + 2 * 256) break;
        if (it < 2 * 960) { const int l = it >= 960, r = it - l * 960, wi = r * 8 + F.wave;
            const float wmax = __uint_as_float(__hip_atomic_load(F.ctl + CW_WMAX + l, __ATOMIC_RELAXED, __HIP_MEMORY_SCOPE_AGENT)), inv = wmax > 0.f ? 440.0f / wmax : 1.0f;
            tr8_item<true>(F.A->in[I_WIN] + (size_t)l * 2048 * IN_DIM, IN_DIM, WSP(unsigned char, WS_WIN) + (size_t)l * IN_DIM * 2048, 0, inv, scr, wi / 240, wi % 240, F.lane); }
        else if (it >= 2 * 960 + 4 * 128) { const int r0 = it - 2 * 960 - 4 * 128, l = r0 >> 8, wi = (r0 & 255) * 8 + F.wave;
            const float wmax = __uint_as_float(__hip_atomic_load(F.ctl + CW_WMAX3 + l, __ATOMIC_RELAXED, __HIP_MEMORY_SCOPE_AGENT)), inv = wmax > 0.f ? 440.0f / wmax : 1.0f;
            tr8_item<false>(F.A->in[I_WOUT] + (size_t)l * 2048 * 2048, 2048, WSP(unsigned char, WS_WO) + (size_t)l * 2048 * 2048, 0, inv, scr, wi / 64, wi % 64, F.lane); }
        else { const int r0 = it - 2 * 960, lh = r0 >> 7, l = lh >> 1, h = lh & 1, wi = (r0 & 127) * 8 + F.wave;
            const float wmax = __uint_as_float(__hip_atomic_load(F.ctl + CW_WMAX2 + lh, __ATOMIC_RELAXED, __HIP_MEMORY_SCOPE_AGENT)), inv = wmax > 0.f ? 440.0f / wmax : 1.0f;
            tr8_item<false>(F.A->in[h ? I_WAO : I_WCO] + (size_t)l * 1024 * 2048, 2048, WSP(unsigned char, WS_WM) + (size_t)l * 2048 * 2048, h * 1024, inv, scr, wi / 64, wi % 64, F.lane); }
    }
}
__device__ __forceinline__ void ada_item(Frame& F, int a) {
    LAS float* csl = (LAS float*)F.lds;
    LAS f32x4* red = (LAS f32x4*)(F.lds + 16384);
    const float* c = F.A->in[I_C];
    { float cv[8];
#pragma unroll
      for (int i = 0; i < 8; ++i) cv[i] = c[i * NTHR + F.tid];
      __builtin_amdgcn_sched_barrier(0);
#pragma unroll
      for (int i = 0; i < 8; ++i) csl[i * NTHR + F.tid] = cv[i] / (1.0f + __expf(-cv[i])); }
    __syncthreads();
    const int l = a / 48, j0 = (a % 48) * 256 + 4 * F.lane;
    const float* wp = F.A->in[I_ADAW] + ((size_t)l * 2048 + F.wave * 256) * 12288 + j0;
    f32x4 a0 = {0.f, 0.f, 0.f, 0.f}, a1 = {0.f, 0.f, 0.f, 0.f};
#define ADA_LD(dst_, k0_) do { _Pragma("unroll") for (int i_ = 0; i_ < 8; ++i_) dst_[i_] = *(const f32x4*)(wp + (size_t)((k0_) + i_) * 12288); } while (0)
#define ADA_USE(src_, k0_) do { _Pragma("unroll") for (int i_ = 0; i_ < 8; ++i_) { const float c0 = csl[F.wave * 256 + (k0_) + i_], c1 = csl[2048 + F.wave * 256 + (k0_) + i_]; a0 += src_[i_] * c0; a1 += src_[i_] * c1; } } while (0)
    f32x4 wA[8], wB[8];
    ADA_LD(wA, 0);
#pragma unroll 1
    for (int kb = 0; kb < 256; kb += 16) {
        ADA_LD(wB, kb + 8); __builtin_amdgcn_sched_barrier(0); ADA_USE(wA, kb); __builtin_amdgcn_sched_barrier(0);
        if (kb + 16 < 256) ADA_LD(wA, kb + 16);
        __builtin_amdgcn_sched_barrier(0); ADA_USE(wB, kb + 8); __builtin_amdgcn_sched_barrier(0);
    }
#undef ADA_LD
#undef ADA_USE
    red[(F.wave * 2 + 0) * 64 + F.lane] = a0; red[(F.wave * 2 + 1) * 64 + F.lane] = a1;
    __syncthreads();
    if (F.wave < 2) { const int b = F.wave; f32x4 s = *(const f32x4*)(F.A->in[I_ADAB] + l * 12288 + j0);
#pragma unroll
        for (int w = 0; w < 8; ++w) s += red[(w * 2 + b) * 64 + F.lane];
        *(f32x4*)(WSP(float, WS_MOD) + (size_t)(l * 2 + b) * 12288 + j0) = s; }
    __syncthreads();
}
__device__ __forceinline__ void fold_item(Frame& F, int it) {
    const int l = it >> 7, hp = (it >> 3) & 15, kb = it & 7, lane = F.lane, fr = lane & 15, fq = lane >> 4;
    constexpr int SKS = 136;
    LAS bf16* skh = (LAS bf16*)F.lds; LAS bf16* skl = skh + 128 * SKS;
    const float* wbase = F.A->in[I_WPQ] + ((size_t)l * 2048 + kb * 256 + F.wave * 32 + fr) * 2048 + hp * 128 + 8 * fq;
    f32x4 wv[2][4][2];
#pragma unroll
    for (int kt = 0; kt < 2; ++kt)
#pragma unroll
        for (int s2 = 0; s2 < 4; ++s2) { wv[kt][s2][0] = *(const f32x4*)(wbase + (size_t)kt * 16 * 2048 + 32 * s2); wv[kt][s2][1] = *(const f32x4*)(wbase + (size_t)kt * 16 * 2048 + 32 * s2 + 4); }
    { const f32x4* sk = (const f32x4*)(F.A->in[I_SK] + (size_t)(l * 16 + hp) * 128 * 128);
      f32x4 v[8];
#pragma unroll
      for (int i = 0; i < 8; ++i) v[i] = sk[i * NTHR + F.tid];
#pragma unroll
      for (int i = 0; i < 8; ++i) { const int f = i * NTHR + F.tid, n = f >> 5, d = (f & 31) * 4;
          const unsigned h0 = pk2(v[i].x, v[i].y), h1 = pk2(v[i].z, v[i].w);
          const unsigned l0 = pk2(v[i].x - bflo(h0), v[i].y - bfhi(h0)), l1 = pk2(v[i].z - bflo(h1), v[i].w - bfhi(h1));
          v2u ho; ho.x = h0; ho.y = h1; v2u lo; lo.x = l0; lo.y = l1;
          *(LAS v2u*)(skh + n * SKS + d) = ho; *(LAS v2u*)(skl + n * SKS + d) = lo; } }
    __syncthreads();
    bf16x8 wh[2][4], wl[2][4];
#pragma unroll
    for (int kt = 0; kt < 2; ++kt)
#pragma unroll
        for (int s2 = 0; s2 < 4; ++s2) { const f32x4 a = wv[kt][s2][0], b = wv[kt][s2][1];
            v4u h, lo; h.x = pk2(a.x, a.y); h.y = pk2(a.z, a.w); h.z = pk2(b.x, b.y); h.w = pk2(b.z, b.w);
            lo.x = pk2(a.x - bflo(h.x), a.y - bfhi(h.x)); lo.y = pk2(a.z - bflo(h.y), a.w - bfhi(h.y)); lo.z = pk2(b.x - bflo(h.z), b.y - bfhi(h.z)); lo.w = pk2(b.z - bflo(h.w), b.w - bfhi(h.w));
            wh[kt][s2] = __builtin_bit_cast(bf16x8, h); wl[kt][s2] = __builtin_bit_cast(bf16x8, lo); }
    bf16* dst = WSP(bf16, WS_WP) + (size_t)l * 2048 * 2048 + (size_t)(hp * 128 + fr) * 2048 + kb * 256 + F.wave * 32 + 4 * fq;
#pragma unroll 2
    for (int nt = 0; nt < 8; ++nt) { f32x4 acc[2] = {{0.f, 0.f, 0.f, 0.f}, {0.f, 0.f, 0.f, 0.f}};
#pragma unroll
        for (int s2 = 0; s2 < 4; ++s2) { const bf16x8 sh = *(const LAS bf16x8*)(skh + (nt * 16 + fr) * SKS + 32 * s2 + 8 * fq), sl = *(const LAS bf16x8*)(skl + (nt * 16 + fr) * SKS + 32 * s2 + 8 * fq);
#pragma unroll
            for (int kt = 0; kt < 2; ++kt) { acc[kt] = __builtin_amdgcn_mfma_f32_16x16x32_bf16(wh[kt][s2], sh, acc[kt], 0, 0, 0); acc[kt] = __builtin_amdgcn_mfma_f32_16x16x32_bf16(wl[kt][s2], sh, acc[kt], 0, 0, 0);
                acc[kt] = __builtin_amdgcn_mfma_f32_16x16x32_bf16(wh[kt][s2], sl, acc[kt], 0, 0, 0); } }
#pragma unroll
        for (int kt = 0; kt < 2; ++kt) { v2u o; o.x = pk2(acc[kt].x, acc[kt].y); o.y = pk2(acc[kt].z, acc[kt].w); *(v2u*)(dst + (size_t)nt * 16 * 2048 + kt * 16) = o; } }
    __syncthreads();
}
__device__ __forceinline__ void cvt_item(Frame& F, int it) {
    const int which = it >> 10, chunk = it & 1023;
    const float* src = F.A->in[which ? I_PV : I_PU]; unsigned char* dst = WSP(unsigned char, which ? WS_PV : WS_PU); float* scl = WSP(float, WS_SCL) + which * 2 * NEXP;
    constexpr int VROW = 2048 + 8;
    LAS unsigned char* vt = F.lds;
    for (int i = 0; i < 4; i += 2) {
        f32x4 a[2][4], b[2][4]; float mx[2] = {0.f, 0.f};
#pragma unroll
        for (int r = 0; r < 2; ++r) { const int row = chunk * 32 + F.wave * 4 + i + r;
#pragma unroll
            for (int m = 0; m < 4; ++m) { const int col = 512 * m + 8 * F.lane; a[r][m] = *(const f32x4*)(src + (size_t)row * D + col); b[r][m] = *(const f32x4*)(src + (size_t)row * D + col + 4); } }
#pragma unroll
        for (int r = 0; r < 2; ++r) {
#pragma unroll
            for (int m = 0; m < 4; ++m) { mx[r] = fmaxf(mx[r], fmaxf(fmaxf(fabsf(a[r][m].x), fabsf(a[r][m].y)), fmaxf(fabsf(a[r][m].z), fabsf(a[r][m].w)))); mx[r] = fmaxf(mx[r], fmaxf(fmaxf(fabsf(b[r][m].x), fabsf(b[r][m].y)), fmaxf(fabsf(b[r][m].z), fabsf(b[r][m].w)))); } }
#pragma unroll
        for (int o = 1; o < 64; o <<= 1) { mx[0] = fmaxf(mx[0], __shfl_xor(mx[0], o)); mx[1] = fmaxf(mx[1], __shfl_xor(mx[1], o)); }
#pragma unroll
        for (int r = 0; r < 2; ++r) { const int row = chunk * 32 + F.wave * 4 + i + r, l = row >> 14, e = row & (NEXP - 1);
            const float sc = mx[r] > 0.f ? mx[r] * (1.0f / 440.0f) : 1.0f, inv = 1.0f / sc;
            if (F.lane == 0) scl[l * NEXP + e] = sc;
#pragma unroll
            for (int m = 0; m < 4; ++m) { const int col = 512 * m + 8 * F.lane;
                int lo = __builtin_amdgcn_cvt_pk_fp8_f32(a[r][m].x * inv, a[r][m].y * inv, 0, false); lo = __builtin_amdgcn_cvt_pk_fp8_f32(a[r][m].z * inv, a[r][m].w * inv, lo, true);
                int hi = __builtin_amdgcn_cvt_pk_fp8_f32(b[r][m].x * inv, b[r][m].y * inv, 0, false); hi = __builtin_amdgcn_cvt_pk_fp8_f32(b[r][m].z * inv, b[r][m].w * inv, hi, true);
                v2u o; o.x = (unsigned)lo; o.y = (unsigned)hi;
                if (which) *(LAS v2u*)(vt + (F.wave * 4 + i + r) * VROW + col) = o;
                else *(v2u*)(dst + ((size_t)(l * NSL + (col >> 7)) * NEXP + e) * SLW + (col & 127)) = o; } }
    }
    if (which) {
        __syncthreads();
        const int row0 = chunk * 32, l = row0 >> 14, e0 = row0 & (NEXP - 1);
#pragma unroll 4
        for (int i = 0; i < 16; ++i) { const int idx = i * NTHR + F.tid, j = idx >> 5, r = idx & 31;
            *(v2u*)(dst + ((size_t)(l * 256 + j) * NEXP + e0 + r) * 8) = *(const LAS v2u*)(vt + r * VROW + 8 * j); }
        __syncthreads();
    }
}
__device__ __forceinline__ void bias_item(Frame& F) {
    for (int i = F.tid; i < 2048; i += NTHR) { const int h = i >> 7, d = i & 127; int bk;
        if (d < 16) bk = d; else { bk = 16 + (int)(logf((float)d / 16.0f) / logf(8.0f) * 16.0f); bk = bk > 31 ? 31 : bk; }
        WSP(float, WS_BIAS)[i] = F.A->in[I_RELB][bk * 16 + h]; }
}
constexpr int IT_FOLD = 256, IT_ADA = 96, IT_WMAX = 64 + 32 + 32, IT_CVT = 2048;
constexpr int IT0_ADA = 0, IT0_BIAS = IT0_ADA + IT_ADA, IT0_WMAX = IT0_BIAS + 1, IT0_CVT = IT0_WMAX + IT_WMAX, N_OTHER = IT0_CVT + IT_CVT, N_ITEMS = N_OTHER + IT_FOLD, FOLD_EVERY = 9;
static_assert((IT_FOLD - 1) * FOLD_EVERY < N_ITEMS, "fold tickets inside the item range");
__device__ __forceinline__ void p0_prologue(Frame& F) {
    PHASE_TID(F);
    if (F.tid == 0) F.MISC[0] = __hip_atomic_fetch_add(F.ctl + CW_QUEUE, 1u, __ATOMIC_RELAXED, __HIP_MEMORY_SCOPE_AGENT);
    for (int par = 0;; par ^= 1) {
        __syncthreads();
        const int it = (int)F.MISC[par];
        if (F.tid == 0) F.MISC[par ^ 1] = __hip_atomic_fetch_add(F.ctl + CW_QUEUE, 1u, __ATOMIC_RELAXED, __HIP_MEMORY_SCOPE_AGENT);
        if (it >= N_ITEMS) break;
        const int fq = it / FOLD_EVERY; const bool is_fold = (it % FOLD_EVERY == 0) && fq < IT_FOLD;
        const int ot = it - (fq + 1 < IT_FOLD ? fq + 1 : IT_FOLD);
        if (is_fold) fold_item(F, fq);
        else if (ot < IT0_BIAS) ada_item(F, ot - IT0_ADA);
        else if (ot < IT0_WMAX) bias_item(F);
        else if (ot < IT0_WMAX + 64) wmax_item(F, ot - IT0_WMAX);
        else if (ot < IT0_WMAX + 96) wmax2_item(F, ot - IT0_WMAX - 64);
        else if (ot < IT0_CVT) wmax3_item(F, ot - IT0_WMAX - 96);
        else cvt_item(F, ot - IT0_CVT);
    }
}

__device__ __forceinline__ void row_to_fp8(const f32x4 (&y)[8], unsigned char* hrow, float* sarow, int lane) {
    float mx = 0.f;
#pragma unroll
    for (int j = 0; j < 8; ++j) mx = fmaxf(mx, fmaxf(fmaxf(fabsf(y[j].x), fabsf(y[j].y)), fmaxf(fabsf(y[j].z), fabsf(y[j].w))));
#pragma unroll
    for (int o = 1; o < 64; o <<= 1) mx = fmaxf(mx, __shfl_xor(mx, o));
    const float sc = mx > 0.f ? mx * (1.0f / 440.0f) : 1.0f, inv = 1.0f / sc;
    if (lane == 0) *sarow = sc;
#pragma unroll
    for (int j = 0; j < 8; ++j) { int w = __builtin_amdgcn_cvt_pk_fp8_f32(y[j].x * inv, y[j].y * inv, 0, false); w = __builtin_amdgcn_cvt_pk_fp8_f32(y[j].z * inv, y[j].w * inv, w, true); ((unsigned*)hrow)[lane + 64 * j] = (unsigned)w; }
}
template <bool TO_FP8, bool IN_BF16>
__device__ __forceinline__ void norm_phase(Frame& F, const void* X, bf16* Hd, const float* g, const float* modl, int ish, int isc) {
    PHASE_TID(F);
    const int gw = F.vcu * NWAVES + F.wave, NGW = F.G * NWAVES;
    int curb = -1; f32x4 gs[8], sh[8];
    for (int m = gw; m < T; m += NGW) {
        const int b = m >> 13;
        if (b != curb) { curb = b;
#pragma unroll
            for (int j = 0; j < 8; ++j) { const int col = 4 * F.lane + 256 * j; const f32x4 g4 = *(const f32x4*)(g + col), sc4 = *(const f32x4*)(modl + (size_t)b * 12288 + isc * 2048 + col);
                sh[j] = *(const f32x4*)(modl + (size_t)b * 12288 + ish * 2048 + col); gs[j] = g4 * (sc4 + 1.0f); } }
        f32x4 v[8]; float ss = 0.f;
        if constexpr (IN_BF16) { const v2u* xr = (const v2u*)((const bf16*)X + (size_t)m * D) + F.lane; v2u q[8];
#pragma unroll
            for (int j = 0; j < 8; ++j) q[j] = xr[64 * j];
            __builtin_amdgcn_sched_barrier(0);
#pragma unroll
            for (int j = 0; j < 8; ++j) v[j] = (f32x4){bflo(q[j].x), bfhi(q[j].x), bflo(q[j].y), bfhi(q[j].y)};
        } else { const f32x4* xr = (const f32x4*)((const float*)X + (size_t)m * D) + F.lane;
#pragma unroll
            for (int j = 0; j < 8; ++j) v[j] = xr[64 * j];
            __builtin_amdgcn_sched_barrier(0); }
#pragma unroll
        for (int j = 0; j < 8; ++j) ss += (v[j].x * v[j].x + v[j].y * v[j].y) + (v[j].z * v[j].z + v[j].w * v[j].w);
        const float rstd = 1.0f / sqrtf(wave_sum(ss) * (1.0f / D) + EPS);
        if constexpr (TO_FP8) { f32x4 y[8];
#pragma unroll
            for (int j = 0; j < 8; ++j) y[j] = v[j] * rstd * gs[j] + sh[j];
            row_to_fp8(y, (unsigned char*)Hd + (size_t)m * D, WSP(float, WS_SA) + m, F.lane);
        } else {
        v2u* o = (v2u*)(Hd + (size_t)m * D) + F.lane;
#pragma unroll
        for (int j = 0; j < 8; ++j) { const f32x4 y = v[j] * rstd * gs[j] + sh[j]; v2u w; w.x = pk2(y.x, y.y); w.y = pk2(y.z, y.w); o[64 * j] = w; }
        }
    }
}

__device__ __forceinline__ void conv_phase(Frame& F, int l) {
    PHASE_TID(F);
    const float* dw = F.A->in[I_DWW] + (size_t)l * CWID * CONV; const int c0 = 2 * F.tid;
    float w0[CWID], w1[CWID];
#pragma unroll
    for (int j = 0; j < CWID; ++j) { const f32x2 w = *(const f32x2*)(dw + j * CONV + c0); w0[j] = w.x; w1[j] = w.y; }
    const f32x2 cb = *(const f32x2*)(F.A->in[I_DWB] + l * CONV + c0), lg = *(const f32x2*)(F.A->in[I_CLNG] + l * CONV + c0), lb = *(const f32x2*)(F.A->in[I_CLNB] + l * CONV + c0);
    LAS float* red = (LAS float*)F.lds;
    LAS float* stat = red + 256;
    float gmx = fmaxf(fabsf(lg.x), fabsf(lg.y)), bmx = fmaxf(fabsf(lb.x), fabsf(lb.y));
#pragma unroll
    for (int o = 1; o < 64; o <<= 1) { gmx = fmaxf(gmx, __shfl_xor(gmx, o)); bmx = fmaxf(bmx, __shfl_xor(bmx, o)); }
    if (F.lane == 0) { red[F.wave] = gmx; red[8 + F.wave] = bmx; }
    __syncthreads();
    { float g_ = red[0], b_ = red[8];
#pragma unroll
      for (int w = 1; w < 8; ++w) { g_ = fmaxf(g_, red[w]); b_ = fmaxf(b_, red[8 + w]); }
      gmx = g_; bmx = b_; }
    __syncthreads();
    const float Bc = fmaxf(32.0f * gmx + bmx, 1e-20f), cinv = 440.0f / Bc;
    if (blockIdx.x == 0 && F.tid == 0) { __hip_atomic_store(F.ctl + CW_BC + l, __float_as_uint(Bc), __ATOMIC_RELAXED, __HIP_MEMORY_SCOPE_AGENT); __hip_atomic_store(F.ctl + CW_BC2 + l, __float_as_uint(gmx + bmx), __ATOMIC_RELAXED, __HIP_MEMORY_SCOPE_AGENT); }
    const unsigned* Ut = WSP(unsigned, WS_U) + F.tid; unsigned short* AM = WSP(unsigned short, WS_AM);
    for (int tile = F.vcu; tile < T / 64; tile += F.G) {
        const int t0 = tile * 64, bstart = t0 & ~(SEQ - 1);
        for (int grp = 0; grp < 4; ++grp) {
            const int tg = t0 + grp * 16;
            float wa[46], wb[46]; unsigned wp[46];
#pragma unroll
            for (int i = 0; i < 46; ++i) { const int r = tg - 30 + i; wp[i] = Ut[(size_t)(r >= bstart ? r : bstart) * (CONV / 2)]; }
            __builtin_amdgcn_sched_barrier(0);
#pragma unroll
            for (int i = 0; i < 46; ++i) { const int r = tg - 30 + i; const unsigned p = wp[i] & (r >= bstart ? 0xffffffffu : 0u); wa[i] = bflo(p); wb[i] = bfhi(p); }
            float oa[16], ob[16];
#pragma unroll
            for (int i = 0; i < 16; ++i) { float a = cb.x, b = cb.y;
#pragma unroll
                for (int j = 0; j < CWID; ++j) { a += w0[j] * wa[i + j]; b += w1[j] * wb[i + j]; }
                oa[i] = a; ob[i] = b; }
#pragma unroll
            for (int i = 0; i < 16; ++i) { const float s = wave_sum(oa[i] + ob[i]), q = wave_sum(oa[i] * oa[i] + ob[i] * ob[i]); if (F.lane == 0) { red[F.wave * 32 + i] = s; red[F.wave * 32 + 16 + i] = q; } }
            __syncthreads();
            if (F.tid < 32) { float v = 0.f;
#pragma unroll
                for (int w = 0; w < 8; ++w) v += red[w * 32 + F.tid];
                stat[F.tid] = v; }
            __syncthreads();
#pragma unroll
            for (int i = 0; i < 16; ++i) { const float mu = stat[i] * (1.0f / CONV), var = fmaxf(stat[16 + i] * (1.0f / CONV) - mu * mu, 0.0f), rstd = 1.0f / sqrtf(var + EPS);
                const float ya = (oa[i] - mu) * rstd * lg.x + lb.x, yb = (ob[i] - mu) * rstd * lg.y + lb.y;
                AM[(size_t)(tg + i) * (D / 2) + F.tid] = (unsigned short)__builtin_amdgcn_cvt_pk_fp8_f32(ya * sigmoidf_(ya) * cinv, yb * sigmoidf_(yb) * cinv, 0, false); }
        }
    }
}

#define MFMA32(a, b, c) __builtin_amdgcn_mfma_f32_32x32x16_bf16((a), (b), (c), 0, 0, 0)
__device__ __forceinline__ void attn_phase(Frame& F, int l) {
    PHASE_TID(F);
    constexpr int VTS = 260;
    constexpr int KS = 72;
    LAS bf16* VT = (LAS bf16*)F.lds;
    LAS bf16* KL = (LAS bf16*)(F.lds + 34816);
    LAS float* BT = (LAS float*)(F.lds + 34816 + 36864);
    const bf16* Qg = WSP(bf16, WS_Q); const bf16* Kg = WSP(bf16, WS_K); const bf16* Vg = WSP(bf16, WS_V); unsigned char* AM = WSP(unsigned char, WS_AM);
    const float* BIAS = WSP(float, WS_BIAS);
    const int r = F.lane & 31, h = F.lane >> 5;
    for (int unit = F.vcu; unit < 512; unit += F.G) {
        const int b = unit >> 8, blk = (unit >> 2) & 63, kvh = unit & 3, kbase = blk * 128 - 128;
        const float vmx = __uint_as_float(__hip_atomic_load(F.ctl + CW_VMAX + 2 * l + b, __ATOMIC_RELAXED, __HIP_MEMORY_SCOPE_AGENT)), ainv = vmx > 0.f ? 440.0f / (1.02f * vmx) : 1.0f;
        for (int c = F.tid; c < 2048; c += NTHR) { const int key = c >> 3, d0 = (c & 7) * 8, kpos = kbase + key; v4u v = {0u, 0u, 0u, 0u}, kq = {0u, 0u, 0u, 0u};
            if (kpos >= 0) { v = *(const v4u*)(Vg + (size_t)(b * SEQ + kpos) * KVD + kvh * HD + d0); kq = *(const v4u*)(Kg + (size_t)(b * SEQ + kpos) * KVD + kvh * HD + d0); }
            *(LAS v4u*)(KL + key * KS + d0) = kq;
            LAS bf16* dst = VT + d0 * VTS + key;
            dst[0 * VTS] = (bf16)v.x; dst[1 * VTS] = (bf16)(v.x >> 16); dst[2 * VTS] = (bf16)v.y; dst[3 * VTS] = (bf16)(v.y >> 16);
            dst[4 * VTS] = (bf16)v.z; dst[5 * VTS] = (bf16)(v.z >> 16); dst[6 * VTS] = (bf16)v.w; dst[7 * VTS] = (bf16)(v.w >> 16); }
        BT[F.tid] = BIAS[(kvh * 4 + (F.tid >> 7)) * 128 + (F.tid & 127)];
        __syncthreads();
        for (int tk = 0; tk < 2; ++tk) {
            const int task = F.wave * 2 + tk, g = task >> 2, qs = task & 3, head = kvh * 4 + g;
            const size_t trow = (size_t)b * SEQ + blk * 128 + qs * 32 + r;
            bf16x8 qf[4];
#pragma unroll
            for (int s = 0; s < 4; ++s) qf[s] = *(const bf16x8*)(Qg + trow * ATT + head * HD + 16 * s + 8 * h);
            const float sink = F.A->in[I_SINK][l * NHEAD + head];
            float mx = sink, lsum = 0.f;
            f32x16 o[2];
#pragma unroll
            for (int i = 0; i < 16; ++i) { o[0][i] = 0.f; o[1][i] = 0.f; }
#pragma unroll 1
            for (int j = 0; j < 5; ++j) { f32x16 a;
#pragma unroll
                for (int i = 0; i < 16; ++i) a[i] = 0.f;
#pragma unroll
                for (int s = 0; s < 4; ++s) { const bf16x8 kf = *(const LAS bf16x8*)(KL + (qs * 32 + 32 * j + r) * KS + 16 * s + 8 * h); a = MFMA32(kf, qf[s], a); }
                float tmax = -INFINITY;
#pragma unroll
                for (int i = 0; i < 16; ++i) { const int kr = 32 * j + (i & 3) + 8 * (i >> 2) + 4 * h, dist = 128 + r - kr; const bool ok = dist >= 0 && dist < 128 && (kbase + qs * 32 + kr) >= 0;
                    const float sv = ok ? a[i] + BT[g * 128 + (dist & 127)] : -INFINITY; a[i] = sv; tmax = fmaxf(tmax, sv); }
                tmax = fmaxf(tmax, __shfl_xor(tmax, 32));
                const float mnew = fmaxf(mx, tmax), alpha = __expf(mx - mnew); mx = mnew; lsum *= alpha;
#pragma unroll
                for (int i = 0; i < 16; ++i) { o[0][i] *= alpha; o[1][i] *= alpha; const float p = __expf(a[i] - mx); a[i] = p; lsum += p; }
#pragma unroll
                for (int s2 = 0; s2 < 2; ++s2) { v4u pp; pp.x = pk2(a[8 * s2 + 0], a[8 * s2 + 1]); pp.y = pk2(a[8 * s2 + 2], a[8 * s2 + 3]); pp.z = pk2(a[8 * s2 + 4], a[8 * s2 + 5]); pp.w = pk2(a[8 * s2 + 6], a[8 * s2 + 7]);
                    const bf16x8 pf = __builtin_bit_cast(bf16x8, pp);
#pragma unroll
                    for (int dt = 0; dt < 2; ++dt) { const LAS bf16* vp = VT + (32 * dt + r) * VTS + qs * 32 + 32 * j + 16 * s2 + 4 * h; const v2u lo = *(const LAS v2u*)vp, hi = *(const LAS v2u*)(vp + 8);
                        v4u vv; vv.x = lo.x; vv.y = lo.y; vv.z = hi.x; vv.w = hi.y; o[dt] = MFMA32(__builtin_bit_cast(bf16x8, vv), pf, o[dt]); } }
            }
            lsum += __shfl_xor(lsum, 32);
            const float inv = ainv / (lsum + __expf(sink - mx));
#pragma unroll
            for (int dt = 0; dt < 2; ++dt)
#pragma unroll
                for (int g4 = 0; g4 < 4; ++g4) { int w = __builtin_amdgcn_cvt_pk_fp8_f32(o[dt][4 * g4 + 0] * inv, o[dt][4 * g4 + 1] * inv, 0, false); w = __builtin_amdgcn_cvt_pk_fp8_f32(o[dt][4 * g4 + 2] * inv, o[dt][4 * g4 + 3] * inv, w, true);
                    *(unsigned*)(AM + trow * D + ATT + head * HD + 32 * dt + 8 * g4 + 4 * h) = (unsigned)w; }
        }
        __syncthreads();
    }
}

__device__ __forceinline__ unsigned f2key(float f) { const unsigned u = __float_as_uint(f); return (u & 0x80000000u) ? ~u : (u | 0x80000000u); }
__device__ __forceinline__ float key2f(unsigned k) { const unsigned u = (k & 0x80000000u) ? (k & 0x7fffffffu) : ~k; return __uint_as_float(u); }
#define INSERT16(L, x_) do { unsigned x__ = (x_); _Pragma("unroll") for (int q_ = 0; q_ < 16; ++q_) { const unsigned hi_ = L[q_] > x__ ? L[q_] : x__; x__ = L[q_] > x__ ? x__ : L[q_]; L[q_] = hi_; } } while (0)
#define CEX(A_, i_, j_) do { const unsigned h__ = A_[i_] > A_[j_] ? A_[i_] : A_[j_], l__ = A_[i_] > A_[j_] ? A_[j_] : A_[i_]; A_[i_] = h__; A_[j_] = l__; } while (0)
#define SORT16(A_) do { CEX(A_, 0,1); CEX(A_, 2,3); CEX(A_, 0,2); CEX(A_, 1,3); CEX(A_, 1,2); CEX(A_, 4,5); CEX(A_, 6,7); CEX(A_, 4,6); CEX(A_, 5,7); CEX(A_, 5,6); CEX(A_, 0,4); CEX(A_, 2,6); CEX(A_, 2,4); CEX(A_, 1,5); CEX(A_, 3,7); CEX(A_, 3,5); CEX(A_, 1,2); CEX(A_, 3,4); CEX(A_, 5,6); CEX(A_, 8,9); CEX(A_, 10,11); CEX(A_, 8,10); CEX(A_, 9,11); CEX(A_, 9,10); CEX(A_, 12,13); CEX(A_, 14,15); CEX(A_, 12,14); CEX(A_, 13,15); CEX(A_, 13,14); CEX(A_, 8,12); CEX(A_, 10,14); CEX(A_, 10,12); CEX(A_, 9,13); CEX(A_, 11,15); CEX(A_, 11,13); CEX(A_, 9,10); CEX(A_, 11,12); CEX(A_, 13,14); CEX(A_, 0,8); CEX(A_, 4,12); CEX(A_, 4,8); CEX(A_, 2,10); CEX(A_, 6,14); CEX(A_, 6,10); CEX(A_, 2,4); CEX(A_, 6,8); CEX(A_, 10,12); CEX(A_, 1,9); CEX(A_, 5,13); CEX(A_, 5,9); CEX(A_, 3,11); CEX(A_, 7,15); CEX(A_, 7,11); CEX(A_, 3,5); CEX(A_, 7,9); CEX(A_, 11,13); CEX(A_, 1,2); CEX(A_, 3,4); CEX(A_, 5,6); CEX(A_, 7,8); CEX(A_, 9,10); CEX(A_, 11,12); CEX(A_, 13,14); } while (0)
#define BMERGE16(A_) do { CEX(A_, 0,8); CEX(A_, 1,9); CEX(A_, 2,10); CEX(A_, 3,11); CEX(A_, 4,12); CEX(A_, 5,13); CEX(A_, 6,14); CEX(A_, 7,15); CEX(A_, 0,4); CEX(A_, 1,5); CEX(A_, 2,6); CEX(A_, 3,7); CEX(A_, 8,12); CEX(A_, 9,13); CEX(A_, 10,14); CEX(A_, 11,15); CEX(A_, 0,2); CEX(A_, 1,3); CEX(A_, 4,6); CEX(A_, 5,7); CEX(A_, 8,10); CEX(A_, 9,11); CEX(A_, 12,14); CEX(A_, 13,15); CEX(A_, 0,1); CEX(A_, 2,3); CEX(A_, 4,5); CEX(A_, 6,7); CEX(A_, 8,9); CEX(A_, 10,11); CEX(A_, 12,13); CEX(A_, 14,15); } while (0)
__device__ __forceinline__ void topk_phase(Frame& F) {
    PHASE_TID(F);
    const _Float16* S = WSP(_Float16, WS_GC); int* IDX = WSP(int, WS_U); float* GATE = WSP(float, WS_U + 8 * MiB);
    const int gw = F.vcu * NWAVES + F.wave, NGW = F.G * NWAVES;
    constexpr int TKS = 256; LAS unsigned char* lw = F.lds + F.wave * (64 * TKS); const LAS unsigned char* lrow = lw + F.lane * TKS;
    for (int grp = gw; grp < T * PHEADS / 64; grp += NGW) {
        const int item = grp * 64 + F.lane, t = item >> 3, hh = item & 7;
        const unsigned char* sg = (const unsigned char*)(S + (size_t)grp * 8 * D) + (size_t)(F.lane >> 4) * 512 + (F.lane & 15) * 16;
        v4u r0[16], r1[16];
#pragma unroll
        for (int i = 0; i < 16; ++i) r0[i] = *(const v4u*)(sg + (size_t)(i >> 1) * 4096 + (i & 1) * 2048);
#pragma unroll
        for (int i = 0; i < 16; ++i) r1[i] = *(const v4u*)(sg + (size_t)(i >> 1) * 4096 + (i & 1) * 2048 + 256);
        __builtin_amdgcn_sched_barrier(0);
#pragma unroll
        for (int i = 0; i < 16; ++i) *(LAS v4u*)(lw + (4 * i + (F.lane >> 4)) * TKS + (((F.lane & 15) ^ ((4 * i + (F.lane >> 4)) & 15)) << 4)) = r0[i];
        __builtin_amdgcn_sched_barrier(0);
        unsigned L1[16], L2[16];
#pragma unroll
        for (int q = 0; q < 16; ++q) { L1[q] = 0u; L2[q] = 0u; }
#pragma unroll 1
        for (int c = 0; c < 16; c += 2) { const pg8::f16x8 va = *(const LAS pg8::f16x8*)(lrow + ((c ^ (F.lane & 15)) << 4)), vb = *(const LAS pg8::f16x8*)(lrow + (((c + 1) ^ (F.lane & 15)) << 4));
            unsigned C[16];
#pragma unroll
            for (int e = 0; e < 8; ++e) { C[e] = (f2key((float)va[e]) & ~127u) | (unsigned)(127 - (8 * c + e)); C[8 + e] = (f2key((float)vb[e]) & ~127u) | (unsigned)(127 - (8 * c + 8 + e)); }
            SORT16(C);
#pragma unroll
            for (int q = 0; q < 16; ++q) L1[q] = L1[q] > C[15 - q] ? L1[q] : C[15 - q];
            BMERGE16(L1); }
        __builtin_amdgcn_sched_barrier(0);
#pragma unroll
        for (int i = 0; i < 16; ++i) *(LAS v4u*)(lw + (4 * i + (F.lane >> 4)) * TKS + (((F.lane & 15) ^ ((4 * i + (F.lane >> 4)) & 15)) << 4)) = r1[i];
        __builtin_amdgcn_sched_barrier(0);
#pragma unroll 1
        for (int c = 0; c < 16; c += 2) { const pg8::f16x8 va = *(const LAS pg8::f16x8*)(lrow + ((c ^ (F.lane & 15)) << 4)), vb = *(const LAS pg8::f16x8*)(lrow + (((c + 1) ^ (F.lane & 15)) << 4));
            unsigned C[16];
#pragma unroll
            for (int e = 0; e < 8; ++e) { C[e] = (f2key((float)va[e]) & ~127u) | (unsigned)(127 - (8 * c + e)); C[8 + e] = (f2key((float)vb[e]) & ~127u) | (unsigned)(127 - (8 * c + 8 + e)); }
            SORT16(C);
#pragma unroll
            for (int q = 0; q < 16; ++q) L2[q] = L2[q] > C[15 - q] ? L2[q] : C[15 - q];
            BMERGE16(L2); }
        float v1[16], v2[16];
#pragma unroll
        for (int q = 0; q < 16; ++q) { v1[q] = key2f(L1[q] & ~127u); v2[q] = key2f(L2[q] & ~127u); }
#define PKEY(i_, j_) ((f2key(v1[i_] + v2[j_]) & ~255u) | (unsigned)(255 - ((i_) * 16 + (j_))))
        unsigned B[16], Cc[16];
#pragma unroll
        for (int q = 0; q < 16; ++q) B[q] = PKEY(0, q);
#pragma unroll
        for (int q = 0; q < 15; ++q) Cc[q] = PKEY(q + 1, 0);
        Cc[15] = 0u;
#pragma unroll
        for (int q = 0; q < 16; ++q) B[q] = B[q] > Cc[15 - q] ? B[q] : Cc[15 - q];
        BMERGE16(B);
        Cc[0] = PKEY(1, 1);        Cc[1] = PKEY(1, 2);        Cc[2] = PKEY(1, 3);        Cc[3] = PKEY(1, 4);
        Cc[4] = PKEY(1, 5);        Cc[5] = PKEY(1, 6);        Cc[6] = PKEY(1, 7);        Cc[7] = PKEY(2, 1);
        Cc[8] = PKEY(2, 2);        Cc[9] = PKEY(2, 3);        Cc[10] = PKEY(2, 4);        Cc[11] = PKEY(3, 1);
        Cc[12] = PKEY(3, 2);        Cc[13] = PKEY(3, 3);        Cc[14] = PKEY(4, 1);        Cc[15] = PKEY(4, 2);
        SORT16(Cc);
#pragma unroll
        for (int q = 0; q < 16; ++q) B[q] = B[q] > Cc[15 - q] ? B[q] : Cc[15 - q];
        BMERGE16(B);
        INSERT16(B, PKEY(5, 1)); INSERT16(B, PKEY(6, 1)); INSERT16(B, PKEY(7, 1));
#undef PKEY
        const float b0 = key2f(B[0] & ~255u); float e[16], es = 0.f;
#pragma unroll
        for (int q = 0; q < 16; ++q) { e[q] = __expf(key2f(B[q] & ~255u) - b0); es += e[q]; }
        const float einv = 1.0f / es;
        int ex[16];
#pragma unroll
        for (int q = 0; q < 16; ++q) { const int code = 255 - (int)(B[q] & 255u), ii = code >> 4, jj = code & 15; unsigned s1 = L1[0], s2 = L2[0];
#pragma unroll
            for (int z = 1; z < 16; ++z) { s1 = (ii == z) ? L1[z] : s1; s2 = (jj == z) ? L2[z] : s2; }
            ex[q] = (127 - (int)(s1 & 127u)) * 128 + (127 - (int)(s2 & 127u)); e[q] *= einv; }
        int* ip = IDX + (size_t)t * 128 + hh * 16; float* gp = GATE + (size_t)t * 128 + hh * 16;
#pragma unroll
        for (int q = 0; q < 4; ++q) { *(int4*)(ip + 4 * q) = make_int4(ex[4 * q], ex[4 * q + 1], ex[4 * q + 2], ex[4 * q + 3]); *(f32x4*)(gp + 4 * q) = (f32x4){e[4 * q], e[4 * q + 1], e[4 * q + 2], e[4 * q + 3]}; }
    }
}

#define FP8LO(w_) __builtin_amdgcn_cvt_pk_f32_fp8((int)(w_), false)
#define FP8HI(w_) __builtin_amdgcn_cvt_pk_f32_fp8((int)(w_), true)
__device__ __forceinline__ void pa_issue(v4u (&rr)[16], int id0, int id1, const unsigned char* tab, int g) {
#pragma unroll
    for (int i = 0; i < 16; ++i) { const int e = __shfl(i < 8 ? id0 : id1, ((8 * i) & 63) + g); rr[i] = *(const v4u*)(tab + (size_t)e * SLW); }
}
__device__ __forceinline__ void pa_compute(const v4u (&rr)[16], const v4u ha, const v4u hb, float o0, float o1, float* d0, float* d1, int lane) {
    f32x2 hf[8];
    hf[0] = (f32x2){bflo(ha.x), bfhi(ha.x)}; hf[1] = (f32x2){bflo(ha.y), bfhi(ha.y)}; hf[2] = (f32x2){bflo(ha.z), bfhi(ha.z)}; hf[3] = (f32x2){bflo(ha.w), bfhi(ha.w)};
    hf[4] = (f32x2){bflo(hb.x), bfhi(hb.x)}; hf[5] = (f32x2){bflo(hb.y), bfhi(hb.y)}; hf[6] = (f32x2){bflo(hb.z), bfhi(hb.z)}; hf[7] = (f32x2){bflo(hb.w), bfhi(hb.w)};
    float p[16];
#pragma unroll
    for (int i = 0; i < 16; ++i) { f32x2 a = FP8LO(rr[i].x) * hf[0];
        a = __builtin_elementwise_fma(FP8HI(rr[i].x), hf[1], a); a = __builtin_elementwise_fma(FP8LO(rr[i].y), hf[2], a); a = __builtin_elementwise_fma(FP8HI(rr[i].y), hf[3], a);
        a = __builtin_elementwise_fma(FP8LO(rr[i].z), hf[4], a); a = __builtin_elementwise_fma(FP8HI(rr[i].z), hf[5], a); a = __builtin_elementwise_fma(FP8LO(rr[i].w), hf[6], a); a = __builtin_elementwise_fma(FP8HI(rr[i].w), hf[7], a);
        p[i] = a.x + a.y; }
    float q8[8], q4[4], q2[2];
    { const bool bt = (lane & 1) != 0;
#pragma unroll
      for (int i = 0; i < 8; ++i) { const float snd = bt ? p[i] : p[i + 8], kp = bt ? p[i + 8] : p[i]; q8[i] = kp + lane_xor1(snd); } }
    { const bool bt = (lane & 2) != 0;
#pragma unroll
      for (int i = 0; i < 4; ++i) { const float snd = bt ? q8[i] : q8[i + 4], kp = bt ? q8[i + 4] : q8[i]; q4[i] = kp + lane_xor2(snd); } }
    { const bool bt = (lane & 4) != 0;
#pragma unroll
      for (int i = 0; i < 2; ++i) { const float snd = bt ? q4[i] : q4[i + 2], kp = bt ? q4[i + 2] : q4[i]; q2[i] = kp + lane_xor4(snd); } }
    *d0 = o0 + q2[0]; *d1 = o1 + q2[1];
}
__device__ __forceinline__ void peer_act_phase(Frame& F, int l) {
    PHASE_TID(F);
    const int lane = F.lane, g = lane >> 3, j = lane & 7;
    const int x = blockIdx.x & 7, bpg = F.G >> 3, wpg = bpg * NWAVES, wgi = (blockIdx.x >> 3) * NWAVES + F.wave;
    const int* IDX = WSP(int, WS_U); const bf16* Hb = WSP(bf16, WS_H);
    float* actp = WSP(float, WS_AM) + (size_t)x * T * 128;
    const int irev = 8 * (j & 1) + 4 * ((j >> 1) & 1) + 2 * (j >> 2), k0 = 8 * irev + g, k1 = k0 + 8;
    const int NT = (T - wgi + wpg - 1) / wpg;
    for (int s = 0; s < 2; ++s) {
        const int sl = 2 * x + s; const unsigned char* tab = WSP(unsigned char, WS_PU) + (size_t)(l * NSL + sl) * NEXP * SLW + 16 * j;
        const bf16* hcol = Hb + sl * SLW + 16 * j;
#define PA_PREF(n_, i0, i1, h0, h1, q0, q1) do { const int t_ = wgi + (n_) * wpg; if ((n_) < NT) { i0 = IDX[(size_t)t_ * 128 + lane]; i1 = IDX[(size_t)t_ * 128 + 64 + lane]; h0 = *(const v4u*)(hcol + (size_t)t_ * D); h1 = *(const v4u*)(hcol + (size_t)t_ * D + 8); \
            if (s > 0) { q0 = actp[(size_t)t_ * 128 + k0]; q1 = actp[(size_t)t_ * 128 + k1]; } } } while (0)
        int ia0 = 0, ia1 = 0, ib0 = 0, ib1 = 0; v4u ha0 = {0u, 0u, 0u, 0u}, ha1 = ha0, hb0 = ha0, hb1 = ha0; float oa0 = 0.f, oa1 = 0.f, ob0 = 0.f, ob1 = 0.f;
        v4u rA[16], rB[16];
        PA_PREF(0, ia0, ia1, ha0, ha1, oa0, oa1); PA_PREF(1, ib0, ib1, hb0, hb1, ob0, ob1);
        if (0 < NT) pa_issue(rA, ia0, ia1, tab, g);
        for (int n = 0; n < NT; n += 2) {
            const v4u ca0 = ha0, ca1 = ha1; const float pa0 = oa0, pa1 = oa1;
            if (n + 1 < NT) pa_issue(rB, ib0, ib1, tab, g);
            PA_PREF(n + 2, ia0, ia1, ha0, ha1, oa0, oa1);
            __builtin_amdgcn_sched_barrier(0);
            { const size_t t_ = (size_t)(wgi + n * wpg); pa_compute(rA, ca0, ca1, pa0, pa1, actp + t_ * 128 + k0, actp + t_ * 128 + k1, lane); }
            __builtin_amdgcn_sched_barrier(0);
            if (n + 1 < NT) {
                const v4u cb0 = hb0, cb1 = hb1; const float pb0 = ob0, pb1 = ob1;
                if (n + 2 < NT) pa_issue(rA, ia0, ia1, tab, g);
                PA_PREF(n + 3, ib0, ib1, hb0, hb1, ob0, ob1);
                __builtin_amdgcn_sched_barrier(0);
                { const size_t t_ = (size_t)(wgi + (n + 1) * wpg); pa_compute(rB, cb0, cb1, pb0, pb1, actp + t_ * 128 + k0, actp + t_ * 128 + k1, lane); }
                __builtin_amdgcn_sched_barrier(0);
            }
        }
#undef PA_PREF
    }
}
__device__ __forceinline__ void peer_w_phase(Frame& F, int l) {
    PHASE_TID(F);
    const int lane = F.lane;
    constexpr int WROW = 136;
    LAS bf16* wl = (LAS bf16*)F.lds; LAS bf16* il = wl + 64 * WROW;
    const int* IDX = WSP(int, WS_U); const float* GATE = WSP(float, WS_U + 8 * MiB); const float* actp = WSP(float, WS_AM);
    bf16* WT = WSP(bf16, WS_Y1); bf16* IT = WSP(bf16, WS_Y1 + 4 * MiB);
    const float* su = WSP(float, WS_SCL) + l * NEXP; const float* sv = WSP(float, WS_SCL) + (2 + l) * NEXP;
    for (int tb = F.vcu; tb < T / 64; tb += F.G) {
#pragma unroll 2
        for (int i = 0; i < 8; ++i) { const int tl = F.wave * 8 + i, t = tb * 64 + tl;
            const int e0 = IDX[(size_t)t * 128 + lane], e1 = IDX[(size_t)t * 128 + 64 + lane];
            float pa[8], pb[8];
#pragma unroll
            for (int xx = 0; xx < 8; ++xx) { pa[xx] = actp[((size_t)xx * T + t) * 128 + lane]; pb[xx] = actp[((size_t)xx * T + t) * 128 + 64 + lane]; }
            const float gt0 = GATE[(size_t)t * 128 + lane], gt1 = GATE[(size_t)t * 128 + 64 + lane];
            const float su0 = su[e0], su1 = su[e1], sv0 = sv[e0], sv1 = sv[e1];
            __builtin_amdgcn_sched_barrier(0);
            float a0 = ((pa[0] + pa[1]) + (pa[2] + pa[3])) + ((pa[4] + pa[5]) + (pa[6] + pa[7])), a1 = ((pb[0] + pb[1]) + (pb[2] + pb[3])) + ((pb[4] + pb[5]) + (pb[6] + pb[7]));
            a0 *= su0; a1 *= su1;
            const float g0 = gt0 * sv0, g1 = gt1 * sv1;
            wl[tl * WROW + lane] = __builtin_bit_cast(bf16, (_Float16)(256.0f * g0 * 0.5f * a0 * (1.0f + erff(a0 * 0.70710678118654752f)))); wl[tl * WROW + 64 + lane] = __builtin_bit_cast(bf16, (_Float16)(256.0f * g1 * 0.5f * a1 * (1.0f + erff(a1 * 0.70710678118654752f))));
            il[tl * WROW + lane] = (bf16)e0; il[tl * WROW + 64 + lane] = (bf16)e1; }
        __syncthreads();
#pragma unroll
        for (int i = 0; i < 2; ++i) { const int p_ = i * NTHR + F.tid, kq = p_ >> 6, tl = p_ & 63; const size_t o = ((size_t)(tb * 16 + kq) * 64 + tl) * 8;
            *(v4u*)(WT + o) = *(const LAS v4u*)(wl + tl * WROW + 8 * kq); *(v4u*)(IT + o) = *(const LAS v4u*)(il + tl * WROW + 8 * kq); }
        __syncthreads();
    }
}
__device__ __forceinline__ void pbl_load(v4u (&iv)[4], v4u (&wv)[4], const bf16* ip, const bf16* wp) {
#pragma unroll
    for (int q = 0; q < 4; ++q) { iv[q] = *(const v4u*)(ip + q * 512); wv[q] = *(const v4u*)(wp + q * 512); }
}
typedef _Float16 h16x2 __attribute__((ext_vector_type(2)));
#define FP8H_LO(w_) __builtin_bit_cast(h16x2, __builtin_amdgcn_cvt_scalef32_pk_f16_fp8((int)(w_), 1.0f, false))
#define FP8H_HI(w_) __builtin_bit_cast(h16x2, __builtin_amdgcn_cvt_scalef32_pk_f16_fp8((int)(w_), 1.0f, true))
#define PBL_FMA_LO(acc_, v_, w_) asm("v_pk_fma_f16 %0, %1, %2, %0 op_sel_hi:[1,0,1]" : "+v"(acc_) : "v"(v_), "v"(w_))
#define PBL_FMA_HI(acc_, v_, w_) asm("v_pk_fma_f16 %0, %1, %2, %0 op_sel:[0,1,0] op_sel_hi:[1,1,1]" : "+v"(acc_) : "v"(v_), "v"(w_))
__device__ __forceinline__ void pbl_compute(const v4u (&iv)[4], const v4u (&wv)[4], h16x2 (&acc)[4], LAS unsigned char* lds) {
    const unsigned three = 3u;
#pragma unroll
    for (int q = 0; q < 4; ++q) { v2u d[8];
#pragma unroll
        for (int ki = 0; ki < 8; ++ki) { const unsigned ipair = iv[q][ki >> 1]; unsigned ad;
            if (ki & 1) asm("v_lshlrev_b32_sdwa %0, %1, %2 dst_sel:DWORD dst_unused:UNUSED_PAD src0_sel:DWORD src1_sel:WORD_1" : "=v"(ad) : "s"(three), "v"(ipair));
            else asm("v_lshlrev_b32_sdwa %0, %1, %2 dst_sel:DWORD dst_unused:UNUSED_PAD src0_sel:DWORD src1_sel:WORD_0" : "=v"(ad) : "s"(three), "v"(ipair));
            d[ki] = *(const LAS v2u*)(size_t)ad; }
        __builtin_amdgcn_sched_barrier(0);
#pragma unroll
        for (int ki = 0; ki < 8; ++ki) { const unsigned wword = wv[q][ki >> 1];
            const h16x2 v0 = FP8H_LO(d[ki].x), v1 = FP8H_HI(d[ki].x), v2 = FP8H_LO(d[ki].y), v3 = FP8H_HI(d[ki].y);
            if (ki & 1) { PBL_FMA_HI(acc[0], v0, wword); PBL_FMA_HI(acc[1], v1, wword); PBL_FMA_HI(acc[2], v2, wword); PBL_FMA_HI(acc[3], v3, wword); }
            else { PBL_FMA_LO(acc[0], v0, wword); PBL_FMA_LO(acc[1], v1, wword); PBL_FMA_LO(acc[2], v2, wword); PBL_FMA_LO(acc[3], v3, wword); } }
        __builtin_amdgcn_sched_barrier(0); }
}
__device__ __forceinline__ void peer_out_phase(Frame& F, int l) {
    PHASE_TID(F);
    const int lane = F.lane;
    const int x = blockIdx.x & 7, ib = blockIdx.x >> 3, j = 8 * (4 * x + (ib >> 3)) + (ib & 7);
    const bf16* WT = WSP(bf16, WS_Y1); const bf16* IT = WSP(bf16, WS_Y1 + 4 * MiB); bf16* OUT = WSP(bf16, WS_GC);
    for (int jj = (F.G == 256 ? j : (int)blockIdx.x); jj < 256; jj += (F.G == 256 ? 256 : F.G)) {
        const unsigned char* sl = WSP(unsigned char, WS_PV) + (size_t)(l * 256 + jj) * NEXP * 8;
        { v4u fr_[16];
#pragma unroll
          for (int i = 0; i < 16; ++i) fr_[i] = *(const v4u*)(sl + (i * NTHR + F.tid) * 16);
          __builtin_amdgcn_sched_barrier(0);
#pragma unroll
          for (int i = 0; i < 16; ++i) *(LAS v4u*)(F.lds + (i * NTHR + F.tid) * 16) = fr_[i]; }
        __syncthreads();
        constexpr int NCH = 4 * (T / 64 / NWAVES);
#define PBL_PTR(c_, arr_) ((arr_) + ((size_t)(F.wave + NWAVES * ((c_) >> 2)) * 16 * 64 + lane) * 8 + ((c_) & 3) * 4 * 512)
        v4u iA[4], wA[4], iB[4], wB[4], iC[4], wC[4]; h16x2 acc[4];
#define PBL_STEP(X_, Z_, c_) do { const int cc_ = (c_); if (cc_ + 2 < NCH) pbl_load(i##Z_, w##Z_, PBL_PTR(cc_ + 2, IT), PBL_PTR(cc_ + 2, WT)); \
            __builtin_amdgcn_sched_barrier(0); \
            if ((cc_ & 3) == 0) { _Pragma("unroll") for (int q = 0; q < 4; ++q) acc[q] = (h16x2){(_Float16)0.f, (_Float16)0.f}; } \
            pbl_compute(i##X_, w##X_, acc, F.lds); \
            if ((cc_ & 3) == 3) { constexpr float us_ = 1.0f / 256.0f; v4u o; o.x = pk2((float)acc[0].x * us_, (float)acc[0].y * us_); o.y = pk2((float)acc[1].x * us_, (float)acc[1].y * us_); o.z = pk2((float)acc[2].x * us_, (float)acc[2].y * us_); o.w = pk2((float)acc[3].x * us_, (float)acc[3].y * us_); \
                *(v4u*)(OUT + (size_t)((F.wave + NWAVES * (cc_ >> 2)) * 64 + lane) * D + 8 * jj) = o; } \
            __builtin_amdgcn_sched_barrier(0); } while (0)
        pbl_load(iA, wA, PBL_PTR(0, IT), PBL_PTR(0, WT)); pbl_load(iB, wB, PBL_PTR(1, IT), PBL_PTR(1, WT));
#pragma unroll 1
        for (int c = 0; c < NCH; c += 3) {
            PBL_STEP(A, C, c);
            if (c + 1 < NCH) PBL_STEP(B, A, c + 1);
            if (c + 2 < NCH) PBL_STEP(C, B, c + 2);
        }
#undef PBL_STEP
#undef PBL_PTR
        __syncthreads();
    }
}
__device__ __forceinline__ void peer_res_phase(Frame& F, int l, bf16* XO) {
    PHASE_TID(F);
    const bool last = (l == 1);
    const int gw = F.vcu * NWAVES + F.wave, NGW = F.G * NWAVES, lane = F.lane;
    const bf16* XA = WSP(bf16, WS_XA); const bf16* OUTS = WSP(bf16, WS_GC); bf16* Hb = WSP(bf16, WS_H); const float* MOD = WSP(float, WS_MOD);
    for (int t = gw; t < T; t += NGW) {
        const int b = t >> 13; const float* g2 = MOD + (size_t)(l * 2 + b) * 12288 + 5 * 2048;
        f32x4 v[8], gq[8]; v2u oq[8], xq[8]; float ss = 0.f;
#pragma unroll
        for (int jj = 0; jj < 8; ++jj) { const int col = 4 * lane + 256 * jj; xq[jj] = *(const v2u*)(XA + (size_t)t * D + col); gq[jj] = *(const f32x4*)(g2 + col); oq[jj] = *(const v2u*)(OUTS + (size_t)t * D + col); }
        __builtin_amdgcn_sched_barrier(0);
#pragma unroll
        for (int jj = 0; jj < 8; ++jj) { const f32x4 o = {bflo(oq[jj].x), bfhi(oq[jj].x), bflo(oq[jj].y), bfhi(oq[jj].y)}; v[jj] = (f32x4){bflo(xq[jj].x), bfhi(xq[jj].x), bflo(xq[jj].y), bfhi(xq[jj].y)};
            v[jj] = v[jj] + gq[jj] * o; ss += (v[jj].x * v[jj].x + v[jj].y * v[jj].y) + (v[jj].z * v[jj].z + v[jj].w * v[jj].w); }
        const float rstd = 1.0f / sqrtf(wave_sum(ss) * (1.0f / D) + EPS);
        if (!last) {
            const float* ng = F.A->in[I_N1G] + (size_t)(l + 1) * D; const float* mn = MOD + (size_t)((l + 1) * 2 + b) * 12288;
#pragma unroll
            for (int jj = 0; jj < 8; ++jj) gq[jj] = *(const f32x4*)(ng + 4 * lane + 256 * jj);
            f32x4 shq[8], scq[8];
#pragma unroll
            for (int jj = 0; jj < 8; ++jj) { scq[jj] = *(const f32x4*)(mn + 2048 + 4 * lane + 256 * jj); shq[jj] = *(const f32x4*)(mn + 4 * lane + 256 * jj); }
            __builtin_amdgcn_sched_barrier(0);
#pragma unroll
            for (int jj = 0; jj < 8; ++jj) gq[jj] = gq[jj] * (scq[jj] + 1.0f);
#pragma unroll
            for (int jj = 0; jj < 8; ++jj) { const int col = 4 * lane + 256 * jj; v2u w; w.x = pk2(v[jj].x, v[jj].y); w.y = pk2(v[jj].z, v[jj].w); *(v2u*)(XO + (size_t)t * D + col) = w; v[jj] = v[jj] * rstd * gq[jj] + shq[jj]; }
            row_to_fp8(v, (unsigned char*)Hb + (size_t)t * D, WSP(float, WS_SA) + t, lane);
        } else {
            const float* fg = F.A->in[I_FG];
#pragma unroll
            for (int jj = 0; jj < 8; ++jj) gq[jj] = *(const f32x4*)(fg + 4 * lane + 256 * jj);
            __builtin_amdgcn_sched_barrier(0);
#pragma unroll
            for (int jj = 0; jj < 8; ++jj) *(f32x4*)(F.out + (size_t)t * D + 4 * lane + 256 * jj) = v[jj] * rstd * gq[jj];
        }
    }
}

#ifndef MK_ONE_LAUNCH
#define MK_ONE_LAUNCH 1
#endif
#define PG8_ALIGN true
#define PG8_SP2 true
constexpr int PH_PER_LAYER = 13, N_PHASES = 1 + 2 * PH_PER_LAYER;
__global__ void __launch_bounds__(NTHR, 2) fwd(Args args) {
    extern __shared__ __attribute__((aligned(16))) unsigned char lds[];
    Frame F;
    F.lds = (LAS unsigned char*)lds; F.MISC = (volatile LAS unsigned*)(F.lds + MISC_OFF);
    F.tid = threadIdx.x; F.lane = F.tid & 63; F.wave = __builtin_amdgcn_readfirstlane(F.tid >> 6);
    F.G = gridDim.x; { const int bx = blockIdx.x; F.vcu = (F.G % 8 == 0) ? (bx % 8) * (F.G / 8) + bx / 8 : bx; }
    F.A = &args;
    F.out = args.out; F.ws = args.ws; F.ctl = (gu32*)(args.ws + WS_CTL);
    for (int u = F.tid; u < (LDS_BYTES - LDSCTL_OFF) / 4; u += NTHR) ((LAS unsigned*)(F.lds + LDSCTL_OFF))[u] = 0u;
    __syncthreads();
#if MK_ONE_LAUNCH
    XcdBarrier bar = xcd_barrier_post((unsigned*)(F.ctl + CW_BAR), F.MISC + 8);
#define GRID_BAR() xcd_barrier(bar)
#else
#define GRID_BAR() do { } while (0)
#endif
    const int lo = args.ph_lo, hi = args.ph_hi;
#define IN(k) (lo <= (k) && (k) < hi)
#define SEAM(k) do { if (IN(k) && IN((k) + 1)) GRID_BAR(); } while (0)
    float* MOD = WSP(float, WS_MOD);
    pg8::bf16_t* Hb = WSP(pg8::bf16_t, WS_H);

    if (IN(0)) { p0_prologue(F); SEAM(0); }
    for (int l = 0; l < 2; ++l) {
        const int pb = 1 + PH_PER_LAYER * l;
        const float* modl = MOD + (size_t)l * 2 * 12288;
        if (IN(pb + 0) && l == 0) { norm_phase<true, false>(F, F.A->in[I_X], WSP(bf16, WS_H), F.A->in[I_N1G], modl, 0, 1);
            win8_phase(F);
            SEAM(pb + 0); }
        if (IN(pb + 1)) {
            pg8::Gemm g{Hb, (const pg8::bf16_t*)(WSP(unsigned char, WS_WIN) + (size_t)l * IN_DIM * 2048), T, IN_DIM, D / 2, D / 2, D / 2}; pg8::StaticOrder S; S.init(T, IN_DIM, F.G, (int)blockIdx.x);
            const float wmax = __uint_as_float(__hip_atomic_load(F.ctl + CW_WMAX + l, __ATOMIC_RELAXED, __HIP_MEMORY_SCOPE_AGENT));
            pg8::EpiInProj E{WSP(pg8::bf16_t, WS_U), WSP(pg8::bf16_t, WS_Q), WSP(pg8::bf16_t, WS_K), WSP(pg8::bf16_t, WS_V), WSP(pg8::bf16_t, WS_GC), WSP(pg8::bf16_t, WS_GA), WSP(float, WS_SA), wmax > 0.f ? wmax * (1.0f / 440.0f) : 1.0f, (unsigned*)(F.ctl + CW_VMAX + 2 * l)};
            pg8::gemm_phase<pg8::EpiInProj, pg8::StaticOrder, PG8_ALIGN, PG8_SP2, true>(F.lds, g, S, E);
            SEAM(pb + 1);
        }
        if (IN(pb + 2)) { conv_phase(F, l); __syncthreads(); attn_phase(F, l); SEAM(pb + 2); }
        if (IN(pb + 3)) {
            pg8::Gemm g{WSP(pg8::bf16_t, WS_AM), (const pg8::bf16_t*)(WSP(unsigned char, WS_WM) + (size_t)l * 2048 * 2048), T, D, D / 2, D / 2, D / 2}; pg8::StaticOrder S; S.init(T, D, F.G, (int)blockIdx.x);
            const float i440 = 1.0f / 440.0f;
            const float wc_ = __uint_as_float(__hip_atomic_load(F.ctl + CW_WMAX2 + 2 * l, __ATOMIC_RELAXED, __HIP_MEMORY_SCOPE_AGENT)), wa_ = __uint_as_float(__hip_atomic_load(F.ctl + CW_WMAX2 + 2 * l + 1, __ATOMIC_RELAXED, __HIP_MEMORY_SCOPE_AGENT));
            const float bc_ = __uint_as_float(__hip_atomic_load(F.ctl + CW_BC + l, __ATOMIC_RELAXED, __HIP_MEMORY_SCOPE_AGENT));
            const float swc = wc_ > 0.f ? wc_ * i440 : 1.0f, swa = wa_ > 0.f ? wa_ * i440 : 1.0f, sc = bc_ * i440;
            const float vm0 = __uint_as_float(__hip_atomic_load(F.ctl + CW_VMAX + 2 * l, __ATOMIC_RELAXED, __HIP_MEMORY_SCOPE_AGENT)), vm1 = __uint_as_float(__hip_atomic_load(F.ctl + CW_VMAX + 2 * l + 1, __ATOMIC_RELAXED, __HIP_MEMORY_SCOPE_AGENT));
            const float fe0 = (vm0 > 0.f ? 1.02f * vm0 * i440 : 1.0f) * swa, fe1 = (vm1 > 0.f ? 1.02f * vm1 * i440 : 1.0f) * swa;
            const float bc2 = __uint_as_float(__hip_atomic_load(F.ctl + CW_BC2 + l, __ATOMIC_RELAXED, __HIP_MEMORY_SCOPE_AGENT));
            const float bm0 = fmaxf(1024.0f * (bc2 * wc_ + 1.02f * vm0 * wa_), 1e-20f), bm1 = fmaxf(1024.0f * (bc2 * wc_ + 1.02f * vm1 * wa_), 1e-20f);
            pg8::EpiMerge E{WSP(pg8::bf16_t, WS_GC), WSP(pg8::bf16_t, WS_GA), WSP(unsigned char, WS_H), (sc * swc) / fe0, (sc * swc) / fe1, fe0 * (440.0f / bm0), fe1 * (440.0f / bm1)};
            pg8::gemm_phase<pg8::EpiMerge, pg8::StaticOrder, PG8_ALIGN, PG8_SP2, true>(F.lds, g, S, E);
            SEAM(pb + 3);
        }
        if (IN(pb + 5)) {
            pg8::Gemm g{Hb, (const pg8::bf16_t*)(WSP(unsigned char, WS_WO) + (size_t)l * 2048 * 2048), T, D, D / 2, D / 2, D / 2}; pg8::StaticOrder S; S.init(T, D, F.G, (int)blockIdx.x);
            const float i440 = 1.0f / 440.0f;
            const float wc_ = __uint_as_float(__hip_atomic_load(F.ctl + CW_WMAX2 + 2 * l, __ATOMIC_RELAXED, __HIP_MEMORY_SCOPE_AGENT)), wa_ = __uint_as_float(__hip_atomic_load(F.ctl + CW_WMAX2 + 2 * l + 1, __ATOMIC_RELAXED, __HIP_MEMORY_SCOPE_AGENT));
            const float wo_ = __uint_as_float(__hip_atomic_load(F.ctl + CW_WMAX3 + l, __ATOMIC_RELAXED, __HIP_MEMORY_SCOPE_AGENT)), swo = wo_ > 0.f ? wo_ * i440 : 1.0f;
            const float bc2 = __uint_as_float(__hip_atomic_load(F.ctl + CW_BC2 + l, __ATOMIC_RELAXED, __HIP_MEMORY_SCOPE_AGENT));
            const float vm0 = __uint_as_float(__hip_atomic_load(F.ctl + CW_VMAX + 2 * l, __ATOMIC_RELAXED, __HIP_MEMORY_SCOPE_AGENT)), vm1 = __uint_as_float(__hip_atomic_load(F.ctl + CW_VMAX + 2 * l + 1, __ATOMIC_RELAXED, __HIP_MEMORY_SCOPE_AGENT));
            const float bm0 = fmaxf(1024.0f * (bc2 * wc_ + 1.02f * vm0 * wa_), 1e-20f), bm1 = fmaxf(1024.0f * (bc2 * wc_ + 1.02f * vm1 * wa_), 1e-20f);
            if (l == 0) { pg8::EpiResid<false> E{F.A->in[I_X], WSP(pg8::bf16_t, WS_XA), modl + 2 * 2048, bm0 * i440 * swo, bm1 * i440 * swo};
                pg8::gemm_phase<pg8::EpiResid<false>, pg8::StaticOrder, PG8_ALIGN, PG8_SP2, true>(F.lds, g, S, E); }
            else { pg8::EpiResid<true> E{WSP(pg8::bf16_t, WS_XA), WSP(pg8::bf16_t, WS_XA), modl + 2 * 2048, bm0 * i440 * swo, bm1 * i440 * swo};
                pg8::gemm_phase<pg8::EpiResid<true>, pg8::StaticOrder, PG8_ALIGN, PG8_SP2, true>(F.lds, g, S, E); }
            SEAM(pb + 5);
        }
        if (IN(pb + 6)) { norm_phase<false, true>(F, WSP(bf16, WS_XA), WSP(bf16, WS_H), F.A->in[I_N2G] + (size_t)l * D, modl, 3, 4); SEAM(pb + 6); }
        if (IN(pb + 7)) {
            pg8::Gemm g{Hb, WSP(pg8::bf16_t, WS_WP) + (size_t)l * 2048 * 2048, T, D, D, D, D}; pg8::StaticOrder S; S.init(T, D, F.G, (int)blockIdx.x);
            pg8::EpiF16 E{WSP(_Float16, WS_GC), D};
            pg8::gemm_phase<pg8::EpiF16, pg8::StaticOrder, PG8_ALIGN, PG8_SP2>(F.lds, g, S, E);
            SEAM(pb + 7);
        }
        if (IN(pb + 8)) { topk_phase(F); SEAM(pb + 8); }
        if (IN(pb + 9)) { peer_act_phase(F, l); SEAM(pb + 9); }
        if (IN(pb + 10)) { peer_w_phase(F, l); SEAM(pb + 10); }
        if (IN(pb + 11)) { peer_out_phase(F, l); SEAM(pb + 11); }
        if (IN(pb + 12)) { peer_res_phase(F, l, WSP(bf16, WS_XA)); SEAM(pb + 12); }
    }
#undef IN
#undef SEAM
}

extern "C" void kernel_launch(void* const* d_in, const int* in_sizes, int n_in, void* d_out, int out_size, void* d_ws, size_t ws_size, hipStream_t stream) {
    static int grid = 0;
    if (grid == 0) {
        if (n_in != N_IN || out_size != T * D || ws_size < WS_END) { fprintf(stderr, "kernel_launch: unexpected problem: n_in %d out %d ws %zu (need %zu)\n", n_in, out_size, ws_size, (size_t)WS_END); grid = -1; return; }
        int dev = 0, cus = 0, per_cu = 0;
        if (hipGetDevice(&dev) != hipSuccess || hipDeviceGetAttribute(&cus, hipDeviceAttributeMultiprocessorCount, dev) != hipSuccess) { grid = -1; return; }
        if (hipFuncSetAttribute((const void*)fwd, hipFuncAttributeMaxDynamicSharedMemorySize, LDS_BYTES) != hipSuccess) { fprintf(stderr, "kernel_launch: hipFuncSetAttribute failed\n"); grid = -1; return; }
        if (hipOccupancyMaxActiveBlocksPerMultiprocessor(&per_cu, (const void*)fwd, NTHR, LDS_BYTES) != hipSuccess || per_cu < 1) fprintf(stderr, "kernel_launch: occupancy query reports %d\n", per_cu);
        (void)hipGetLastError();
        grid = cus;
    }
    if (grid < 0) return;
    (void)in_sizes;
    if (hipMemsetAsync((char*)d_ws + WS_CTL, 0, CTL_ZERO_BYTES, stream) != hipSuccess) return;
    Args a{};
    for (int i = 0; i < N_IN; ++i) a.in[i] = (const float*)d_in[i];
    a.out = (float*)d_out; a.ws = (unsigned char*)d_ws;
#if MK_ONE_LAUNCH
    a.ph_lo = 0; a.ph_hi = N_PHASES;
    hipLaunchKernelGGL(fwd, dim3(grid), dim3(NTHR), LDS_BYTES, stream, a);
#else
    for (int p = 0; p < N_PHASES; ++p) {
        if (p == 1 + PH_PER_LAYER) continue;
        a.ph_lo = p; a.ph_hi = p + 1;
        hipLaunchKernelGGL(fwd, dim3(grid), dim3(NTHR), LDS_BYTES, stream, a);
    }
#endif
}
```

```cpp
#include <hip/hip_runtime.h>
#include <cstdio>
#include <cstdint>
namespace pg8 {
#define PG8_LAS __attribute__((address_space(3)))
typedef unsigned short bf16_t;
typedef short bf16x8 __attribute__((ext_vector_type(8)));
typedef float f32x4 __attribute__((ext_vector_type(4)));
typedef unsigned u32x4 __attribute__((ext_vector_type(4)));
typedef int i32x4 __attribute__((ext_vector_type(4)));
typedef int i32x8 __attribute__((ext_vector_type(8)));
__device__ __forceinline__ i32x8 cat8(const bf16x8& a, const bf16x8& b) { const i32x4 x = __builtin_bit_cast(i32x4, a), y = __builtin_bit_cast(i32x4, b); return (i32x8){x[0], x[1], x[2], x[3], y[0], y[1], y[2], y[3]}; }
constexpr int BM = 256, BK = 64, HALF = 128, HTB = HALF * BK * 2  , STAGE_BYTES = 8 * HTB, NXCD = 8, WGM = 4;

__host__ __device__ __forceinline__ int lds_byte(int r, int c) { const int st = (r >> 4) * 2 + (c >> 5), rr = r & 15, cc = c & 31, ob = rr * 64 + cc * 2; return st * 1024 + (ob ^ (((ob >> 9) & 1) << 5)); }
__host__ __device__ __forceinline__ void stage_rc(int b, int& R, int& C) { const int st = b / 1024, sb = b % 1024, swz = sb ^ (((sb >> 9) & 1) << 5); R = (st >> 1) * 16 + swz / 64; C = (st & 1) * 32 + (swz % 64) / 2; }
__host__ __device__ __forceinline__ int perm32(int rho) { const int n = rho >> 4, i = rho & 15; return 8 * (i >> 2) + 4 * n + (i & 3); }

struct Unit { int pm, pn; };
struct Gemm { const bf16_t* A; const bf16_t* Bt; int M, N, K, lda, ldb; };

struct StaticOrder {
    int nM, nN, nwg, G, c, wgm;
    __host__ __device__ void init(int M, int N, int G_, int c_, int wgm_ = WGM) { nM = M / BM; nN = N / BM; nwg = nM * nN; G = G_; c = c_; wgm = wgm_; }
    __host__ __device__ bool next(int i, Unit& u) const {
        const long L = (long)i * G + c; if (L >= nwg) return false;
        int wgid = (int)L; { const int q = nwg / NXCD, r = nwg % NXCD, xcd = wgid % NXCD, off = wgid / NXCD; wgid = (xcd < r ? xcd * (q + 1) : r * (q + 1) + (xcd - r) * q) + off; }
        const int nig = wgm * nN, gid = wgid / nig, fm = gid * wgm, gsz = (nM - fm) < wgm ? (nM - fm) : wgm;
        u.pm = fm + ((wgid % nig) % gsz); u.pn = (wgid % nig) / gsz; return true;
    }
    __device__ __forceinline__ void a_ready(const Unit&) const {}
    __device__ __forceinline__ void done(const Unit&) const {}
};

__device__ __forceinline__ unsigned cvt_pk_bf16(float lo, float hi) { unsigned r; asm volatile("v_cvt_pk_bf16_f32 %0, %1, %2" : "=v"(r) : "v"(lo), "v"(hi)); return r; }
typedef float f32x2 __attribute__((ext_vector_type(2)));
template <class Epi, class Sched, bool ALIGN_EPI = false, bool SP2 = false, bool FP8 = false>
__device__ __forceinline__ void gemm_phase(PG8_LAS unsigned char* lds, const Gemm g, const Sched& S, const Epi& E) {
    int tid_ = threadIdx.x; asm volatile("" : "+v"(tid_));
    const int tid = tid_, wid = __builtin_amdgcn_readfirstlane(tid >> 6), lane = tid & 63, wr = wid >> 2, wc = wid & 3, fr = lane & 15, fq = lane >> 4;
    const int K = g.K, nt = K / BK;
    unsigned voffA[2], voffB[2];
#pragma unroll
    for (int i = 0; i < 2; ++i) { int R, C; stage_rc(tid * 16 + i * 8192, R, C); const int Rb = Epi::PERM ? ((R & ~31) + perm32(R & 31)) : R;
        voffA[i] = (unsigned)(R * g.lda + C) * 2u; voffB[i] = (unsigned)(Rb * g.ldb + C) * 2u; }
    const size_t kstep = (size_t)(BK * 2);
    const size_t hstepA = (size_t)HALF * g.lda * 2, hstepB = (size_t)HALF * g.ldb * 2;
    const size_t tstepA = 2 * hstepA, tstepB = 2 * hstepB;
    const unsigned ldsw = (unsigned)wid * 1024u;
    const int aoff = lds_byte(wr * 64 + fr, fq * 8), boff = lds_byte(wc * 32 + fr, fq * 8);
#define PG8_SA(b, h) (((b) * 2 + (h)) * HTB)
#define PG8_SB(b, h) ((4 + (b) * 2 + (h)) * HTB)
#define PG8_STAGE(bufoff, gbase, voff) do { _Pragma("unroll") for (int _i = 0; _i < 2; ++_i) \
        __builtin_amdgcn_global_load_lds((const unsigned*)((const char*)(gbase) + (voff)[_i]), (PG8_LAS unsigned*)(lds + (bufoff) + ldsw + _i * 8192), 16, 0, 0); } while (0)
#define PG8_LDA(dst, b, h) do { _Pragma("unroll") for (int m = 0; m < 4; ++m) _Pragma("unroll") for (int k = 0; k < 2; ++k) dst[m][k] = *(const PG8_LAS bf16x8*)(lds + PG8_SA(b, h) + aoff + m * 2048 + k * 1024); } while (0)
#define PG8_LDB(dst, b, h) do { _Pragma("unroll") for (int n = 0; n < 2; ++n) _Pragma("unroll") for (int k = 0; k < 2; ++k) dst[n][k] = *(const PG8_LAS bf16x8*)(lds + PG8_SB(b, h) + boff + n * 2048 + k * 1024); } while (0)
#define PG8_MMA(ai, bj, At, Bt) do { __builtin_amdgcn_s_setprio(1); _Pragma("unroll") for (int m = 0; m < 4; ++m) _Pragma("unroll") for (int n = 0; n < 2; ++n) { \
        if constexpr (FP8) { asm volatile("v_mfma_f32_16x16x128_f8f6f4 %0, %1, %2, %0" : "+v"(acc[ai][bj][m][n]) : "v"(cat8(Bt[n][0], Bt[n][1])), "v"(cat8(At[m][0], At[m][1]))); } \
        else { _Pragma("unroll") for (int k = 0; k < 2; ++k) acc[ai][bj][m][n] = __builtin_amdgcn_mfma_f32_16x16x32_bf16(Bt[n][k], At[m][k], acc[ai][bj][m][n], 0, 0, 0); } } __builtin_amdgcn_s_setprio(0); } while (0)
#define PG8_WAIT_V(n) asm volatile("s_waitcnt vmcnt(" #n ")" ::: "memory")
#define PG8_WAIT_L(n) asm volatile("s_waitcnt lgkmcnt(" #n ")" ::: "memory")
#define PG8_BAR __builtin_amdgcn_s_barrier()
#define PG8_SCHED __builtin_amdgcn_sched_barrier(0)
    Unit cur, nxt; int ui = 0;
    if (!S.next(0, cur)) return;
    f32x4 acc[2][2][4][2];
#pragma unroll
    for (int a = 0; a < 2; ++a)
#pragma unroll
        for (int b = 0; b < 2; ++b)
#pragma unroll
            for (int m = 0; m < 4; ++m)
#pragma unroll
                for (int n = 0; n < 2; ++n) acc[a][b][m][n] = (f32x4){0.f, 0.f, 0.f, 0.f};
    bf16x8 At[4][2], B0[2][2], B1[2][2];
    const char* cA = (const char*)g.A + (size_t)cur.pm * tstepA; const char* cB = (const char*)g.Bt + (size_t)cur.pn * tstepB;
    S.a_ready(cur);
    if constexpr (SP2) {
        PG8_STAGE(PG8_SB(0, 0), cB, voffB); PG8_STAGE(PG8_SB(0, 1), cB + hstepB, voffB); PG8_STAGE(PG8_SA(0, 0), cA, voffA); PG8_STAGE(PG8_SA(0, 1), cA + hstepA, voffA);
        if (wr == 1) PG8_BAR;
        PG8_WAIT_V(2); PG8_BAR;
        PG8_STAGE(PG8_SB(1, 0), cB + kstep, voffB); PG8_STAGE(PG8_SA(1, 0), cA + kstep, voffA); PG8_STAGE(PG8_SB(1, 1), cB + hstepB + kstep, voffB);
        PG8_WAIT_V(6); PG8_BAR;
    } else {
        PG8_STAGE(PG8_SB(0, 0), cB, voffB); PG8_STAGE(PG8_SA(0, 0), cA, voffA); PG8_STAGE(PG8_SB(0, 1), cB + hstepB, voffB); PG8_STAGE(PG8_SA(0, 1), cA + hstepA, voffA);
        if (wr == 1) PG8_BAR;
        PG8_WAIT_V(4); PG8_BAR;
        PG8_STAGE(PG8_SB(1, 0), cB + kstep, voffB); PG8_STAGE(PG8_SA(1, 0), cA + kstep, voffA); PG8_STAGE(PG8_SB(1, 1), cB + hstepB + kstep, voffB);
        PG8_WAIT_V(6); PG8_BAR;
    }
    for (;;) {
        const bool has_next = S.next(ui + 1, nxt);
        const char* nA = has_next ? (const char*)g.A + (size_t)nxt.pm * tstepA : cA; const char* nB = has_next ? (const char*)g.Bt + (size_t)nxt.pn * tstepB : cB;
        for (int t = 0; t < nt; t += 2) {
            if constexpr (Epi::HAS_MID) { if (t == (nt >> 1)) { if constexpr (FP8) { asm volatile("s_nop 15\n\ts_nop 15" ::: "memory"); }
                E.mid(acc, cur, wr, wc, fr, fq); } }
            const bool last = (t == nt - 2);
            const char* a1 = cA + (size_t)(t + 1) * kstep;
            const char* a2 = last ? nA : cA + (size_t)(t + 2) * kstep; const char* b2 = last ? nB : cB + (size_t)(t + 2) * kstep;
            const char* a3 = a2 + kstep; const char* b3 = b2 + kstep;
            if (last && has_next) S.a_ready(nxt);
            if constexpr (SP2) {
            PG8_LDB(B0, 0, 0); PG8_LDB(B1, 0, 1); PG8_SCHED; PG8_LDA(At, 0, 0); PG8_STAGE(PG8_SA(1, 1), a1 + hstepA, voffA);
            PG8_WAIT_V(8); PG8_WAIT_L(0); PG8_BAR; PG8_MMA(0, 0, At, B0); PG8_MMA(0, 1, At, B1); PG8_BAR; PG8_SCHED;
            PG8_LDA(At, 0, 1); PG8_STAGE(PG8_SB(0, 0), b2, voffB); PG8_STAGE(PG8_SB(0, 1), b2 + hstepB, voffB); PG8_STAGE(PG8_SA(0, 0), a2, voffA);
            PG8_WAIT_V(8); PG8_WAIT_L(0); PG8_BAR; PG8_MMA(1, 0, At, B0); PG8_MMA(1, 1, At, B1); PG8_BAR; PG8_SCHED;
            PG8_LDB(B0, 1, 0); PG8_LDB(B1, 1, 1); PG8_SCHED; PG8_LDA(At, 1, 0); PG8_STAGE(PG8_SA(0, 1), a2 + hstepA, voffA);
            PG8_WAIT_V(8); PG8_WAIT_L(0); PG8_BAR; PG8_MMA(0, 0, At, B0); PG8_MMA(0, 1, At, B1); PG8_BAR; PG8_SCHED;
            PG8_LDA(At, 1, 1); PG8_STAGE(PG8_SB(1, 0), b3, voffB); PG8_STAGE(PG8_SB(1, 1), b3 + hstepB, voffB); PG8_STAGE(PG8_SA(1, 0), a3, voffA);
            PG8_WAIT_V(8); PG8_WAIT_L(0); PG8_BAR; PG8_MMA(1, 0, At, B0); PG8_MMA(1, 1, At, B1); PG8_BAR; PG8_SCHED;
            } else {
            PG8_LDB(B0, 0, 0); PG8_SCHED; PG8_LDA(At, 0, 0); PG8_STAGE(PG8_SA(1, 1), a1 + hstepA, voffA);
            PG8_WAIT_L(8); PG8_BAR; PG8_WAIT_L(0); PG8_MMA(0, 0, At, B0); PG8_BAR; PG8_SCHED;
            PG8_LDB(B1, 0, 1); PG8_STAGE(PG8_SB(0, 0), b2, voffB);
            PG8_BAR; PG8_WAIT_L(0); PG8_MMA(0, 1, At, B1); PG8_BAR;
            PG8_LDA(At, 0, 1); PG8_STAGE(PG8_SA(0, 0), a2, voffA);
            PG8_BAR; PG8_WAIT_L(0); PG8_MMA(1, 0, At, B0); PG8_BAR; PG8_SCHED;
            PG8_STAGE(PG8_SB(0, 1), b2 + hstepB, voffB);
            PG8_WAIT_V(6); PG8_BAR; PG8_MMA(1, 1, At, B1); PG8_BAR;
            PG8_LDB(B0, 1, 0); PG8_SCHED; PG8_LDA(At, 1, 0); PG8_STAGE(PG8_SA(0, 1), a2 + hstepA, voffA);
            PG8_WAIT_L(8); PG8_BAR; PG8_WAIT_L(0); PG8_MMA(0, 0, At, B0); PG8_BAR; PG8_SCHED;
            PG8_LDB(B1, 1, 1); PG8_STAGE(PG8_SB(1, 0), b3, voffB);
            PG8_BAR; PG8_WAIT_L(0); PG8_MMA(0, 1, At, B1); PG8_BAR;
            PG8_LDA(At, 1, 1); PG8_STAGE(PG8_SA(1, 0), a3, voffA);
            PG8_BAR; PG8_WAIT_L(0); PG8_MMA(1, 0, At, B0); PG8_BAR; PG8_SCHED;
            PG8_STAGE(PG8_SB(1, 1), b3 + hstepB, voffB);
            PG8_WAIT_V(6); PG8_BAR; PG8_MMA(1, 1, At, B1); PG8_BAR;
            }
        }
        if constexpr (FP8) { asm volatile("s_nop 15\n\ts_nop 15" ::: "memory"); }
        if constexpr (ALIGN_EPI) { if (wr == 0) PG8_BAR; }
        if constexpr (!Epi::AFTER_DRAIN) { E(acc, cur, wr, wc, fr, fq); S.done(cur); }
        if (!has_next) break;
#pragma unroll
        for (int a = 0; a < 2; ++a)
#pragma unroll
            for (int b = 0; b < 2; ++b)
#pragma unroll
                for (int m = 0; m < 4; ++m)
#pragma unroll
                    for (int n = 0; n < 2; ++n) acc[a][b][m][n] = (f32x4){0.f, 0.f, 0.f, 0.f};
        cur = nxt; cA = nA; cB = nB; ++ui;
        if constexpr (ALIGN_EPI) { if (wr == 1) PG8_BAR; }
    }
    PG8_WAIT_V(0);
    if constexpr (!ALIGN_EPI) { if (wr == 0) PG8_BAR; }
    PG8_BAR;
    if constexpr (Epi::AFTER_DRAIN) { E.fused(acc, cur, wr, wc, fr, fq, lds, wid, lane); S.done(cur); }
#undef PG8_SA
#undef PG8_SB
#undef PG8_STAGE
#undef PG8_LDA
#undef PG8_LDB
#undef PG8_MMA
#undef PG8_WAIT_V
#undef PG8_WAIT_L
#undef PG8_BAR
#undef PG8_SCHED
}
}

constexpr int T = 16384, D = 2048, SEQ = 8192, CONV = 1024, CWID = 31, NHEAD = 16, NKVH = 4, HD = 64, ATT = 1024, KVD = 256, IN_DIM = 7680, NEXP = 16384, PHEADS = 8, TOPK = 16;
constexpr float EPS = 1e-6f;
constexpr int NSL = 16, SLW = 128;
constexpr int NWAVES = 8, NTHR = NWAVES * 64;
enum { I_X = 0, I_C, I_RELB, I_ADAW, I_ADAB, I_N1G, I_WIN, I_DWW, I_DWB, I_CLNG, I_CLNB, I_WCO, I_SINK, I_WAO, I_WOUT, I_N2G, I_WPQ, I_SK, I_PU, I_PV, I_FG, N_IN };

constexpr size_t MiB = 1u << 20;
constexpr size_t WS_CTL = 0, CTL_ZERO_BYTES = 1 * MiB;
constexpr size_t WS_MOD = 1 * MiB;
constexpr size_t WS_BIAS = 1 * MiB + 512 * 1024;
constexpr size_t WS_SCL = 1 * MiB + 640 * 1024;
constexpr size_t WS_WIN = 2 * MiB;
constexpr size_t WS_SA = 1 * MiB + 896 * 1024;
constexpr size_t WS_WM = 62 * MiB;
constexpr size_t WS_WO = 78 * MiB;
constexpr size_t WS_WP = 94 * MiB;
constexpr size_t WS_PU = 110 * MiB;
constexpr size_t WS_PV = 238 * MiB;
constexpr size_t WS_H = 366 * MiB;
constexpr size_t WS_U = 430 * MiB;
constexpr size_t WS_Q = 462 * MiB;
constexpr size_t WS_K = 494 * MiB;
constexpr size_t WS_V = 502 * MiB;
constexpr size_t WS_GC = 510 * MiB;
constexpr size_t WS_GA = 574 * MiB;
constexpr size_t WS_AM = 638 * MiB;
constexpr size_t WS_Y1 = 702 * MiB;
constexpr size_t WS_XA = 766 * MiB;
constexpr size_t WS_END = 894 * MiB;
constexpr int CW_TMO = 0, CW_QUEUE = 64, CW_QUEUE2 = 128, CW_WMAX = 192, CW_WMAX2 = 194, CW_WMAX3 = 198, CW_VMAX = 200, CW_BC = 204, CW_BC2 = 206, CW_BAR = 4096;

constexpr int RING_BYTES = 131072, LDSCTL_OFF = RING_BYTES, MISC_OFF = LDSCTL_OFF + 320, LDS_BYTES = 147456;

#define GAS __attribute__((address_space(1)))
#define LAS __attribute__((address_space(3)))
typedef unsigned short bf16;
typedef unsigned v4u __attribute__((ext_vector_type(4)));
typedef unsigned v2u __attribute__((ext_vector_type(2)));
typedef float f32x4 __attribute__((ext_vector_type(4)));
typedef float f32x2 __attribute__((ext_vector_type(2)));
typedef float f32x16 __attribute__((ext_vector_type(16)));
typedef short bf16x8 __attribute__((ext_vector_type(8)));
typedef __bf16 bf16x2v __attribute__((ext_vector_type(2)));
typedef GAS unsigned gu32;
#define LDS_WAIT() asm volatile("s_waitcnt lgkmcnt(0)" ::: "memory")
#define VM_WAIT() asm volatile("s_waitcnt vmcnt(0)" ::: "memory")
__device__ __forceinline__ unsigned f2bf(float f) { unsigned u = __builtin_bit_cast(unsigned, f); return (u + 0x7fffu + ((u >> 16) & 1u)) >> 16; }
__device__ __forceinline__ unsigned pk2(float lo, float hi) { f32x2 v = {lo, hi}; bf16x2v b = __builtin_convertvector(v, bf16x2v); return __builtin_bit_cast(unsigned, b); }
__device__ __forceinline__ float bflo(unsigned p) { return __uint_as_float(p << 16); }
__device__ __forceinline__ float bfhi(unsigned p) { return __uint_as_float(p & 0xffff0000u); }
__device__ __forceinline__ float sigmoidf_(float x) { return __builtin_amdgcn_rcpf(1.0f + __expf(-x)); }
__device__ __forceinline__ float dot2bf(unsigned a, unsigned b, float c) { return __builtin_amdgcn_fdot2_f32_bf16(__builtin_bit_cast(bf16x2v, a), __builtin_bit_cast(bf16x2v, b), c, false); }
__device__ __forceinline__ float wave_sum(float v) {
#pragma unroll
    for (int o = 1; o < 64; o <<= 1) v += __shfl_xor(v, o);
    return v;
}

template <int CTRL> __device__ __forceinline__ float dpp_mov(float v) { return __builtin_bit_cast(float, __builtin_amdgcn_update_dpp(0, __builtin_bit_cast(int, v), CTRL, 0xf, 0xf, true)); }
__device__ __forceinline__ float lane_xor1(float v) { return dpp_mov<0xB1>(v); }
__device__ __forceinline__ float lane_xor2(float v) { return dpp_mov<0x4E>(v); }
__device__ __forceinline__ float lane_xor4(float v) { return dpp_mov<0x141>(dpp_mov<0x1B>(v)); }
__device__ __forceinline__ float lane_xor8(float v) { return dpp_mov<0x128>(v); }
__device__ __forceinline__ float lane_xor16(float v) { return __builtin_bit_cast(float, __builtin_amdgcn_ds_swizzle(__builtin_bit_cast(int, v), 0x401F)); }

namespace pg8 {
__device__ __forceinline__ float sigm(float x) { return __builtin_amdgcn_rcpf(1.0f + __expf(-x)); }
__device__ __forceinline__ u32x4 pack8(const f32x4& v0, const f32x4& v1) { u32x4 w; w.x = cvt_pk_bf16(v0[0], v0[1]); w.y = cvt_pk_bf16(v0[2], v0[3]); w.z = cvt_pk_bf16(v1[0], v1[1]); w.w = cvt_pk_bf16(v1[2], v1[3]); return w; }
__device__ __forceinline__ float blo(unsigned p) { return __uint_as_float(p << 16); }
__device__ __forceinline__ float bhi(unsigned p) { return __uint_as_float(p & 0xffff0000u); }
struct EpiInProj {
    static constexpr bool PERM = true, AFTER_DRAIN = false, HAS_MID = false;
    bf16_t *U, *Q, *K, *V, *GC, *GA; const float* sa; float sw; unsigned* vmax;
    __device__ __forceinline__ void operator()(const f32x4 (&acc)[2][2][4][2], const Unit& u, int wr, int wc, int fr, int fq) const {
        const int row0 = u.pm * BM + wr * 64 + fr, cw = wc * 32 + 8 * fq, pn = u.pn;
        float rsv[2][4];
        { const float* sp = sa + row0;
          asm volatile("global_load_dword %0, %8, off\n\tglobal_load_dword %1, %8, off offset:64\n\tglobal_load_dword %2, %8, off offset:128\n\tglobal_load_dword %3, %8, off offset:192\n\t"
                       "global_load_dword %4, %8, off offset:512\n\tglobal_load_dword %5, %8, off offset:576\n\tglobal_load_dword %6, %8, off offset:640\n\tglobal_load_dword %7, %8, off offset:704\n\ts_waitcnt vmcnt(0)"
                       : "=&v"(rsv[0][0]), "=&v"(rsv[0][1]), "=&v"(rsv[0][2]), "=&v"(rsv[0][3]), "=&v"(rsv[1][0]), "=&v"(rsv[1][1]), "=&v"(rsv[1][2]), "=&v"(rsv[1][3]) : "v"(sp) : "memory"); }
        if (pn < 8) {
#pragma unroll
            for (int ai = 0; ai < 2; ++ai)
#pragma unroll
                for (int m = 0; m < 4; ++m) { bf16_t* p = U + (size_t)(row0 + ai * HALF + m * 16) * 1024 + pn * 128 + cw; const float rs = rsv[ai][m] * sw;
                    f32x4 a0 = acc[ai][0][m][0] * rs, a1 = acc[ai][0][m][1] * rs; const f32x4 b0 = acc[ai][1][m][0] * rs, b1 = acc[ai][1][m][1] * rs;
#pragma unroll
                    for (int i = 0; i < 4; ++i) { a0[i] *= sigm(b0[i]); a1[i] *= sigm(b1[i]); }
                    *(u32x4*)p = pack8(a0, a1); }
        } else {
            bf16_t* base; int ld, cb, mode;
            if (pn < 12) { base = Q; ld = 1024; cb = (pn - 8) * 256; mode = 0; }
            else if (pn == 12) { base = K; ld = 256; cb = 0; mode = 1; }
            else if (pn == 13) { base = V; ld = 256; cb = 0; mode = 1; }
            else if (pn < 22) { base = GC; ld = 2048; cb = (pn - 14) * 256; mode = 2; }
            else { base = GA; ld = 2048; cb = (pn - 22) * 256; mode = 2; }
            float vm = 0.f;
#pragma unroll
            for (int ai = 0; ai < 2; ++ai)
#pragma unroll
                for (int m = 0; m < 4; ++m) { bf16_t* p = base + (size_t)(row0 + ai * HALF + m * 16) * ld + cb + cw; const float rs = rsv[ai][m] * sw;
#pragma unroll
                    for (int bj = 0; bj < 2; ++bj) { f32x4 v0 = acc[ai][bj][m][0] * rs, v1 = acc[ai][bj][m][1] * rs;
                        if (pn == 13) vm = fmaxf(vm, fmaxf(fmaxf(fmaxf(fabsf(v0[0]), fabsf(v0[1])), fmaxf(fabsf(v0[2]), fabsf(v0[3]))), fmaxf(fmaxf(fabsf(v1[0]), fabsf(v1[1])), fmaxf(fabsf(v1[2]), fabsf(v1[3])))));
                        if (mode == 0) { v0 = v0 * 0.125f; v1 = v1 * 0.125f; }
                        else if (mode == 2) {
#pragma unroll
                            for (int i = 0; i < 4; ++i) { v0[i] = sigm(v0[i]); v1[i] = sigm(v1[i]); } }
                        *(u32x4*)(p + bj * HALF) = pack8(v0, v1); } }
            if (pn == 13) {
#pragma unroll
                for (int o = 1; o < 64; o <<= 1) vm = fmaxf(vm, __shfl_xor(vm, o));
                if ((threadIdx.x & 63) == 0) __hip_atomic_fetch_max(vmax + (u.pm >> 5), __float_as_uint(vm), __ATOMIC_RELAXED, __HIP_MEMORY_SCOPE_AGENT); }
        }
    }
};
struct EpiMerge {
    static constexpr bool PERM = true, AFTER_DRAIN = false, HAS_MID = true;
    const bf16_t* GC; const bf16_t* GA; unsigned char* O; float fmid0, fmid1, fend0, fend1;
    __device__ __forceinline__ void mid(f32x4 (&acc)[2][2][4][2], const Unit& u, int wr, int wc, int fr, int fq) const {
        int row0 = u.pm * BM + wr * 64 + fr, c0 = u.pn * BM + wc * 32 + 8 * fq; const float fmd = (u.pm >> 5) ? fmid1 : fmid0;
        asm volatile("" : "+v"(row0), "+v"(c0));
#pragma unroll
        for (int ai = 0; ai < 2; ++ai)
#pragma unroll
            for (int mh = 0; mh < 2; ++mh) { u32x4 gc[2][2], ga[2][2];
#pragma unroll
                for (int mm = 0; mm < 2; ++mm)
#pragma unroll
                    for (int bj = 0; bj < 2; ++bj) { const size_t off = (size_t)(row0 + ai * HALF + (2 * mh + mm) * 16) * 2048 + c0 + bj * HALF; gc[mm][bj] = *(const u32x4*)(GC + off); ga[mm][bj] = *(const u32x4*)(GA + off); }
                __builtin_amdgcn_sched_barrier(0);
#pragma unroll
                for (int mm = 0; mm < 2; ++mm)
#pragma unroll
                    for (int bj = 0; bj < 2; ++bj) { const int m = 2 * mh + mm; const u32x4 c = gc[mm][bj], a = ga[mm][bj];
#define RT_(cw_, aw_, HI_) ((HI_ ? bhi(cw_) : blo(cw_)) * fmd * __builtin_amdgcn_rcpf(fmaxf(HI_ ? bhi(aw_) : blo(aw_), 1e-30f)))
                        acc[ai][bj][m][0][0] *= RT_(c.x, a.x, 0); acc[ai][bj][m][0][1] *= RT_(c.x, a.x, 1); acc[ai][bj][m][0][2] *= RT_(c.y, a.y, 0); acc[ai][bj][m][0][3] *= RT_(c.y, a.y, 1);
                        acc[ai][bj][m][1][0] *= RT_(c.z, a.z, 0); acc[ai][bj][m][1][1] *= RT_(c.z, a.z, 1); acc[ai][bj][m][1][2] *= RT_(c.w, a.w, 0); acc[ai][bj][m][1][3] *= RT_(c.w, a.w, 1);
#undef RT_
                    }
                __builtin_amdgcn_sched_barrier(0); }
    }
    __device__ __forceinline__ void operator()(const f32x4 (&acc)[2][2][4][2], const Unit& u, int wr, int wc, int fr, int fq) const {
        const int row0 = u.pm * BM + wr * 64 + fr, c0 = u.pn * BM + wc * 32 + 8 * fq; const float fe = (u.pm >> 5) ? fend1 : fend0;
#pragma unroll
        for (int ai = 0; ai < 2; ++ai) { u32x4 g[4][2];
#pragma unroll
            for (int m = 0; m < 4; ++m)
#pragma unroll
                for (int bj = 0; bj < 2; ++bj) g[m][bj] = *(const u32x4*)(GA + (size_t)(row0 + ai * HALF + m * 16) * 2048 + c0 + bj * HALF);
            __builtin_amdgcn_sched_barrier(0);
#pragma unroll
            for (int m = 0; m < 4; ++m)
#pragma unroll
                for (int bj = 0; bj < 2; ++bj) { const size_t off = (size_t)(row0 + ai * HALF + m * 16) * 2048 + c0 + bj * HALF; const u32x4 gg = g[m][bj]; f32x4 v0 = acc[ai][bj][m][0], v1 = acc[ai][bj][m][1];
                    v0[0] *= fmaxf(blo(gg.x), 1e-30f) * fe; v0[1] *= fmaxf(bhi(gg.x), 1e-30f) * fe; v0[2] *= fmaxf(blo(gg.y), 1e-30f) * fe; v0[3] *= fmaxf(bhi(gg.y), 1e-30f) * fe;
                    v1[0] *= fmaxf(blo(gg.z), 1e-30f) * fe; v1[1] *= fmaxf(bhi(gg.z), 1e-30f) * fe; v1[2] *= fmaxf(blo(gg.w), 1e-30f) * fe; v1[3] *= fmaxf(bhi(gg.w), 1e-30f) * fe;
                    int lo = __builtin_amdgcn_cvt_pk_fp8_f32(v0[0], v0[1], 0, false); lo = __builtin_amdgcn_cvt_pk_fp8_f32(v0[2], v0[3], lo, true);
                    int hi = __builtin_amdgcn_cvt_pk_fp8_f32(v1[0], v1[1], 0, false); hi = __builtin_amdgcn_cvt_pk_fp8_f32(v1[2], v1[3], hi, true);
                    typedef unsigned u32x2s __attribute__((ext_vector_type(2))); *(u32x2s*)(O + off) = (u32x2s){(unsigned)lo, (unsigned)hi}; }
            __builtin_amdgcn_sched_barrier(0); }
    }
};
template <bool XB_BF16>
struct EpiResid {
    static constexpr bool PERM = true, AFTER_DRAIN = false, HAS_MID = false;
    const void* XB; bf16_t* XO; const float* gvec; float fo0, fo1;
    __device__ __forceinline__ void operator()(const f32x4 (&acc)[2][2][4][2], const Unit& u, int wr, int wc, int fr, int fq) const {
        const int row0 = u.pm * BM + wr * 64 + fr, c0 = u.pn * BM + wc * 32 + 8 * fq; const float* gp = gvec + (size_t)(u.pm >> 5) * 12288;
        const float fo = (u.pm >> 5) ? fo1 : fo0;
#pragma unroll
        for (int bj = 0; bj < 2; ++bj) { const int col = c0 + bj * HALF; const f32x4 g0 = *(const f32x4*)(gp + col) * fo, g1 = *(const f32x4*)(gp + col + 4) * fo;
#pragma unroll
            for (int ai = 0; ai < 2; ++ai) { f32x4 xa[4], xb[4]; u32x4 xq[4];
#pragma unroll
                for (int m = 0; m < 4; ++m) { const size_t off = (size_t)(row0 + ai * HALF + m * 16) * 2048 + col;
                    if constexpr (XB_BF16) xq[m] = *(const u32x4*)((const bf16_t*)XB + off); else { xa[m] = *(const f32x4*)((const float*)XB + off); xb[m] = *(const f32x4*)((const float*)XB + off + 4); } }
                __builtin_amdgcn_sched_barrier(0);
#pragma unroll
                for (int m = 0; m < 4; ++m) { const size_t off = (size_t)(row0 + ai * HALF + m * 16) * 2048 + col;
                    if constexpr (XB_BF16) { xa[m] = (f32x4){blo(xq[m].x), bhi(xq[m].x), blo(xq[m].y), bhi(xq[m].y)}; xb[m] = (f32x4){blo(xq[m].z), bhi(xq[m].z), blo(xq[m].w), bhi(xq[m].w)}; }
                    *(u32x4*)(XO + off) = pack8(xa[m] + g0 * acc[ai][bj][m][0], xb[m] + g1 * acc[ai][bj][m][1]); }
                __builtin_amdgcn_sched_barrier(0); } }
    }
};
typedef _Float16 f16x8 __attribute__((ext_vector_type(8)));
struct EpiF16 {
    static constexpr bool PERM = true, AFTER_DRAIN = false, HAS_MID = false;
    _Float16* O; int ldc;
    __device__ __forceinline__ void operator()(const f32x4 (&acc)[2][2][4][2], const Unit& u, int wr, int wc, int fr, int fq) const {
        const int row0 = u.pm * BM + wr * 64 + fr, c0 = u.pn * BM + wc * 32 + 8 * fq;
#pragma unroll
        for (int ai = 0; ai < 2; ++ai)
#pragma unroll
            for (int m = 0; m < 4; ++m)
#pragma unroll
                for (int bj = 0; bj < 2; ++bj) { const f32x4 v0 = acc[ai][bj][m][0], v1 = acc[ai][bj][m][1];
                    const f16x8 h = {(_Float16)v0[0], (_Float16)v0[1], (_Float16)v0[2], (_Float16)v0[3], (_Float16)v1[0], (_Float16)v1[1], (_Float16)v1[2], (_Float16)v1[3]};
                    *(f16x8*)(O + (size_t)(row0 + ai * HALF + m * 16) * ldc + c0 + bj * HALF) = h; }
    }
};
}

#define XB_TMO      128
#define XB_XCNT(j)  (256  + 64 * (j))
#define XB_XSUB(j)  (1280 + 64 * (j))
#define XB_XGEN(j)  (2304 + 64 * (j))
#define XB_TOP      3328
#define XB_TOPGEN   3392
#define XCD_BAR_WORDS 3456
#define XB_SPIN_CAP (1u << 18)

__device__ __forceinline__ unsigned xb_ld(unsigned* p)              { return __hip_atomic_load(p, __ATOMIC_RELAXED, __HIP_MEMORY_SCOPE_AGENT); }
__device__ __forceinline__ unsigned xb_add(unsigned* p, unsigned v) { return __hip_atomic_fetch_add(p, v, __ATOMIC_RELAXED, __HIP_MEMORY_SCOPE_AGENT); }
__device__ __forceinline__ unsigned xb_xcc_id() { return (unsigned)__builtin_amdgcn_s_getreg((3 << 11) | 20) & 0xFu; }
#define XB_SPIN(cond, bar) do { unsigned _sp = 0; while (cond) { __builtin_amdgcn_s_sleep(1); \
    if ((++_sp & 255u) == 0u) { if (xb_ld(&(bar)[XB_TMO])) break; if (_sp > XB_SPIN_CAP) { atomicAdd(&(bar)[XB_TMO], 1u); break; } } } } while (0)

struct XcdBarrier {
    unsigned* bar; unsigned x;
    volatile LAS unsigned* st;
};

__device__ __forceinline__ XcdBarrier xcd_barrier_post(unsigned* bar, volatile LAS unsigned* st) {
    XcdBarrier b; b.bar = bar; b.x = xb_xcc_id(); b.st = st;
    if (threadIdx.x == 0) (void)xb_add(&bar[XB_XCNT(b.x)], 1u);
    return b;
}
__device__ __forceinline__ void xcd_barrier_complete(unsigned* bar, unsigned x, unsigned& nloc, unsigned& nx) {
    const unsigned G = gridDim.x * gridDim.y * gridDim.z;
    unsigned sum, cnt, mine, sp = 0u;
    for (;;) {
        sum = 0u; cnt = 0u; mine = 0u;
#pragma unroll
        for (unsigned j = 0; j < 16; ++j) { const unsigned c = xb_ld(&bar[XB_XCNT(j)]); sum += c; cnt += (c > 0u) ? 1u : 0u; mine = (j == x) ? c : mine; }
        if (sum == G) break;
        __builtin_amdgcn_s_sleep(1);
        if ((++sp & 255u) == 0u) { if (xb_ld(&bar[XB_TMO])) break; if (sp > XB_SPIN_CAP) { atomicAdd(&bar[XB_TMO], 1u); break; } }
    }
    nloc = mine > 0u ? mine : 1u; nx = cnt > 0u ? cnt : 1u;
}

__device__ __forceinline__ void xcd_barrier(const XcdBarrier& b) {
    asm volatile("s_waitcnt vmcnt(0)" ::: "memory");
    __syncthreads();
    if (threadIdx.x == 0) {
        unsigned* bar = b.bar;
        __builtin_amdgcn_s_waitcnt(0);
        unsigned nloc = b.st[0], nx = b.st[1];
        if (nloc == 0u) { xcd_barrier_complete(bar, b.x, nloc, nx); b.st[0] = nloc; b.st[1] = nx; }
        const unsigned old = xb_add(&bar[XB_XSUB(b.x)], 1u);
        const unsigned gen = old / nloc;
        if (old + 1u == (gen + 1u) * nloc) {
            __builtin_amdgcn_fence(__ATOMIC_RELEASE, "agent");
            asm volatile("s_waitcnt vmcnt(0)" ::: "memory");
            const unsigned og = xb_add(&bar[XB_TOP], 1u);
            const unsigned tg = og / nx;
            if (og + 1u == (tg + 1u) * nx) xb_add(&bar[XB_TOPGEN], 1u);
            else XB_SPIN(xb_ld(&bar[XB_TOPGEN]) == tg, bar);
            __builtin_amdgcn_fence(__ATOMIC_ACQUIRE, "agent");
            xb_add(&bar[XB_XGEN(b.x)], 1u);
            asm volatile("s_waitcnt vmcnt(0)" ::: "memory");
        } else {
            XB_SPIN(xb_ld(&bar[XB_XGEN(b.x)]) == gen, bar);
            __builtin_amdgcn_fence(__ATOMIC_ACQUIRE, "agent");
            asm volatile("s_waitcnt vmcnt(0)" ::: "memory");
        }
    }
    __syncthreads();
}

struct Args { const float* in[N_IN]; float* out; unsigned char* ws; int ph_lo, ph_hi; };
struct Frame {
    LAS unsigned char* lds; volatile LAS unsigned* MISC; gu32* ctl;
    int tid, lane, wave, vcu, G;
    const Args* A; float* out; unsigned char* ws;
};
#define WSP(T_, off) ((T_*)(F.ws + (off)))
#define PHASE_TID(F) do { int t_ = threadIdx.x; asm volatile("" : "+v"(t_)); (F).tid = t_; (F).lane = t_ & 63; (F).wave = __builtin_amdgcn_readfirstlane(t_ >> 6); } while (0)

__device__ __forceinline__ int glu_row(int n) { return n < 2048 ? (((n & 1023) >> 7) * 256 + (n >> 10) * 128 + (n & 127)) : n; }
template <int MODE>
__device__ __forceinline__ void tr_item(const float* W, int N, bf16* WT, int dstride, int koff, LAS float* scr, int kb, int nb, int lane) {
    const int k0 = 64 * kb, n0 = 32 * nb;
    f32x4 v[8];
#pragma unroll
    for (int i = 0; i < 8; ++i) v[i] = *(const f32x4*)(W + (size_t)(k0 + (lane >> 3) + 8 * i) * N + n0 + (lane & 7) * 4);
#pragma unroll
    for (int i = 0; i < 8; ++i) { LAS float* d = scr + ((lane >> 3) + 8 * i) * 33 + (lane & 7) * 4; d[0] = v[i].x; d[1] = v[i].y; d[2] = v[i].z; d[3] = v[i].w; }
    LDS_WAIT(); asm volatile("" ::: "memory");
    const int c = lane & 7;
#pragma unroll
    for (int j = 0; j < 4; ++j) { const int n = (lane >> 3) + 8 * j; const LAS float* s = scr + (8 * c) * 33 + n;
        v4u o; o.x = pk2(s[0 * 33], s[1 * 33]); o.y = pk2(s[2 * 33], s[3 * 33]); o.z = pk2(s[4 * 33], s[5 * 33]); o.w = pk2(s[6 * 33], s[7 * 33]);
        const int nn = n0 + n, row = MODE == 1 ? glu_row(nn) : nn;
        *(v4u*)(WT + (size_t)row * dstride + koff + k0 + 8 * c) = o; }
    LDS_WAIT(); asm volatile("" ::: "memory");
}
__device__ __forceinline__ void wmax_item(Frame& F, int it) {
    const int l = it >> 5, kc = it & 31; const float* W = F.A->in[I_WIN] + ((size_t)l * 2048 + kc * 64) * IN_DIM; float mx = 0.f;
#pragma unroll 4
    for (int k = 0; k < 64; ++k)
#pragma unroll
        for (int j = 0; j < 4; ++j) { const int c4r = F.tid + NTHR * j, c4 = c4r < IN_DIM / 4 ? c4r : IN_DIM / 4 - 1;
            const f32x4 v = *(const f32x4*)(W + (size_t)k * IN_DIM + 4 * c4); mx = fmaxf(mx, fmaxf(fmaxf(fabsf(v.x), fabsf(v.y)), fmaxf(fabsf(v.z), fabsf(v.w)))); }
#pragma unroll
    for (int o = 1; o < 64; o <<= 1) mx = fmaxf(mx, __shfl_xor(mx, o));
    if (F.lane == 0) __hip_atomic_fetch_max(F.ctl + CW_WMAX + l, __float_as_uint(mx), __ATOMIC_RELAXED, __HIP_MEMORY_SCOPE_AGENT);
}
__device__ __forceinline__ void wmax2_item(Frame& F, int it) {
    const int lh = it >> 3, kc = it & 7, l = lh >> 1, h = lh & 1; const float* W = F.A->in[h ? I_WAO : I_WCO] + ((size_t)l * 1024 + kc * 128) * 2048 + 4 * F.tid; float mx = 0.f;
#pragma unroll 8
    for (int k = 0; k < 128; ++k) { const f32x4 v = *(const f32x4*)(W + (size_t)k * 2048); mx = fmaxf(mx, fmaxf(fmaxf(fabsf(v.x), fabsf(v.y)), fmaxf(fabsf(v.z), fabsf(v.w)))); }
#pragma unroll
    for (int o = 1; o < 64; o <<= 1) mx = fmaxf(mx, __shfl_xor(mx, o));
    if (F.lane == 0) __hip_atomic_fetch_max(F.ctl + CW_WMAX2 + lh, __float_as_uint(mx), __ATOMIC_RELAXED, __HIP_MEMORY_SCOPE_AGENT);
}
__device__ __forceinline__ void wmax3_item(Frame& F, int it) {
    const int l = it >> 4, kc = it & 15; const float* W = F.A->in[I_WOUT] + ((size_t)l * 2048 + kc * 128) * 2048 + 4 * F.tid; float mx = 0.f;
#pragma unroll 8
    for (int k = 0; k < 128; ++k) { const f32x4 v = *(const f32x4*)(W + (size_t)k * 2048); mx = fmaxf(mx, fmaxf(fmaxf(fabsf(v.x), fabsf(v.y)), fmaxf(fabsf(v.z), fabsf(v.w)))); }
#pragma unroll
    for (int o = 1; o < 64; o <<= 1) mx = fmaxf(mx, __shfl_xor(mx, o));
    if (F.lane == 0) __hip_atomic_fetch_max(F.ctl + CW_WMAX3 + l, __float_as_uint(mx), __ATOMIC_RELAXED, __HIP_MEMORY_SCOPE_AGENT);
}
template <bool GLU>
__device__ __forceinline__ void tr8_item(const float* W, int N, unsigned char* WT, int koff, float inv, LAS float* scr, int kb, int nb, int lane) {
    const int k0 = 64 * kb, n0 = 32 * nb;
    f32x4 v[8];
#pragma unroll
    for (int i = 0; i < 8; ++i) v[i] = *(const f32x4*)(W + (size_t)(k0 + (lane >> 3) + 8 * i) * N + n0 + (lane & 7) * 4);
#pragma unroll
    for (int i = 0; i < 8; ++i) { LAS float* d = scr + ((lane >> 3) + 8 * i) * 33 + (lane & 7) * 4; d[0] = v[i].x * inv; d[1] = v[i].y * inv; d[2] = v[i].z * inv; d[3] = v[i].w * inv; }
    LDS_WAIT(); asm volatile("" ::: "memory");
    const int c = lane & 7;
#pragma unroll
    for (int j = 0; j < 4; ++j) { const int n = (lane >> 3) + 8 * j; const LAS float* s = scr + (8 * c) * 33 + n;
        int lo = __builtin_amdgcn_cvt_pk_fp8_f32(s[0 * 33], s[1 * 33], 0, false); lo = __builtin_amdgcn_cvt_pk_fp8_f32(s[2 * 33], s[3 * 33], lo, true);
        int hi = __builtin_amdgcn_cvt_pk_fp8_f32(s[4 * 33], s[5 * 33], 0, false); hi = __builtin_amdgcn_cvt_pk_fp8_f32(s[6 * 33], s[7 * 33], hi, true);
        v2u o; o.x = (unsigned)lo; o.y = (unsigned)hi;
        *(v2u*)(WT + (size_t)(GLU ? glu_row(n0 + n) : n0 + n) * 2048 + koff + k0 + 8 * c) = o; }
    LDS_WAIT(); asm volatile("" ::: "memory");
}
__device__ __forceinline__ void win8_phase(Frame& F) {
    PHASE_TID(F);
    LAS float* scr = (LAS float*)(F.lds + F.wave * 16384);
    if (F.tid == 0) F.MISC[0] = __hip_atomic_fetch_add(F.ctl + CW_QUEUE2, 1u, __ATOMIC_RELAXED, __HIP_MEMORY_SCOPE_AGENT);
    for (int par = 0;; par ^= 1) {
        __syncthreads();
        const int it = (int)F.MISC[par];
        if (F.tid == 0) F.MISC[par ^ 1] = __hip_atomic_fetch_add(F.ctl + CW_QUEUE2, 1u, __ATOMIC_RELAXED, __HIP_MEMORY_SCOPE_AGENT);
        if (it >= 2 * 960 + 4 * 128 + 2 * 256) break;
        if (it < 2 * 960) { const int l = it >= 960, r = it - l * 960, wi = r * 8 + F.wave;
            const float wmax = __uint_as_float(__hip_atomic_load(F.ctl + CW_WMAX + l, __ATOMIC_RELAXED, __HIP_MEMORY_SCOPE_AGENT)), inv = wmax > 0.f ? 440.0f / wmax : 1.0f;
            tr8_item<true>(F.A->in[I_WIN] + (size_t)l * 2048 * IN_DIM, IN_DIM, WSP(unsigned char, WS_WIN) + (size_t)l * IN_DIM * 2048, 0, inv, scr, wi / 240, wi % 240, F.lane); }
        else if (it >= 2 * 960 + 4 * 128) { const int r0 = it - 2 * 960 - 4 * 128, l = r0 >> 8, wi = (r0 & 255) * 8 + F.wave;
            const float wmax = __uint_as_float(__hip_atomic_load(F.ctl + CW_WMAX3 + l, __ATOMIC_RELAXED, __HIP_MEMORY_SCOPE_AGENT)), inv = wmax > 0.f ? 440.0f / wmax : 1.0f;
            tr8_item<false>(F.A->in[I_WOUT] + (size_t)l * 2048 * 2048, 2048, WSP(unsigned char, WS_WO) + (size_t)l * 2048 * 2048, 0, inv, scr, wi / 64, wi % 64, F.lane); }
        else { const int r0 = it - 2 * 960, lh = r0 >> 7, l = lh >> 1, h = lh & 1, wi = (r0 & 127) * 8 + F.wave;
            const float wmax = __uint_as_float(__hip_atomic_load(F.ctl + CW_WMAX2 + lh, __ATOMIC_RELAXED, __HIP_MEMORY_SCOPE_AGENT)), inv = wmax > 0.f ? 440.0f / wmax : 1.0f;
            tr8_item<false>(F.A->in[h ? I_WAO : I_WCO] + (size_t)l * 1024 * 2048, 2048, WSP(unsigned char, WS_WM) + (size_t)l * 2048 * 2048, h * 1024, inv, scr, wi / 64, wi % 64, F.lane); }
    }
}
__device__ __forceinline__ void ada_item(Frame& F, int a) {
    LAS float* csl = (LAS float*)F.lds;
    LAS f32x4* red = (LAS f32x4*)(F.lds + 16384);
    const float* c = F.A->in[I_C];
    { float cv[8];
#pragma unroll
      for (int i = 0; i < 8; ++i) cv[i] = c[i * NTHR + F.tid];
      __builtin_amdgcn_sched_barrier(0);
#pragma unroll
      for (int i = 0; i < 8; ++i) csl[i * NTHR + F.tid] = cv[i] / (1.0f + __expf(-cv[i])); }
    __syncthreads();
    const int l = a / 48, j0 = (a % 48) * 256 + 4 * F.lane;
    const float* wp = F.A->in[I_ADAW] + ((size_t)l * 2048 + F.wave * 256) * 12288 + j0;
    f32x4 a0 = {0.f, 0.f, 0.f, 0.f}, a1 = {0.f, 0.f, 0.f, 0.f};
#define ADA_LD(dst_, k0_) do { _Pragma("unroll") for (int i_ = 0; i_ < 8; ++i_) dst_[i_] = *(const f32x4*)(wp + (size_t)((k0_) + i_) * 12288); } while (0)
#define ADA_USE(src_, k0_) do { _Pragma("unroll") for (int i_ = 0; i_ < 8; ++i_) { const float c0 = csl[F.wave * 256 + (k0_) + i_], c1 = csl[2048 + F.wave * 256 + (k0_) + i_]; a0 += src_[i_] * c0; a1 += src_[i_] * c1; } } while (0)
    f32x4 wA[8], wB[8];
    ADA_LD(wA, 0);
#pragma unroll 1
    for (int kb = 0; kb < 256; kb += 16) {
        ADA_LD(wB, kb + 8); __builtin_amdgcn_sched_barrier(0); ADA_USE(wA, kb); __builtin_amdgcn_sched_barrier(0);
        if (kb + 16 < 256) ADA_LD(wA, kb + 16);
        __builtin_amdgcn_sched_barrier(0); ADA_USE(wB, kb + 8); __builtin_amdgcn_sched_barrier(0);
    }
#undef ADA_LD
#undef ADA_USE
    red[(F.wave * 2 + 0) * 64 + F.lane] = a0; red[(F.wave * 2 + 1) * 64 + F.lane] = a1;
    __syncthreads();
    if (F.wave < 2) { const int b = F.wave; f32x4 s = *(const f32x4*)(F.A->in[I_ADAB] + l * 12288 + j0);
#pragma unroll
        for (int w = 0; w < 8; ++w) s += red[(w * 2 + b) * 64 + F.lane];
        *(f32x4*)(WSP(float, WS_MOD) + (size_t)(l * 2 + b) * 12288 + j0) = s; }
    __syncthreads();
}
__device__ __forceinline__ void fold_item(Frame& F, int it) {
    const int l = it >> 7, hp = (it >> 3) & 15, kb = it & 7, lane = F.lane, fr = lane & 15, fq = lane >> 4;
    constexpr int SKS = 136;
    LAS bf16* skh = (LAS bf16*)F.lds; LAS bf16* skl = skh + 128 * SKS;
    const float* wbase = F.A->in[I_WPQ] + ((size_t)l * 2048 + kb * 256 + F.wave * 32 + fr) * 2048 + hp * 128 + 8 * fq;
    f32x4 wv[2][4][2];
#pragma unroll
    for (int kt = 0; kt < 2; ++kt)
#pragma unroll
        for (int s2 = 0; s2 < 4; ++s2) { wv[kt][s2][0] = *(const f32x4*)(wbase + (size_t)kt * 16 * 2048 + 32 * s2); wv[kt][s2][1] = *(const f32x4*)(wbase + (size_t)kt * 16 * 2048 + 32 * s2 + 4); }
    { const f32x4* sk = (const f32x4*)(F.A->in[I_SK] + (size_t)(l * 16 + hp) * 128 * 128);
      f32x4 v[8];
#pragma unroll
      for (int i = 0; i < 8; ++i) v[i] = sk[i * NTHR + F.tid];
#pragma unroll
      for (int i = 0; i < 8; ++i) { const int f = i * NTHR + F.tid, n = f >> 5, d = (f & 31) * 4;
          const unsigned h0 = pk2(v[i].x, v[i].y), h1 = pk2(v[i].z, v[i].w);
          const unsigned l0 = pk2(v[i].x - bflo(h0), v[i].y - bfhi(h0)), l1 = pk2(v[i].z - bflo(h1), v[i].w - bfhi(h1));
          v2u ho; ho.x = h0; ho.y = h1; v2u lo; lo.x = l0; lo.y = l1;
          *(LAS v2u*)(skh + n * SKS + d) = ho; *(LAS v2u*)(skl + n * SKS + d) = lo; } }
    __syncthreads();
    bf16x8 wh[2][4], wl[2][4];
#pragma unroll
    for (int kt = 0; kt < 2; ++kt)
#pragma unroll
        for (int s2 = 0; s2 < 4; ++s2) { const f32x4 a = wv[kt][s2][0], b = wv[kt][s2][1];
            v4u h, lo; h.x = pk2(a.x, a.y); h.y = pk2(a.z, a.w); h.z = pk2(b.x, b.y); h.w = pk2(b.z, b.w);
            lo.x = pk2(a.x - bflo(h.x), a.y - bfhi(h.x)); lo.y = pk2(a.z - bflo(h.y), a.w - bfhi(h.y)); lo.z = pk2(b.x - bflo(h.z), b.y - bfhi(h.z)); lo.w = pk2(b.z - bflo(h.w), b.w - bfhi(h.w));
            wh[kt][s2] = __builtin_bit_cast(bf16x8, h); wl[kt][s2] = __builtin_bit_cast(bf16x8, lo); }
    bf16* dst = WSP(bf16, WS_WP) + (size_t)l * 2048 * 2048 + (size_t)(hp * 128 + fr) * 2048 + kb * 256 + F.wave * 32 + 4 * fq;
#pragma unroll 2
    for (int nt = 0; nt < 8; ++nt) { f32x4 acc[2] = {{0.f, 0.f, 0.f, 0.f}, {0.f, 0.f, 0.f, 0.f}};
#pragma unroll
        for (int s2 = 0; s2 < 4; ++s2) { const bf16x8 sh = *(const LAS bf16x8*)(skh + (nt * 16 + fr) * SKS + 32 * s2 + 8 * fq), sl = *(const LAS bf16x8*)(skl + (nt * 16 + fr) * SKS + 32 * s2 + 8 * fq);
#pragma unroll
            for (int kt = 0; kt < 2; ++kt) { acc[kt] = __builtin_amdgcn_mfma_f32_16x16x32_bf16(wh[kt][s2], sh, acc[kt], 0, 0, 0); acc[kt] = __builtin_amdgcn_mfma_f32_16x16x32_bf16(wl[kt][s2], sh, acc[kt], 0, 0, 0);
                acc[kt] = __builtin_amdgcn_mfma_f32_16x16x32_bf16(wh[kt][s2], sl, acc[kt], 0, 0, 0); } }
#pragma unroll
        for (int kt = 0; kt < 2; ++kt) { v2u o; o.x = pk2(acc[kt].x, acc[kt].y); o.y = pk2(acc[kt].z, acc[kt].w); *(v2u*)(dst + (size_t)nt * 16 * 2048 + kt * 16) = o; } }
    __syncthreads();
}
__device__ __forceinline__ void cvt_item(Frame& F, int it) {
    const int which = it >> 10, chunk = it & 1023;
    const float* src = F.A->in[which ? I_PV : I_PU]; unsigned char* dst = WSP(unsigned char, which ? WS_PV : WS_PU); float* scl = WSP(float, WS_SCL) + which * 2 * NEXP;
    constexpr int VROW = 2048 + 8;
    LAS unsigned char* vt = F.lds;
    for (int i = 0; i < 4; i += 2) {
        f32x4 a[2][4], b[2][4]; float mx[2] = {0.f, 0.f};
#pragma unroll
        for (int r = 0; r < 2; ++r) { const int row = chunk * 32 + F.wave * 4 + i + r;
#pragma unroll
            for (int m = 0; m < 4; ++m) { const int col = 512 * m + 8 * F.lane; a[r][m] = *(const f32x4*)(src + (size_t)row * D + col); b[r][m] = *(const f32x4*)(src + (size_t)row * D + col + 4); } }
#pragma unroll
        for (int r = 0; r < 2; ++r) {
#pragma unroll
            for (int m = 0; m < 4; ++m) { mx[r] = fmaxf(mx[r], fmaxf(fmaxf(fabsf(a[r][m].x), fabsf(a[r][m].y)), fmaxf(fabsf(a[r][m].z), fabsf(a[r][m].w)))); mx[r] = fmaxf(mx[r], fmaxf(fmaxf(fabsf(b[r][m].x), fabsf(b[r][m].y)), fmaxf(fabsf(b[r][m].z), fabsf(b[r][m].w)))); } }
#pragma unroll
        for (int o = 1; o < 64; o <<= 1) { mx[0] = fmaxf(mx[0], __shfl_xor(mx[0], o)); mx[1] = fmaxf(mx[1], __shfl_xor(mx[1], o)); }
#pragma unroll
        for (int r = 0; r < 2; ++r) { const int row = chunk * 32 + F.wave * 4 + i + r, l = row >> 14, e = row & (NEXP - 1);
            const float sc = mx[r] > 0.f ? mx[r] * (1.0f / 440.0f) : 1.0f, inv = 1.0f / sc;
            if (F.lane == 0) scl[l * NEXP + e] = sc;
#pragma unroll
            for (int m = 0; m < 4; ++m) { const int col = 512 * m + 8 * F.lane;
                int lo = __builtin_amdgcn_cvt_pk_fp8_f32(a[r][m].x * inv, a[r][m].y * inv, 0, false); lo = __builtin_amdgcn_cvt_pk_fp8_f32(a[r][m].z * inv, a[r][m].w * inv, lo, true);
                int hi = __builtin_amdgcn_cvt_pk_fp8_f32(b[r][m].x * inv, b[r][m].y * inv, 0, false); hi = __builtin_amdgcn_cvt_pk_fp8_f32(b[r][m].z * inv, b[r][m].w * inv, hi, true);
                v2u o; o.x = (unsigned)lo; o.y = (unsigned)hi;
                if (which) *(LAS v2u*)(vt + (F.wave * 4 + i + r) * VROW + col) = o;
                else *(v2u*)(dst + ((size_t)(l * NSL + (col >> 7)) * NEXP + e) * SLW + (col & 127)) = o; } }
    }
    if (which) {
        __syncthreads();
        const int row0 = chunk * 32, l = row0 >> 14, e0 = row0 & (NEXP - 1);
#pragma unroll 4
        for (int i = 0; i < 16; ++i) { const int idx = i * NTHR + F.tid, j = idx >> 5, r = idx & 31;
            *(v2u*)(dst + ((size_t)(l * 256 + j) * NEXP + e0 + r) * 8) = *(const LAS v2u*)(vt + r * VROW + 8 * j); }
        __syncthreads();
    }
}
__device__ __forceinline__ void bias_item(Frame& F) {
    for (int i = F.tid; i < 2048; i += NTHR) { const int h = i >> 7, d = i & 127; int bk;
        if (d < 16) bk = d; else { bk = 16 + (int)(logf((float)d / 16.0f) / logf(8.0f) * 16.0f); bk = bk > 31 ? 31 : bk; }
        WSP(float, WS_BIAS)[i] = F.A->in[I_RELB][bk * 16 + h]; }
}
constexpr int IT_FOLD = 256, IT_ADA = 96, IT_WMAX = 64 + 32 + 32, IT_CVT = 2048;
constexpr int IT0_ADA = 0, IT0_BIAS = IT0_ADA + IT_ADA, IT0_WMAX = IT0_BIAS + 1, IT0_CVT = IT0_WMAX + IT_WMAX, N_OTHER = IT0_CVT + IT_CVT, N_ITEMS = N_OTHER + IT_FOLD, FOLD_EVERY = 9;
static_assert((IT_FOLD - 1) * FOLD_EVERY < N_ITEMS, "fold tickets inside the item range");
__device__ __forceinline__ void p0_prologue(Frame& F) {
    PHASE_TID(F);
    if (F.tid == 0) F.MISC[0] = __hip_atomic_fetch_add(F.ctl + CW_QUEUE, 1u, __ATOMIC_RELAXED, __HIP_MEMORY_SCOPE_AGENT);
    for (int par = 0;; par ^= 1) {
        __syncthreads();
        const int it = (int)F.MISC[par];
        if (F.tid == 0) F.MISC[par ^ 1] = __hip_atomic_fetch_add(F.ctl + CW_QUEUE, 1u, __ATOMIC_RELAXED, __HIP_MEMORY_SCOPE_AGENT);
        if (it >= N_ITEMS) break;
        const int fq = it / FOLD_EVERY; const bool is_fold = (it % FOLD_EVERY == 0) && fq < IT_FOLD;
        const int ot = it - (fq + 1 < IT_FOLD ? fq + 1 : IT_FOLD);
        if (is_fold) fold_item(F, fq);
        else if (ot < IT0_BIAS) ada_item(F, ot - IT0_ADA);
        else if (ot < IT0_WMAX) bias_item(F);
        else if (ot < IT0_WMAX + 64) wmax_item(F, ot - IT0_WMAX);
        else if (ot < IT0_WMAX + 96) wmax2_item(F, ot - IT0_WMAX - 64);
        else if (ot < IT0_CVT) wmax3_item(F, ot - IT0_WMAX - 96);
        else cvt_item(F, ot - IT0_CVT);
    }
}

__device__ __forceinline__ void row_to_fp8(const f32x4 (&y)[8], unsigned char* hrow, float* sarow, int lane) {
    float mx = 0.f;
#pragma unroll
    for (int j = 0; j < 8; ++j) mx = fmaxf(mx, fmaxf(fmaxf(fabsf(y[j].x), fabsf(y[j].y)), fmaxf(fabsf(y[j].z), fabsf(y[j].w))));
#pragma unroll
    for (int o = 1; o < 64; o <<= 1) mx = fmaxf(mx, __shfl_xor(mx, o));
    const float sc = mx > 0.f ? mx * (1.0f / 440.0f) : 1.0f, inv = 1.0f / sc;
    if (lane == 0) *sarow = sc;
#pragma unroll
    for (int j = 0; j < 8; ++j) { int w = __builtin_amdgcn_cvt_pk_fp8_f32(y[j].x * inv, y[j].y * inv, 0, false); w = __builtin_amdgcn_cvt_pk_fp8_f32(y[j].z * inv, y[j].w * inv, w, true); ((unsigned*)hrow)[lane + 64 * j] = (unsigned)w; }
}
template <bool TO_FP8, bool IN_BF16>
__device__ __forceinline__ void norm_phase(Frame& F, const void* X, bf16* Hd, const float* g, const float* modl, int ish, int isc) {
    PHASE_TID(F);
    const int gw = F.vcu * NWAVES + F.wave, NGW = F.G * NWAVES;
    int curb = -1; f32x4 gs[8], sh[8];
    for (int m = gw; m < T; m += NGW) {
        const int b = m >> 13;
        if (b != curb) { curb = b;
#pragma unroll
            for (int j = 0; j < 8; ++j) { const int col = 4 * F.lane + 256 * j; const f32x4 g4 = *(const f32x4*)(g + col), sc4 = *(const f32x4*)(modl + (size_t)b * 12288 + isc * 2048 + col);
                sh[j] = *(const f32x4*)(modl + (size_t)b * 12288 + ish * 2048 + col); gs[j] = g4 * (sc4 + 1.0f); } }
        f32x4 v[8]; float ss = 0.f;
        if constexpr (IN_BF16) { const v2u* xr = (const v2u*)((const bf16*)X + (size_t)m * D) + F.lane; v2u q[8];
#pragma unroll
            for (int j = 0; j < 8; ++j) q[j] = xr[64 * j];
            __builtin_amdgcn_sched_barrier(0);
#pragma unroll
            for (int j = 0; j < 8; ++j) v[j] = (f32x4){bflo(q[j].x), bfhi(q[j].x), bflo(q[j].y), bfhi(q[j].y)};
        } else { const f32x4* xr = (const f32x4*)((const float*)X + (size_t)m * D) + F.lane;
#pragma unroll
            for (int j = 0; j < 8; ++j) v[j] = xr[64 * j];
            __builtin_amdgcn_sched_barrier(0); }
#pragma unroll
        for (int j = 0; j < 8; ++j) ss += (v[j].x * v[j].x + v[j].y * v[j].y) + (v[j].z * v[j].z + v[j].w * v[j].w);
        const float rstd = 1.0f / sqrtf(wave_sum(ss) * (1.0f / D) + EPS);
        if constexpr (TO_FP8) { f32x4 y[8];
#pragma unroll
            for (int j = 0; j < 8; ++j) y[j] = v[j] * rstd * gs[j] + sh[j];
            row_to_fp8(y, (unsigned char*)Hd + (size_t)m * D, WSP(float, WS_SA) + m, F.lane);
        } else {
        v2u* o = (v2u*)(Hd + (size_t)m * D) + F.lane;
#pragma unroll
        for (int j = 0; j < 8; ++j) { const f32x4 y = v[j] * rstd * gs[j] + sh[j]; v2u w; w.x = pk2(y.x, y.y); w.y = pk2(y.z, y.w); o[64 * j] = w; }
        }
    }
}

__device__ __forceinline__ void conv_phase(Frame& F, int l) {
    PHASE_TID(F);
    const float* dw = F.A->in[I_DWW] + (size_t)l * CWID * CONV; const int c0 = 2 * F.tid;
    f32x2 wv[CWID];
#pragma unroll
    for (int j = 0; j < CWID; ++j) wv[j] = *(const f32x2*)(dw + j * CONV + c0);
    const f32x2 cb = *(const f32x2*)(F.A->in[I_DWB] + l * CONV + c0), lg = *(const f32x2*)(F.A->in[I_CLNG] + l * CONV + c0), lb = *(const f32x2*)(F.A->in[I_CLNB] + l * CONV + c0);
    LAS float* red = (LAS float*)F.lds;
    LAS float* stat = red + 256;
    float gmx = fmaxf(fabsf(lg.x), fabsf(lg.y)), bmx = fmaxf(fabsf(lb.x), fabsf(lb.y));
#pragma unroll
    for (int o = 1; o < 64; o <<= 1) { gmx = fmaxf(gmx, __shfl_xor(gmx, o)); bmx = fmaxf(bmx, __shfl_xor(bmx, o)); }
    if (F.lane == 0) { red[F.wave] = gmx; red[8 + F.wave] = bmx; }
    __syncthreads();
    { float g_ = red[0], b_ = red[8];
#pragma unroll
      for (int w = 1; w < 8; ++w) { g_ = fmaxf(g_, red[w]); b_ = fmaxf(b_, red[8 + w]); }
      gmx = g_; bmx = b_; }
    __syncthreads();
    const float Bc = fmaxf(32.0f * gmx + bmx, 1e-20f), cinv = 440.0f / Bc;
    if (blockIdx.x == 0 && F.tid == 0) { __hip_atomic_store(F.ctl + CW_BC + l, __float_as_uint(Bc), __ATOMIC_RELAXED, __HIP_MEMORY_SCOPE_AGENT); __hip_atomic_store(F.ctl + CW_BC2 + l, __float_as_uint(gmx + bmx), __ATOMIC_RELAXED, __HIP_MEMORY_SCOPE_AGENT); }
    const unsigned* Ut = WSP(unsigned, WS_U) + F.tid; unsigned short* AM = WSP(unsigned short, WS_AM);
    for (int tile = F.vcu; tile < T / 64; tile += F.G) {
        const int t0 = tile * 64, bstart = t0 & ~(SEQ - 1);
        for (int grp = 0; grp < 4; ++grp) {
            const int tg = t0 + grp * 16;
            f32x2 xv[46]; unsigned wp[46];
#pragma unroll
            for (int i = 0; i < 46; ++i) { const int r = tg - 30 + i; wp[i] = Ut[(size_t)(r >= bstart ? r : bstart) * (CONV / 2)]; }
            __builtin_amdgcn_sched_barrier(0);
#pragma unroll
            for (int i = 0; i < 46; ++i) { const int r = tg - 30 + i; const unsigned p = wp[i] & (r >= bstart ? 0xffffffffu : 0u); xv[i] = (f32x2){bflo(p), bfhi(p)}; }
            f32x2 ov[16];
#pragma unroll
            for (int i = 0; i < 16; ++i) { f32x2 a = cb;
#pragma unroll
                for (int j = 0; j < CWID; ++j) a = __builtin_elementwise_fma(wv[j], xv[i + j], a);
                ov[i] = a; }
            { float p32[32];
#pragma unroll
              for (int i = 0; i < 16; ++i) { p32[i] = ov[i].x + ov[i].y; p32[16 + i] = ov[i].x * ov[i].x + ov[i].y * ov[i].y; }
              float p16[16], p8[8], p4[4], p2[2];
              { const bool bt = (F.lane & 1) != 0;
#pragma unroll
                for (int i = 0; i < 16; ++i) { const float snd = bt ? p32[i] : p32[i + 16], kp = bt ? p32[i + 16] : p32[i]; p16[i] = kp + lane_xor1(snd); } }
              { const bool bt = (F.lane & 2) != 0;
#pragma unroll
                for (int i = 0; i < 8; ++i) { const float snd = bt ? p16[i] : p16[i + 8], kp = bt ? p16[i + 8] : p16[i]; p8[i] = kp + lane_xor2(snd); } }
              { const bool bt = (F.lane & 4) != 0;
#pragma unroll
                for (int i = 0; i < 4; ++i) { const float snd = bt ? p8[i] : p8[i + 4], kp = bt ? p8[i + 4] : p8[i]; p4[i] = kp + lane_xor4(snd); } }
              { const bool bt = (F.lane & 8) != 0;
#pragma unroll
                for (int i = 0; i < 2; ++i) { const float snd = bt ? p4[i] : p4[i + 2], kp = bt ? p4[i + 2] : p4[i]; p2[i] = kp + lane_xor8(snd); } }
              const bool bt16 = (F.lane & 16) != 0; const float snd = bt16 ? p2[0] : p2[1], kp = bt16 ? p2[1] : p2[0];
              float tot = kp + lane_xor16(snd); tot += __shfl_xor(tot, 32);
              const int sidx = 16 * (F.lane & 1) + 8 * ((F.lane >> 1) & 1) + 4 * ((F.lane >> 2) & 1) + 2 * ((F.lane >> 3) & 1) + ((F.lane >> 4) & 1);
              if (F.lane < 32) red[F.wave * 32 + sidx] = tot; }
            __syncthreads();
            if (F.tid < 32) { float v = 0.f;
#pragma unroll
                for (int w = 0; w < 8; ++w) v += red[w * 32 + F.tid];
                stat[F.tid] = v; }
            __syncthreads();
#pragma unroll
            for (int i = 0; i < 16; ++i) { const float mu = stat[i] * (1.0f / CONV), var = fmaxf(stat[16 + i] * (1.0f / CONV) - mu * mu, 0.0f), rstd = 1.0f / sqrtf(var + EPS);
                const float ya = (ov[i].x - mu) * rstd * lg.x + lb.x, yb = (ov[i].y - mu) * rstd * lg.y + lb.y;
                AM[(size_t)(tg + i) * (D / 2) + F.tid] = (unsigned short)__builtin_amdgcn_cvt_pk_fp8_f32(ya * sigmoidf_(ya) * cinv, yb * sigmoidf_(yb) * cinv, 0, false); }
        }
    }
}

#define MFMA32(a, b, c) __builtin_amdgcn_mfma_f32_32x32x16_bf16((a), (b), (c), 0, 0, 0)
__device__ __forceinline__ void attn_phase(Frame& F, int l) {
    PHASE_TID(F);
    constexpr int VTS = 260;
    constexpr int KS = 72;
    LAS bf16* VT = (LAS bf16*)F.lds;
    LAS bf16* KL = (LAS bf16*)(F.lds + 34816);
    LAS float* BT = (LAS float*)(F.lds + 34816 + 36864);
    const bf16* Qg = WSP(bf16, WS_Q); const bf16* Kg = WSP(bf16, WS_K); const bf16* Vg = WSP(bf16, WS_V); unsigned char* AM = WSP(unsigned char, WS_AM);
    const float* BIAS = WSP(float, WS_BIAS);
    const int r = F.lane & 31, h = F.lane >> 5;
    for (int unit = F.vcu; unit < 512; unit += F.G) {
        const int b = unit >> 8, blk = (unit >> 2) & 63, kvh = unit & 3, kbase = blk * 128 - 128;
        const float vmx = __uint_as_float(__hip_atomic_load(F.ctl + CW_VMAX + 2 * l + b, __ATOMIC_RELAXED, __HIP_MEMORY_SCOPE_AGENT)), ainv = vmx > 0.f ? 440.0f / (1.02f * vmx) : 1.0f;
        { v4u vv_[4], kk_[4];
#pragma unroll
          for (int it = 0; it < 4; ++it) { const int c = it * NTHR + F.tid, key = c >> 3, d0 = (c & 7) * 8, kpos = kbase + key, kp_ = kpos >= 0 ? kpos : 0;
              vv_[it] = *(const v4u*)(Vg + (size_t)(b * SEQ + kp_) * KVD + kvh * HD + d0); kk_[it] = *(const v4u*)(Kg + (size_t)(b * SEQ + kp_) * KVD + kvh * HD + d0); }
          __builtin_amdgcn_sched_barrier(0);
#pragma unroll
          for (int it = 0; it < 4; ++it) { const int c = it * NTHR + F.tid, key = c >> 3, d0 = (c & 7) * 8, kpos = kbase + key; const unsigned msk = kpos >= 0 ? 0xffffffffu : 0u;
              const v4u v = vv_[it] & msk, kq = kk_[it] & msk;
              *(LAS v4u*)(KL + key * KS + d0) = kq;
              LAS bf16* dst = VT + d0 * VTS + key;
              dst[0 * VTS] = (bf16)v.x; dst[1 * VTS] = (bf16)(v.x >> 16); dst[2 * VTS] = (bf16)v.y; dst[3 * VTS] = (bf16)(v.y >> 16);
              dst[4 * VTS] = (bf16)v.z; dst[5 * VTS] = (bf16)(v.z >> 16); dst[6 * VTS] = (bf16)v.w; dst[7 * VTS] = (bf16)(v.w >> 16); } }
        BT[F.tid] = BIAS[(kvh * 4 + (F.tid >> 7)) * 128 + (F.tid & 127)];
        __syncthreads();
        for (int tk = 0; tk < 2; ++tk) {
            const int task = F.wave * 2 + tk, g = task >> 2, qs = task & 3, head = kvh * 4 + g;
            const size_t trow = (size_t)b * SEQ + blk * 128 + qs * 32 + r;
            bf16x8 qf[4];
#pragma unroll
            for (int s = 0; s < 4; ++s) qf[s] = *(const bf16x8*)(Qg + trow * ATT + head * HD + 16 * s + 8 * h);
            const float sink = F.A->in[I_SINK][l * NHEAD + head];
            float mx = sink, lsum = 0.f;
            f32x16 o[2];
#pragma unroll
            for (int i = 0; i < 16; ++i) { o[0][i] = 0.f; o[1][i] = 0.f; }
#pragma unroll 1
            for (int j = 0; j < 5; ++j) { f32x16 a;
#pragma unroll
                for (int i = 0; i < 16; ++i) a[i] = 0.f;
#pragma unroll
                for (int s = 0; s < 4; ++s) { const bf16x8 kf = *(const LAS bf16x8*)(KL + (qs * 32 + 32 * j + r) * KS + 16 * s + 8 * h); a = MFMA32(kf, qf[s], a); }
                float tmax = -INFINITY;
#pragma unroll
                for (int i = 0; i < 16; ++i) { const int kr = 32 * j + (i & 3) + 8 * (i >> 2) + 4 * h, dist = 128 + r - kr; const bool ok = dist >= 0 && dist < 128 && (kbase + qs * 32 + kr) >= 0;
                    const float sv = ok ? a[i] + BT[g * 128 + (dist & 127)] : -INFINITY; a[i] = sv; tmax = fmaxf(tmax, sv); }
                tmax = fmaxf(tmax, __shfl_xor(tmax, 32));
                const float mnew = fmaxf(mx, tmax), alpha = __expf(mx - mnew); mx = mnew; lsum *= alpha;
#pragma unroll
                for (int i = 0; i < 16; ++i) { o[0][i] *= alpha; o[1][i] *= alpha; const float p = __expf(a[i] - mx); a[i] = p; lsum += p; }
#pragma unroll
                for (int s2 = 0; s2 < 2; ++s2) { v4u pp; pp.x = pk2(a[8 * s2 + 0], a[8 * s2 + 1]); pp.y = pk2(a[8 * s2 + 2], a[8 * s2 + 3]); pp.z = pk2(a[8 * s2 + 4], a[8 * s2 + 5]); pp.w = pk2(a[8 * s2 + 6], a[8 * s2 + 7]);
                    const bf16x8 pf = __builtin_bit_cast(bf16x8, pp);
#pragma unroll
                    for (int dt = 0; dt < 2; ++dt) { const LAS bf16* vp = VT + (32 * dt + r) * VTS + qs * 32 + 32 * j + 16 * s2 + 4 * h; const v2u lo = *(const LAS v2u*)vp, hi = *(const LAS v2u*)(vp + 8);
                        v4u vv; vv.x = lo.x; vv.y = lo.y; vv.z = hi.x; vv.w = hi.y; o[dt] = MFMA32(__builtin_bit_cast(bf16x8, vv), pf, o[dt]); } }
            }
            lsum += __shfl_xor(lsum, 32);
            const float inv = ainv / (lsum + __expf(sink - mx));
#pragma unroll
            for (int dt = 0; dt < 2; ++dt)
#pragma unroll
                for (int g4 = 0; g4 < 4; ++g4) { int w = __builtin_amdgcn_cvt_pk_fp8_f32(o[dt][4 * g4 + 0] * inv, o[dt][4 * g4 + 1] * inv, 0, false); w = __builtin_amdgcn_cvt_pk_fp8_f32(o[dt][4 * g4 + 2] * inv, o[dt][4 * g4 + 3] * inv, w, true);
                    *(unsigned*)(AM + trow * D + ATT + head * HD + 32 * dt + 8 * g4 + 4 * h) = (unsigned)w; }
        }
        __syncthreads();
    }
}

__device__ __forceinline__ unsigned f2key(float f) { const unsigned u = __float_as_uint(f); return (u & 0x80000000u) ? ~u : (u | 0x80000000u); }
__device__ __forceinline__ float key2f(unsigned k) { const unsigned u = (k & 0x80000000u) ? (k & 0x7fffffffu) : ~k; return __uint_as_float(u); }
#define INSERT16(L, x_) do { unsigned x__ = (x_); _Pragma("unroll") for (int q_ = 0; q_ < 16; ++q_) { const unsigned hi_ = L[q_] > x__ ? L[q_] : x__; x__ = L[q_] > x__ ? x__ : L[q_]; L[q_] = hi_; } } while (0)
#define CEX(A_, i_, j_) do { const unsigned h__ = A_[i_] > A_[j_] ? A_[i_] : A_[j_], l__ = A_[i_] > A_[j_] ? A_[j_] : A_[i_]; A_[i_] = h__; A_[j_] = l__; } while (0)
#define SORT16(A_) do { CEX(A_, 0,1); CEX(A_, 2,3); CEX(A_, 0,2); CEX(A_, 1,3); CEX(A_, 1,2); CEX(A_, 4,5); CEX(A_, 6,7); CEX(A_, 4,6); CEX(A_, 5,7); CEX(A_, 5,6); CEX(A_, 0,4); CEX(A_, 2,6); CEX(A_, 2,4); CEX(A_, 1,5); CEX(A_, 3,7); CEX(A_, 3,5); CEX(A_, 1,2); CEX(A_, 3,4); CEX(A_, 5,6); CEX(A_, 8,9); CEX(A_, 10,11); CEX(A_, 8,10); CEX(A_, 9,11); CEX(A_, 9,10); CEX(A_, 12,13); CEX(A_, 14,15); CEX(A_, 12,14); CEX(A_, 13,15); CEX(A_, 13,14); CEX(A_, 8,12); CEX(A_, 10,14); CEX(A_, 10,12); CEX(A_, 9,13); CEX(A_, 11,15); CEX(A_, 11,13); CEX(A_, 9,10); CEX(A_, 11,12); CEX(A_, 13,14); CEX(A_, 0,8); CEX(A_, 4,12); CEX(A_, 4,8); CEX(A_, 2,10); CEX(A_, 6,14); CEX(A_, 6,10); CEX(A_, 2,4); CEX(A_, 6,8); CEX(A_, 10,12); CEX(A_, 1,9); CEX(A_, 5,13); CEX(A_, 5,9); CEX(A_, 3,11); CEX(A_, 7,15); CEX(A_, 7,11); CEX(A_, 3,5); CEX(A_, 7,9); CEX(A_, 11,13); CEX(A_, 1,2); CEX(A_, 3,4); CEX(A_, 5,6); CEX(A_, 7,8); CEX(A_, 9,10); CEX(A_, 11,12); CEX(A_, 13,14); } while (0)
#define BMERGE16(A_) do { CEX(A_, 0,8); CEX(A_, 1,9); CEX(A_, 2,10); CEX(A_, 3,11); CEX(A_, 4,12); CEX(A_, 5,13); CEX(A_, 6,14); CEX(A_, 7,15); CEX(A_, 0,4); CEX(A_, 1,5); CEX(A_, 2,6); CEX(A_, 3,7); CEX(A_, 8,12); CEX(A_, 9,13); CEX(A_, 10,14); CEX(A_, 11,15); CEX(A_, 0,2); CEX(A_, 1,3); CEX(A_, 4,6); CEX(A_, 5,7); CEX(A_, 8,10); CEX(A_, 9,11); CEX(A_, 12,14); CEX(A_, 13,15); CEX(A_, 0,1); CEX(A_, 2,3); CEX(A_, 4,5); CEX(A_, 6,7); CEX(A_, 8,9); CEX(A_, 10,11); CEX(A_, 12,13); CEX(A_, 14,15); } while (0)
__device__ __forceinline__ void topk_phase(Frame& F) {
    PHASE_TID(F);
    const _Float16* S = WSP(_Float16, WS_GC); int* IDX = WSP(int, WS_U); float* GATE = WSP(float, WS_U + 8 * MiB);
    const int gw = F.vcu * NWAVES + F.wave, NGW = F.G * NWAVES;
    constexpr int TKS = 256; LAS unsigned char* lw = F.lds + F.wave * (64 * TKS); const LAS unsigned char* lrow = lw + F.lane * TKS;
    for (int grp = gw; grp < T * PHEADS / 64; grp += NGW) {
        const int item = grp * 64 + F.lane, t = item >> 3, hh = item & 7;
        const unsigned char* sg = (const unsigned char*)(S + (size_t)grp * 8 * D) + (size_t)(F.lane >> 4) * 512 + (F.lane & 15) * 16;
        v4u r0[16], r1[16];
#pragma unroll
        for (int i = 0; i < 16; ++i) r0[i] = *(const v4u*)(sg + (size_t)(i >> 1) * 4096 + (i & 1) * 2048);
#pragma unroll
        for (int i = 0; i < 16; ++i) r1[i] = *(const v4u*)(sg + (size_t)(i >> 1) * 4096 + (i & 1) * 2048 + 256);
        __builtin_amdgcn_sched_barrier(0);
#pragma unroll
        for (int i = 0; i < 16; ++i) *(LAS v4u*)(lw + (4 * i + (F.lane >> 4)) * TKS + (((F.lane & 15) ^ ((4 * i + (F.lane >> 4)) & 15)) << 4)) = r0[i];
        __builtin_amdgcn_sched_barrier(0);
        unsigned L1[16], L2[16];
#pragma unroll
        for (int q = 0; q < 16; ++q) { L1[q] = 0u; L2[q] = 0u; }
#pragma unroll 1
        for (int c = 0; c < 16; c += 2) { const pg8::f16x8 va = *(const LAS pg8::f16x8*)(lrow + ((c ^ (F.lane & 15)) << 4)), vb = *(const LAS pg8::f16x8*)(lrow + (((c + 1) ^ (F.lane & 15)) << 4));
            unsigned C[16];
#pragma unroll
            for (int e = 0; e < 8; ++e) { C[e] = (f2key((float)va[e]) & ~127u) | (unsigned)(127 - (8 * c + e)); C[8 + e] = (f2key((float)vb[e]) & ~127u) | (unsigned)(127 - (8 * c + 8 + e)); }
            SORT16(C);
#pragma unroll
            for (int q = 0; q < 16; ++q) L1[q] = L1[q] > C[15 - q] ? L1[q] : C[15 - q];
            BMERGE16(L1); }
        __builtin_amdgcn_sched_barrier(0);
#pragma unroll
        for (int i = 0; i < 16; ++i) *(LAS v4u*)(lw + (4 * i + (F.lane >> 4)) * TKS + (((F.lane & 15) ^ ((4 * i + (F.lane >> 4)) & 15)) << 4)) = r1[i];
        __builtin_amdgcn_sched_barrier(0);
#pragma unroll 1
        for (int c = 0; c < 16; c += 2) { const pg8::f16x8 va = *(const LAS pg8::f16x8*)(lrow + ((c ^ (F.lane & 15)) << 4)), vb = *(const LAS pg8::f16x8*)(lrow + (((c + 1) ^ (F.lane & 15)) << 4));
            unsigned C[16];
#pragma unroll
            for (int e = 0; e < 8; ++e) { C[e] = (f2key((float)va[e]) & ~127u) | (unsigned)(127 - (8 * c + e)); C[8 + e] = (f2key((float)vb[e]) & ~127u) | (unsigned)(127 - (8 * c + 8 + e)); }
            SORT16(C);
#pragma unroll
            for (int q = 0; q < 16; ++q) L2[q] = L2[q] > C[15 - q] ? L2[q] : C[15 - q];
            BMERGE16(L2); }
        float v1[16], v2[16];
#pragma unroll
        for (int q = 0; q < 16; ++q) { v1[q] = key2f(L1[q] & ~127u); v2[q] = key2f(L2[q] & ~127u); }
#define PKEY(i_, j_) ((f2key(v1[i_] + v2[j_]) & ~255u) | (unsigned)(255 - ((i_) * 16 + (j_))))
        unsigned B[16], Cc[16];
#pragma unroll
        for (int q = 0; q < 16; ++q) B[q] = PKEY(0, q);
#pragma unroll
        for (int q = 0; q < 15; ++q) Cc[q] = PKEY(q + 1, 0);
        Cc[15] = 0u;
#pragma unroll
        for (int q = 0; q < 16; ++q) B[q] = B[q] > Cc[15 - q] ? B[q] : Cc[15 - q];
        BMERGE16(B);
        Cc[0] = PKEY(1, 1);        Cc[1] = PKEY(1, 2);        Cc[2] = PKEY(1, 3);        Cc[3] = PKEY(1, 4);
        Cc[4] = PKEY(1, 5);        Cc[5] = PKEY(1, 6);        Cc[6] = PKEY(1, 7);        Cc[7] = PKEY(2, 1);
        Cc[8] = PKEY(2, 2);        Cc[9] = PKEY(2, 3);        Cc[10] = PKEY(2, 4);        Cc[11] = PKEY(3, 1);
        Cc[12] = PKEY(3, 2);        Cc[13] = PKEY(3, 3);        Cc[14] = PKEY(4, 1);        Cc[15] = PKEY(4, 2);
        SORT16(Cc);
#pragma unroll
        for (int q = 0; q < 16; ++q) B[q] = B[q] > Cc[15 - q] ? B[q] : Cc[15 - q];
        BMERGE16(B);
        INSERT16(B, PKEY(5, 1)); INSERT16(B, PKEY(6, 1)); INSERT16(B, PKEY(7, 1));
#undef PKEY
        const float b0 = key2f(B[0] & ~255u); float e[16], es = 0.f;
#pragma unroll
        for (int q = 0; q < 16; ++q) { e[q] = __expf(key2f(B[q] & ~255u) - b0); es += e[q]; }
        const float einv = 1.0f / es;
        int ex[16];
#pragma unroll
        for (int q = 0; q < 16; ++q) { const int code = 255 - (int)(B[q] & 255u), ii = code >> 4, jj = code & 15; unsigned s1 = L1[0], s2 = L2[0];
#pragma unroll
            for (int z = 1; z < 16; ++z) { s1 = (ii == z) ? L1[z] : s1; s2 = (jj == z) ? L2[z] : s2; }
            ex[q] = (127 - (int)(s1 & 127u)) * 128 + (127 - (int)(s2 & 127u)); e[q] *= einv; }
        int* ip = IDX + (size_t)t * 128 + hh * 16; float* gp = GATE + (size_t)t * 128 + hh * 16;
#pragma unroll
        for (int q = 0; q < 4; ++q) { *(int4*)(ip + 4 * q) = make_int4(ex[4 * q], ex[4 * q + 1], ex[4 * q + 2], ex[4 * q + 3]); *(f32x4*)(gp + 4 * q) = (f32x4){e[4 * q], e[4 * q + 1], e[4 * q + 2], e[4 * q + 3]}; }
    }
}

#define FP8LO(w_) __builtin_amdgcn_cvt_pk_f32_fp8((int)(w_), false)
#define FP8HI(w_) __builtin_amdgcn_cvt_pk_f32_fp8((int)(w_), true)
__device__ __forceinline__ void pa_issue(v4u (&rr)[16], int id0, int id1, const unsigned char* tab, int g) {
#pragma unroll
    for (int i = 0; i < 16; ++i) { const int e = __shfl(i < 8 ? id0 : id1, ((8 * i) & 63) + g); rr[i] = *(const v4u*)(tab + (size_t)e * SLW); }
}
__device__ __forceinline__ void pa_compute(const v4u (&rr)[16], const v4u ha, const v4u hb, float o0, float o1, float* d0, float* d1, int lane) {
    f32x2 hf[8];
    hf[0] = (f32x2){bflo(ha.x), bfhi(ha.x)}; hf[1] = (f32x2){bflo(ha.y), bfhi(ha.y)}; hf[2] = (f32x2){bflo(ha.z), bfhi(ha.z)}; hf[3] = (f32x2){bflo(ha.w), bfhi(ha.w)};
    hf[4] = (f32x2){bflo(hb.x), bfhi(hb.x)}; hf[5] = (f32x2){bflo(hb.y), bfhi(hb.y)}; hf[6] = (f32x2){bflo(hb.z), bfhi(hb.z)}; hf[7] = (f32x2){bflo(hb.w), bfhi(hb.w)};
    float p[16];
#pragma unroll
    for (int i = 0; i < 16; ++i) { f32x2 a = FP8LO(rr[i].x) * hf[0];
        a = __builtin_elementwise_fma(FP8HI(rr[i].x), hf[1], a); a = __builtin_elementwise_fma(FP8LO(rr[i].y), hf[2], a); a = __builtin_elementwise_fma(FP8HI(rr[i].y), hf[3], a);
        a = __builtin_elementwise_fma(FP8LO(rr[i].z), hf[4], a); a = __builtin_elementwise_fma(FP8HI(rr[i].z), hf[5], a); a = __builtin_elementwise_fma(FP8LO(rr[i].w), hf[6], a); a = __builtin_elementwise_fma(FP8HI(rr[i].w), hf[7], a);
        p[i] = a.x + a.y; }
    float q8[8], q4[4], q2[2];
    { const bool bt = (lane & 1) != 0;
#pragma unroll
      for (int i = 0; i < 8; ++i) { const float snd = bt ? p[i] : p[i + 8], kp = bt ? p[i + 8] : p[i]; q8[i] = kp + lane_xor1(snd); } }
    { const bool bt = (lane & 2) != 0;
#pragma unroll
      for (int i = 0; i < 4; ++i) { const float snd = bt ? q8[i] : q8[i + 4], kp = bt ? q8[i + 4] : q8[i]; q4[i] = kp + lane_xor2(snd); } }
    { const bool bt = (lane & 4) != 0;
#pragma unroll
      for (int i = 0; i < 2; ++i) { const float snd = bt ? q4[i] : q4[i + 2], kp = bt ? q4[i + 2] : q4[i]; q2[i] = kp + lane_xor4(snd); } }
    *d0 = o0 + q2[0]; *d1 = o1 + q2[1];
}
__device__ __forceinline__ void peer_act_phase(Frame& F, int l) {
    PHASE_TID(F);
    const int lane = F.lane, g = lane >> 3, j = lane & 7;
    const int x = blockIdx.x & 7, bpg = F.G >> 3, wpg = bpg * NWAVES, wgi = (blockIdx.x >> 3) * NWAVES + F.wave;
    const int* IDX = WSP(int, WS_U); const bf16* Hb = WSP(bf16, WS_H);
    float* actp = WSP(float, WS_AM) + (size_t)x * T * 128;
    const int irev = 8 * (j & 1) + 4 * ((j >> 1) & 1) + 2 * (j >> 2), k0 = 8 * irev + g, k1 = k0 + 8;
    const int NT = (T - wgi + wpg - 1) / wpg;
    for (int s = 0; s < 2; ++s) {
        const int sl = 2 * x + s; const unsigned char* tab = WSP(unsigned char, WS_PU) + (size_t)(l * NSL + sl) * NEXP * SLW + 16 * j;
        const bf16* hcol = Hb + sl * SLW + 16 * j;
#define PA_PREF(n_, i0, i1, h0, h1, q0, q1) do { const int t_ = wgi + (n_) * wpg; if ((n_) < NT) { i0 = IDX[(size_t)t_ * 128 + lane]; i1 = IDX[(size_t)t_ * 128 + 64 + lane]; h0 = *(const v4u*)(hcol + (size_t)t_ * D); h1 = *(const v4u*)(hcol + (size_t)t_ * D + 8); \
            if (s > 0) { q0 = actp[(size_t)t_ * 128 + k0]; q1 = actp[(size_t)t_ * 128 + k1]; } } } while (0)
        int ia0 = 0, ia1 = 0, ib0 = 0, ib1 = 0; v4u ha0 = {0u, 0u, 0u, 0u}, ha1 = ha0, hb0 = ha0, hb1 = ha0; float oa0 = 0.f, oa1 = 0.f, ob0 = 0.f, ob1 = 0.f;
        v4u rA[16], rB[16];
        PA_PREF(0, ia0, ia1, ha0, ha1, oa0, oa1); PA_PREF(1, ib0, ib1, hb0, hb1, ob0, ob1);
        if (0 < NT) pa_issue(rA, ia0, ia1, tab, g);
        for (int n = 0; n < NT; n += 2) {
            const v4u ca0 = ha0, ca1 = ha1; const float pa0 = oa0, pa1 = oa1;
            if (n + 1 < NT) pa_issue(rB, ib0, ib1, tab, g);
            PA_PREF(n + 2, ia0, ia1, ha0, ha1, oa0, oa1);
            __builtin_amdgcn_sched_barrier(0);
            { const size_t t_ = (size_t)(wgi + n * wpg); pa_compute(rA, ca0, ca1, pa0, pa1, actp + t_ * 128 + k0, actp + t_ * 128 + k1, lane); }
            __builtin_amdgcn_sched_barrier(0);
            if (n + 1 < NT) {
                const v4u cb0 = hb0, cb1 = hb1; const float pb0 = ob0, pb1 = ob1;
                if (n + 2 < NT) pa_issue(rA, ia0, ia1, tab, g);
                PA_PREF(n + 3, ib0, ib1, hb0, hb1, ob0, ob1);
                __builtin_amdgcn_sched_barrier(0);
                { const size_t t_ = (size_t)(wgi + (n + 1) * wpg); pa_compute(rB, cb0, cb1, pb0, pb1, actp + t_ * 128 + k0, actp + t_ * 128 + k1, lane); }
                __builtin_amdgcn_sched_barrier(0);
            }
        }
#undef PA_PREF
    }
}
__device__ __forceinline__ void peer_w_phase(Frame& F, int l) {
    PHASE_TID(F);
    const int lane = F.lane;
    constexpr int WROW = 136;
    LAS bf16* wl = (LAS bf16*)F.lds; LAS bf16* il = wl + 64 * WROW;
    const int* IDX = WSP(int, WS_U); const float* GATE = WSP(float, WS_U + 8 * MiB); const float* actp = WSP(float, WS_AM);
    bf16* WT = WSP(bf16, WS_Y1); bf16* IT = WSP(bf16, WS_Y1 + 4 * MiB);
    const float* su = WSP(float, WS_SCL) + l * NEXP; const float* sv = WSP(float, WS_SCL) + (2 + l) * NEXP;
    for (int tb = F.vcu; tb < T / 64; tb += F.G) {
#pragma unroll 2
        for (int i = 0; i < 8; ++i) { const int tl = F.wave * 8 + i, t = tb * 64 + tl;
            const int e0 = IDX[(size_t)t * 128 + lane], e1 = IDX[(size_t)t * 128 + 64 + lane];
            float pa[8], pb[8];
#pragma unroll
            for (int xx = 0; xx < 8; ++xx) { pa[xx] = actp[((size_t)xx * T + t) * 128 + lane]; pb[xx] = actp[((size_t)xx * T + t) * 128 + 64 + lane]; }
            const float gt0 = GATE[(size_t)t * 128 + lane], gt1 = GATE[(size_t)t * 128 + 64 + lane];
            const float su0 = su[e0], su1 = su[e1], sv0 = sv[e0], sv1 = sv[e1];
            __builtin_amdgcn_sched_barrier(0);
            float a0 = ((pa[0] + pa[1]) + (pa[2] + pa[3])) + ((pa[4] + pa[5]) + (pa[6] + pa[7])), a1 = ((pb[0] + pb[1]) + (pb[2] + pb[3])) + ((pb[4] + pb[5]) + (pb[6] + pb[7]));
            a0 *= su0; a1 *= su1;
            const float g0 = gt0 * sv0, g1 = gt1 * sv1;
            wl[tl * WROW + lane] = __builtin_bit_cast(bf16, (_Float16)(256.0f * g0 * 0.5f * a0 * (1.0f + erff(a0 * 0.70710678118654752f)))); wl[tl * WROW + 64 + lane] = __builtin_bit_cast(bf16, (_Float16)(256.0f * g1 * 0.5f * a1 * (1.0f + erff(a1 * 0.70710678118654752f))));
            il[tl * WROW + lane] = (bf16)e0; il[tl * WROW + 64 + lane] = (bf16)e1; }
        __syncthreads();
#pragma unroll
        for (int i = 0; i < 2; ++i) { const int p_ = i * NTHR + F.tid, kq = p_ >> 6, tl = p_ & 63; const size_t o = ((size_t)(tb * 16 + kq) * 64 + tl) * 8;
            *(v4u*)(WT + o) = *(const LAS v4u*)(wl + tl * WROW + 8 * kq); *(v4u*)(IT + o) = *(const LAS v4u*)(il + tl * WROW + 8 * kq); }
        __syncthreads();
    }
}
__device__ __forceinline__ void pbl_load(v4u (&iv)[4], v4u (&wv)[4], const bf16* ip, const bf16* wp) {
#pragma unroll
    for (int q = 0; q < 4; ++q) { iv[q] = *(const v4u*)(ip + q * 512); wv[q] = *(const v4u*)(wp + q * 512); }
}
typedef _Float16 h16x2 __attribute__((ext_vector_type(2)));
#define FP8H_LO(w_) __builtin_bit_cast(h16x2, __builtin_amdgcn_cvt_scalef32_pk_f16_fp8((int)(w_), 1.0f, false))
#define FP8H_HI(w_) __builtin_bit_cast(h16x2, __builtin_amdgcn_cvt_scalef32_pk_f16_fp8((int)(w_), 1.0f, true))
#define PBL_FMA_LO(acc_, v_, w_) asm("v_pk_fma_f16 %0, %1, %2, %0 op_sel_hi:[1,0,1]" : "+v"(acc_) : "v"(v_), "v"(w_))
#define PBL_FMA_HI(acc_, v_, w_) asm("v_pk_fma_f16 %0, %1, %2, %0 op_sel:[0,1,0] op_sel_hi:[1,1,1]" : "+v"(acc_) : "v"(v_), "v"(w_))
__device__ __forceinline__ void pbl_compute(const v4u (&iv)[4], const v4u (&wv)[4], h16x2 (&acc)[4], LAS unsigned char* lds) {
    const unsigned three = 3u;
#pragma unroll
    for (int q = 0; q < 4; ++q) { v2u d[8];
#pragma unroll
        for (int ki = 0; ki < 8; ++ki) { const unsigned ipair = iv[q][ki >> 1]; unsigned ad;
            if (ki & 1) asm("v_lshlrev_b32_sdwa %0, %1, %2 dst_sel:DWORD dst_unused:UNUSED_PAD src0_sel:DWORD src1_sel:WORD_1" : "=v"(ad) : "s"(three), "v"(ipair));
            else asm("v_lshlrev_b32_sdwa %0, %1, %2 dst_sel:DWORD dst_unused:UNUSED_PAD src0_sel:DWORD src1_sel:WORD_0" : "=v"(ad) : "s"(three), "v"(ipair));
            d[ki] = *(const LAS v2u*)(size_t)ad; }
        __builtin_amdgcn_sched_barrier(0);
#pragma unroll
        for (int ki = 0; ki < 8; ++ki) { const unsigned wword = wv[q][ki >> 1];
            const h16x2 v0 = FP8H_LO(d[ki].x), v1 = FP8H_HI(d[ki].x), v2 = FP8H_LO(d[ki].y), v3 = FP8H_HI(d[ki].y);
            if (ki & 1) { PBL_FMA_HI(acc[0], v0, wword); PBL_FMA_HI(acc[1], v1, wword); PBL_FMA_HI(acc[2], v2, wword); PBL_FMA_HI(acc[3], v3, wword); }
            else { PBL_FMA_LO(acc[0], v0, wword); PBL_FMA_LO(acc[1], v1, wword); PBL_FMA_LO(acc[2], v2, wword); PBL_FMA_LO(acc[3], v3, wword); } }
        __builtin_amdgcn_sched_barrier(0); }
}
__device__ __forceinline__ void peer_out_phase(Frame& F, int l) {
    PHASE_TID(F);
    const int lane = F.lane;
    const int x = blockIdx.x & 7, ib = blockIdx.x >> 3, j = 8 * (4 * x + (ib >> 3)) + (ib & 7);
    const bf16* WT = WSP(bf16, WS_Y1); const bf16* IT = WSP(bf16, WS_Y1 + 4 * MiB); bf16* OUT = WSP(bf16, WS_GC);
    for (int jj = (F.G == 256 ? j : (int)blockIdx.x); jj < 256; jj += (F.G == 256 ? 256 : F.G)) {
        const unsigned char* sl = WSP(unsigned char, WS_PV) + (size_t)(l * 256 + jj) * NEXP * 8;
        { v4u fr_[16];
#pragma unroll
          for (int i = 0; i < 16; ++i) fr_[i] = *(const v4u*)(sl + (i * NTHR + F.tid) * 16);
          __builtin_amdgcn_sched_barrier(0);
#pragma unroll
          for (int i = 0; i < 16; ++i) *(LAS v4u*)(F.lds + (i * NTHR + F.tid) * 16) = fr_[i]; }
        __syncthreads();
        constexpr int NCH = 4 * (T / 64 / NWAVES);
#define PBL_PTR(c_, arr_) ((arr_) + ((size_t)(F.wave + NWAVES * ((c_) >> 2)) * 16 * 64 + lane) * 8 + ((c_) & 3) * 4 * 512)
        v4u iA[4], wA[4], iB[4], wB[4], iC[4], wC[4]; h16x2 acc[4];
#define PBL_STEP(X_, Z_, c_) do { const int cc_ = (c_); if (cc_ + 2 < NCH) pbl_load(i##Z_, w##Z_, PBL_PTR(cc_ + 2, IT), PBL_PTR(cc_ + 2, WT)); \
            __builtin_amdgcn_sched_barrier(0); \
            if ((cc_ & 3) == 0) { _Pragma("unroll") for (int q = 0; q < 4; ++q) acc[q] = (h16x2){(_Float16)0.f, (_Float16)0.f}; } \
            pbl_compute(i##X_, w##X_, acc, F.lds); \
            if ((cc_ & 3) == 3) { constexpr float us_ = 1.0f / 256.0f; v4u o; o.x = pk2((float)acc[0].x * us_, (float)acc[0].y * us_); o.y = pk2((float)acc[1].x * us_, (float)acc[1].y * us_); o.z = pk2((float)acc[2].x * us_, (float)acc[2].y * us_); o.w = pk2((float)acc[3].x * us_, (float)acc[3].y * us_); \
                *(v4u*)(OUT + (size_t)((F.wave + NWAVES * (cc_ >> 2)) * 64 + lane) * D + 8 * jj) = o; } \
            __builtin_amdgcn_sched_barrier(0); } while (0)
        pbl_load(iA, wA, PBL_PTR(0, IT), PBL_PTR(0, WT)); pbl_load(iB, wB, PBL_PTR(1, IT), PBL_PTR(1, WT));
#pragma unroll 1
        for (int c = 0; c < NCH; c += 3) {
            PBL_STEP(A, C, c);
            if (c + 1 < NCH) PBL_STEP(B, A, c + 1);
            if (c + 2 < NCH) PBL_STEP(C, B, c + 2);
        }
#undef PBL_STEP
#undef PBL_PTR
        __syncthreads();
    }
}
__device__ __forceinline__ void peer_res_phase(Frame& F, int l, bf16* XO) {
    PHASE_TID(F);
    const bool last = (l == 1);
    const int gw = F.vcu * NWAVES + F.wave, NGW = F.G * NWAVES, lane = F.lane;
    const bf16* XA = WSP(bf16, WS_XA); const bf16* OUTS = WSP(bf16, WS_GC); bf16* Hb = WSP(bf16, WS_H); const float* MOD = WSP(float, WS_MOD);
    for (int t = gw; t < T; t += NGW) {
        const int b = t >> 13; const float* g2 = MOD + (size_t)(l * 2 + b) * 12288 + 5 * 2048;
        f32x4 v[8], gq[8]; v2u oq[8], xq[8]; float ss = 0.f;
#pragma unroll
        for (int jj = 0; jj < 8; ++jj) { const int col = 4 * lane + 256 * jj; xq[jj] = *(const v2u*)(XA + (size_t)t * D + col); gq[jj] = *(const f32x4*)(g2 + col); oq[jj] = *(const v2u*)(OUTS + (size_t)t * D + col); }
        __builtin_amdgcn_sched_barrier(0);
#pragma unroll
        for (int jj = 0; jj < 8; ++jj) { const f32x4 o = {bflo(oq[jj].x), bfhi(oq[jj].x), bflo(oq[jj].y), bfhi(oq[jj].y)}; v[jj] = (f32x4){bflo(xq[jj].x), bfhi(xq[jj].x), bflo(xq[jj].y), bfhi(xq[jj].y)};
            v[jj] = v[jj] + gq[jj] * o; ss += (v[jj].x * v[jj].x + v[jj].y * v[jj].y) + (v[jj].z * v[jj].z + v[jj].w * v[jj].w); }
        const float rstd = 1.0f / sqrtf(wave_sum(ss) * (1.0f / D) + EPS);
        if (!last) {
            const float* ng = F.A->in[I_N1G] + (size_t)(l + 1) * D; const float* mn = MOD + (size_t)((l + 1) * 2 + b) * 12288;
#pragma unroll
            for (int jj = 0; jj < 8; ++jj) gq[jj] = *(const f32x4*)(ng + 4 * lane + 256 * jj);
            f32x4 shq[8], scq[8];
#pragma unroll
            for (int jj = 0; jj < 8; ++jj) { scq[jj] = *(const f32x4*)(mn + 2048 + 4 * lane + 256 * jj); shq[jj] = *(const f32x4*)(mn + 4 * lane + 256 * jj); }
            __builtin_amdgcn_sched_barrier(0);
#pragma unroll
            for (int jj = 0; jj < 8; ++jj) gq[jj] = gq[jj] * (scq[jj] + 1.0f);
#pragma unroll
            for (int jj = 0; jj < 8; ++jj) { const int col = 4 * lane + 256 * jj; v2u w; w.x = pk2(v[jj].x, v[jj].y); w.y = pk2(v[jj].z, v[jj].w); *(v2u*)(XO + (size_t)t * D + col) = w; v[jj] = v[jj] * rstd * gq[jj] + shq[jj]; }
            row_to_fp8(v, (unsigned char*)Hb + (size_t)t * D, WSP(float, WS_SA) + t, lane);
        } else {
            const float* fg = F.A->in[I_FG];
#pragma unroll
            for (int jj = 0; jj < 8; ++jj) gq[jj] = *(const f32x4*)(fg + 4 * lane + 256 * jj);
            __builtin_amdgcn_sched_barrier(0);
#pragma unroll
            for (int jj = 0; jj < 8; ++jj) *(f32x4*)(F.out + (size_t)t * D + 4 * lane + 256 * jj) = v[jj] * rstd * gq[jj];
        }
    }
}

#ifndef MK_ONE_LAUNCH
#define MK_ONE_LAUNCH 1
#endif
#define PG8_ALIGN true
#define PG8_SP2 true
constexpr int PH_PER_LAYER = 13, N_PHASES = 1 + 2 * PH_PER_LAYER;
__global__ void __launch_bounds__(NTHR, 2) fwd(Args args) {
    extern __shared__ __attribute__((aligned(16))) unsigned char lds[];
    Frame F;
    F.lds = (LAS unsigned char*)lds; F.MISC = (volatile LAS unsigned*)(F.lds + MISC_OFF);
    F.tid = threadIdx.x; F.lane = F.tid & 63; F.wave = __builtin_amdgcn_readfirstlane(F.tid >> 6);
    F.G = gridDim.x; { const int bx = blockIdx.x; F.vcu = (F.G % 8 == 0) ? (bx % 8) * (F.G / 8) + bx / 8 : bx; }
    F.A = &args;
    F.out = args.out; F.ws = args.ws; F.ctl = (gu32*)(args.ws + WS_CTL);
    for (int u = F.tid; u < (LDS_BYTES - LDSCTL_OFF) / 4; u += NTHR) ((LAS unsigned*)(F.lds + LDSCTL_OFF))[u] = 0u;
    __syncthreads();
#if MK_ONE_LAUNCH
    XcdBarrier bar = xcd_barrier_post((unsigned*)(F.ctl + CW_BAR), F.MISC + 8);
#define GRID_BAR() xcd_barrier(bar)
#else
#define GRID_BAR() do { } while (0)
#endif
    const int lo = args.ph_lo, hi = args.ph_hi;
#define IN(k) (lo <= (k) && (k) < hi)
#define SEAM(k) do { if (IN(k) && IN((k) + 1)) GRID_BAR(); } while (0)
    float* MOD = WSP(float, WS_MOD);
    pg8::bf16_t* Hb = WSP(pg8::bf16_t, WS_H);

    if (IN(0)) { p0_prologue(F); SEAM(0); }
    for (int l = 0; l < 2; ++l) {
        const int pb = 1 + PH_PER_LAYER * l;
        const float* modl = MOD + (size_t)l * 2 * 12288;
        if (IN(pb + 0) && l == 0) { norm_phase<true, false>(F, F.A->in[I_X], WSP(bf16, WS_H), F.A->in[I_N1G], modl, 0, 1);
            win8_phase(F);
            SEAM(pb + 0); }
        if (IN(pb + 1)) {
            pg8::Gemm g{Hb, (const pg8::bf16_t*)(WSP(unsigned char, WS_WIN) + (size_t)l * IN_DIM * 2048), T, IN_DIM, D / 2, D / 2, D / 2}; pg8::StaticOrder S; S.init(T, IN_DIM, F.G, (int)blockIdx.x);
            const float wmax = __uint_as_float(__hip_atomic_load(F.ctl + CW_WMAX + l, __ATOMIC_RELAXED, __HIP_MEMORY_SCOPE_AGENT));
            pg8::EpiInProj E{WSP(pg8::bf16_t, WS_U), WSP(pg8::bf16_t, WS_Q), WSP(pg8::bf16_t, WS_K), WSP(pg8::bf16_t, WS_V), WSP(pg8::bf16_t, WS_GC), WSP(pg8::bf16_t, WS_GA), WSP(float, WS_SA), wmax > 0.f ? wmax * (1.0f / 440.0f) : 1.0f, (unsigned*)(F.ctl + CW_VMAX + 2 * l)};
            pg8::gemm_phase<pg8::EpiInProj, pg8::StaticOrder, PG8_ALIGN, PG8_SP2, true>(F.lds, g, S, E);
            SEAM(pb + 1);
        }
        if (IN(pb + 2)) { conv_phase(F, l); __syncthreads(); attn_phase(F, l); SEAM(pb + 2); }
        if (IN(pb + 3)) {
            pg8::Gemm g{WSP(pg8::bf16_t, WS_AM), (const pg8::bf16_t*)(WSP(unsigned char, WS_WM) + (size_t)l * 2048 * 2048), T, D, D / 2, D / 2, D / 2}; pg8::StaticOrder S; S.init(T, D, F.G, (int)blockIdx.x);
            const float i440 = 1.0f / 440.0f;
            const float wc_ = __uint_as_float(__hip_atomic_load(F.ctl + CW_WMAX2 + 2 * l, __ATOMIC_RELAXED, __HIP_MEMORY_SCOPE_AGENT)), wa_ = __uint_as_float(__hip_atomic_load(F.ctl + CW_WMAX2 + 2 * l + 1, __ATOMIC_RELAXED, __HIP_MEMORY_SCOPE_AGENT));
            const float bc_ = __uint_as_float(__hip_atomic_load(F.ctl + CW_BC + l, __ATOMIC_RELAXED, __HIP_MEMORY_SCOPE_AGENT));
            const float swc = wc_ > 0.f ? wc_ * i440 : 1.0f, swa = wa_ > 0.f ? wa_ * i440 : 1.0f, sc = bc_ * i440;
            const float vm0 = __uint_as_float(__hip_atomic_load(F.ctl + CW_VMAX + 2 * l, __ATOMIC_RELAXED, __HIP_MEMORY_SCOPE_AGENT)), vm1 = __uint_as_float(__hip_atomic_load(F.ctl + CW_VMAX + 2 * l + 1, __ATOMIC_RELAXED, __HIP_MEMORY_SCOPE_AGENT));
            const float fe0 = (vm0 > 0.f ? 1.02f * vm0 * i440 : 1.0f) * swa, fe1 = (vm1 > 0.f ? 1.02f * vm1 * i440 : 1.0f) * swa;
            const float bc2 = __uint_as_float(__hip_atomic_load(F.ctl + CW_BC2 + l, __ATOMIC_RELAXED, __HIP_MEMORY_SCOPE_AGENT));
            const float bm0 = fmaxf(1024.0f * (bc2 * wc_ + 1.02f * vm0 * wa_), 1e-20f), bm1 = fmaxf(1024.0f * (bc2 * wc_ + 1.02f * vm1 * wa_), 1e-20f);
            pg8::EpiMerge E{WSP(pg8::bf16_t, WS_GC), WSP(pg8::bf16_t, WS_GA), WSP(unsigned char, WS_H), (sc * swc) / fe0, (sc * swc) / fe1, fe0 * (440.0f / bm0), fe1 * (440.0f / bm1)};
            pg8::gemm_phase<pg8::EpiMerge, pg8::StaticOrder, PG8_ALIGN, PG8_SP2, true>(F.lds, g, S, E);
            SEAM(pb + 3);
        }
        if (IN(pb + 5)) {
            pg8::Gemm g{Hb, (const pg8::bf16_t*)(WSP(unsigned char, WS_WO) + (size_t)l * 2048 * 2048), T, D, D / 2, D / 2, D / 2}; pg8::StaticOrder S; S.init(T, D, F.G, (int)blockIdx.x);
            const float i440 = 1.0f / 440.0f;
            const float wc_ = __uint_as_float(__hip_atomic_load(F.ctl + CW_WMAX2 + 2 * l, __ATOMIC_RELAXED, __HIP_MEMORY_SCOPE_AGENT)), wa_ = __uint_as_float(__hip_atomic_load(F.ctl + CW_WMAX2 + 2 * l + 1, __ATOMIC_RELAXED, __HIP_MEMORY_SCOPE_AGENT));
            const float wo_ = __uint_as_float(__hip_atomic_load(F.ctl + CW_WMAX3 + l, __ATOMIC_RELAXED, __HIP_MEMORY_SCOPE_AGENT)), swo = wo_ > 0.f ? wo_ * i440 : 1.0f;
            const float bc2 = __uint_as_float(__hip_atomic_load(F.ctl + CW_BC2 + l, __ATOMIC_RELAXED, __HIP_MEMORY_SCOPE_AGENT));
            const float vm0 = __uint_as_float(__hip_atomic_load(F.ctl + CW_VMAX + 2 * l, __ATOMIC_RELAXED, __HIP_MEMORY_SCOPE_AGENT)), vm1 = __uint_as_float(__hip_atomic_load(F.ctl + CW_VMAX + 2 * l + 1, __ATOMIC_RELAXED, __HIP_MEMORY_SCOPE_AGENT));
            const float bm0 = fmaxf(1024.0f * (bc2 * wc_ + 1.02f * vm0 * wa_), 1e-20f), bm1 = fmaxf(1024.0f * (bc2 * wc_ + 1.02f * vm1 * wa_), 1e-20f);
            if (l == 0) { pg8::EpiResid<false> E{F.A->in[I_X], WSP(pg8::bf16_t, WS_XA), modl + 2 * 2048, bm0 * i440 * swo, bm1 * i440 * swo};
                pg8::gemm_phase<pg8::EpiResid<false>, pg8::StaticOrder, PG8_ALIGN, PG8_SP2, true>(F.lds, g, S, E); }
            else { pg8::EpiResid<true> E{WSP(pg8::bf16_t, WS_XA), WSP(pg8::bf16_t, WS_XA), modl + 2 * 2048, bm0 * i440 * swo, bm1 * i440 * swo};
                pg8::gemm_phase<pg8::EpiResid<true>, pg8::StaticOrder, PG8_ALIGN, PG8_SP2, true>(F.lds, g, S, E); }
            SEAM(pb + 5);
        }
        if (IN(pb + 6)) { norm_phase<false, true>(F, WSP(bf16, WS_XA), WSP(bf16, WS_H), F.A->in[I_N2G] + (size_t)l * D, modl, 3, 4); SEAM(pb + 6); }
        if (IN(pb + 7)) {
            pg8::Gemm g{Hb, WSP(pg8::bf16_t, WS_WP) + (size_t)l * 2048 * 2048, T, D, D, D, D}; pg8::StaticOrder S; S.init(T, D, F.G, (int)blockIdx.x);
            pg8::EpiF16 E{WSP(_Float16, WS_GC), D};
            pg8::gemm_phase<pg8::EpiF16, pg8::StaticOrder, PG8_ALIGN, PG8_SP2>(F.lds, g, S, E);
            SEAM(pb + 7);
        }
        if (IN(pb + 8)) { topk_phase(F); SEAM(pb + 8); }
        if (IN(pb + 9)) { peer_act_phase(F, l); SEAM(pb + 9); }
        if (IN(pb + 10)) { peer_w_phase(F, l); SEAM(pb + 10); }
        if (IN(pb + 11)) { peer_out_phase(F, l); SEAM(pb + 11); }
        if (IN(pb + 12)) { peer_res_phase(F, l, WSP(bf16, WS_XA)); SEAM(pb + 12); }
    }
#undef IN
#undef SEAM
}

extern "C" void kernel_launch(void* const* d_in, const int* in_sizes, int n_in, void* d_out, int out_size, void* d_ws, size_t ws_size, hipStream_t stream) {
    static int grid = 0;
    if (grid == 0) {
        if (n_in != N_IN || out_size != T * D || ws_size < WS_END) { fprintf(stderr, "kernel_launch: unexpected problem: n_in %d out %d ws %zu (need %zu)\n", n_in, out_size, ws_size, (size_t)WS_END); grid = -1; return; }
        int dev = 0, cus = 0, per_cu = 0;
        if (hipGetDevice(&dev) != hipSuccess || hipDeviceGetAttribute(&cus, hipDeviceAttributeMultiprocessorCount, dev) != hipSuccess) { grid = -1; return; }
        if (hipFuncSetAttribute((const void*)fwd, hipFuncAttributeMaxDynamicSharedMemorySize, LDS_BYTES) != hipSuccess) { fprintf(stderr, "kernel_launch: hipFuncSetAttribute failed\n"); grid = -1; return; }
        if (hipOccupancyMaxActiveBlocksPerMultiprocessor(&per_cu, (const void*)fwd, NTHR, LDS_BYTES) != hipSuccess || per_cu < 1) fprintf(stderr, "kernel_launch: occupancy query reports %d\n", per_cu);
        (void)hipGetLastError();
        grid = cus;
    }
    if (grid < 0) return;
    (void)in_sizes;
    if (hipMemsetAsync((char*)d_ws + WS_CTL, 0, CTL_ZERO_BYTES, stream) != hipSuccess) return;
    Args a{};
    for (int i = 0; i < N_IN; ++i) a.in[i] = (const float*)d_in[i];
    a.out = (float*)d_out; a.ws = (unsigned char*)d_ws;
#if MK_ONE_LAUNCH
    a.ph_lo = 0; a.ph_hi = N_PHASES;
    hipLaunchKernelGGL(fwd, dim3(grid), dim3(NTHR), LDS_BYTES, stream, a);
#else
    for (int p = 0; p < N_PHASES; ++p) {
        if (p == 1 + PH_PER_LAYER) continue;
        a.ph_lo = p; a.ph_hi = p + 1;
        hipLaunchKernelGGL(fwd, dim3(grid), dim3(NTHR), LDS_BYTES, stream, a);
    }
#endif
}
```

```cpp
#include <hip/hip_runtime.h>
#include <cstdio>
#include <cstdint>
namespace pg8 {
#define PG8_LAS __attribute__((address_space(3)))
typedef unsigned short bf16_t;
typedef short bf16x8 __attribute__((ext_vector_type(8)));
typedef float f32x4 __attribute__((ext_vector_type(4)));
typedef unsigned u32x4 __attribute__((ext_vector_type(4)));
typedef int i32x4 __attribute__((ext_vector_type(4)));
typedef int i32x8 __attribute__((ext_vector_type(8)));
__device__ __forceinline__ i32x8 cat8(const bf16x8& a, const bf16x8& b) { const i32x4 x = __builtin_bit_cast(i32x4, a), y = __builtin_bit_cast(i32x4, b); return (i32x8){x[0], x[1], x[2], x[3], y[0], y[1], y[2], y[3]}; }
constexpr int BM = 256, BK = 64, HALF = 128, HTB = HALF * BK * 2  , STAGE_BYTES = 8 * HTB, NXCD = 8, WGM = 4;

__host__ __device__ __forceinline__ int lds_byte(int r, int c) { const int st = (r >> 4) * 2 + (c >> 5), rr = r & 15, cc = c & 31, ob = rr * 64 + cc * 2; return st * 1024 + (ob ^ (((ob >> 9) & 1) << 5)); }
__host__ __device__ __forceinline__ void stage_rc(int b, int& R, int& C) { const int st = b / 1024, sb = b % 1024, swz = sb ^ (((sb >> 9) & 1) << 5); R = (st >> 1) * 16 + swz / 64; C = (st & 1) * 32 + (swz % 64) / 2; }
__host__ __device__ __forceinline__ int perm32(int rho) { const int n = rho >> 4, i = rho & 15; return 8 * (i >> 2) + 4 * n + (i & 3); }

struct Unit { int pm, pn; };
struct Gemm { const bf16_t* A; const bf16_t* Bt; int M, N, K, lda, ldb; };

struct StaticOrder {
    int nM, nN, nwg, G, c, wgm;
    __host__ __device__ void init(int M, int N, int G_, int c_, int wgm_ = WGM) { nM = M / BM; nN = N / BM; nwg = nM * nN; G = G_; c = c_; wgm = wgm_; }
    __host__ __device__ bool next(int i, Unit& u) const {
        const long L = (long)i * G + c; if (L >= nwg) return false;
        int wgid = (int)L; { const int q = nwg / NXCD, r = nwg % NXCD, xcd = wgid % NXCD, off = wgid / NXCD; wgid = (xcd < r ? xcd * (q + 1) : r * (q + 1) + (xcd - r) * q) + off; }
        const int nig = wgm * nN, gid = wgid / nig, fm = gid * wgm, gsz = (nM - fm) < wgm ? (nM - fm) : wgm;
        u.pm = fm + ((wgid % nig) % gsz); u.pn = (wgid % nig) / gsz; return true;
    }
    __device__ __forceinline__ void a_ready(const Unit&) const {}
    __device__ __forceinline__ void done(const Unit&) const {}
};

__device__ __forceinline__ unsigned cvt_pk_bf16(float lo, float hi) { unsigned r; asm volatile("v_cvt_pk_bf16_f32 %0, %1, %2" : "=v"(r) : "v"(lo), "v"(hi)); return r; }
typedef float f32x2 __attribute__((ext_vector_type(2)));
template <class Epi, class Sched, bool ALIGN_EPI = false, bool SP2 = false, bool FP8 = false>
__device__ __forceinline__ void gemm_phase(PG8_LAS unsigned char* lds, const Gemm g, const Sched& S, const Epi& E) {
    int tid_ = threadIdx.x; asm volatile("" : "+v"(tid_));
    const int tid = tid_, wid = __builtin_amdgcn_readfirstlane(tid >> 6), lane = tid & 63, wr = wid >> 2, wc = wid & 3, fr = lane & 15, fq = lane >> 4;
    const int K = g.K, nt = K / BK;
    unsigned voffA[2], voffB[2];
#pragma unroll
    for (int i = 0; i < 2; ++i) { int R, C; stage_rc(tid * 16 + i * 8192, R, C); const int Rb = Epi::PERM ? ((R & ~31) + perm32(R & 31)) : R;
        voffA[i] = (unsigned)(R * g.lda + C) * 2u; voffB[i] = (unsigned)(Rb * g.ldb + C) * 2u; }
    const size_t kstep = (size_t)(BK * 2);
    const size_t hstepA = (size_t)HALF * g.lda * 2, hstepB = (size_t)HALF * g.ldb * 2;
    const size_t tstepA = 2 * hstepA, tstepB = 2 * hstepB;
    const unsigned ldsw = (unsigned)wid * 1024u;
    const int aoff = lds_byte(wr * 64 + fr, fq * 8), boff = lds_byte(wc * 32 + fr, fq * 8);
#define PG8_SA(b, h) (((b) * 2 + (h)) * HTB)
#define PG8_SB(b, h) ((4 + (b) * 2 + (h)) * HTB)
#define PG8_STAGE(bufoff, gbase, voff) do { _Pragma("unroll") for (int _i = 0; _i < 2; ++_i) \
        __builtin_amdgcn_global_load_lds((const unsigned*)((const char*)(gbase) + (voff)[_i]), (PG8_LAS unsigned*)(lds + (bufoff) + ldsw + _i * 8192), 16, 0, 0); } while (0)
#define PG8_LDA(dst, b, h) do { _Pragma("unroll") for (int m = 0; m < 4; ++m) _Pragma("unroll") for (int k = 0; k < 2; ++k) dst[m][k] = *(const PG8_LAS bf16x8*)(lds + PG8_SA(b, h) + aoff + m * 2048 + k * 1024); } while (0)
#define PG8_LDB(dst, b, h) do { _Pragma("unroll") for (int n = 0; n < 2; ++n) _Pragma("unroll") for (int k = 0; k < 2; ++k) dst[n][k] = *(const PG8_LAS bf16x8*)(lds + PG8_SB(b, h) + boff + n * 2048 + k * 1024); } while (0)
#define PG8_MMA(ai, bj, At, Bt) do { __builtin_amdgcn_s_setprio(1); _Pragma("unroll") for (int m = 0; m < 4; ++m) _Pragma("unroll") for (int n = 0; n < 2; ++n) { \
        if constexpr (FP8) { asm volatile("v_mfma_f32_16x16x128_f8f6f4 %0, %1, %2, %0" : "+v"(acc[ai][bj][m][n]) : "v"(cat8(Bt[n][0], Bt[n][1])), "v"(cat8(At[m][0], At[m][1]))); } \
        else { _Pragma("unroll") for (int k = 0; k < 2; ++k) acc[ai][bj][m][n] = __builtin_amdgcn_mfma_f32_16x16x32_bf16(Bt[n][k], At[m][k], acc[ai][bj][m][n], 0, 0, 0); } } __builtin_amdgcn_s_setprio(0); } while (0)
#define PG8_WAIT_V(n) asm volatile("s_waitcnt vmcnt(" #n ")" ::: "memory")
#define PG8_WAIT_L(n) asm volatile("s_waitcnt lgkmcnt(" #n ")" ::: "memory")
#define PG8_BAR __builtin_amdgcn_s_barrier()
#define PG8_SCHED __builtin_amdgcn_sched_barrier(0)
    Unit cur, nxt; int ui = 0;
    if (!S.next(0, cur)) return;
    f32x4 acc[2][2][4][2];
#pragma unroll
    for (int a = 0; a < 2; ++a)
#pragma unroll
        for (int b = 0; b < 2; ++b)
#pragma unroll
            for (int m = 0; m < 4; ++m)
#pragma unroll
                for (int n = 0; n < 2; ++n) acc[a][b][m][n] = (f32x4){0.f, 0.f, 0.f, 0.f};
    bf16x8 At[4][2], B0[2][2], B1[2][2];
    const char* cA = (const char*)g.A + (size_t)cur.pm * tstepA; const char* cB = (const char*)g.Bt + (size_t)cur.pn * tstepB;
    S.a_ready(cur);
    if constexpr (SP2) {
        PG8_STAGE(PG8_SB(0, 0), cB, voffB); PG8_STAGE(PG8_SB(0, 1), cB + hstepB, voffB); PG8_STAGE(PG8_SA(0, 0), cA, voffA); PG8_STAGE(PG8_SA(0, 1), cA + hstepA, voffA);
        if (wr == 1) PG8_BAR;
        PG8_WAIT_V(2); PG8_BAR;
        PG8_STAGE(PG8_SB(1, 0), cB + kstep, voffB); PG8_STAGE(PG8_SA(1, 0), cA + kstep, voffA); PG8_STAGE(PG8_SB(1, 1), cB + hstepB + kstep, voffB);
        PG8_WAIT_V(6); PG8_BAR;
    } else {
        PG8_STAGE(PG8_SB(0, 0), cB, voffB); PG8_STAGE(PG8_SA(0, 0), cA, voffA); PG8_STAGE(PG8_SB(0, 1), cB + hstepB, voffB); PG8_STAGE(PG8_SA(0, 1), cA + hstepA, voffA);
        if (wr == 1) PG8_BAR;
        PG8_WAIT_V(4); PG8_BAR;
        PG8_STAGE(PG8_SB(1, 0), cB + kstep, voffB); PG8_STAGE(PG8_SA(1, 0), cA + kstep, voffA); PG8_STAGE(PG8_SB(1, 1), cB + hstepB + kstep, voffB);
        PG8_WAIT_V(6); PG8_BAR;
    }
    for (;;) {
        const bool has_next = S.next(ui + 1, nxt);
        const char* nA = has_next ? (const char*)g.A + (size_t)nxt.pm * tstepA : cA; const char* nB = has_next ? (const char*)g.Bt + (size_t)nxt.pn * tstepB : cB;
        for (int t = 0; t < nt; t += 2) {
            if constexpr (Epi::HAS_MID) { if (t == (nt >> 1)) { if constexpr (FP8) { asm volatile("s_nop 15\n\ts_nop 15" ::: "memory"); }
                E.mid(acc, cur, wr, wc, fr, fq); } }
            const bool last = (t == nt - 2);
            const char* a1 = cA + (size_t)(t + 1) * kstep;
            const char* a2 = last ? nA : cA + (size_t)(t + 2) * kstep; const char* b2 = last ? nB : cB + (size_t)(t + 2) * kstep;
            const char* a3 = a2 + kstep; const char* b3 = b2 + kstep;
            if (last && has_next) S.a_ready(nxt);
            if constexpr (SP2) {
            PG8_LDB(B0, 0, 0); PG8_LDB(B1, 0, 1); PG8_SCHED; PG8_LDA(At, 0, 0); PG8_STAGE(PG8_SA(1, 1), a1 + hstepA, voffA);
            PG8_WAIT_V(8); PG8_WAIT_L(0); PG8_BAR; PG8_MMA(0, 0, At, B0); PG8_MMA(0, 1, At, B1); PG8_BAR; PG8_SCHED;
            PG8_LDA(At, 0, 1); PG8_STAGE(PG8_SB(0, 0), b2, voffB); PG8_STAGE(PG8_SB(0, 1), b2 + hstepB, voffB); PG8_STAGE(PG8_SA(0, 0), a2, voffA);
            PG8_WAIT_V(8); PG8_WAIT_L(0); PG8_BAR; PG8_MMA(1, 0, At, B0); PG8_MMA(1, 1, At, B1); PG8_BAR; PG8_SCHED;
            PG8_LDB(B0, 1, 0); PG8_LDB(B1, 1, 1); PG8_SCHED; PG8_LDA(At, 1, 0); PG8_STAGE(PG8_SA(0, 1), a2 + hstepA, voffA);
            PG8_WAIT_V(8); PG8_WAIT_L(0); PG8_BAR; PG8_MMA(0, 0, At, B0); PG8_MMA(0, 1, At, B1); PG8_BAR; PG8_SCHED;
            PG8_LDA(At, 1, 1); PG8_STAGE(PG8_SB(1, 0), b3, voffB); PG8_STAGE(PG8_SB(1, 1), b3 + hstepB, voffB); PG8_STAGE(PG8_SA(1, 0), a3, voffA);
            PG8_WAIT_V(8); PG8_WAIT_L(0); PG8_BAR; PG8_MMA(1, 0, At, B0); PG8_MMA(1, 1, At, B1); PG8_BAR; PG8_SCHED;
            } else {
            PG8_LDB(B0, 0, 0); PG8_SCHED; PG8_LDA(At, 0, 0); PG8_STAGE(PG8_SA(1, 1), a1 + hstepA, voffA);
            PG8_WAIT_L(8); PG8_BAR; PG8_WAIT_L(0); PG8_MMA(0, 0, At, B0); PG8_BAR; PG8_SCHED;
            PG8_LDB(B1, 0, 1); PG8_STAGE(PG8_SB(0, 0), b2, voffB);
            PG8_BAR; PG8_WAIT_L(0); PG8_MMA(0, 1, At, B1); PG8_BAR;
            PG8_LDA(At, 0, 1); PG8_STAGE(PG8_SA(0, 0), a2, voffA);
            PG8_BAR; PG8_WAIT_L(0); PG8_MMA(1, 0, At, B0); PG8_BAR; PG8_SCHED;
            PG8_STAGE(PG8_SB(0, 1), b2 + hstepB, voffB);
            PG8_WAIT_V(6); PG8_BAR; PG8_MMA(1, 1, At, B1); PG8_BAR;
            PG8_LDB(B0, 1, 0); PG8_SCHED; PG8_LDA(At, 1, 0); PG8_STAGE(PG8_SA(0, 1), a2 + hstepA, voffA);
            PG8_WAIT_L(8); PG8_BAR; PG8_WAIT_L(0); PG8_MMA(0, 0, At, B0); PG8_BAR; PG8_SCHED;
            PG8_LDB(B1, 1, 1); PG8_STAGE(PG8_SB(1, 0), b3, voffB);
            PG8_BAR; PG8_WAIT_L(0); PG8_MMA(0, 1, At, B1); PG8_BAR;
            PG8_LDA(At, 1, 1); PG8_STAGE(PG8_SA(1, 0), a3, voffA);
            PG8_BAR; PG8_WAIT_L(0); PG8_MMA(1, 0, At, B0); PG8_BAR; PG8_SCHED;
            PG8_STAGE(PG8_SB(1, 1), b3 + hstepB, voffB);
            PG8_WAIT_V(6); PG8_BAR; PG8_MMA(1, 1, At, B1); PG8_BAR;
            }
        }
        if constexpr (FP8) { asm volatile("s_nop 15\n\ts_nop 15" ::: "memory"); }
        if constexpr (ALIGN_EPI) { if (wr == 0) PG8_BAR; }
        if constexpr (!Epi::AFTER_DRAIN) { E(acc, cur, wr, wc, fr, fq); S.done(cur); }
        if (!has_next) break;
#pragma unroll
        for (int a = 0; a < 2; ++a)
#pragma unroll
            for (int b = 0; b < 2; ++b)
#pragma unroll
                for (int m = 0; m < 4; ++m)
#pragma unroll
                    for (int n = 0; n < 2; ++n) acc[a][b][m][n] = (f32x4){0.f, 0.f, 0.f, 0.f};
        cur = nxt; cA = nA; cB = nB; ++ui;
        if constexpr (ALIGN_EPI) { if (wr == 1) PG8_BAR; }
    }
    PG8_WAIT_V(0);
    if constexpr (!ALIGN_EPI) { if (wr == 0) PG8_BAR; }
    PG8_BAR;
    if constexpr (Epi::AFTER_DRAIN) { E.fused(acc, cur, wr, wc, fr, fq, lds, wid, lane); S.done(cur); }
#undef PG8_SA
#undef PG8_SB
#undef PG8_STAGE
#undef PG8_LDA
#undef PG8_LDB
#undef PG8_MMA
#undef PG8_WAIT_V
#undef PG8_WAIT_L
#undef PG8_BAR
#undef PG8_SCHED
}
}

constexpr int T = 16384, D = 2048, SEQ = 8192, CONV = 1024, CWID = 31, NHEAD = 16, NKVH = 4, HD = 64, ATT = 1024, KVD = 256, IN_DIM = 7680, NEXP = 16384, PHEADS = 8, TOPK = 16;
constexpr float EPS = 1e-6f;
constexpr int NSL = 16, SLW = 128;
constexpr int NWAVES = 8, NTHR = NWAVES * 64;
enum { I_X = 0, I_C, I_RELB, I_ADAW, I_ADAB, I_N1G, I_WIN, I_DWW, I_DWB, I_CLNG, I_CLNB, I_WCO, I_SINK, I_WAO, I_WOUT, I_N2G, I_WPQ, I_SK, I_PU, I_PV, I_FG, N_IN };

constexpr size_t MiB = 1u << 20;
constexpr size_t WS_CTL = 0, CTL_ZERO_BYTES = 1 * MiB;
constexpr size_t WS_MOD = 1 * MiB;
constexpr size_t WS_BIAS = 1 * MiB + 512 * 1024;
constexpr size_t WS_SCL = 1 * MiB + 640 * 1024;
constexpr size_t WS_WIN = 2 * MiB;
constexpr size_t WS_SA = 1 * MiB + 896 * 1024;
constexpr size_t WS_WM = 62 * MiB;
constexpr size_t WS_WO = 78 * MiB;
constexpr size_t WS_WP = 94 * MiB;
constexpr size_t WS_PU = 110 * MiB;
constexpr size_t WS_PV = 238 * MiB;
constexpr size_t WS_H = 366 * MiB;
constexpr size_t WS_U = 430 * MiB;
constexpr size_t WS_Q = 462 * MiB;
constexpr size_t WS_K = 494 * MiB;
constexpr size_t WS_V = 502 * MiB;
constexpr size_t WS_GC = 510 * MiB;
constexpr size_t WS_GA = 574 * MiB;
constexpr size_t WS_AM = 638 * MiB;
constexpr size_t WS_Y1 = 702 * MiB;
constexpr size_t WS_XA = 766 * MiB;
constexpr size_t WS_END = 894 * MiB;
constexpr int CW_TMO = 0, CW_QUEUE = 64, CW_QUEUE2 = 128, CW_WMAX = 192, CW_WMAX2 = 194, CW_WMAX3 = 198, CW_VMAX = 200, CW_BC = 204, CW_BC2 = 206, CW_BAR = 4096;

constexpr int RING_BYTES = 131072, LDSCTL_OFF = RING_BYTES, MISC_OFF = LDSCTL_OFF + 320, LDS_BYTES = 147456;

#define GAS __attribute__((address_space(1)))
#define LAS __attribute__((address_space(3)))
typedef unsigned short bf16;
typedef unsigned v4u __attribute__((ext_vector_type(4)));
typedef unsigned v2u __attribute__((ext_vector_type(2)));
typedef float f32x4 __attribute__((ext_vector_type(4)));
typedef float f32x2 __attribute__((ext_vector_type(2)));
typedef float f32x16 __attribute__((ext_vector_type(16)));
typedef short bf16x8 __attribute__((ext_vector_type(8)));
typedef __bf16 bf16x2v __attribute__((ext_vector_type(2)));
typedef GAS unsigned gu32;
#define LDS_WAIT() asm volatile("s_waitcnt lgkmcnt(0)" ::: "memory")
#define VM_WAIT() asm volatile("s_waitcnt vmcnt(0)" ::: "memory")
__device__ __forceinline__ unsigned f2bf(float f) { unsigned u = __builtin_bit_cast(unsigned, f); return (u + 0x7fffu + ((u >> 16) & 1u)) >> 16; }
__device__ __forceinline__ unsigned pk2(float lo, float hi) { f32x2 v = {lo, hi}; bf16x2v b = __builtin_convertvector(v, bf16x2v); return __builtin_bit_cast(unsigned, b); }
__device__ __forceinline__ float bflo(unsigned p) { return __uint_as_float(p << 16); }
__device__ __forceinline__ float bfhi(unsigned p) { return __uint_as_float(p & 0xffff0000u); }
__device__ __forceinline__ float sigmoidf_(float x) { return __builtin_amdgcn_rcpf(1.0f + __expf(-x)); }
__device__ __forceinline__ float dot2bf(unsigned a, unsigned b, float c) { return __builtin_amdgcn_fdot2_f32_bf16(__builtin_bit_cast(bf16x2v, a), __builtin_bit_cast(bf16x2v, b), c, false); }
__device__ __forceinline__ float wave_sum(float v) {
#pragma unroll
    for (int o = 1; o < 64; o <<= 1) v += __shfl_xor(v, o);
    return v;
}

template <int CTRL> __device__ __forceinline__ float dpp_mov(float v) { return __builtin_bit_cast(float, __builtin_amdgcn_update_dpp(0, __builtin_bit_cast(int, v), CTRL, 0xf, 0xf, true)); }
__device__ __forceinline__ float lane_xor1(float v) { return dpp_mov<0xB1>(v); }
__device__ __forceinline__ float lane_xor2(float v) { return dpp_mov<0x4E>(v); }
__device__ __forceinline__ float lane_xor4(float v) { return dpp_mov<0x141>(dpp_mov<0x1B>(v)); }
__device__ __forceinline__ float lane_xor8(float v) { return dpp_mov<0x128>(v); }
__device__ __forceinline__ float lane_xor16(float v) { return __builtin_bit_cast(float, __builtin_amdgcn_ds_swizzle(__builtin_bit_cast(int, v), 0x401F)); }

namespace pg8 {
__device__ __forceinline__ float sigm(float x) { return __builtin_amdgcn_rcpf(1.0f + __expf(-x)); }
__device__ __forceinline__ u32x4 pack8(const f32x4& v0, const f32x4& v1) { u32x4 w; w.x = cvt_pk_bf16(v0[0], v0[1]); w.y = cvt_pk_bf16(v0[2], v0[3]); w.z = cvt_pk_bf16(v1[0], v1[1]); w.w = cvt_pk_bf16(v1[2], v1[3]); return w; }
__device__ __forceinline__ float blo(unsigned p) { return __uint_as_float(p << 16); }
__device__ __forceinline__ float bhi(unsigned p) { return __uint_as_float(p & 0xffff0000u); }
struct EpiInProj {
    static constexpr bool PERM = true, AFTER_DRAIN = false, HAS_MID = false;
    bf16_t *U, *Q, *K, *V, *GC, *GA; const float* sa; float sw; unsigned* vmax;
    __device__ __forceinline__ void operator()(const f32x4 (&acc)[2][2][4][2], const Unit& u, int wr, int wc, int fr, int fq) const {
        const int row0 = u.pm * BM + wr * 64 + fr, cw = wc * 32 + 8 * fq, pn = u.pn;
        float rsv[2][4];
        { const float* sp = sa + row0;
          asm volatile("global_load_dword %0, %8, off\n\tglobal_load_dword %1, %8, off offset:64\n\tglobal_load_dword %2, %8, off offset:128\n\tglobal_load_dword %3, %8, off offset:192\n\t"
                       "global_load_dword %4, %8, off offset:512\n\tglobal_load_dword %5, %8, off offset:576\n\tglobal_load_dword %6, %8, off offset:640\n\tglobal_load_dword %7, %8, off offset:704\n\ts_waitcnt vmcnt(0)"
                       : "=&v"(rsv[0][0]), "=&v"(rsv[0][1]), "=&v"(rsv[0][2]), "=&v"(rsv[0][3]), "=&v"(rsv[1][0]), "=&v"(rsv[1][1]), "=&v"(rsv[1][2]), "=&v"(rsv[1][3]) : "v"(sp) : "memory"); }
        if (pn < 8) {
#pragma unroll
            for (int ai = 0; ai < 2; ++ai)
#pragma unroll
                for (int m = 0; m < 4; ++m) { bf16_t* p = U + (size_t)(row0 + ai * HALF + m * 16) * 1024 + pn * 128 + cw; const float rs = rsv[ai][m] * sw;
                    f32x4 a0 = acc[ai][0][m][0] * rs, a1 = acc[ai][0][m][1] * rs; const f32x4 b0 = acc[ai][1][m][0] * rs, b1 = acc[ai][1][m][1] * rs;
#pragma unroll
                    for (int i = 0; i < 4; ++i) { a0[i] *= sigm(b0[i]); a1[i] *= sigm(b1[i]); }
                    *(u32x4*)p = pack8(a0, a1); }
        } else {
            bf16_t* base; int ld, cb, mode;
            if (pn < 12) { base = Q; ld = 1024; cb = (pn - 8) * 256; mode = 0; }
            else if (pn == 12) { base = K; ld = 256; cb = 0; mode = 1; }
            else if (pn == 13) { base = V; ld = 256; cb = 0; mode = 1; }
            else if (pn < 22) { base = GC; ld = 2048; cb = (pn - 14) * 256; mode = 2; }
            else { base = GA; ld = 2048; cb = (pn - 22) * 256; mode = 2; }
            float vm = 0.f;
#pragma unroll
            for (int ai = 0; ai < 2; ++ai)
#pragma unroll
                for (int m = 0; m < 4; ++m) { bf16_t* p = base + (size_t)(row0 + ai * HALF + m * 16) * ld + cb + cw; const float rs = rsv[ai][m] * sw;
#pragma unroll
                    for (int bj = 0; bj < 2; ++bj) { f32x4 v0 = acc[ai][bj][m][0] * rs, v1 = acc[ai][bj][m][1] * rs;
                        if (pn == 13) vm = fmaxf(vm, fmaxf(fmaxf(fmaxf(fabsf(v0[0]), fabsf(v0[1])), fmaxf(fabsf(v0[2]), fabsf(v0[3]))), fmaxf(fmaxf(fabsf(v1[0]), fabsf(v1[1])), fmaxf(fabsf(v1[2]), fabsf(v1[3])))));
                        if (mode == 0) { v0 = v0 * 0.125f; v1 = v1 * 0.125f; }
                        else if (mode == 2) {
#pragma unroll
                            for (int i = 0; i < 4; ++i) { v0[i] = sigm(v0[i]); v1[i] = sigm(v1[i]); } }
                        *(u32x4*)(p + bj * HALF) = pack8(v0, v1); } }
            if (pn == 13) {
#pragma unroll
                for (int o = 1; o < 64; o <<= 1) vm = fmaxf(vm, __shfl_xor(vm, o));
                if ((threadIdx.x & 63) == 0) __hip_atomic_fetch_max(vmax + (u.pm >> 5), __float_as_uint(vm), __ATOMIC_RELAXED, __HIP_MEMORY_SCOPE_AGENT); }
        }
    }
};
struct EpiMerge {
    static constexpr bool PERM = true, AFTER_DRAIN = false, HAS_MID = true;
    const bf16_t* GC; const bf16_t* GA; unsigned char* O; float fmid0, fmid1, fend0, fend1;
    __device__ __forceinline__ void mid(f32x4 (&acc)[2][2][4][2], const Unit& u, int wr, int wc, int fr, int fq) const {
        unsigned lo_ = (unsigned)((wr * 64 + fr) * 2048 + wc * 32 + 8 * fq) * 2u; const float fmd = (u.pm >> 5) ? fmid1 : fmid0;
        asm volatile("" : "+v"(lo_));
        const size_t ub = (size_t)(u.pm * BM) * 2048 + (size_t)u.pn * BM;
#pragma unroll
        for (int ai = 0; ai < 2; ++ai) { u32x4 gc[4][2], ga[4][2];
#pragma unroll
            for (int m = 0; m < 4; ++m)
#pragma unroll
                for (int bj = 0; bj < 2; ++bj) { const size_t off = ub + (size_t)(ai * HALF + m * 16) * 2048 + bj * HALF; gc[m][bj] = *(const u32x4*)((const char*)(GC + off) + lo_); ga[m][bj] = *(const u32x4*)((const char*)(GA + off) + lo_); }
            __builtin_amdgcn_sched_barrier(0);
#pragma unroll
            for (int m = 0; m < 4; ++m)
#pragma unroll
                for (int bj = 0; bj < 2; ++bj) { const u32x4 c = gc[m][bj], a = ga[m][bj];
#define RT_(cw_, aw_, HI_) ((HI_ ? bhi(cw_) : blo(cw_)) * fmd * __builtin_amdgcn_rcpf(fmaxf(HI_ ? bhi(aw_) : blo(aw_), 1e-30f)))
                    acc[ai][bj][m][0][0] *= RT_(c.x, a.x, 0); acc[ai][bj][m][0][1] *= RT_(c.x, a.x, 1); acc[ai][bj][m][0][2] *= RT_(c.y, a.y, 0); acc[ai][bj][m][0][3] *= RT_(c.y, a.y, 1);
                    acc[ai][bj][m][1][0] *= RT_(c.z, a.z, 0); acc[ai][bj][m][1][1] *= RT_(c.z, a.z, 1); acc[ai][bj][m][1][2] *= RT_(c.w, a.w, 0); acc[ai][bj][m][1][3] *= RT_(c.w, a.w, 1);
#undef RT_
                }
            __builtin_amdgcn_sched_barrier(0); }
    }
    __device__ __forceinline__ void operator()(const f32x4 (&acc)[2][2][4][2], const Unit& u, int wr, int wc, int fr, int fq) const {
        const unsigned lo_ = (unsigned)((wr * 64 + fr) * 2048 + wc * 32 + 8 * fq); const size_t ub = (size_t)(u.pm * BM) * 2048 + (size_t)u.pn * BM; const float fe = (u.pm >> 5) ? fend1 : fend0;
        u32x4 g[2][4][2];
#pragma unroll
        for (int ai = 0; ai < 2; ++ai)
#pragma unroll
            for (int m = 0; m < 4; ++m)
#pragma unroll
                for (int bj = 0; bj < 2; ++bj) g[ai][m][bj] = *(const u32x4*)((const char*)(GA + ub + (size_t)(ai * HALF + m * 16) * 2048 + bj * HALF) + lo_ * 2u);
        __builtin_amdgcn_sched_barrier(0);
#pragma unroll
        for (int ai = 0; ai < 2; ++ai)
#pragma unroll
            for (int m = 0; m < 4; ++m)
#pragma unroll
                for (int bj = 0; bj < 2; ++bj) { const u32x4 gg = g[ai][m][bj]; f32x4 v0 = acc[ai][bj][m][0], v1 = acc[ai][bj][m][1];
                    v0[0] *= fmaxf(blo(gg.x), 1e-30f) * fe; v0[1] *= fmaxf(bhi(gg.x), 1e-30f) * fe; v0[2] *= fmaxf(blo(gg.y), 1e-30f) * fe; v0[3] *= fmaxf(bhi(gg.y), 1e-30f) * fe;
                    v1[0] *= fmaxf(blo(gg.z), 1e-30f) * fe; v1[1] *= fmaxf(bhi(gg.z), 1e-30f) * fe; v1[2] *= fmaxf(blo(gg.w), 1e-30f) * fe; v1[3] *= fmaxf(bhi(gg.w), 1e-30f) * fe;
                    int lo = __builtin_amdgcn_cvt_pk_fp8_f32(v0[0], v0[1], 0, false); lo = __builtin_amdgcn_cvt_pk_fp8_f32(v0[2], v0[3], lo, true);
                    int hi = __builtin_amdgcn_cvt_pk_fp8_f32(v1[0], v1[1], 0, false); hi = __builtin_amdgcn_cvt_pk_fp8_f32(v1[2], v1[3], hi, true);
                    typedef unsigned u32x2s __attribute__((ext_vector_type(2))); *(u32x2s*)(O + ub + (size_t)(ai * HALF + m * 16) * 2048 + bj * HALF + lo_) = (u32x2s){(unsigned)lo, (unsigned)hi}; }
    }
};
template <bool XB_BF16>
struct EpiResid {
    static constexpr bool PERM = true, AFTER_DRAIN = false, HAS_MID = false;
    const void* XB; bf16_t* XO; const float* gvec; float fo0, fo1;
    __device__ __forceinline__ void operator()(const f32x4 (&acc)[2][2][4][2], const Unit& u, int wr, int wc, int fr, int fq) const {
        const int row0 = u.pm * BM + wr * 64 + fr, c0 = u.pn * BM + wc * 32 + 8 * fq; const float* gp = gvec + (size_t)(u.pm >> 5) * 12288;
        const float fo = (u.pm >> 5) ? fo1 : fo0;
        const unsigned lo_ = (unsigned)((wr * 64 + fr) * 2048 + wc * 32 + 8 * fq);
        const size_t ub = (size_t)(u.pm * BM) * 2048 + (size_t)u.pn * BM;
        if constexpr (XB_BF16) {
#pragma unroll
            for (int bj = 0; bj < 2; ++bj) { const int col = c0 + bj * HALF; const f32x4 g0 = *(const f32x4*)(gp + col) * fo, g1 = *(const f32x4*)(gp + col + 4) * fo;
                u32x4 xq[2][4];
#pragma unroll
                for (int ai = 0; ai < 2; ++ai)
#pragma unroll
                    for (int m = 0; m < 4; ++m) xq[ai][m] = *(const u32x4*)((const char*)((const bf16_t*)XB + ub + (size_t)(ai * HALF + m * 16) * 2048 + bj * HALF) + lo_ * 2u);
                __builtin_amdgcn_sched_barrier(0);
#pragma unroll
                for (int ai = 0; ai < 2; ++ai)
#pragma unroll
                    for (int m = 0; m < 4; ++m) { const u32x4 q = xq[ai][m];
                        const f32x4 xa = {blo(q.x), bhi(q.x), blo(q.y), bhi(q.y)}, xb = {blo(q.z), bhi(q.z), blo(q.w), bhi(q.w)};
                        *(u32x4*)((char*)(XO + ub + (size_t)(ai * HALF + m * 16) * 2048 + bj * HALF) + lo_ * 2u) = pack8(xa + g0 * acc[ai][bj][m][0], xb + g1 * acc[ai][bj][m][1]); }
                __builtin_amdgcn_sched_barrier(0); }
        } else {
#pragma unroll
            for (int bj = 0; bj < 2; ++bj) { const int col = c0 + bj * HALF; const f32x4 g0 = *(const f32x4*)(gp + col) * fo, g1 = *(const f32x4*)(gp + col + 4) * fo;
#pragma unroll
              for (int ai = 0; ai < 2; ++ai) { f32x4 xa[4], xb[4];
#pragma unroll
                for (int m = 0; m < 4; ++m) { const char* pp = (const char*)((const float*)XB + ub + (size_t)(ai * HALF + m * 16) * 2048 + bj * HALF) + lo_ * 4u; xa[m] = *(const f32x4*)pp; xb[m] = *(const f32x4*)(pp + 16); }
                __builtin_amdgcn_sched_barrier(0);
#pragma unroll
                for (int m = 0; m < 4; ++m)
                    *(u32x4*)((char*)(XO + ub + (size_t)(ai * HALF + m * 16) * 2048 + bj * HALF) + lo_ * 2u) = pack8(xa[m] + g0 * acc[ai][bj][m][0], xb[m] + g1 * acc[ai][bj][m][1]);
                __builtin_amdgcn_sched_barrier(0); } } }
    }
};
typedef _Float16 f16x8 __attribute__((ext_vector_type(8)));
struct EpiF16 {
    static constexpr bool PERM = true, AFTER_DRAIN = false, HAS_MID = false;
    _Float16* O; int ldc;
    __device__ __forceinline__ void operator()(const f32x4 (&acc)[2][2][4][2], const Unit& u, int wr, int wc, int fr, int fq) const {
        const int row0 = u.pm * BM + wr * 64 + fr, c0 = u.pn * BM + wc * 32 + 8 * fq;
#pragma unroll
        for (int ai = 0; ai < 2; ++ai)
#pragma unroll
            for (int m = 0; m < 4; ++m)
#pragma unroll
                for (int bj = 0; bj < 2; ++bj) { const f32x4 v0 = acc[ai][bj][m][0], v1 = acc[ai][bj][m][1];
                    const f16x8 h = {(_Float16)v0[0], (_Float16)v0[1], (_Float16)v0[2], (_Float16)v0[3], (_Float16)v1[0], (_Float16)v1[1], (_Float16)v1[2], (_Float16)v1[3]};
                    *(f16x8*)(O + (size_t)(row0 + ai * HALF + m * 16) * ldc + c0 + bj * HALF) = h; }
    }
};
}

#define XB_TMO      128
#define XB_XCNT(j)  (256  + 64 * (j))
#define XB_XSUB(j)  (1280 + 64 * (j))
#define XB_XGEN(j)  (2304 + 64 * (j))
#define XB_TOP      3328
#define XB_TOPGEN   3392
#define XCD_BAR_WORDS 3456
#define XB_SPIN_CAP (1u << 18)

__device__ __forceinline__ unsigned xb_ld(unsigned* p)              { return __hip_atomic_load(p, __ATOMIC_RELAXED, __HIP_MEMORY_SCOPE_AGENT); }
__device__ __forceinline__ unsigned xb_add(unsigned* p, unsigned v) { return __hip_atomic_fetch_add(p, v, __ATOMIC_RELAXED, __HIP_MEMORY_SCOPE_AGENT); }
__device__ __forceinline__ unsigned xb_xcc_id() { return (unsigned)__builtin_amdgcn_s_getreg((3 << 11) | 20) & 0xFu; }
#define XB_SPIN(cond, bar) do { unsigned _sp = 0; while (cond) { __builtin_amdgcn_s_sleep(1); \
    if ((++_sp & 255u) == 0u) { if (xb_ld(&(bar)[XB_TMO])) break; if (_sp > XB_SPIN_CAP) { atomicAdd(&(bar)[XB_TMO], 1u); break; } } } } while (0)

struct XcdBarrier {
    unsigned* bar; unsigned x;
    volatile LAS unsigned* st;
};

__device__ __forceinline__ XcdBarrier xcd_barrier_post(unsigned* bar, volatile LAS unsigned* st) {
    XcdBarrier b; b.bar = bar; b.x = xb_xcc_id(); b.st = st;
    if (threadIdx.x == 0) (void)xb_add(&bar[XB_XCNT(b.x)], 1u);
    return b;
}
__device__ __forceinline__ void xcd_barrier_complete(unsigned* bar, unsigned x, unsigned& nloc, unsigned& nx) {
    const unsigned G = gridDim.x * gridDim.y * gridDim.z;
    unsigned sum, cnt, mine, sp = 0u;
    for (;;) {
        sum = 0u; cnt = 0u; mine = 0u;
#pragma unroll
        for (unsigned j = 0; j < 16; ++j) { const unsigned c = xb_ld(&bar[XB_XCNT(j)]); sum += c; cnt += (c > 0u) ? 1u : 0u; mine = (j == x) ? c : mine; }
        if (sum == G) break;
        __builtin_amdgcn_s_sleep(1);
        if ((++sp & 255u) == 0u) { if (xb_ld(&bar[XB_TMO])) break; if (sp > XB_SPIN_CAP) { atomicAdd(&bar[XB_TMO], 1u); break; } }
    }
    nloc = mine > 0u ? mine : 1u; nx = cnt > 0u ? cnt : 1u;
}

__device__ __forceinline__ void xcd_barrier(const XcdBarrier& b) {
    asm volatile("s_waitcnt vmcnt(0)" ::: "memory");
    __syncthreads();
    if (threadIdx.x == 0) {
        unsigned* bar = b.bar;
        __builtin_amdgcn_s_waitcnt(0);
        unsigned nloc = b.st[0], nx = b.st[1];
        if (nloc == 0u) { xcd_barrier_complete(bar, b.x, nloc, nx); b.st[0] = nloc; b.st[1] = nx; }
        const unsigned old = xb_add(&bar[XB_XSUB(b.x)], 1u);
        const unsigned gen = old / nloc;
        if (old + 1u == (gen + 1u) * nloc) {
            __builtin_amdgcn_fence(__ATOMIC_RELEASE, "agent");
            asm volatile("s_waitcnt vmcnt(0)" ::: "memory");
            const unsigned og = xb_add(&bar[XB_TOP], 1u);
            const unsigned tg = og / nx;
            if (og + 1u == (tg + 1u) * nx) xb_add(&bar[XB_TOPGEN], 1u);
            else XB_SPIN(xb_ld(&bar[XB_TOPGEN]) == tg, bar);
            __builtin_amdgcn_fence(__ATOMIC_ACQUIRE, "agent");
            xb_add(&bar[XB_XGEN(b.x)], 1u);
            asm volatile("s_waitcnt vmcnt(0)" ::: "memory");
        } else {
            XB_SPIN(xb_ld(&bar[XB_XGEN(b.x)]) == gen, bar);
            __builtin_amdgcn_fence(__ATOMIC_ACQUIRE, "agent");
            asm volatile("s_waitcnt vmcnt(0)" ::: "memory");
        }
    }
    __syncthreads();
}

struct Args { const float* in[N_IN]; float* out; unsigned char* ws; int ph_lo, ph_hi; };
struct Frame {
    LAS unsigned char* lds; volatile LAS unsigned* MISC; gu32* ctl;
    int tid, lane, wave, vcu, G;
    const Args* A; float* out; unsigned char* ws;
};
#define WSP(T_, off) ((T_*)(F.ws + (off)))
#define PHASE_TID(F) do { int t_ = threadIdx.x; asm volatile("" : "+v"(t_)); (F).tid = t_; (F).lane = t_ & 63; (F).wave = __builtin_amdgcn_readfirstlane(t_ >> 6); } while (0)

__device__ __forceinline__ int glu_row(int n) { return n < 2048 ? (((n & 1023) >> 7) * 256 + (n >> 10) * 128 + (n & 127)) : n; }
template <int MODE>
__device__ __forceinline__ void tr_item(const float* W, int N, bf16* WT, int dstride, int koff, LAS float* scr, int kb, int nb, int lane) {
    const int k0 = 64 * kb, n0 = 32 * nb;
    f32x4 v[8];
#pragma unroll
    for (int i = 0; i < 8; ++i) v[i] = *(const f32x4*)(W + (size_t)(k0 + (lane >> 3) + 8 * i) * N + n0 + (lane & 7) * 4);
#pragma unroll
    for (int i = 0; i < 8; ++i) { LAS float* d = scr + ((lane >> 3) + 8 * i) * 33 + (lane & 7) * 4; d[0] = v[i].x; d[1] = v[i].y; d[2] = v[i].z; d[3] = v[i].w; }
    LDS_WAIT(); asm volatile("" ::: "memory");
    const int c = lane & 7;
#pragma unroll
    for (int j = 0; j < 4; ++j) { const int n = (lane >> 3) + 8 * j; const LAS float* s = scr + (8 * c) * 33 + n;
        v4u o; o.x = pk2(s[0 * 33], s[1 * 33]); o.y = pk2(s[2 * 33], s[3 * 33]); o.z = pk2(s[4 * 33], s[5 * 33]); o.w = pk2(s[6 * 33], s[7 * 33]);
        const int nn = n0 + n, row = MODE == 1 ? glu_row(nn) : nn;
        *(v4u*)(WT + (size_t)row * dstride + koff + k0 + 8 * c) = o; }
    LDS_WAIT(); asm volatile("" ::: "memory");
}
__device__ __forceinline__ void wmax_item(Frame& F, int it) {
    const int l = it >> 5, kc = it & 31; const float* W = F.A->in[I_WIN] + ((size_t)l * 2048 + kc * 64) * IN_DIM; float mx = 0.f;
#pragma unroll 4
    for (int k = 0; k < 64; ++k)
#pragma unroll
        for (int j = 0; j < 4; ++j) { const int c4r = F.tid + NTHR * j, c4 = c4r < IN_DIM / 4 ? c4r : IN_DIM / 4 - 1;
            const f32x4 v = *(const f32x4*)(W + (size_t)k * IN_DIM + 4 * c4); mx = fmaxf(mx, fmaxf(fmaxf(fabsf(v.x), fabsf(v.y)), fmaxf(fabsf(v.z), fabsf(v.w)))); }
#pragma unroll
    for (int o = 1; o < 64; o <<= 1) mx = fmaxf(mx, __shfl_xor(mx, o));
    if (F.lane == 0) __hip_atomic_fetch_max(F.ctl + CW_WMAX + l, __float_as_uint(mx), __ATOMIC_RELAXED, __HIP_MEMORY_SCOPE_AGENT);
}
__device__ __forceinline__ void wmax2_item(Frame& F, int it) {
    const int lh = it >> 3, kc = it & 7, l = lh >> 1, h = lh & 1; const float* W = F.A->in[h ? I_WAO : I_WCO] + ((size_t)l * 1024 + kc * 128) * 2048 + 4 * F.tid; float mx = 0.f;
#pragma unroll 8
    for (int k = 0; k < 128; ++k) { const f32x4 v = *(const f32x4*)(W + (size_t)k * 2048); mx = fmaxf(mx, fmaxf(fmaxf(fabsf(v.x), fabsf(v.y)), fmaxf(fabsf(v.z), fabsf(v.w)))); }
#pragma unroll
    for (int o = 1; o < 64; o <<= 1) mx = fmaxf(mx, __shfl_xor(mx, o));
    if (F.lane == 0) __hip_atomic_fetch_max(F.ctl + CW_WMAX2 + lh, __float_as_uint(mx), __ATOMIC_RELAXED, __HIP_MEMORY_SCOPE_AGENT);
}
__device__ __forceinline__ void wmax3_item(Frame& F, int it) {
    const int l = it >> 4, kc = it & 15; const float* W = F.A->in[I_WOUT] + ((size_t)l * 2048 + kc * 128) * 2048 + 4 * F.tid; float mx = 0.f;
#pragma unroll 8
    for (int k = 0; k < 128; ++k) { const f32x4 v = *(const f32x4*)(W + (size_t)k * 2048); mx = fmaxf(mx, fmaxf(fmaxf(fabsf(v.x), fabsf(v.y)), fmaxf(fabsf(v.z), fabsf(v.w)))); }
#pragma unroll
    for (int o = 1; o < 64; o <<= 1) mx = fmaxf(mx, __shfl_xor(mx, o));
    if (F.lane == 0) __hip_atomic_fetch_max(F.ctl + CW_WMAX3 + l, __float_as_uint(mx), __ATOMIC_RELAXED, __HIP_MEMORY_SCOPE_AGENT);
}
template <bool GLU>
__device__ __forceinline__ void tr8_item(const float* W, int N, unsigned char* WT, int koff, float inv, LAS float* scr, int kb, int nb, int lane) {
    const int k0 = 64 * kb, n0 = 32 * nb;
    f32x4 v[8];
#pragma unroll
    for (int i = 0; i < 8; ++i) v[i] = *(const f32x4*)(W + (size_t)(k0 + (lane >> 3) + 8 * i) * N + n0 + (lane & 7) * 4);
#pragma unroll
    for (int i = 0; i < 8; ++i) { LAS float* d = scr + ((lane >> 3) + 8 * i) * 33 + (lane & 7) * 4; d[0] = v[i].x * inv; d[1] = v[i].y * inv; d[2] = v[i].z * inv; d[3] = v[i].w * inv; }
    LDS_WAIT(); asm volatile("" ::: "memory");
    const int c = lane & 7;
#pragma unroll
    for (int j = 0; j < 4; ++j) { const int n = (lane >> 3) + 8 * j; const LAS float* s = scr + (8 * c) * 33 + n;
        int lo = __builtin_amdgcn_cvt_pk_fp8_f32(s[0 * 33], s[1 * 33], 0, false); lo = __builtin_amdgcn_cvt_pk_fp8_f32(s[2 * 33], s[3 * 33], lo, true);
        int hi = __builtin_amdgcn_cvt_pk_fp8_f32(s[4 * 33], s[5 * 33], 0, false); hi = __builtin_amdgcn_cvt_pk_fp8_f32(s[6 * 33], s[7 * 33], hi, true);
        v2u o; o.x = (unsigned)lo; o.y = (unsigned)hi;
        *(v2u*)(WT + (size_t)(GLU ? glu_row(n0 + n) : n0 + n) * 2048 + koff + k0 + 8 * c) = o; }
    LDS_WAIT(); asm volatile("" ::: "memory");
}
__device__ __forceinline__ void win8_phase(Frame& F) {
    PHASE_TID(F);
    LAS float* scr = (LAS float*)(F.lds + F.wave * 16384);
    if (F.tid == 0) F.MISC[0] = __hip_atomic_fetch_add(F.ctl + CW_QUEUE2, 1u, __ATOMIC_RELAXED, __HIP_MEMORY_SCOPE_AGENT);
    for (int par = 0;; par ^= 1) {
        __syncthreads();
        const int it = (int)F.MISC[par];
        if (F.tid == 0) F.MISC[par ^ 1] = __hip_atomic_fetch_add(F.ctl + CW_QUEUE2, 1u, __ATOMIC_RELAXED, __HIP_MEMORY_SCOPE_AGENT);
        if (it >= 2 * 960 + 4 * 128 + 2 * 256) break;
        if (it < 2 * 960) { const int l = it >= 960, r = it - l * 960, wi = r * 8 + F.wave;
            const float wmax = __uint_as_float(__hip_atomic_load(F.ctl + CW_WMAX + l, __ATOMIC_RELAXED, __HIP_MEMORY_SCOPE_AGENT)), inv = wmax > 0.f ? 440.0f / wmax : 1.0f;
            tr8_item<true>(F.A->in[I_WIN] + (size_t)l * 2048 * IN_DIM, IN_DIM, WSP(unsigned char, WS_WIN) + (size_t)l * IN_DIM * 2048, 0, inv, scr, wi / 240, wi % 240, F.lane); }
        else if (it >= 2 * 960 + 4 * 128) { const int r0 = it - 2 * 960 - 4 * 128, l = r0 >> 8, wi = (r0 & 255) * 8 + F.wave;
            const float wmax = __uint_as_float(__hip_atomic_load(F.ctl + CW_WMAX3 + l, __ATOMIC_RELAXED, __HIP_MEMORY_SCOPE_AGENT)), inv = wmax > 0.f ? 440.0f / wmax : 1.0f;
            tr8_item<false>(F.A->in[I_WOUT] + (size_t)l * 2048 * 2048, 2048, WSP(unsigned char, WS_WO) + (size_t)l * 2048 * 2048, 0, inv, scr, wi / 64, wi % 64, F.lane); }
        else { const int r0 = it - 2 * 960, lh = r0 >> 7, l = lh >> 1, h = lh & 1, wi = (r0 & 127) * 8 + F.wave;
            const float wmax = __uint_as_float(__hip_atomic_load(F.ctl + CW_WMAX2 + lh, __ATOMIC_RELAXED, __HIP_MEMORY_SCOPE_AGENT)), inv = wmax > 0.f ? 440.0f / wmax : 1.0f;
            tr8_item<false>(F.A->in[h ? I_WAO : I_WCO] + (size_t)l * 1024 * 2048, 2048, WSP(unsigned char, WS_WM) + (size_t)l * 2048 * 2048, h * 1024, inv, scr, wi / 64, wi % 64, F.lane); }
    }
}
__device__ __forceinline__ void ada_item(Frame& F, int a) {
    LAS float* csl = (LAS float*)F.lds;
    LAS f32x4* red = (LAS f32x4*)(F.lds + 16384);
    const float* c = F.A->in[I_C];
    { float cv[8];
#pragma unroll
      for (int i = 0; i < 8; ++i) cv[i] = c[i * NTHR + F.tid];
      __builtin_amdgcn_sched_barrier(0);
#pragma unroll
      for (int i = 0; i < 8; ++i) csl[i * NTHR + F.tid] = cv[i] / (1.0f + __expf(-cv[i])); }
    __syncthreads();
    const int l = a / 48, j0 = (a % 48) * 256 + 4 * F.lane;
    const float* wp = F.A->in[I_ADAW] + ((size_t)l * 2048 + F.wave * 256) * 12288 + j0;
    f32x4 a0 = {0.f, 0.f, 0.f, 0.f}, a1 = {0.f, 0.f, 0.f, 0.f};
#define ADA_LD(dst_, k0_) do { _Pragma("unroll") for (int i_ = 0; i_ < 8; ++i_) dst_[i_] = *(const f32x4*)(wp + (size_t)((k0_) + i_) * 12288); } while (0)
#define ADA_USE(src_, k0_) do { _Pragma("unroll") for (int i_ = 0; i_ < 8; ++i_) { const float c0 = csl[F.wave * 256 + (k0_) + i_], c1 = csl[2048 + F.wave * 256 + (k0_) + i_]; a0 += src_[i_] * c0; a1 += src_[i_] * c1; } } while (0)
    f32x4 wA[8], wB[8];
    ADA_LD(wA, 0);
#pragma unroll 1
    for (int kb = 0; kb < 256; kb += 16) {
        ADA_LD(wB, kb + 8); __builtin_amdgcn_sched_barrier(0); ADA_USE(wA, kb); __builtin_amdgcn_sched_barrier(0);
        if (kb + 16 < 256) ADA_LD(wA, kb + 16);
        __builtin_amdgcn_sched_barrier(0); ADA_USE(wB, kb + 8); __builtin_amdgcn_sched_barrier(0);
    }
#undef ADA_LD
#undef ADA_USE
    red[(F.wave * 2 + 0) * 64 + F.lane] = a0; red[(F.wave * 2 + 1) * 64 + F.lane] = a1;
    __syncthreads();
    if (F.wave < 2) { const int b = F.wave; f32x4 s = *(const f32x4*)(F.A->in[I_ADAB] + l * 12288 + j0);
#pragma unroll
        for (int w = 0; w < 8; ++w) s += red[(w * 2 + b) * 64 + F.lane];
        *(f32x4*)(WSP(float, WS_MOD) + (size_t)(l * 2 + b) * 12288 + j0) = s; }
    __syncthreads();
}
__device__ __forceinline__ void fold_item(Frame& F, int it) {
    const int l = it >> 7, hp = (it >> 3) & 15, kb = it & 7, lane = F.lane, fr = lane & 15, fq = lane >> 4;
    constexpr int SKS = 136;
    LAS bf16* skh = (LAS bf16*)F.lds; LAS bf16* skl = skh + 128 * SKS;
    const float* wbase = F.A->in[I_WPQ] + ((size_t)l * 2048 + kb * 256 + F.wave * 32 + fr) * 2048 + hp * 128 + 8 * fq;
    f32x4 wv[2][4][2];
#pragma unroll
    for (int kt = 0; kt < 2; ++kt)
#pragma unroll
        for (int s2 = 0; s2 < 4; ++s2) { wv[kt][s2][0] = *(const f32x4*)(wbase + (size_t)kt * 16 * 2048 + 32 * s2); wv[kt][s2][1] = *(const f32x4*)(wbase + (size_t)kt * 16 * 2048 + 32 * s2 + 4); }
    { const f32x4* sk = (const f32x4*)(F.A->in[I_SK] + (size_t)(l * 16 + hp) * 128 * 128);
      f32x4 v[8];
#pragma unroll
      for (int i = 0; i < 8; ++i) v[i] = sk[i * NTHR + F.tid];
#pragma unroll
      for (int i = 0; i < 8; ++i) { const int f = i * NTHR + F.tid, n = f >> 5, d = (f & 31) * 4;
          const unsigned h0 = pk2(v[i].x, v[i].y), h1 = pk2(v[i].z, v[i].w);
          const unsigned l0 = pk2(v[i].x - bflo(h0), v[i].y - bfhi(h0)), l1 = pk2(v[i].z - bflo(h1), v[i].w - bfhi(h1));
          v2u ho; ho.x = h0; ho.y = h1; v2u lo; lo.x = l0; lo.y = l1;
          *(LAS v2u*)(skh + n * SKS + d) = ho; *(LAS v2u*)(skl + n * SKS + d) = lo; } }
    __syncthreads();
    bf16x8 wh[2][4], wl[2][4];
#pragma unroll
    for (int kt = 0; kt < 2; ++kt)
#pragma unroll
        for (int s2 = 0; s2 < 4; ++s2) { const f32x4 a = wv[kt][s2][0], b = wv[kt][s2][1];
            v4u h, lo; h.x = pk2(a.x, a.y); h.y = pk2(a.z, a.w); h.z = pk2(b.x, b.y); h.w = pk2(b.z, b.w);
            lo.x = pk2(a.x - bflo(h.x), a.y - bfhi(h.x)); lo.y = pk2(a.z - bflo(h.y), a.w - bfhi(h.y)); lo.z = pk2(b.x - bflo(h.z), b.y - bfhi(h.z)); lo.w = pk2(b.z - bflo(h.w), b.w - bfhi(h.w));
            wh[kt][s2] = __builtin_bit_cast(bf16x8, h); wl[kt][s2] = __builtin_bit_cast(bf16x8, lo); }
    bf16* dst = WSP(bf16, WS_WP) + (size_t)l * 2048 * 2048 + (size_t)(hp * 128 + fr) * 2048 + kb * 256 + F.wave * 32 + 4 * fq;
#pragma unroll 2
    for (int nt = 0; nt < 8; ++nt) { f32x4 acc[2] = {{0.f, 0.f, 0.f, 0.f}, {0.f, 0.f, 0.f, 0.f}};
#pragma unroll
        for (int s2 = 0; s2 < 4; ++s2) { const bf16x8 sh = *(const LAS bf16x8*)(skh + (nt * 16 + fr) * SKS + 32 * s2 + 8 * fq), sl = *(const LAS bf16x8*)(skl + (nt * 16 + fr) * SKS + 32 * s2 + 8 * fq);
#pragma unroll
            for (int kt = 0; kt < 2; ++kt) { acc[kt] = __builtin_amdgcn_mfma_f32_16x16x32_bf16(wh[kt][s2], sh, acc[kt], 0, 0, 0); acc[kt] = __builtin_amdgcn_mfma_f32_16x16x32_bf16(wl[kt][s2], sh, acc[kt], 0, 0, 0);
                acc[kt] = __builtin_amdgcn_mfma_f32_16x16x32_bf16(wh[kt][s2], sl, acc[kt], 0, 0, 0); } }
#pragma unroll
        for (int kt = 0; kt < 2; ++kt) { v2u o; o.x = pk2(acc[kt].x, acc[kt].y); o.y = pk2(acc[kt].z, acc[kt].w); *(v2u*)(dst + (size_t)nt * 16 * 2048 + kt * 16) = o; } }
    __syncthreads();
}
__device__ __forceinline__ void cvt_item(Frame& F, int it) {
    const int which = it >> 10, chunk = it & 1023;
    const float* src = F.A->in[which ? I_PV : I_PU]; unsigned char* dst = WSP(unsigned char, which ? WS_PV : WS_PU); float* scl = WSP(float, WS_SCL) + which * 2 * NEXP;
    constexpr int VROW = 2048 + 8;
    LAS unsigned char* vt = F.lds;
    for (int i = 0; i < 4; i += 2) {
        f32x4 a[2][4], b[2][4]; float mx[2] = {0.f, 0.f};
#pragma unroll
        for (int r = 0; r < 2; ++r) { const int row = chunk * 32 + F.wave * 4 + i + r;
#pragma unroll
            for (int m = 0; m < 4; ++m) { const int col = 512 * m + 8 * F.lane; a[r][m] = *(const f32x4*)(src + (size_t)row * D + col); b[r][m] = *(const f32x4*)(src + (size_t)row * D + col + 4); } }
#pragma unroll
        for (int r = 0; r < 2; ++r) {
#pragma unroll
            for (int m = 0; m < 4; ++m) { mx[r] = fmaxf(mx[r], fmaxf(fmaxf(fabsf(a[r][m].x), fabsf(a[r][m].y)), fmaxf(fabsf(a[r][m].z), fabsf(a[r][m].w)))); mx[r] = fmaxf(mx[r], fmaxf(fmaxf(fabsf(b[r][m].x), fabsf(b[r][m].y)), fmaxf(fabsf(b[r][m].z), fabsf(b[r][m].w)))); } }
#pragma unroll
        for (int o = 1; o < 64; o <<= 1) { mx[0] = fmaxf(mx[0], __shfl_xor(mx[0], o)); mx[1] = fmaxf(mx[1], __shfl_xor(mx[1], o)); }
#pragma unroll
        for (int r = 0; r < 2; ++r) { const int row = chunk * 32 + F.wave * 4 + i + r, l = row >> 14, e = row & (NEXP - 1);
            const float sc = mx[r] > 0.f ? mx[r] * (1.0f / 440.0f) : 1.0f, inv = 1.0f / sc;
            if (F.lane == 0) scl[l * NEXP + e] = sc;
#pragma unroll
            for (int m = 0; m < 4; ++m) { const int col = 512 * m + 8 * F.lane;
                int lo = __builtin_amdgcn_cvt_pk_fp8_f32(a[r][m].x * inv, a[r][m].y * inv, 0, false); lo = __builtin_amdgcn_cvt_pk_fp8_f32(a[r][m].z * inv, a[r][m].w * inv, lo, true);
                int hi = __builtin_amdgcn_cvt_pk_fp8_f32(b[r][m].x * inv, b[r][m].y * inv, 0, false); hi = __builtin_amdgcn_cvt_pk_fp8_f32(b[r][m].z * inv, b[r][m].w * inv, hi, true);
                v2u o; o.x = (unsigned)lo; o.y = (unsigned)hi;
                if (which) *(LAS v2u*)(vt + (F.wave * 4 + i + r) * VROW + col) = o;
                else *(v2u*)(dst + ((size_t)(l * NSL + (col >> 7)) * NEXP + e) * SLW + (col & 127)) = o; } }
    }
    if (which) {
        __syncthreads();
        const int row0 = chunk * 32, l = row0 >> 14, e0 = row0 & (NEXP - 1);
#pragma unroll 4
        for (int i = 0; i < 16; ++i) { const int idx = i * NTHR + F.tid, j = idx >> 5, r = idx & 31;
            *(v2u*)(dst + ((size_t)(l * 256 + j) * NEXP + e0 + r) * 8) = *(const LAS v2u*)(vt + r * VROW + 8 * j); }
        __syncthreads();
    }
}
__device__ __forceinline__ void bias_item(Frame& F) {
    for (int i = F.tid; i < 2048; i += NTHR) { const int h = i >> 7, d = i & 127; int bk;
        if (d < 16) bk = d; else { bk = 16 + (int)(logf((float)d / 16.0f) / logf(8.0f) * 16.0f); bk = bk > 31 ? 31 : bk; }
        WSP(float, WS_BIAS)[i] = F.A->in[I_RELB][bk * 16 + h]; }
}
constexpr int IT_FOLD = 256, IT_ADA = 96, IT_WMAX = 64 + 32 + 32, IT_CVT = 2048;
constexpr int IT0_ADA = 0, IT0_BIAS = IT0_ADA + IT_ADA, IT0_WMAX = IT0_BIAS + 1, IT0_CVT = IT0_WMAX + IT_WMAX, N_OTHER = IT0_CVT + IT_CVT, N_ITEMS = N_OTHER + IT_FOLD, FOLD_EVERY = 9;
static_assert((IT_FOLD - 1) * FOLD_EVERY < N_ITEMS, "fold tickets inside the item range");
__device__ __forceinline__ void p0_prologue(Frame& F) {
    PHASE_TID(F);
    if (F.tid == 0) F.MISC[0] = __hip_atomic_fetch_add(F.ctl + CW_QUEUE, 1u, __ATOMIC_RELAXED, __HIP_MEMORY_SCOPE_AGENT);
    for (int par = 0;; par ^= 1) {
        __syncthreads();
        const int it = (int)F.MISC[par];
        if (F.tid == 0) F.MISC[par ^ 1] = __hip_atomic_fetch_add(F.ctl + CW_QUEUE, 1u, __ATOMIC_RELAXED, __HIP_MEMORY_SCOPE_AGENT);
        if (it >= N_ITEMS) break;
        const int fq = it / FOLD_EVERY; const bool is_fold = (it % FOLD_EVERY == 0) && fq < IT_FOLD;
        const int ot = it - (fq + 1 < IT_FOLD ? fq + 1 : IT_FOLD);
        if (is_fold) fold_item(F, fq);
        else if (ot < IT0_BIAS) ada_item(F, ot - IT0_ADA);
        else if (ot < IT0_WMAX) bias_item(F);
        else if (ot < IT0_WMAX + 64) wmax_item(F, ot - IT0_WMAX);
        else if (ot < IT0_WMAX + 96) wmax2_item(F, ot - IT0_WMAX - 64);
        else if (ot < IT0_CVT) wmax3_item(F, ot - IT0_WMAX - 96);
        else cvt_item(F, ot - IT0_CVT);
    }
}

__device__ __forceinline__ void row_to_fp8(const f32x4 (&y)[8], unsigned char* hrow, float* sarow, int lane) {
    float mx = 0.f;
#pragma unroll
    for (int j = 0; j < 8; ++j) mx = fmaxf(mx, fmaxf(fmaxf(fabsf(y[j].x), fabsf(y[j].y)), fmaxf(fabsf(y[j].z), fabsf(y[j].w))));
#pragma unroll
    for (int o = 1; o < 64; o <<= 1) mx = fmaxf(mx, __shfl_xor(mx, o));
    const float sc = mx > 0.f ? mx * (1.0f / 440.0f) : 1.0f, inv = 1.0f / sc;
    if (lane == 0) *sarow = sc;
#pragma unroll
    for (int j = 0; j < 8; ++j) { int w = __builtin_amdgcn_cvt_pk_fp8_f32(y[j].x * inv, y[j].y * inv, 0, false); w = __builtin_amdgcn_cvt_pk_fp8_f32(y[j].z * inv, y[j].w * inv, w, true); ((unsigned*)hrow)[lane + 64 * j] = (unsigned)w; }
}
template <bool TO_FP8, bool IN_BF16>
__device__ __forceinline__ void norm_phase(Frame& F, const void* X, bf16* Hd, const float* g, const float* modl, int ish, int isc) {
    PHASE_TID(F);
    const int gw = F.vcu * NWAVES + F.wave, NGW = F.G * NWAVES;
    int curb = -1; f32x4 gs[8], sh[8];
    for (int m = gw; m < T; m += NGW) {
        const int b = m >> 13;
        if (b != curb) { curb = b;
#pragma unroll
            for (int j = 0; j < 8; ++j) { const int col = 4 * F.lane + 256 * j; const f32x4 g4 = *(const f32x4*)(g + col), sc4 = *(const f32x4*)(modl + (size_t)b * 12288 + isc * 2048 + col);
                sh[j] = *(const f32x4*)(modl + (size_t)b * 12288 + ish * 2048 + col); gs[j] = g4 * (sc4 + 1.0f); } }
        f32x4 v[8]; float ss = 0.f;
        if constexpr (IN_BF16) { const v2u* xr = (const v2u*)((const bf16*)X + (size_t)m * D) + F.lane; v2u q[8];
#pragma unroll
            for (int j = 0; j < 8; ++j) q[j] = xr[64 * j];
            __builtin_amdgcn_sched_barrier(0);
#pragma unroll
            for (int j = 0; j < 8; ++j) v[j] = (f32x4){bflo(q[j].x), bfhi(q[j].x), bflo(q[j].y), bfhi(q[j].y)};
        } else { const f32x4* xr = (const f32x4*)((const float*)X + (size_t)m * D) + F.lane;
#pragma unroll
            for (int j = 0; j < 8; ++j) v[j] = xr[64 * j];
            __builtin_amdgcn_sched_barrier(0); }
#pragma unroll
        for (int j = 0; j < 8; ++j) ss += (v[j].x * v[j].x + v[j].y * v[j].y) + (v[j].z * v[j].z + v[j].w * v[j].w);
        const float rstd = 1.0f / sqrtf(wave_sum(ss) * (1.0f / D) + EPS);
        if constexpr (TO_FP8) { f32x4 y[8];
#pragma unroll
            for (int j = 0; j < 8; ++j) y[j] = v[j] * rstd * gs[j] + sh[j];
            row_to_fp8(y, (unsigned char*)Hd + (size_t)m * D, WSP(float, WS_SA) + m, F.lane);
        } else {
        v2u* o = (v2u*)(Hd + (size_t)m * D) + F.lane;
#pragma unroll
        for (int j = 0; j < 8; ++j) { const f32x4 y = v[j] * rstd * gs[j] + sh[j]; v2u w; w.x = pk2(y.x, y.y); w.y = pk2(y.z, y.w); o[64 * j] = w; }
        }
    }
}

__device__ __forceinline__ void conv_phase(Frame& F, int l) {
    PHASE_TID(F);
    const float* dw = F.A->in[I_DWW] + (size_t)l * CWID * CONV; const int c0 = 2 * F.tid;
    f32x2 wv[CWID];
#pragma unroll
    for (int j = 0; j < CWID; ++j) wv[j] = *(const f32x2*)(dw + j * CONV + c0);
    const f32x2 cb = *(const f32x2*)(F.A->in[I_DWB] + l * CONV + c0), lg = *(const f32x2*)(F.A->in[I_CLNG] + l * CONV + c0), lb = *(const f32x2*)(F.A->in[I_CLNB] + l * CONV + c0);
    LAS float* red = (LAS float*)F.lds;
    LAS float* stat = red + 256;
    float gmx = fmaxf(fabsf(lg.x), fabsf(lg.y)), bmx = fmaxf(fabsf(lb.x), fabsf(lb.y));
#pragma unroll
    for (int o = 1; o < 64; o <<= 1) { gmx = fmaxf(gmx, __shfl_xor(gmx, o)); bmx = fmaxf(bmx, __shfl_xor(bmx, o)); }
    if (F.lane == 0) { red[F.wave] = gmx; red[8 + F.wave] = bmx; }
    __syncthreads();
    { float g_ = red[0], b_ = red[8];
#pragma unroll
      for (int w = 1; w < 8; ++w) { g_ = fmaxf(g_, red[w]); b_ = fmaxf(b_, red[8 + w]); }
      gmx = g_; bmx = b_; }
    __syncthreads();
    const float Bc = fmaxf(32.0f * gmx + bmx, 1e-20f), cinv = 440.0f / Bc;
    if (blockIdx.x == 0 && F.tid == 0) { __hip_atomic_store(F.ctl + CW_BC + l, __float_as_uint(Bc), __ATOMIC_RELAXED, __HIP_MEMORY_SCOPE_AGENT); __hip_atomic_store(F.ctl + CW_BC2 + l, __float_as_uint(gmx + bmx), __ATOMIC_RELAXED, __HIP_MEMORY_SCOPE_AGENT); }
    const unsigned* Ut = WSP(unsigned, WS_U) + F.tid; unsigned short* AM = WSP(unsigned short, WS_AM);
    for (int tile = F.vcu; tile < T / 64; tile += F.G) {
        const int t0 = tile * 64, bstart = t0 & ~(SEQ - 1);
        for (int grp = 0; grp < 4; ++grp) {
            const int tg = t0 + grp * 16;
            f32x2 xv[46]; unsigned wp[46];
#pragma unroll
            for (int i = 0; i < 46; ++i) { const int r = tg - 30 + i; wp[i] = Ut[(size_t)(r >= bstart ? r : bstart) * (CONV / 2)]; }
            __builtin_amdgcn_sched_barrier(0);
#pragma unroll
            for (int i = 0; i < 46; ++i) { const int r = tg - 30 + i; const unsigned p = wp[i] & (r >= bstart ? 0xffffffffu : 0u); xv[i] = (f32x2){bflo(p), bfhi(p)}; }
            f32x2 ov[16];
#pragma unroll
            for (int i = 0; i < 16; ++i) { f32x2 a = cb;
#pragma unroll
                for (int j = 0; j < CWID; ++j) a = __builtin_elementwise_fma(wv[j], xv[i + j], a);
                ov[i] = a; }
            { float p32[32];
#pragma unroll
              for (int i = 0; i < 16; ++i) { p32[i] = ov[i].x + ov[i].y; p32[16 + i] = ov[i].x * ov[i].x + ov[i].y * ov[i].y; }
              float p16[16], p8[8], p4[4], p2[2];
              { const bool bt = (F.lane & 1) != 0;
#pragma unroll
                for (int i = 0; i < 16; ++i) { const float snd = bt ? p32[i] : p32[i + 16], kp = bt ? p32[i + 16] : p32[i]; p16[i] = kp + lane_xor1(snd); } }
              { const bool bt = (F.lane & 2) != 0;
#pragma unroll
                for (int i = 0; i < 8; ++i) { const float snd = bt ? p16[i] : p16[i + 8], kp = bt ? p16[i + 8] : p16[i]; p8[i] = kp + lane_xor2(snd); } }
              { const bool bt = (F.lane & 4) != 0;
#pragma unroll
                for (int i = 0; i < 4; ++i) { const float snd = bt ? p8[i] : p8[i + 4], kp = bt ? p8[i + 4] : p8[i]; p4[i] = kp + lane_xor4(snd); } }
              { const bool bt = (F.lane & 8) != 0;
#pragma unroll
                for (int i = 0; i < 2; ++i) { const float snd = bt ? p4[i] : p4[i + 2], kp = bt ? p4[i + 2] : p4[i]; p2[i] = kp + lane_xor8(snd); } }
              const bool bt16 = (F.lane & 16) != 0; const float snd = bt16 ? p2[0] : p2[1], kp = bt16 ? p2[1] : p2[0];
              float tot = kp + lane_xor16(snd); tot += __shfl_xor(tot, 32);
              const int sidx = 16 * (F.lane & 1) + 8 * ((F.lane >> 1) & 1) + 4 * ((F.lane >> 2) & 1) + 2 * ((F.lane >> 3) & 1) + ((F.lane >> 4) & 1);
              if (F.lane < 32) red[F.wave * 32 + sidx] = tot; }
            __syncthreads();
            if (F.tid < 32) { float v = 0.f;
#pragma unroll
                for (int w = 0; w < 8; ++w) v += red[w * 32 + F.tid];
                stat[F.tid] = v; }
            __syncthreads();
#pragma unroll
            for (int i = 0; i < 16; ++i) { const float mu = stat[i] * (1.0f / CONV), var = fmaxf(stat[16 + i] * (1.0f / CONV) - mu * mu, 0.0f), rstd = 1.0f / sqrtf(var + EPS);
                const float ya = (ov[i].x - mu) * rstd * lg.x + lb.x, yb = (ov[i].y - mu) * rstd * lg.y + lb.y;
                AM[(size_t)(tg + i) * (D / 2) + F.tid] = (unsigned short)__builtin_amdgcn_cvt_pk_fp8_f32(ya * sigmoidf_(ya) * cinv, yb * sigmoidf_(yb) * cinv, 0, false); }
        }
    }
}

#define MFMA32(a, b, c) __builtin_amdgcn_mfma_f32_32x32x16_bf16((a), (b), (c), 0, 0, 0)
__device__ __forceinline__ void attn_phase(Frame& F, int l) {
    PHASE_TID(F);
    constexpr int VTS = 260;
    constexpr int KS = 72;
    LAS bf16* VT = (LAS bf16*)F.lds;
    LAS bf16* KL = (LAS bf16*)(F.lds + 34816);
    LAS float* BT = (LAS float*)(F.lds + 34816 + 36864);
    const bf16* Qg = WSP(bf16, WS_Q); const bf16* Kg = WSP(bf16, WS_K); const bf16* Vg = WSP(bf16, WS_V); unsigned char* AM = WSP(unsigned char, WS_AM);
    const float* BIAS = WSP(float, WS_BIAS);
    const int r = F.lane & 31, h = F.lane >> 5;
    for (int unit = F.vcu; unit < 512; unit += F.G) {
        const int b = unit >> 8, blk = (unit >> 2) & 63, kvh = unit & 3, kbase = blk * 128 - 128;
        const float vmx = __uint_as_float(__hip_atomic_load(F.ctl + CW_VMAX + 2 * l + b, __ATOMIC_RELAXED, __HIP_MEMORY_SCOPE_AGENT)), ainv = vmx > 0.f ? 440.0f / (1.02f * vmx) : 1.0f;
        { v4u vv_[4], kk_[4];
#pragma unroll
          for (int it = 0; it < 4; ++it) { const int c = it * NTHR + F.tid, key = c >> 3, d0 = (c & 7) * 8, kpos = kbase + key, kp_ = kpos >= 0 ? kpos : 0;
              vv_[it] = *(const v4u*)(Vg + (size_t)(b * SEQ + kp_) * KVD + kvh * HD + d0); kk_[it] = *(const v4u*)(Kg + (size_t)(b * SEQ + kp_) * KVD + kvh * HD + d0); }
          __builtin_amdgcn_sched_barrier(0);
#pragma unroll
          for (int it = 0; it < 4; ++it) { const int c = it * NTHR + F.tid, key = c >> 3, d0 = (c & 7) * 8, kpos = kbase + key; const unsigned msk = kpos >= 0 ? 0xffffffffu : 0u;
              const v4u v = vv_[it] & msk, kq = kk_[it] & msk;
              *(LAS v4u*)(KL + key * KS + d0) = kq;
              LAS bf16* dst = VT + d0 * VTS + key;
              dst[0 * VTS] = (bf16)v.x; dst[1 * VTS] = (bf16)(v.x >> 16); dst[2 * VTS] = (bf16)v.y; dst[3 * VTS] = (bf16)(v.y >> 16);
              dst[4 * VTS] = (bf16)v.z; dst[5 * VTS] = (bf16)(v.z >> 16); dst[6 * VTS] = (bf16)v.w; dst[7 * VTS] = (bf16)(v.w >> 16); } }
        BT[F.tid] = BIAS[(kvh * 4 + (F.tid >> 7)) * 128 + (F.tid & 127)];
        __syncthreads();
        for (int tk = 0; tk < 2; ++tk) {
            const int task = F.wave * 2 + tk, g = task >> 2, qs = task & 3, head = kvh * 4 + g;
            const size_t trow = (size_t)b * SEQ + blk * 128 + qs * 32 + r;
            bf16x8 qf[4];
#pragma unroll
            for (int s = 0; s < 4; ++s) qf[s] = *(const bf16x8*)(Qg + trow * ATT + head * HD + 16 * s + 8 * h);
            const float sink = F.A->in[I_SINK][l * NHEAD + head];
            float mx = sink, lsum = 0.f;
            f32x16 o[2];
#pragma unroll
            for (int i = 0; i < 16; ++i) { o[0][i] = 0.f; o[1][i] = 0.f; }
#pragma unroll 1
            for (int j = 0; j < 5; ++j) { f32x16 a;
#pragma unroll
                for (int i = 0; i < 16; ++i) a[i] = 0.f;
#pragma unroll
                for (int s = 0; s < 4; ++s) { const bf16x8 kf = *(const LAS bf16x8*)(KL + (qs * 32 + 32 * j + r) * KS + 16 * s + 8 * h); a = MFMA32(kf, qf[s], a); }
                float tmax = -INFINITY;
#pragma unroll
                for (int i = 0; i < 16; ++i) { const int kr = 32 * j + (i & 3) + 8 * (i >> 2) + 4 * h, dist = 128 + r - kr; const bool ok = dist >= 0 && dist < 128 && (kbase + qs * 32 + kr) >= 0;
                    const float sv = ok ? a[i] + BT[g * 128 + (dist & 127)] : -INFINITY; a[i] = sv; tmax = fmaxf(tmax, sv); }
                tmax = fmaxf(tmax, __shfl_xor(tmax, 32));
                const float mnew = fmaxf(mx, tmax), alpha = __expf(mx - mnew); mx = mnew; lsum *= alpha;
#pragma unroll
                for (int i = 0; i < 16; ++i) { o[0][i] *= alpha; o[1][i] *= alpha; const float p = __expf(a[i] - mx); a[i] = p; lsum += p; }
#pragma unroll
                for (int s2 = 0; s2 < 2; ++s2) { v4u pp; pp.x = pk2(a[8 * s2 + 0], a[8 * s2 + 1]); pp.y = pk2(a[8 * s2 + 2], a[8 * s2 + 3]); pp.z = pk2(a[8 * s2 + 4], a[8 * s2 + 5]); pp.w = pk2(a[8 * s2 + 6], a[8 * s2 + 7]);
                    const bf16x8 pf = __builtin_bit_cast(bf16x8, pp);
#pragma unroll
                    for (int dt = 0; dt < 2; ++dt) { const LAS bf16* vp = VT + (32 * dt + r) * VTS + qs * 32 + 32 * j + 16 * s2 + 4 * h; const v2u lo = *(const LAS v2u*)vp, hi = *(const LAS v2u*)(vp + 8);
                        v4u vv; vv.x = lo.x; vv.y = lo.y; vv.z = hi.x; vv.w = hi.y; o[dt] = MFMA32(__builtin_bit_cast(bf16x8, vv), pf, o[dt]); } }
            }
            lsum += __shfl_xor(lsum, 32);
            const float inv = ainv / (lsum + __expf(sink - mx));
#pragma unroll
            for (int dt = 0; dt < 2; ++dt)
#pragma unroll
                for (int g4 = 0; g4 < 4; ++g4) { int w = __builtin_amdgcn_cvt_pk_fp8_f32(o[dt][4 * g4 + 0] * inv, o[dt][4 * g4 + 1] * inv, 0, false); w = __builtin_amdgcn_cvt_pk_fp8_f32(o[dt][4 * g4 + 2] * inv, o[dt][4 * g4 + 3] * inv, w, true);
                    *(unsigned*)(AM + trow * D + ATT + head * HD + 32 * dt + 8 * g4 + 4 * h) = (unsigned)w; }
        }
        __syncthreads();
    }
}

__device__ __forceinline__ unsigned f2key(float f) { const unsigned u = __float_as_uint(f); return (u & 0x80000000u) ? ~u : (u | 0x80000000u); }
__device__ __forceinline__ float key2f(unsigned k) { const unsigned u = (k & 0x80000000u) ? (k & 0x7fffffffu) : ~k; return __uint_as_float(u); }
#define INSERT16(L, x_) do { unsigned x__ = (x_); _Pragma("unroll") for (int q_ = 0; q_ < 16; ++q_) { const unsigned hi_ = L[q_] > x__ ? L[q_] : x__; x__ = L[q_] > x__ ? x__ : L[q_]; L[q_] = hi_; } } while (0)
#define CEX(A_, i_, j_) do { const unsigned h__ = A_[i_] > A_[j_] ? A_[i_] : A_[j_], l__ = A_[i_] > A_[j_] ? A_[j_] : A_[i_]; A_[i_] = h__; A_[j_] = l__; } while (0)
#define SORT16(A_) do { CEX(A_, 0,1); CEX(A_, 2,3); CEX(A_, 0,2); CEX(A_, 1,3); CEX(A_, 1,2); CEX(A_, 4,5); CEX(A_, 6,7); CEX(A_, 4,6); CEX(A_, 5,7); CEX(A_, 5,6); CEX(A_, 0,4); CEX(A_, 2,6); CEX(A_, 2,4); CEX(A_, 1,5); CEX(A_, 3,7); CEX(A_, 3,5); CEX(A_, 1,2); CEX(A_, 3,4); CEX(A_, 5,6); CEX(A_, 8,9); CEX(A_, 10,11); CEX(A_, 8,10); CEX(A_, 9,11); CEX(A_, 9,10); CEX(A_, 12,13); CEX(A_, 14,15); CEX(A_, 12,14); CEX(A_, 13,15); CEX(A_, 13,14); CEX(A_, 8,12); CEX(A_, 10,14); CEX(A_, 10,12); CEX(A_, 9,13); CEX(A_, 11,15); CEX(A_, 11,13); CEX(A_, 9,10); CEX(A_, 11,12); CEX(A_, 13,14); CEX(A_, 0,8); CEX(A_, 4,12); CEX(A_, 4,8); CEX(A_, 2,10); CEX(A_, 6,14); CEX(A_, 6,10); CEX(A_, 2,4); CEX(A_, 6,8); CEX(A_, 10,12); CEX(A_, 1,9); CEX(A_, 5,13); CEX(A_, 5,9); CEX(A_, 3,11); CEX(A_, 7,15); CEX(A_, 7,11); CEX(A_, 3,5); CEX(A_, 7,9); CEX(A_, 11,13); CEX(A_, 1,2); CEX(A_, 3,4); CEX(A_, 5,6); CEX(A_, 7,8); CEX(A_, 9,10); CEX(A_, 11,12); CEX(A_, 13,14); } while (0)
#define BMERGE16(A_) do { CEX(A_, 0,8); CEX(A_, 1,9); CEX(A_, 2,10); CEX(A_, 3,11); CEX(A_, 4,12); CEX(A_, 5,13); CEX(A_, 6,14); CEX(A_, 7,15); CEX(A_, 0,4); CEX(A_, 1,5); CEX(A_, 2,6); CEX(A_, 3,7); CEX(A_, 8,12); CEX(A_, 9,13); CEX(A_, 10,14); CEX(A_, 11,15); CEX(A_, 0,2); CEX(A_, 1,3); CEX(A_, 4,6); CEX(A_, 5,7); CEX(A_, 8,10); CEX(A_, 9,11); CEX(A_, 12,14); CEX(A_, 13,15); CEX(A_, 0,1); CEX(A_, 2,3); CEX(A_, 4,5); CEX(A_, 6,7); CEX(A_, 8,9); CEX(A_, 10,11); CEX(A_, 12,13); CEX(A_, 14,15); } while (0)
__device__ __forceinline__ void topk_phase(Frame& F) {
    PHASE_TID(F);
    const _Float16* S = WSP(_Float16, WS_GC); int* IDX = WSP(int, WS_U); float* GATE = WSP(float, WS_U + 8 * MiB);
    const int gw = F.vcu * NWAVES + F.wave, NGW = F.G * NWAVES;
    constexpr int TKS = 256; LAS unsigned char* lw = F.lds + F.wave * (64 * TKS); const LAS unsigned char* lrow = lw + F.lane * TKS;
    for (int grp = gw; grp < T * PHEADS / 64; grp += NGW) {
        const int item = grp * 64 + F.lane, t = item >> 3, hh = item & 7;
        const unsigned char* sg = (const unsigned char*)(S + (size_t)grp * 8 * D) + (size_t)(F.lane >> 4) * 512 + (F.lane & 15) * 16;
        v4u r0[16], r1[16];
#pragma unroll
        for (int i = 0; i < 16; ++i) r0[i] = *(const v4u*)(sg + (size_t)(i >> 1) * 4096 + (i & 1) * 2048);
#pragma unroll
        for (int i = 0; i < 16; ++i) r1[i] = *(const v4u*)(sg + (size_t)(i >> 1) * 4096 + (i & 1) * 2048 + 256);
        __builtin_amdgcn_sched_barrier(0);
#pragma unroll
        for (int i = 0; i < 16; ++i) *(LAS v4u*)(lw + (4 * i + (F.lane >> 4)) * TKS + (((F.lane & 15) ^ ((4 * i + (F.lane >> 4)) & 15)) << 4)) = r0[i];
        __builtin_amdgcn_sched_barrier(0);
        unsigned L1[16], L2[16];
#pragma unroll
        for (int q = 0; q < 16; ++q) { L1[q] = 0u; L2[q] = 0u; }
#pragma unroll 1
        for (int c = 0; c < 16; c += 2) { const pg8::f16x8 va = *(const LAS pg8::f16x8*)(lrow + ((c ^ (F.lane & 15)) << 4)), vb = *(const LAS pg8::f16x8*)(lrow + (((c + 1) ^ (F.lane & 15)) << 4));
            unsigned C[16];
#pragma unroll
            for (int e = 0; e < 8; ++e) { C[e] = (f2key((float)va[e]) & ~127u) | (unsigned)(127 - (8 * c + e)); C[8 + e] = (f2key((float)vb[e]) & ~127u) | (unsigned)(127 - (8 * c + 8 + e)); }
            SORT16(C);
#pragma unroll
            for (int q = 0; q < 16; ++q) L1[q] = L1[q] > C[15 - q] ? L1[q] : C[15 - q];
            BMERGE16(L1); }
        __builtin_amdgcn_sched_barrier(0);
#pragma unroll
        for (int i = 0; i < 16; ++i) *(LAS v4u*)(lw + (4 * i + (F.lane >> 4)) * TKS + (((F.lane & 15) ^ ((4 * i + (F.lane >> 4)) & 15)) << 4)) = r1[i];
        __builtin_amdgcn_sched_barrier(0);
#pragma unroll 1
        for (int c = 0; c < 16; c += 2) { const pg8::f16x8 va = *(const LAS pg8::f16x8*)(lrow + ((c ^ (F.lane & 15)) << 4)), vb = *(const LAS pg8::f16x8*)(lrow + (((c + 1) ^ (F.lane & 15)) << 4));
            unsigned C[16];
#pragma unroll
            for (int e = 0; e < 8; ++e) { C[e] = (f2key((float)va[e]) & ~127u) | (unsigned)(127 - (8 * c + e)); C[8 + e] = (f2key((float)vb[e]) & ~127u) | (unsigned)(127 - (8 * c + 8 + e)); }
            SORT16(C);
#pragma unroll
            for (int q = 0; q < 16; ++q) L2[q] = L2[q] > C[15 - q] ? L2[q] : C[15 - q];
            BMERGE16(L2); }
        float v1[16], v2[16];
#pragma unroll
        for (int q = 0; q < 16; ++q) { v1[q] = key2f(L1[q] & ~127u); v2[q] = key2f(L2[q] & ~127u); }
#define PKEY(i_, j_) ((f2key(v1[i_] + v2[j_]) & ~255u) | (unsigned)(255 - ((i_) * 16 + (j_))))
        unsigned B[16], Cc[16];
#pragma unroll
        for (int q = 0; q < 16; ++q) B[q] = PKEY(0, q);
#pragma unroll
        for (int q = 0; q < 15; ++q) Cc[q] = PKEY(q + 1, 0);
        Cc[15] = 0u;
#pragma unroll
        for (int q = 0; q < 16; ++q) B[q] = B[q] > Cc[15 - q] ? B[q] : Cc[15 - q];
        BMERGE16(B);
        Cc[0] = PKEY(1, 1);        Cc[1] = PKEY(1, 2);        Cc[2] = PKEY(1, 3);        Cc[3] = PKEY(1, 4);
        Cc[4] = PKEY(1, 5);        Cc[5] = PKEY(1, 6);        Cc[6] = PKEY(1, 7);        Cc[7] = PKEY(2, 1);
        Cc[8] = PKEY(2, 2);        Cc[9] = PKEY(2, 3);        Cc[10] = PKEY(2, 4);        Cc[11] = PKEY(3, 1);
        Cc[12] = PKEY(3, 2);        Cc[13] = PKEY(3, 3);        Cc[14] = PKEY(4, 1);        Cc[15] = PKEY(4, 2);
        SORT16(Cc);
#pragma unroll
        for (int q = 0; q < 16; ++q) B[q] = B[q] > Cc[15 - q] ? B[q] : Cc[15 - q];
        BMERGE16(B);
        INSERT16(B, PKEY(5, 1)); INSERT16(B, PKEY(6, 1)); INSERT16(B, PKEY(7, 1));
#undef PKEY
        const float b0 = key2f(B[0] & ~255u); float e[16], es = 0.f;
#pragma unroll
        for (int q = 0; q < 16; ++q) { e[q] = __expf(key2f(B[q] & ~255u) - b0); es += e[q]; }
        const float einv = 1.0f / es;
        int ex[16];
#pragma unroll
        for (int q = 0; q < 16; ++q) { const int code = 255 - (int)(B[q] & 255u), ii = code >> 4, jj = code & 15; unsigned s1 = L1[0], s2 = L2[0];
#pragma unroll
            for (int z = 1; z < 16; ++z) { s1 = (ii == z) ? L1[z] : s1; s2 = (jj == z) ? L2[z] : s2; }
            ex[q] = (127 - (int)(s1 & 127u)) * 128 + (127 - (int)(s2 & 127u)); e[q] *= einv; }
        int* ip = IDX + (size_t)t * 128 + hh * 16; float* gp = GATE + (size_t)t * 128 + hh * 16;
#pragma unroll
        for (int q = 0; q < 4; ++q) { *(int4*)(ip + 4 * q) = make_int4(ex[4 * q], ex[4 * q + 1], ex[4 * q + 2], ex[4 * q + 3]); *(f32x4*)(gp + 4 * q) = (f32x4){e[4 * q], e[4 * q + 1], e[4 * q + 2], e[4 * q + 3]}; }
    }
}

#define FP8LO(w_) __builtin_amdgcn_cvt_pk_f32_fp8((int)(w_), false)
#define FP8HI(w_) __builtin_amdgcn_cvt_pk_f32_fp8((int)(w_), true)
__device__ __forceinline__ void pa_issue(v4u (&rr)[16], int id0, int id1, const unsigned char* tab, int g) {
#pragma unroll
    for (int i = 0; i < 16; ++i) { const int e = __shfl(i < 8 ? id0 : id1, ((8 * i) & 63) + g); rr[i] = *(const v4u*)(tab + (size_t)e * SLW); }
}
__device__ __forceinline__ void pa_compute(const v4u (&rr)[16], const v4u ha, const v4u hb, float o0, float o1, float* d0, float* d1, int lane) {
    f32x2 hf[8];
    hf[0] = (f32x2){bflo(ha.x), bfhi(ha.x)}; hf[1] = (f32x2){bflo(ha.y), bfhi(ha.y)}; hf[2] = (f32x2){bflo(ha.z), bfhi(ha.z)}; hf[3] = (f32x2){bflo(ha.w), bfhi(ha.w)};
    hf[4] = (f32x2){bflo(hb.x), bfhi(hb.x)}; hf[5] = (f32x2){bflo(hb.y), bfhi(hb.y)}; hf[6] = (f32x2){bflo(hb.z), bfhi(hb.z)}; hf[7] = (f32x2){bflo(hb.w), bfhi(hb.w)};
    float p[16];
#pragma unroll
    for (int i = 0; i < 16; ++i) { f32x2 a = FP8LO(rr[i].x) * hf[0];
        a = __builtin_elementwise_fma(FP8HI(rr[i].x), hf[1], a); a = __builtin_elementwise_fma(FP8LO(rr[i].y), hf[2], a); a = __builtin_elementwise_fma(FP8HI(rr[i].y), hf[3], a);
        a = __builtin_elementwise_fma(FP8LO(rr[i].z), hf[4], a); a = __builtin_elementwise_fma(FP8HI(rr[i].z), hf[5], a); a = __builtin_elementwise_fma(FP8LO(rr[i].w), hf[6], a); a = __builtin_elementwise_fma(FP8HI(rr[i].w), hf[7], a);
        p[i] = a.x + a.y; }
    float q8[8], q4[4], q2[2];
    { const bool bt = (lane & 1) != 0;
#pragma unroll
      for (int i = 0; i < 8; ++i) { const float snd = bt ? p[i] : p[i + 8], kp = bt ? p[i + 8] : p[i]; q8[i] = kp + lane_xor1(snd); } }
    { const bool bt = (lane & 2) != 0;
#pragma unroll
      for (int i = 0; i < 4; ++i) { const float snd = bt ? q8[i] : q8[i + 4], kp = bt ? q8[i + 4] : q8[i]; q4[i] = kp + lane_xor2(snd); } }
    { const bool bt = (lane & 4) != 0;
#pragma unroll
      for (int i = 0; i < 2; ++i) { const float snd = bt ? q4[i] : q4[i + 2], kp = bt ? q4[i + 2] : q4[i]; q2[i] = kp + lane_xor4(snd); } }
    *d0 = o0 + q2[0]; *d1 = o1 + q2[1];
}
__device__ __forceinline__ void peer_act_phase(Frame& F, int l) {
    PHASE_TID(F);
    const int lane = F.lane, g = lane >> 3, j = lane & 7;
    const int x = blockIdx.x & 7, bpg = F.G >> 3, wpg = bpg * NWAVES, wgi = (blockIdx.x >> 3) * NWAVES + F.wave;
    const int* IDX = WSP(int, WS_U); const bf16* Hb = WSP(bf16, WS_H);
    float* actp = WSP(float, WS_AM) + (size_t)x * T * 128;
    const int irev = 8 * (j & 1) + 4 * ((j >> 1) & 1) + 2 * (j >> 2), k0 = 8 * irev + g, k1 = k0 + 8;
    const int NT = (T - wgi + wpg - 1) / wpg;
    for (int s = 0; s < 2; ++s) {
        const int sl = 2 * x + s; const unsigned char* tab = WSP(unsigned char, WS_PU) + (size_t)(l * NSL + sl) * NEXP * SLW + 16 * j;
        const bf16* hcol = Hb + sl * SLW + 16 * j;
#define PA_PREF(n_, i0, i1, h0, h1, q0, q1) do { const int t_ = wgi + (n_) * wpg; if ((n_) < NT) { i0 = IDX[(size_t)t_ * 128 + lane]; i1 = IDX[(size_t)t_ * 128 + 64 + lane]; h0 = *(const v4u*)(hcol + (size_t)t_ * D); h1 = *(const v4u*)(hcol + (size_t)t_ * D + 8); \
            if (s > 0) { q0 = actp[(size_t)t_ * 128 + k0]; q1 = actp[(size_t)t_ * 128 + k1]; } } } while (0)
        int ia0 = 0, ia1 = 0, ib0 = 0, ib1 = 0; v4u ha0 = {0u, 0u, 0u, 0u}, ha1 = ha0, hb0 = ha0, hb1 = ha0; float oa0 = 0.f, oa1 = 0.f, ob0 = 0.f, ob1 = 0.f;
        v4u rA[16], rB[16];
        PA_PREF(0, ia0, ia1, ha0, ha1, oa0, oa1); PA_PREF(1, ib0, ib1, hb0, hb1, ob0, ob1);
        if (0 < NT) pa_issue(rA, ia0, ia1, tab, g);
        for (int n = 0; n < NT; n += 2) {
            const v4u ca0 = ha0, ca1 = ha1; const float pa0 = oa0, pa1 = oa1;
            if (n + 1 < NT) pa_issue(rB, ib0, ib1, tab, g);
            PA_PREF(n + 2, ia0, ia1, ha0, ha1, oa0, oa1);
            __builtin_amdgcn_sched_barrier(0);
            { const size_t t_ = (size_t)(wgi + n * wpg); pa_compute(rA, ca0, ca1, pa0, pa1, actp + t_ * 128 + k0, actp + t_ * 128 + k1, lane); }
            __builtin_amdgcn_sched_barrier(0);
            if (n + 1 < NT) {
                const v4u cb0 = hb0, cb1 = hb1; const float pb0 = ob0, pb1 = ob1;
                if (n + 2 < NT) pa_issue(rA, ia0, ia1, tab, g);
                PA_PREF(n + 3, ib0, ib1, hb0, hb1, ob0, ob1);
                __builtin_amdgcn_sched_barrier(0);
                { const size_t t_ = (size_t)(wgi + (n + 1) * wpg); pa_compute(rB, cb0, cb1, pb0, pb1, actp + t_ * 128 + k0, actp + t_ * 128 + k1, lane); }
                __builtin_amdgcn_sched_barrier(0);
            }
        }
#undef PA_PREF
    }
}
__device__ __forceinline__ void peer_w_phase(Frame& F, int l) {
    PHASE_TID(F);
    const int lane = F.lane;
    constexpr int WROW = 136;
    LAS bf16* wl = (LAS bf16*)F.lds; LAS bf16* il = wl + 64 * WROW;
    const int* IDX = WSP(int, WS_U); const float* GATE = WSP(float, WS_U + 8 * MiB); const float* actp = WSP(float, WS_AM);
    bf16* WT = WSP(bf16, WS_Y1); bf16* IT = WSP(bf16, WS_Y1 + 4 * MiB);
    const float* su = WSP(float, WS_SCL) + l * NEXP; const float* sv = WSP(float, WS_SCL) + (2 + l) * NEXP;
    for (int tb = F.vcu; tb < T / 64; tb += F.G) {
#pragma unroll 2
        for (int i = 0; i < 8; ++i) { const int tl = F.wave * 8 + i, t = tb * 64 + tl;
            const int e0 = IDX[(size_t)t * 128 + lane], e1 = IDX[(size_t)t * 128 + 64 + lane];
            float pa[8], pb[8];
#pragma unroll
            for (int xx = 0; xx < 8; ++xx) { pa[xx] = actp[((size_t)xx * T + t) * 128 + lane]; pb[xx] = actp[((size_t)xx * T + t) * 128 + 64 + lane]; }
            const float gt0 = GATE[(size_t)t * 128 + lane], gt1 = GATE[(size_t)t * 128 + 64 + lane];
            const float su0 = su[e0], su1 = su[e1], sv0 = sv[e0], sv1 = sv[e1];
            __builtin_amdgcn_sched_barrier(0);
            float a0 = ((pa[0] + pa[1]) + (pa[2] + pa[3])) + ((pa[4] + pa[5]) + (pa[6] + pa[7])), a1 = ((pb[0] + pb[1]) + (pb[2] + pb[3])) + ((pb[4] + pb[5]) + (pb[6] + pb[7]));
            a0 *= su0; a1 *= su1;
            const float g0 = gt0 * sv0, g1 = gt1 * sv1;
            wl[tl * WROW + lane] = __builtin_bit_cast(bf16, (_Float16)(256.0f * g0 * 0.5f * a0 * (1.0f + erff(a0 * 0.70710678118654752f)))); wl[tl * WROW + 64 + lane] = __builtin_bit_cast(bf16, (_Float16)(256.0f * g1 * 0.5f * a1 * (1.0f + erff(a1 * 0.70710678118654752f))));
            il[tl * WROW + lane] = (bf16)e0; il[tl * WROW + 64 + lane] = (bf16)e1; }
        __syncthreads();
#pragma unroll
        for (int i = 0; i < 2; ++i) { const int p_ = i * NTHR + F.tid, kq = p_ >> 6, tl = p_ & 63; const size_t o = ((size_t)(tb * 16 + kq) * 64 + tl) * 8;
            *(v4u*)(WT + o) = *(const LAS v4u*)(wl + tl * WROW + 8 * kq); *(v4u*)(IT + o) = *(const LAS v4u*)(il + tl * WROW + 8 * kq); }
        __syncthreads();
    }
}
__device__ __forceinline__ void pbl_load(v4u (&iv)[4], v4u (&wv)[4], const bf16* ip, const bf16* wp) {
#pragma unroll
    for (int q = 0; q < 4; ++q) { iv[q] = *(const v4u*)(ip + q * 512); wv[q] = *(const v4u*)(wp + q * 512); }
}
typedef _Float16 h16x2 __attribute__((ext_vector_type(2)));
#define FP8H_LO(w_) __builtin_bit_cast(h16x2, __builtin_amdgcn_cvt_scalef32_pk_f16_fp8((int)(w_), 1.0f, false))
#define FP8H_HI(w_) __builtin_bit_cast(h16x2, __builtin_amdgcn_cvt_scalef32_pk_f16_fp8((int)(w_), 1.0f, true))
#define PBL_FMA_LO(acc_, v_, w_) asm("v_pk_fma_f16 %0, %1, %2, %0 op_sel_hi:[1,0,1]" : "+v"(acc_) : "v"(v_), "v"(w_))
#define PBL_FMA_HI(acc_, v_, w_) asm("v_pk_fma_f16 %0, %1, %2, %0 op_sel:[0,1,0] op_sel_hi:[1,1,1]" : "+v"(acc_) : "v"(v_), "v"(w_))
__device__ __forceinline__ void pbl_compute(const v4u (&iv)[4], const v4u (&wv)[4], h16x2 (&acc)[4], LAS unsigned char* lds) {
    const unsigned three = 3u;
#pragma unroll
    for (int q = 0; q < 4; ++q) { v2u d[8];
#pragma unroll
        for (int ki = 0; ki < 8; ++ki) { const unsigned ipair = iv[q][ki >> 1]; unsigned ad;
            if (ki & 1) asm("v_lshlrev_b32_sdwa %0, %1, %2 dst_sel:DWORD dst_unused:UNUSED_PAD src0_sel:DWORD src1_sel:WORD_1" : "=v"(ad) : "s"(three), "v"(ipair));
            else asm("v_lshlrev_b32_sdwa %0, %1, %2 dst_sel:DWORD dst_unused:UNUSED_PAD src0_sel:DWORD src1_sel:WORD_0" : "=v"(ad) : "s"(three), "v"(ipair));
            d[ki] = *(const LAS v2u*)(size_t)ad; }
        __builtin_amdgcn_sched_barrier(0);
#pragma unroll
        for (int ki = 0; ki < 8; ++ki) { const unsigned wword = wv[q][ki >> 1];
            const h16x2 v0 = FP8H_LO(d[ki].x), v1 = FP8H_HI(d[ki].x), v2 = FP8H_LO(d[ki].y), v3 = FP8H_HI(d[ki].y);
            if (ki & 1) { PBL_FMA_HI(acc[0], v0, wword); PBL_FMA_HI(acc[1], v1, wword); PBL_FMA_HI(acc[2], v2, wword); PBL_FMA_HI(acc[3], v3, wword); }
            else { PBL_FMA_LO(acc[0], v0, wword); PBL_FMA_LO(acc[1], v1, wword); PBL_FMA_LO(acc[2], v2, wword); PBL_FMA_LO(acc[3], v3, wword); } }
        __builtin_amdgcn_sched_barrier(0); }
}
__device__ __forceinline__ void peer_out_phase(Frame& F, int l) {
    PHASE_TID(F);
    const int lane = F.lane;
    const int x = blockIdx.x & 7, ib = blockIdx.x >> 3, j = 8 * (4 * x + (ib >> 3)) + (ib & 7);
    const bf16* WT = WSP(bf16, WS_Y1); const bf16* IT = WSP(bf16, WS_Y1 + 4 * MiB); bf16* OUT = WSP(bf16, WS_GC);
    for (int jj = (F.G == 256 ? j : (int)blockIdx.x); jj < 256; jj += (F.G == 256 ? 256 : F.G)) {
        const unsigned char* sl = WSP(unsigned char, WS_PV) + (size_t)(l * 256 + jj) * NEXP * 8;
        { v4u fr_[16];
#pragma unroll
          for (int i = 0; i < 16; ++i) fr_[i] = *(const v4u*)(sl + (i * NTHR + F.tid) * 16);
          __builtin_amdgcn_sched_barrier(0);
#pragma unroll
          for (int i = 0; i < 16; ++i) *(LAS v4u*)(F.lds + (i * NTHR + F.tid) * 16) = fr_[i]; }
        __syncthreads();
        constexpr int NCH = 4 * (T / 64 / NWAVES);
#define PBL_PTR(c_, arr_) ((arr_) + ((size_t)(F.wave + NWAVES * ((c_) >> 2)) * 16 * 64 + lane) * 8 + ((c_) & 3) * 4 * 512)
        v4u iA[4], wA[4], iB[4], wB[4], iC[4], wC[4]; h16x2 acc[4];
#define PBL_STEP(X_, Z_, c_) do { const int cc_ = (c_); if (cc_ + 2 < NCH) pbl_load(i##Z_, w##Z_, PBL_PTR(cc_ + 2, IT), PBL_PTR(cc_ + 2, WT)); \
            __builtin_amdgcn_sched_barrier(0); \
            if ((cc_ & 3) == 0) { _Pragma("unroll") for (int q = 0; q < 4; ++q) acc[q] = (h16x2){(_Float16)0.f, (_Float16)0.f}; } \
            pbl_compute(i##X_, w##X_, acc, F.lds); \
            if ((cc_ & 3) == 3) { constexpr float us_ = 1.0f / 256.0f; v4u o; o.x = pk2((float)acc[0].x * us_, (float)acc[0].y * us_); o.y = pk2((float)acc[1].x * us_, (float)acc[1].y * us_); o.z = pk2((float)acc[2].x * us_, (float)acc[2].y * us_); o.w = pk2((float)acc[3].x * us_, (float)acc[3].y * us_); \
                *(v4u*)(OUT + (size_t)((F.wave + NWAVES * (cc_ >> 2)) * 64 + lane) * D + 8 * jj) = o; } \
            __builtin_amdgcn_sched_barrier(0); } while (0)
        pbl_load(iA, wA, PBL_PTR(0, IT), PBL_PTR(0, WT)); pbl_load(iB, wB, PBL_PTR(1, IT), PBL_PTR(1, WT));
#pragma unroll 1
        for (int c = 0; c < NCH; c += 3) {
            PBL_STEP(A, C, c);
            if (c + 1 < NCH) PBL_STEP(B, A, c + 1);
            if (c + 2 < NCH) PBL_STEP(C, B, c + 2);
        }
#undef PBL_STEP
#undef PBL_PTR
        __syncthreads();
    }
}
__device__ __forceinline__ void peer_res_phase(Frame& F, int l, bf16* XO) {
    PHASE_TID(F);
    const bool last = (l == 1);
    const int gw = F.vcu * NWAVES + F.wave, NGW = F.G * NWAVES, lane = F.lane;
    const bf16* XA = WSP(bf16, WS_XA); const bf16* OUTS = WSP(bf16, WS_GC); bf16* Hb = WSP(bf16, WS_H); const float* MOD = WSP(float, WS_MOD);
    for (int t = gw; t < T; t += NGW) {
        const int b = t >> 13; const float* g2 = MOD + (size_t)(l * 2 + b) * 12288 + 5 * 2048;
        f32x4 v[8], gq[8]; v2u oq[8], xq[8]; float ss = 0.f;
#pragma unroll
        for (int jj = 0; jj < 8; ++jj) { const int col = 4 * lane + 256 * jj; xq[jj] = *(const v2u*)(XA + (size_t)t * D + col); gq[jj] = *(const f32x4*)(g2 + col); oq[jj] = *(const v2u*)(OUTS + (size_t)t * D + col); }
        __builtin_amdgcn_sched_barrier(0);
#pragma unroll
        for (int jj = 0; jj < 8; ++jj) { const f32x4 o = {bflo(oq[jj].x), bfhi(oq[jj].x), bflo(oq[jj].y), bfhi(oq[jj].y)}; v[jj] = (f32x4){bflo(xq[jj].x), bfhi(xq[jj].x), bflo(xq[jj].y), bfhi(xq[jj].y)};
            v[jj] = v[jj] + gq[jj] * o; ss += (v[jj].x * v[jj].x + v[jj].y * v[jj].y) + (v[jj].z * v[jj].z + v[jj].w * v[jj].w); }
        const float rstd = 1.0f / sqrtf(wave_sum(ss) * (1.0f / D) + EPS);
        if (!last) {
            const float* ng = F.A->in[I_N1G] + (size_t)(l + 1) * D; const float* mn = MOD + (size_t)((l + 1) * 2 + b) * 12288;
#pragma unroll
            for (int jj = 0; jj < 8; ++jj) gq[jj] = *(const f32x4*)(ng + 4 * lane + 256 * jj);
            f32x4 shq[8], scq[8];
#pragma unroll
            for (int jj = 0; jj < 8; ++jj) { scq[jj] = *(const f32x4*)(mn + 2048 + 4 * lane + 256 * jj); shq[jj] = *(const f32x4*)(mn + 4 * lane + 256 * jj); }
            __builtin_amdgcn_sched_barrier(0);
#pragma unroll
            for (int jj = 0; jj < 8; ++jj) gq[jj] = gq[jj] * (scq[jj] + 1.0f);
#pragma unroll
            for (int jj = 0; jj < 8; ++jj) { const int col = 4 * lane + 256 * jj; v2u w; w.x = pk2(v[jj].x, v[jj].y); w.y = pk2(v[jj].z, v[jj].w); *(v2u*)(XO + (size_t)t * D + col) = w; v[jj] = v[jj] * rstd * gq[jj] + shq[jj]; }
            row_to_fp8(v, (unsigned char*)Hb + (size_t)t * D, WSP(float, WS_SA) + t, lane);
        } else {
            const float* fg = F.A->in[I_FG];
#pragma unroll
            for (int jj = 0; jj < 8; ++jj) gq[jj] = *(const f32x4*)(fg + 4 * lane + 256 * jj);
            __builtin_amdgcn_sched_barrier(0);
#pragma unroll
            for (int jj = 0; jj < 8; ++jj) *(f32x4*)(F.out + (size_t)t * D + 4 * lane + 256 * jj) = v[jj] * rstd * gq[jj];
        }
    }
}

#ifndef MK_ONE_LAUNCH
#define MK_ONE_LAUNCH 1
#endif
#define PG8_ALIGN true
#define PG8_SP2 true
constexpr int PH_PER_LAYER = 13, N_PHASES = 1 + 2 * PH_PER_LAYER;
__global__ void __launch_bounds__(NTHR, 2) fwd(Args args) {
    extern __shared__ __attribute__((aligned(16))) unsigned char lds[];
    Frame F;
    F.lds = (LAS unsigned char*)lds; F.MISC = (volatile LAS unsigned*)(F.lds + MISC_OFF);
    F.tid = threadIdx.x; F.lane = F.tid & 63; F.wave = __builtin_amdgcn_readfirstlane(F.tid >> 6);
    F.G = gridDim.x; { const int bx = blockIdx.x; F.vcu = (F.G % 8 == 0) ? (bx % 8) * (F.G / 8) + bx / 8 : bx; }
    F.A = &args;
    F.out = args.out; F.ws = args.ws; F.ctl = (gu32*)(args.ws + WS_CTL);
    for (int u = F.tid; u < (LDS_BYTES - LDSCTL_OFF) / 4; u += NTHR) ((LAS unsigned*)(F.lds + LDSCTL_OFF))[u] = 0u;
    __syncthreads();
#if MK_ONE_LAUNCH
    XcdBarrier bar = xcd_barrier_post((unsigned*)(F.ctl + CW_BAR), F.MISC + 8);
#define GRID_BAR() xcd_barrier(bar)
#else
#define GRID_BAR() do { } while (0)
#endif
    const int lo = args.ph_lo, hi = args.ph_hi;
#define IN(k) (lo <= (k) && (k) < hi)
#define SEAM(k) do { if (IN(k) && IN((k) + 1)) GRID_BAR(); } while (0)
    float* MOD = WSP(float, WS_MOD);
    pg8::bf16_t* Hb = WSP(pg8::bf16_t, WS_H);

    if (IN(0)) { p0_prologue(F); SEAM(0); }
    for (int l = 0; l < 2; ++l) {
        const int pb = 1 + PH_PER_LAYER * l;
        const float* modl = MOD + (size_t)l * 2 * 12288;
        if (IN(pb + 0) && l == 0) { norm_phase<true, false>(F, F.A->in[I_X], WSP(bf16, WS_H), F.A->in[I_N1G], modl, 0, 1);
            win8_phase(F);
            SEAM(pb + 0); }
        if (IN(pb + 1)) {
            pg8::Gemm g{Hb, (const pg8::bf16_t*)(WSP(unsigned char, WS_WIN) + (size_t)l * IN_DIM * 2048), T, IN_DIM, D / 2, D / 2, D / 2}; pg8::StaticOrder S; S.init(T, IN_DIM, F.G, (int)blockIdx.x);
            const float wmax = __uint_as_float(__hip_atomic_load(F.ctl + CW_WMAX + l, __ATOMIC_RELAXED, __HIP_MEMORY_SCOPE_AGENT));
            pg8::EpiInProj E{WSP(pg8::bf16_t, WS_U), WSP(pg8::bf16_t, WS_Q), WSP(pg8::bf16_t, WS_K), WSP(pg8::bf16_t, WS_V), WSP(pg8::bf16_t, WS_GC), WSP(pg8::bf16_t, WS_GA), WSP(float, WS_SA), wmax > 0.f ? wmax * (1.0f / 440.0f) : 1.0f, (unsigned*)(F.ctl + CW_VMAX + 2 * l)};
            pg8::gemm_phase<pg8::EpiInProj, pg8::StaticOrder, PG8_ALIGN, PG8_SP2, true>(F.lds, g, S, E);
            SEAM(pb + 1);
        }
        if (IN(pb + 2)) { conv_phase(F, l); __syncthreads(); attn_phase(F, l); SEAM(pb + 2); }
        if (IN(pb + 3)) {
            pg8::Gemm g{WSP(pg8::bf16_t, WS_AM), (const pg8::bf16_t*)(WSP(unsigned char, WS_WM) + (size_t)l * 2048 * 2048), T, D, D / 2, D / 2, D / 2}; pg8::StaticOrder S; S.init(T, D, F.G, (int)blockIdx.x);
            const float i440 = 1.0f / 440.0f;
            const float wc_ = __uint_as_float(__hip_atomic_load(F.ctl + CW_WMAX2 + 2 * l, __ATOMIC_RELAXED, __HIP_MEMORY_SCOPE_AGENT)), wa_ = __uint_as_float(__hip_atomic_load(F.ctl + CW_WMAX2 + 2 * l + 1, __ATOMIC_RELAXED, __HIP_MEMORY_SCOPE_AGENT));
            const float bc_ = __uint_as_float(__hip_atomic_load(F.ctl + CW_BC + l, __ATOMIC_RELAXED, __HIP_MEMORY_SCOPE_AGENT));
            const float swc = wc_ > 0.f ? wc_ * i440 : 1.0f, swa = wa_ > 0.f ? wa_ * i440 : 1.0f, sc = bc_ * i440;
            const float vm0 = __uint_as_float(__hip_atomic_load(F.ctl + CW_VMAX + 2 * l, __ATOMIC_RELAXED, __HIP_MEMORY_SCOPE_AGENT)), vm1 = __uint_as_float(__hip_atomic_load(F.ctl + CW_VMAX + 2 * l + 1, __ATOMIC_RELAXED, __HIP_MEMORY_SCOPE_AGENT));
            const float fe0 = (vm0 > 0.f ? 1.02f * vm0 * i440 : 1.0f) * swa, fe1 = (vm1 > 0.f ? 1.02f * vm1 * i440 : 1.0f) * swa;
            const float bc2 = __uint_as_float(__hip_atomic_load(F.ctl + CW_BC2 + l, __ATOMIC_RELAXED, __HIP_MEMORY_SCOPE_AGENT));
            const float bm0 = fmaxf(1024.0f * (bc2 * wc_ + 1.02f * vm0 * wa_), 1e-20f), bm1 = fmaxf(1024.0f * (bc2 * wc_ + 1.02f * vm1 * wa_), 1e-20f);
            pg8::EpiMerge E{WSP(pg8::bf16_t, WS_GC), WSP(pg8::bf16_t, WS_GA), WSP(unsigned char, WS_H), (sc * swc) / fe0, (sc * swc) / fe1, fe0 * (440.0f / bm0), fe1 * (440.0f / bm1)};
            pg8::gemm_phase<pg8::EpiMerge, pg8::StaticOrder, PG8_ALIGN, PG8_SP2, true>(F.lds, g, S, E);
            SEAM(pb + 3);
        }
        if (IN(pb + 5)) {
            pg8::Gemm g{Hb, (const pg8::bf16_t*)(WSP(unsigned char, WS_WO) + (size_t)l * 2048 * 2048), T, D, D / 2, D / 2, D / 2}; pg8::StaticOrder S; S.init(T, D, F.G, (int)blockIdx.x);
            const float i440 = 1.0f / 440.0f;
            const float wc_ = __uint_as_float(__hip_atomic_load(F.ctl + CW_WMAX2 + 2 * l, __ATOMIC_RELAXED, __HIP_MEMORY_SCOPE_AGENT)), wa_ = __uint_as_float(__hip_atomic_load(F.ctl + CW_WMAX2 + 2 * l + 1, __ATOMIC_RELAXED, __HIP_MEMORY_SCOPE_AGENT));
            const float wo_ = __uint_as_float(__hip_atomic_load(F.ctl + CW_WMAX3 + l, __ATOMIC_RELAXED, __HIP_MEMORY_SCOPE_AGENT)), swo = wo_ > 0.f ? wo_ * i440 : 1.0f;
            const float bc2 = __uint_as_float(__hip_atomic_load(F.ctl + CW_BC2 + l, __ATOMIC_RELAXED, __HIP_MEMORY_SCOPE_AGENT));
            const float vm0 = __uint_as_float(__hip_atomic_load(F.ctl + CW_VMAX + 2 * l, __ATOMIC_RELAXED, __HIP_MEMORY_SCOPE_AGENT)), vm1 = __uint_as_float(__hip_atomic_load(F.ctl + CW_VMAX + 2 * l + 1, __ATOMIC_RELAXED, __HIP_MEMORY_SCOPE_AGENT));
            const float bm0 = fmaxf(1024.0f * (bc2 * wc_ + 1.02f * vm0 * wa_), 1e-20f), bm1 = fmaxf(1024.0f * (bc2 * wc_ + 1.02f * vm1 * wa_), 1e-20f);
            if (l == 0) { pg8::EpiResid<false> E{F.A->in[I_X], WSP(pg8::bf16_t, WS_XA), modl + 2 * 2048, bm0 * i440 * swo, bm1 * i440 * swo};
                pg8::gemm_phase<pg8::EpiResid<false>, pg8::StaticOrder, PG8_ALIGN, PG8_SP2, true>(F.lds, g, S, E); }
            else { pg8::EpiResid<true> E{WSP(pg8::bf16_t, WS_XA), WSP(pg8::bf16_t, WS_XA), modl + 2 * 2048, bm0 * i440 * swo, bm1 * i440 * swo};
                pg8::gemm_phase<pg8::EpiResid<true>, pg8::StaticOrder, PG8_ALIGN, PG8_SP2, true>(F.lds, g, S, E); }
            SEAM(pb + 5);
        }
        if (IN(pb + 6)) { norm_phase<false, true>(F, WSP(bf16, WS_XA), WSP(bf16, WS_H), F.A->in[I_N2G] + (size_t)l * D, modl, 3, 4); SEAM(pb + 6); }
        if (IN(pb + 7)) {
            pg8::Gemm g{Hb, WSP(pg8::bf16_t, WS_WP) + (size_t)l * 2048 * 2048, T, D, D, D, D}; pg8::StaticOrder S; S.init(T, D, F.G, (int)blockIdx.x);
            pg8::EpiF16 E{WSP(_Float16, WS_GC), D};
            pg8::gemm_phase<pg8::EpiF16, pg8::StaticOrder, PG8_ALIGN, PG8_SP2>(F.lds, g, S, E);
            SEAM(pb + 7);
        }
        if (IN(pb + 8)) { topk_phase(F); SEAM(pb + 8); }
        if (IN(pb + 9)) { peer_act_phase(F, l); SEAM(pb + 9); }
        if (IN(pb + 10)) { peer_w_phase(F, l); SEAM(pb + 10); }
        if (IN(pb + 11)) { peer_out_phase(F, l); SEAM(pb + 11); }
        if (IN(pb + 12)) { peer_res_phase(F, l, WSP(bf16, WS_XA)); SEAM(pb + 12); }
    }
#undef IN
#undef SEAM
}

extern "C" void kernel_launch(void* const* d_in, const int* in_sizes, int n_in, void* d_out, int out_size, void* d_ws, size_t ws_size, hipStream_t stream) {
    static int grid = 0;
    if (grid == 0) {
        if (n_in != N_IN || out_size != T * D || ws_size < WS_END) { fprintf(stderr, "kernel_launch: unexpected problem: n_in %d out %d ws %zu (need %zu)\n", n_in, out_size, ws_size, (size_t)WS_END); grid = -1; return; }
        int dev = 0, cus = 0, per_cu = 0;
        if (hipGetDevice(&dev) != hipSuccess || hipDeviceGetAttribute(&cus, hipDeviceAttributeMultiprocessorCount, dev) != hipSuccess) { grid = -1; return; }
        if (hipFuncSetAttribute((const void*)fwd, hipFuncAttributeMaxDynamicSharedMemorySize, LDS_BYTES) != hipSuccess) { fprintf(stderr, "kernel_launch: hipFuncSetAttribute failed\n"); grid = -1; return; }
        if (hipOccupancyMaxActiveBlocksPerMultiprocessor(&per_cu, (const void*)fwd, NTHR, LDS_BYTES) != hipSuccess || per_cu < 1) fprintf(stderr, "kernel_launch: occupancy query reports %d\n", per_cu);
        (void)hipGetLastError();
        grid = cus;
    }
    if (grid < 0) return;
    (void)in_sizes;
    if (hipMemsetAsync((char*)d_ws + WS_CTL, 0, CTL_ZERO_BYTES, stream) != hipSuccess) return;
    Args a{};
    for (int i = 0; i < N_IN; ++i) a.in[i] = (const float*)d_in[i];
    a.out = (float*)d_out; a.ws = (unsigned char*)d_ws;
#if MK_ONE_LAUNCH
    a.ph_lo = 0; a.ph_hi = N_PHASES;
    hipLaunchKernelGGL(fwd, dim3(grid), dim3(NTHR), LDS_BYTES, stream, a);
#else
    for (int p = 0; p < N_PHASES; ++p) {
        if (p == 1 + PH_PER_LAYER) continue;
        a.ph_lo = p; a.ph_hi = p + 1;
        hipLaunchKernelGGL(fwd, dim3(grid), dim3(NTHR), LDS_BYTES, stream, a);
    }
#endif
}
```
